# Optimizing an MI355X kernel written in HIP

```python
import jax, jax.numpy as jnp
from jax import lax
import numpy as np

D_MODEL = 1024
BATCH = 8
SEQ = 4096
DEPTH = 1
DEC_BATCH = 8
DEC_SEQ = 16
PAST_LEN = 1024

CHUNK = 64
N_META = 16
HEAD_DIM = 64
N_Q_HEADS = 16
N_KV_HEADS = 2
GQA_GROUP = N_Q_HEADS // N_KV_HEADS
WINDOW = 128
WIN_CHUNKS = WINDOW // CHUNK
ROPE_THETA = 10000.0
POOL_WINDOWS = (2, 4, 8, 16)
N_POOL_GROUPS = 4
POOL_WIDTH = D_MODEL // 2
POOL_GROUP_W = POOL_WIDTH // N_POOL_GROUPS
POOL_HIST = max(POOL_WINDOWS) - 1
Q_W = N_Q_HEADS * HEAD_DIM
KV_W = N_KV_HEADS * HEAD_DIM
GATE_W = 2 * D_MODEL
IN_W = Q_W + 2 * KV_W + POOL_WIDTH + GATE_W
D_FF = ((8 * D_MODEL // 3) + 127) // 128 * 128
CONV_W = 3
RMS_EPS = 1e-6

kernel_name = "hybrid_swa_pool_convffn_stream_step"


def rmsnorm(x, g):
    xf = x.astype(jnp.float32)
    r = lax.rsqrt(jnp.mean(xf * xf, axis=-1, keepdims=True) + RMS_EPS)
    return (xf * r).astype(x.dtype) * g


def rope(x, pos):
    half = HEAD_DIM // 2
    inv = ROPE_THETA ** (-jnp.arange(half, dtype=jnp.float32) / half)
    ang = pos.astype(jnp.float32)[:, None] * inv[None, :]
    cos = jnp.cos(ang)[None, :, None, :]
    sin = jnp.sin(ang)[None, :, None, :]
    xf = x.astype(jnp.float32)
    x1, x2 = xf[..., :half], xf[..., half:]
    return jnp.concatenate([x1 * cos - x2 * sin, x2 * cos + x1 * sin], axis=-1).astype(x.dtype)


def attend(q, k, v, sinks, mask):
    s = jnp.einsum('...qngd,...snd->...ngqs', q, k).astype(jnp.float32) * (HEAD_DIM ** -0.5)
    if mask is not None:
        s = jnp.where(mask, s, -1e30)
    sink = jnp.broadcast_to(sinks.astype(jnp.float32)[..., None, None], s.shape[:-1] + (1,))
    p = jax.nn.softmax(jnp.concatenate([s, sink], axis=-1), axis=-1)[..., :-1]
    return jnp.einsum('...ngqs,...snd->...qngd', p.astype(v.dtype), v)


def project_inputs(h, w_in, b_gate):
    z = h @ w_in
    q = z[..., :Q_W]
    k = z[..., Q_W:Q_W + KV_W]
    v = z[..., Q_W + KV_W:Q_W + 2 * KV_W]
    p = z[..., Q_W + 2 * KV_W:Q_W + 2 * KV_W + POOL_WIDTH]
    g = jax.nn.sigmoid((z[..., Q_W + 2 * KV_W + POOL_WIDTH:] + b_gate).astype(jnp.float32)).astype(h.dtype)
    return q, k, v, p, g[..., :D_MODEL], g[..., D_MODEL:]


def multiscale_pool(p, pos):
    bsz, s = p.shape[0], p.shape[1]
    pg = p.reshape(bsz, s, N_POOL_GROUPS, POOL_GROUP_W).astype(jnp.float32)
    cs = jnp.cumsum(pg, axis=1)
    cs0 = jnp.concatenate([jnp.zeros_like(cs[:, :1]), cs], axis=1)
    outs = []
    for gi, w in enumerate(POOL_WINDOWS):
        c = cs0[:, :, gi]
        prev = jnp.concatenate([jnp.zeros_like(c[:, :w - 1]), c[:, :s - w + 1]], axis=1)
        cnt = jnp.minimum(w, pos + 1).astype(jnp.float32)[None, :, None]
        outs.append((c[:, 1:] - prev) / cnt - pg[:, :, gi])
    return jnp.stack(outs, axis=2)


def mixer_residual(x, o_attn, pm, g_attn, g_pool, w_attn_o, w_pool_grp, pool_scale, w_pool_o, w_out):
    bsz, s = pm.shape[0], pm.shape[1]
    pool = jnp.einsum('bsgc,gcd->bsgd', pm.astype(x.dtype), w_pool_grp).reshape(bsz, s, POOL_WIDTH) * pool_scale
    mix = g_attn * (o_attn @ w_attn_o) + g_pool * (pool @ w_pool_o)
    return x + mix @ w_out


def channel_mixer(x1, conv_prefix, g_norm_ffn, w_up, conv_w, conv_b, w_down):
    up = rmsnorm(x1, g_norm_ffn) @ w_up
    up_ext = jnp.concatenate([conv_prefix, up], axis=1)
    t = up.shape[1]
    c = conv_b + up_ext[:, 0:t] * conv_w[0]
    for j in range(1, CONV_W):
        c = c + up_ext[:, j:j + t] * conv_w[j]
    gate, val = c[..., :D_FF], c[..., D_FF:]
    return x1 + (jax.nn.silu(gate) * val) @ w_down, up_ext[:, -(CONV_W - 1):]


def setup_inputs(seed: int = 0) -> dict:
    key = jax.random.key(seed)
    ks = jax.random.split(key, 24)
    n = jax.random.normal
    f32 = jnp.float32
    return {
        "x_prompt": n(ks[0], (BATCH, SEQ, D_MODEL), f32),
        "x_sample": n(ks[1], (DEC_BATCH, DEC_SEQ, D_MODEL), f32),
        "cache_swa_k": n(ks[2], (DEC_BATCH, WINDOW, N_KV_HEADS, HEAD_DIM), f32),
        "cache_swa_v": n(ks[3], (DEC_BATCH, WINDOW, N_KV_HEADS, HEAD_DIM), f32),
        "cache_meta_k": n(ks[4], (DEC_BATCH, N_META, N_KV_HEADS, HEAD_DIM), f32),
        "cache_meta_v": n(ks[5], (DEC_BATCH, N_META, N_KV_HEADS, HEAD_DIM), f32),
        "state_pool": n(ks[6], (DEC_BATCH, POOL_HIST, POOL_WIDTH), f32),
        "state_conv": n(ks[7], (DEC_BATCH, CONV_W - 1, 2 * D_FF), f32),
        "meta_tokens": n(ks[8], (N_META, D_MODEL), f32),
        "g_norm_mix": 1.0 + 0.05 * n(ks[9], (D_MODEL,), f32),
        "w_in": n(ks[10], (D_MODEL, IN_W), f32) * D_MODEL ** -0.5,
        "b_gate": 0.01 * n(ks[11], (GATE_W,), f32),
        "sinks": 0.5 * n(ks[12], (N_Q_HEADS,), f32),
        "w_attn_o": n(ks[13], (Q_W, D_MODEL), f32) * Q_W ** -0.5,
        "w_pool_grp": n(ks[14], (N_POOL_GROUPS, POOL_GROUP_W, POOL_GROUP_W), f32) * POOL_GROUP_W ** -0.5,
        "pool_scale": 1.0 + 0.1 * n(ks[15], (POOL_WIDTH,), f32),
        "w_pool_o": n(ks[16], (POOL_WIDTH, D_MODEL), f32) * POOL_WIDTH ** -0.5,
        "w_out": n(ks[17], (D_MODEL, D_MODEL), f32) * D_MODEL ** -0.5,
        "g_norm_ffn": 1.0 + 0.05 * n(ks[18], (D_MODEL,), f32),
        "w_up": n(ks[19], (D_MODEL, 2 * D_FF), f32) * D_MODEL ** -0.5,
        "conv_w": n(ks[20], (CONV_W, 2 * D_FF), f32) * CONV_W ** -0.5,
        "conv_b": 0.01 * n(ks[21], (2 * D_FF,), f32),
        "w_down": n(ks[22], (D_FF, D_MODEL), f32) * D_FF ** -0.5,
        "g_norm_final": 1.0 + 0.05 * n(ks[23], (D_MODEL,), f32),
    }


def reference(x_prompt, x_sample, cache_swa_k, cache_swa_v, cache_meta_k, cache_meta_v, state_pool, state_conv,
              meta_tokens, g_norm_mix, w_in, b_gate, sinks, w_attn_o, w_pool_grp, pool_scale, w_pool_o, w_out,
              g_norm_ffn, w_up, conv_w, conv_b, w_down, g_norm_final):
    dt = x_prompt.dtype
    sinks_r = sinks.reshape(N_KV_HEADS, GQA_GROUP)

    bsz, seq = x_prompt.shape[0], x_prompt.shape[1]
    length = N_META + seq
    nc = seq // CHUNK
    x = jnp.concatenate([jnp.broadcast_to(meta_tokens.astype(dt)[None], (bsz, N_META, D_MODEL)), x_prompt], axis=1)
    pos = jnp.arange(length, dtype=jnp.int32)
    h = rmsnorm(x, g_norm_mix)
    q, k, v, p, g_attn, g_pool = project_inputs(h, w_in, b_gate)
    q = rope(q.reshape(bsz, length, N_Q_HEADS, HEAD_DIM), pos).reshape(bsz, length, N_KV_HEADS, GQA_GROUP, HEAD_DIM)
    k = rope(k.reshape(bsz, length, N_KV_HEADS, HEAD_DIM), pos)
    v = v.reshape(bsz, length, N_KV_HEADS, HEAD_DIM)
    km, vm = k[:, :N_META], v[:, :N_META]
    o_meta = attend(q[:, :N_META], km, vm, sinks_r, None)
    qr = q[:, N_META:].reshape(bsz, nc, CHUNK, N_KV_HEADS, GQA_GROUP, HEAD_DIM)

    def band(t):
        tc = t.reshape(bsz, nc, CHUNK, N_KV_HEADS, HEAD_DIM)
        tp = jnp.pad(tc, ((0, 0), (WIN_CHUNKS, 0), (0, 0), (0, 0), (0, 0)))
        return jnp.concatenate([tp[:, j:j + nc] for j in range(WIN_CHUNKS + 1)], axis=2)

    meta_b = lambda t: jnp.broadcast_to(t[:, None], (bsz, nc, N_META, N_KV_HEADS, HEAD_DIM))
    kb = jnp.concatenate([meta_b(km), band(k[:, N_META:])], axis=2)
    vb = jnp.concatenate([meta_b(vm), band(v[:, N_META:])], axis=2)
    cidx = jnp.arange(nc)[:, None]
    jidx = jnp.arange((WIN_CHUNKS + 1) * CHUNK)[None, :]
    band_ok = (cidx - WIN_CHUNKS + jidx // CHUNK) >= 0
    mask = jnp.concatenate([jnp.ones((nc, N_META), dtype=bool), band_ok], axis=1)[:, None, None, None, :]
    o_real = attend(qr, kb, vb, sinks_r, mask)
    o_attn = jnp.concatenate([o_meta.reshape(bsz, N_META, Q_W), o_real.reshape(bsz, seq, Q_W)], axis=1)
    pm = multiscale_pool(p, pos)
    x1 = mixer_residual(x, o_attn, pm, g_attn, g_pool, w_attn_o, w_pool_grp, pool_scale, w_pool_o, w_out)
    conv_prefix = jnp.zeros((bsz, CONV_W - 1, 2 * D_FF), dtype=dt)
    x2, p_conv = channel_mixer(x1, conv_prefix, g_norm_ffn, w_up, conv_w, conv_b, w_down)
    y_prompt = rmsnorm(x2, g_norm_final)[:, N_META:]
    p_swa_k = k[:, -WINDOW:]
    p_swa_v = v[:, -WINDOW:]
    p_pool = p[:, -POOL_HIST:]

    dbsz, t = x_sample.shape[0], x_sample.shape[1]
    pos_s = N_META + PAST_LEN + jnp.arange(t, dtype=jnp.int32)
    hs = rmsnorm(x_sample, g_norm_mix)
    qs, ks_, vs, ps, ga_s, gp_s = project_inputs(hs, w_in, b_gate)
    qs = rope(qs.reshape(dbsz, t, N_Q_HEADS, HEAD_DIM), pos_s).reshape(dbsz, t, N_KV_HEADS, GQA_GROUP, HEAD_DIM)
    ks_ = rope(ks_.reshape(dbsz, t, N_KV_HEADS, HEAD_DIM), pos_s)
    vs = vs.reshape(dbsz, t, N_KV_HEADS, HEAD_DIM)
    k_all = jnp.concatenate([cache_meta_k, cache_swa_k, ks_], axis=1)
    v_all = jnp.concatenate([cache_meta_v, cache_swa_v, vs], axis=1)
    o_s = attend(qs, k_all, v_all, sinks_r, None).reshape(dbsz, t, Q_W)
    p_ext = jnp.concatenate([state_pool, ps], axis=1)
    pos_ext = N_META + PAST_LEN - POOL_HIST + jnp.arange(POOL_HIST + t, dtype=jnp.int32)
    pm_s = multiscale_pool(p_ext, pos_ext)[:, POOL_HIST:]
    x1s = mixer_residual(x_sample, o_s, pm_s, ga_s, gp_s, w_attn_o, w_pool_grp, pool_scale, w_pool_o, w_out)
    x2s, s_conv = channel_mixer(x1s, state_conv, g_norm_ffn, w_up, conv_w, conv_b, w_down)
    y_sample = rmsnorm(x2s, g_norm_final)
    s_pool = p_ext[:, -POOL_HIST:]

    return (y_prompt, y_sample, p_swa_k, p_swa_v, km, vm, p_pool, p_conv, ks_, vs, s_pool, s_conv)
```

```cpp
#include <hip/hip_runtime.h>
#include <hip/hip_cooperative_groups.h>
#include <cstdio>
#include <cstdint>
#include <cmath>
namespace cg = cooperative_groups;
namespace pg8 {
#define PG8_LAS __attribute__((address_space(3)))
typedef unsigned short bf16_t;
typedef short bf16x8 __attribute__((ext_vector_type(8)));
typedef float f32x4 __attribute__((ext_vector_type(4)));
typedef unsigned u32x4 __attribute__((ext_vector_type(4)));
constexpr int BM = 256, BK = 64, HALF = 128, HTB = HALF * BK * 2  , STAGE_BYTES = 8 * HTB, NXCD = 8, WGM = 8;

__host__ __device__ __forceinline__ int lds_byte(int r, int c) { const int st = (r >> 4) * 2 + (c >> 5), rr = r & 15, cc = c & 31, ob = rr * 64 + cc * 2; return st * 1024 + (ob ^ (((ob >> 9) & 1) << 5)); }
__host__ __device__ __forceinline__ void stage_rc(int b, int& R, int& C) { const int st = b / 1024, sb = b % 1024, swz = sb ^ (((sb >> 9) & 1) << 5); R = (st >> 1) * 16 + swz / 64; C = (st & 1) * 32 + (swz % 64) / 2; }
__host__ __device__ __forceinline__ int perm32(int rho) { const int n = rho >> 4, i = rho & 15; return 8 * (i >> 2) + 4 * n + (i & 3); }

struct Unit { int pm, pn; };
struct Gemm { const bf16_t* A; const bf16_t* Bt; int M, N, K; };

struct StaticOrder {
    int nM, nN, nwg, G, c, rev;
    __host__ __device__ void init(int M, int N, int G_, int c_, int rev_ = 0) { nM = M / BM; nN = N / BM; nwg = nM * nN; G = G_; c = c_; rev = rev_; }
    __host__ __device__ bool next(int i, Unit& u) const {
        const int nr = (nwg + G - 1) / G;
        if (i >= nr) return false;
        const long L = (long)((rev && nwg % G == 0) ? nr - 1 - i : i) * G + c; if (L >= nwg) return false;
        int wgid = (int)L; { const int q = nwg / NXCD, r = nwg % NXCD, xcd = wgid % NXCD, off = wgid / NXCD; wgid = (xcd < r ? xcd * (q + 1) : r * (q + 1) + (xcd - r) * q) + off; }
        const int nig = WGM * nN, gid = wgid / nig, fm = gid * WGM, gsz = (nM - fm) < WGM ? (nM - fm) : WGM;
        u.pm = fm + ((wgid % nig) % gsz); u.pn = (wgid % nig) / gsz; return true;
    }
    __device__ __forceinline__ void a_ready(const Unit&) const {}
    __device__ __forceinline__ void done(const Unit&) const {}
};

__device__ __forceinline__ unsigned cvt_pk_bf16(float lo, float hi) { unsigned r; asm volatile("v_cvt_pk_bf16_f32 %0, %1, %2" : "=v"(r) : "v"(lo), "v"(hi)); return r; }
template <class Epi, class Sched, bool ALIGN_EPI = false, bool SP2 = false>
__device__ __forceinline__ void gemm_phase(PG8_LAS unsigned char* lds, const Gemm g, const Sched& S, const Epi& E) {
    const int tid = threadIdx.x, wid = __builtin_amdgcn_readfirstlane(tid >> 6), lane = tid & 63, wr = wid >> 2, wc = wid & 3, fr = lane & 15, fq = lane >> 4;
    const int K = g.K, nt = K / BK;
    unsigned voffA[2], voffB[2];
#pragma unroll
    for (int i = 0; i < 2; ++i) { int R, C; stage_rc(tid * 16 + i * 8192, R, C); const int Rb = Epi::PERM ? ((R & ~31) + perm32(R & 31)) : R;
        voffA[i] = (unsigned)(R * K + C) * 2u; voffB[i] = (unsigned)(Rb * K + C) * 2u; }
    const size_t kstep = (size_t)(BK * 2);
    const size_t hstep = (size_t)HALF * K * 2;
    const size_t tstep = 2 * hstep;
    const unsigned ldsw = (unsigned)wid * 1024u;
    const int aoff = lds_byte(wr * 64 + fr, fq * 8), boff = lds_byte(wc * 32 + fr, fq * 8);
#define PG8_SA(b, h) (((b) * 2 + (h)) * HTB)
#define PG8_SB(b, h) ((4 + (b) * 2 + (h)) * HTB)
#define PG8_STAGE(bufoff, gbase, voff) do { _Pragma("unroll") for (int _i = 0; _i < 2; ++_i) \
        __builtin_amdgcn_global_load_lds((const unsigned*)((const char*)(gbase) + (voff)[_i]), (PG8_LAS unsigned*)(lds + (bufoff) + ldsw + _i * 8192), 16, 0, 0); } while (0)
#define PG8_LDA(dst, b, h) do { _Pragma("unroll") for (int m = 0; m < 4; ++m) _Pragma("unroll") for (int k = 0; k < 2; ++k) dst[m][k] = *(const PG8_LAS bf16x8*)(lds + PG8_SA(b, h) + aoff + m * 2048 + k * 1024); } while (0)
#define PG8_LDB(dst, b, h) do { _Pragma("unroll") for (int n = 0; n < 2; ++n) _Pragma("unroll") for (int k = 0; k < 2; ++k) dst[n][k] = *(const PG8_LAS bf16x8*)(lds + PG8_SB(b, h) + boff + n * 2048 + k * 1024); } while (0)
#define PG8_MMA(ai, bj, At, Bt) do { __builtin_amdgcn_s_setprio(1); _Pragma("unroll") for (int m = 0; m < 4; ++m) _Pragma("unroll") for (int n = 0; n < 2; ++n) _Pragma("unroll") for (int k = 0; k < 2; ++k) \
        acc[ai][bj][m][n] = __builtin_amdgcn_mfma_f32_16x16x32_bf16(Bt[n][k], At[m][k], acc[ai][bj][m][n], 0, 0, 0); __builtin_amdgcn_s_setprio(0); } while (0)
#define PG8_WAIT_V(n) asm volatile("s_waitcnt vmcnt(" #n ")" ::: "memory")
#define PG8_WAIT_L(n) asm volatile("s_waitcnt lgkmcnt(" #n ")" ::: "memory")
#define PG8_BAR __builtin_amdgcn_s_barrier()
#define PG8_SCHED __builtin_amdgcn_sched_barrier(0)
    Unit cur, nxt; int ui = 0;
    if (!S.next(0, cur)) return;
    f32x4 acc[2][2][4][2];
#pragma unroll
    for (int a = 0; a < 2; ++a)
#pragma unroll
        for (int b = 0; b < 2; ++b)
#pragma unroll
            for (int m = 0; m < 4; ++m)
#pragma unroll
                for (int n = 0; n < 2; ++n) acc[a][b][m][n] = (f32x4){0.f, 0.f, 0.f, 0.f};
    bf16x8 At[4][2], B0[2][2], B1[2][2];
    const char* cA = (const char*)g.A + (size_t)cur.pm * tstep; const char* cB = (const char*)g.Bt + (size_t)cur.pn * tstep;
    S.a_ready(cur);
    if constexpr (SP2) {
        PG8_STAGE(PG8_SB(0, 0), cB, voffB); PG8_STAGE(PG8_SB(0, 1), cB + hstep, voffB); PG8_STAGE(PG8_SA(0, 0), cA, voffA); PG8_STAGE(PG8_SA(0, 1), cA + hstep, voffA);
        if (wr == 1) PG8_BAR;
        PG8_WAIT_V(2); PG8_BAR;
        PG8_STAGE(PG8_SB(1, 0), cB + kstep, voffB); PG8_STAGE(PG8_SA(1, 0), cA + kstep, voffA); PG8_STAGE(PG8_SB(1, 1), cB + hstep + kstep, voffB);
        PG8_WAIT_V(6); PG8_BAR;
    } else {
        PG8_STAGE(PG8_SB(0, 0), cB, voffB); PG8_STAGE(PG8_SA(0, 0), cA, voffA); PG8_STAGE(PG8_SB(0, 1), cB + hstep, voffB); PG8_STAGE(PG8_SA(0, 1), cA + hstep, voffA);
        if (wr == 1) PG8_BAR;
        PG8_WAIT_V(4); PG8_BAR;
        PG8_STAGE(PG8_SB(1, 0), cB + kstep, voffB); PG8_STAGE(PG8_SA(1, 0), cA + kstep, voffA); PG8_STAGE(PG8_SB(1, 1), cB + hstep + kstep, voffB);
        PG8_WAIT_V(6); PG8_BAR;
    }
    for (;;) {
        const bool has_next = S.next(ui + 1, nxt);
        const char* nA = has_next ? (const char*)g.A + (size_t)nxt.pm * tstep : cA; const char* nB = has_next ? (const char*)g.Bt + (size_t)nxt.pn * tstep : cB;
        for (int t = 0; t < nt; t += 2) {
            const bool last = (t == nt - 2);
            const char* a1 = cA + (size_t)(t + 1) * kstep;
            const char* a2 = last ? nA : cA + (size_t)(t + 2) * kstep; const char* b2 = last ? nB : cB + (size_t)(t + 2) * kstep;
            const char* a3 = a2 + kstep; const char* b3 = b2 + kstep;
            if (last && has_next) S.a_ready(nxt);
            if constexpr (SP2) {
            PG8_LDB(B0, 0, 0); PG8_LDB(B1, 0, 1); PG8_SCHED; PG8_LDA(At, 0, 0); PG8_STAGE(PG8_SA(1, 1), a1 + hstep, voffA);
            PG8_WAIT_V(8); PG8_WAIT_L(0); PG8_BAR; PG8_MMA(0, 0, At, B0); PG8_MMA(0, 1, At, B1); PG8_BAR; PG8_SCHED;
            PG8_LDA(At, 0, 1); PG8_STAGE(PG8_SB(0, 0), b2, voffB); PG8_STAGE(PG8_SB(0, 1), b2 + hstep, voffB); PG8_STAGE(PG8_SA(0, 0), a2, voffA);
            PG8_WAIT_V(8); PG8_WAIT_L(0); PG8_BAR; PG8_MMA(1, 0, At, B0); PG8_MMA(1, 1, At, B1); PG8_BAR; PG8_SCHED;
            PG8_LDB(B0, 1, 0); PG8_LDB(B1, 1, 1); PG8_SCHED; PG8_LDA(At, 1, 0); PG8_STAGE(PG8_SA(0, 1), a2 + hstep, voffA);
            PG8_WAIT_V(8); PG8_WAIT_L(0); PG8_BAR; PG8_MMA(0, 0, At, B0); PG8_MMA(0, 1, At, B1); PG8_BAR; PG8_SCHED;
            PG8_LDA(At, 1, 1); PG8_STAGE(PG8_SB(1, 0), b3, voffB); PG8_STAGE(PG8_SB(1, 1), b3 + hstep, voffB); PG8_STAGE(PG8_SA(1, 0), a3, voffA);
            PG8_WAIT_V(8); PG8_WAIT_L(0); PG8_BAR; PG8_MMA(1, 0, At, B0); PG8_MMA(1, 1, At, B1); PG8_BAR; PG8_SCHED;
            } else {
            PG8_LDB(B0, 0, 0); PG8_SCHED; PG8_LDA(At, 0, 0); PG8_STAGE(PG8_SA(1, 1), a1 + hstep, voffA);
            PG8_WAIT_L(8); PG8_BAR; PG8_WAIT_L(0); PG8_MMA(0, 0, At, B0); PG8_BAR; PG8_SCHED;
            PG8_LDB(B1, 0, 1); PG8_STAGE(PG8_SB(0, 0), b2, voffB);
            PG8_BAR; PG8_WAIT_L(0); PG8_MMA(0, 1, At, B1); PG8_BAR;
            PG8_LDA(At, 0, 1); PG8_STAGE(PG8_SA(0, 0), a2, voffA);
            PG8_BAR; PG8_WAIT_L(0); PG8_MMA(1, 0, At, B0); PG8_BAR; PG8_SCHED;
            PG8_STAGE(PG8_SB(0, 1), b2 + hstep, voffB);
            PG8_WAIT_V(6); PG8_BAR; PG8_MMA(1, 1, At, B1); PG8_BAR;
            PG8_LDB(B0, 1, 0); PG8_SCHED; PG8_LDA(At, 1, 0); PG8_STAGE(PG8_SA(0, 1), a2 + hstep, voffA);
            PG8_WAIT_L(8); PG8_BAR; PG8_WAIT_L(0); PG8_MMA(0, 0, At, B0); PG8_BAR; PG8_SCHED;
            PG8_LDB(B1, 1, 1); PG8_STAGE(PG8_SB(1, 0), b3, voffB);
            PG8_BAR; PG8_WAIT_L(0); PG8_MMA(0, 1, At, B1); PG8_BAR;
            PG8_LDA(At, 1, 1); PG8_STAGE(PG8_SA(1, 0), a3, voffA);
            PG8_BAR; PG8_WAIT_L(0); PG8_MMA(1, 0, At, B0); PG8_BAR; PG8_SCHED;
            PG8_STAGE(PG8_SB(1, 1), b3 + hstep, voffB);
            PG8_WAIT_V(6); PG8_BAR; PG8_MMA(1, 1, At, B1); PG8_BAR;
            }
        }
        if constexpr (ALIGN_EPI) { if (wr == 0) PG8_BAR; }
        if constexpr (!Epi::AFTER_DRAIN) { E(acc, cur, wr, wc, fr, fq); S.done(cur); }
        if (!has_next) break;
#pragma unroll
        for (int a = 0; a < 2; ++a)
#pragma unroll
            for (int b = 0; b < 2; ++b)
#pragma unroll
                for (int m = 0; m < 4; ++m)
#pragma unroll
                    for (int n = 0; n < 2; ++n) acc[a][b][m][n] = (f32x4){0.f, 0.f, 0.f, 0.f};
        cur = nxt; cA = nA; cB = nB; ++ui;
        if constexpr (ALIGN_EPI) { if (wr == 1) PG8_BAR; }
    }
    PG8_WAIT_V(0);
    if constexpr (!ALIGN_EPI) { if (wr == 0) PG8_BAR; }
    PG8_BAR;
    if constexpr (Epi::AFTER_DRAIN) { E.fused(acc, cur, wr, wc, fr, fq, lds, wid, lane); S.done(cur); }
#undef PG8_SA
#undef PG8_SB
#undef PG8_STAGE
#undef PG8_LDA
#undef PG8_LDB
#undef PG8_MMA
#undef PG8_WAIT_V
#undef PG8_WAIT_L
#undef PG8_BAR
#undef PG8_SCHED
}
}

using pg8::bf16_t; using pg8::bf16x8; using pg8::f32x4; using pg8::u32x4; using pg8::Unit;
#define LAS __attribute__((address_space(3)))
typedef float f32x2v __attribute__((ext_vector_type(2)));
typedef __bf16 bf16x2v __attribute__((ext_vector_type(2)));
typedef unsigned u32x2 __attribute__((ext_vector_type(2)));

constexpr int D = 1024, NBATCH = 8, SEQ = 4096;
constexpr int MREAL = NBATCH * SEQ;
constexpr int ROW_META = MREAL;
constexpr int ROW_SAMP = MREAL + 16;
constexpr int ROW_PAD = ROW_SAMP + 128;
constexpr int M = MREAL + 256;
constexpr int INW = 3840, FF = 2816, FF2 = 5632, PW = 512;
constexpr float RMS_EPS = 1e-6f;
constexpr int NPOS = 4112;

constexpr size_t MiB = 1u << 20;
constexpr size_t WS_ROPE = 1 * MiB, WS_SSQ1 = 3 * MiB, WS_SSQ2 = 6 * MiB;
constexpr size_t WS_WIN = 9 * MiB, WS_WAO = 17 * MiB, WS_WPO = 19 * MiB, WS_WOUT = 20 * MiB, WS_WUP = 22 * MiB, WS_WDOWN = 33 * MiB, WS_WGRP = 39 * MiB;
constexpr size_t WS_XN = 40 * MiB, WS_MIX = 105 * MiB  , WS_HALO = 40 * MiB, WS_UPT = 84 * MiB;
constexpr size_t WS_R0I = 64 * 1024;
constexpr size_t WS_Q = 105 * MiB, WS_K = 170 * MiB, WS_V = 179 * MiB, WS_P = 188 * MiB, WS_GA = 221 * MiB, WS_GP = 286 * MiB, WS_ATT = 351 * MiB, WS_POOL = 416 * MiB;
constexpr size_t WS_X1 = 105 * MiB, WS_XG = 234 * MiB, WS_ACT = 299 * MiB, WS_END = 477 * MiB;

constexpr int LDS_BYTES = 147456;

struct Params {
    const float *x_prompt, *x_sample, *cache_swa_k, *cache_swa_v, *cache_meta_k, *cache_meta_v, *state_pool, *state_conv, *meta_tokens, *g_norm_mix, *w_in, *b_gate, *sinks,
        *w_attn_o, *w_pool_grp, *pool_scale, *w_pool_o, *w_out, *g_norm_ffn, *w_up, *conv_w, *conv_b, *w_down, *g_norm_final;
    float* out; unsigned char* ws;
    float inv_freq[32];
    int ph_lo, ph_hi;
};
constexpr size_t O_YP = 0, O_YS = O_YP + (size_t)MREAL * D, O_PSK = O_YS + 128 * D, O_PSV = O_PSK + 131072, O_KM = O_PSV + 131072, O_VM = O_KM + 16384,
    O_PPOOL = O_VM + 16384, O_PCONV = O_PPOOL + 61440, O_SSK = O_PCONV + 90112, O_SSV = O_SSK + 16384, O_SPOOL = O_SSV + 16384, O_SCONV = O_SPOOL + 61440, O_END = O_SCONV + 90112;

__device__ __forceinline__ unsigned pk2(float lo, float hi) { f32x2v v = {lo, hi}; bf16x2v b = __builtin_convertvector(v, bf16x2v); return __builtin_bit_cast(unsigned, b); }
__device__ __forceinline__ float bf_lo(unsigned u) { return __uint_as_float(u << 16); }
__device__ __forceinline__ float bf_hi(unsigned u) { return __uint_as_float(u & 0xffff0000u); }
__device__ __forceinline__ float bf1(bf16_t h) { return __uint_as_float((unsigned)h << 16); }
__device__ __forceinline__ int row_pos(int r) {
    if (r < MREAL) return 16 + (r & 4095);
    if (r < ROW_SAMP) return r - ROW_META;
    if (r < ROW_PAD) return 16 + 1024 + ((r - ROW_SAMP) & 15);
    return 0;
}
__device__ __forceinline__ const float* row_x(const float* xp, const float* mt, const float* xs, int r) {
    if (r < MREAL) return xp + (size_t)r * D;
    if (r < ROW_SAMP) return mt + (size_t)(r - ROW_META) * D;
    if (r < ROW_PAD) return xs + (size_t)(r - ROW_SAMP) * D;
    return nullptr;
}
__device__ __forceinline__ float wave_sum(float v) {
#pragma unroll
    for (int o = 1; o < 64; o <<= 1) v += __shfl_xor(v, o);
    return v;
}
__device__ __forceinline__ float sigmoidf_(float x) { return __builtin_amdgcn_rcpf(1.0f + __builtin_amdgcn_exp2f(x * -1.4426950408889634f)); }

struct EpiZ {
    static constexpr bool PERM = true, AFTER_DRAIN = false;
    bf16_t *Q, *Kb, *Vb, *Pb, *GA, *GP; const float* b_gate; const float* rope;
    __device__ __forceinline__ void operator()(const f32x4 (&acc)[2][2][4][2], const Unit& u, int wr, int wc, int fr_in, int fq_in) const {
        int fr = fr_in, fq = fq_in; asm volatile("" : "+v"(fr), "+v"(fq));
        const int pn = u.pn, cw = wc * 32 + 8 * fq;
        if (pn < 4) {
#pragma unroll
            for (int ai = 0; ai < 2; ++ai) {
                f32x4 t[4][2][2];
#pragma unroll
                for (int m = 0; m < 4; ++m) {
                    const int row = u.pm * 256 + ai * 128 + wr * 64 + m * 16 + fr; const int pos = row_pos(row);
#pragma unroll
                    for (int bj = 0; bj < 2; ++bj) { const f32x4* tp = (const f32x4*)(rope + ((size_t)pos * 32 + (((bj * 128 + cw) & 63) >> 1)) * 2); t[m][bj][0] = tp[0]; t[m][bj][1] = tp[1]; }
                }
#pragma unroll
                for (int m = 0; m < 4; ++m) {
                    const int row = u.pm * 256 + ai * 128 + wr * 64 + m * 16 + fr;
#pragma unroll
                    for (int bj = 0; bj < 2; ++bj) {
                        const f32x4 v0 = acc[ai][bj][m][0], v1 = acc[ai][bj][m][1], t0 = t[m][bj][0], t1 = t[m][bj][1];
                        u32x4 w;
                        w.x = pk2(v0[0] * t0[0] - v0[1] * t0[1], v0[1] * t0[0] + v0[0] * t0[1]); w.y = pk2(v0[2] * t0[2] - v0[3] * t0[3], v0[3] * t0[2] + v0[2] * t0[3]);
                        w.z = pk2(v1[0] * t1[0] - v1[1] * t1[1], v1[1] * t1[0] + v1[0] * t1[1]); w.w = pk2(v1[2] * t1[2] - v1[3] * t1[3], v1[3] * t1[2] + v1[2] * t1[3]);
                        *(u32x4*)(Q + (size_t)row * 1024 + pn * 256 + bj * 128 + cw) = w;
                    }
                }
            }
        } else if (pn == 4) {
            f32x4 t[2][4][2];
#pragma unroll
            for (int ai = 0; ai < 2; ++ai)
#pragma unroll
                for (int m = 0; m < 4; ++m) {
                    const int row = u.pm * 256 + ai * 128 + wr * 64 + m * 16 + fr; const int pos = row_pos(row);
                    const f32x4* tp = (const f32x4*)(rope + ((size_t)pos * 32 + ((cw & 63) >> 1)) * 2); t[ai][m][0] = tp[0]; t[ai][m][1] = tp[1];
                }
#pragma unroll
            for (int ai = 0; ai < 2; ++ai)
#pragma unroll
                for (int m = 0; m < 4; ++m) {
                    const int row = u.pm * 256 + ai * 128 + wr * 64 + m * 16 + fr;
                    { const f32x4 v0 = acc[ai][0][m][0], v1 = acc[ai][0][m][1], t0 = t[ai][m][0], t1 = t[ai][m][1];
                      u32x4 w;
                      w.x = pk2(v0[0] * t0[0] - v0[1] * t0[1], v0[1] * t0[0] + v0[0] * t0[1]); w.y = pk2(v0[2] * t0[2] - v0[3] * t0[3], v0[3] * t0[2] + v0[2] * t0[3]);
                      w.z = pk2(v1[0] * t1[0] - v1[1] * t1[1], v1[1] * t1[0] + v1[0] * t1[1]); w.w = pk2(v1[2] * t1[2] - v1[3] * t1[3], v1[3] * t1[2] + v1[2] * t1[3]);
                      *(u32x4*)(Kb + (size_t)row * 128 + cw) = w; }
                    { const f32x4 v0 = acc[ai][1][m][0], v1 = acc[ai][1][m][1];
                      u32x4 w; w.x = pk2(v0[0], v0[1]); w.y = pk2(v0[2], v0[3]); w.z = pk2(v1[0], v1[1]); w.w = pk2(v1[2], v1[3]);
                      *(u32x4*)(Vb + (size_t)row * 128 + cw) = w; }
                }
        } else if (pn < 7) {
#pragma unroll
            for (int ai = 0; ai < 2; ++ai)
#pragma unroll
                for (int m = 0; m < 4; ++m) {
                    const int row = u.pm * 256 + ai * 128 + wr * 64 + m * 16 + fr;
#pragma unroll
                    for (int bj = 0; bj < 2; ++bj) {
                        const f32x4 v0 = acc[ai][bj][m][0], v1 = acc[ai][bj][m][1];
                        u32x4 w; w.x = pk2(v0[0], v0[1]); w.y = pk2(v0[2], v0[3]); w.z = pk2(v1[0], v1[1]); w.w = pk2(v1[2], v1[3]);
                        *(u32x4*)(Pb + (size_t)row * 512 + (pn - 5) * 256 + bj * 128 + cw) = w;
                    }
                }
        } else {
            const int gc = pn * 256 - 1792 + cw;
            f32x4 b[2][2];
#pragma unroll
            for (int bj = 0; bj < 2; ++bj) { b[bj][0] = *(const f32x4*)(b_gate + gc + bj * 128); b[bj][1] = *(const f32x4*)(b_gate + gc + bj * 128 + 4); }
            bf16_t* dstb = (pn < 11) ? GA + gc : GP + (gc - 1024);
#pragma unroll
            for (int ai = 0; ai < 2; ++ai)
#pragma unroll
                for (int m = 0; m < 4; ++m) {
                    const int row = u.pm * 256 + ai * 128 + wr * 64 + m * 16 + fr;
#pragma unroll
                    for (int bj = 0; bj < 2; ++bj) {
                        f32x4 v0 = acc[ai][bj][m][0] + b[bj][0], v1 = acc[ai][bj][m][1] + b[bj][1];
#pragma unroll
                        for (int i = 0; i < 4; ++i) { v0[i] = sigmoidf_(v0[i]); v1[i] = sigmoidf_(v1[i]); }
                        u32x4 w; w.x = pk2(v0[0], v0[1]); w.y = pk2(v0[2], v0[3]); w.z = pk2(v1[0], v1[1]); w.w = pk2(v1[2], v1[3]);
                        *(u32x4*)(dstb + (size_t)row * 1024 + bj * 128) = w;
                    }
                }
        }
    }
};
struct EpiT1 {
    static constexpr bool PERM = true, AFTER_DRAIN = false;
    const bf16_t* G; bf16_t* O;
    __device__ __forceinline__ void operator()(const f32x4 (&acc)[2][2][4][2], const Unit& u, int wr, int wc, int fr_in, int fq_in) const {
        int fr = fr_in, fq = fq_in; asm volatile("" : "+v"(fr), "+v"(fq));
        const size_t base = (size_t)(u.pm * 256 + wr * 64 + fr) * 1024 + u.pn * 256 + wc * 32 + 8 * fq;
        u32x4 g[2][4][2];
#pragma unroll
        for (int ai = 0; ai < 2; ++ai)
#pragma unroll
            for (int m = 0; m < 4; ++m)
#pragma unroll
                for (int bj = 0; bj < 2; ++bj) g[ai][m][bj] = *(const u32x4*)(G + base + (size_t)(ai * 128 + m * 16) * 1024 + bj * 128);
#pragma unroll
        for (int ai = 0; ai < 2; ++ai)
#pragma unroll
            for (int m = 0; m < 4; ++m)
#pragma unroll
                for (int bj = 0; bj < 2; ++bj) {
                    const u32x4 gg = g[ai][m][bj]; const f32x4 v0 = acc[ai][bj][m][0], v1 = acc[ai][bj][m][1];
                    u32x4 w; w.x = pk2(v0[0] * bf_lo(gg.x), v0[1] * bf_hi(gg.x)); w.y = pk2(v0[2] * bf_lo(gg.y), v0[3] * bf_hi(gg.y));
                    w.z = pk2(v1[0] * bf_lo(gg.z), v1[1] * bf_hi(gg.z)); w.w = pk2(v1[2] * bf_lo(gg.w), v1[3] * bf_hi(gg.w));
                    *(u32x4*)(O + base + (size_t)(ai * 128 + m * 16) * 1024 + bj * 128) = w;
                }
    }
};
struct EpiMix {
    static constexpr bool PERM = true, AFTER_DRAIN = false;
    const bf16_t* G; bf16_t* O;
    __device__ __forceinline__ void operator()(const f32x4 (&acc)[2][2][4][2], const Unit& u, int wr, int wc, int fr_in, int fq_in) const {
        int fr = fr_in, fq = fq_in; asm volatile("" : "+v"(fr), "+v"(fq));
        const size_t base = (size_t)(u.pm * 256 + wr * 64 + fr) * 1024 + u.pn * 256 + wc * 32 + 8 * fq;
#pragma unroll
        for (int ai = 0; ai < 2; ++ai) {
            u32x4 g[4][2], t[4][2];
#pragma unroll
            for (int m = 0; m < 4; ++m)
#pragma unroll
                for (int bj = 0; bj < 2; ++bj) { g[m][bj] = *(const u32x4*)(G + base + (size_t)(ai * 128 + m * 16) * 1024 + bj * 128); t[m][bj] = *(const u32x4*)(O + base + (size_t)(ai * 128 + m * 16) * 1024 + bj * 128); }
#pragma unroll
            for (int m = 0; m < 4; ++m)
#pragma unroll
                for (int bj = 0; bj < 2; ++bj) {
                    const u32x4 gg = g[m][bj], tt = t[m][bj]; const f32x4 v0 = acc[ai][bj][m][0], v1 = acc[ai][bj][m][1];
                    u32x4 w; w.x = pk2(bf_lo(tt.x) + v0[0] * bf_lo(gg.x), bf_hi(tt.x) + v0[1] * bf_hi(gg.x)); w.y = pk2(bf_lo(tt.y) + v0[2] * bf_lo(gg.y), bf_hi(tt.y) + v0[3] * bf_hi(gg.y));
                    w.z = pk2(bf_lo(tt.z) + v1[0] * bf_lo(gg.z), bf_hi(tt.z) + v1[1] * bf_hi(gg.z)); w.w = pk2(bf_lo(tt.w) + v1[2] * bf_lo(gg.w), bf_hi(tt.w) + v1[3] * bf_hi(gg.w));
                    *(u32x4*)(O + base + (size_t)(ai * 128 + m * 16) * 1024 + bj * 128) = w;
                }
        }
    }
};
struct EpiX1 {
    static constexpr bool PERM = true, AFTER_DRAIN = false;
    const bf16_t* XN; const float *r0i, *gmix, *gffn; bf16_t* XG; float* ssq;
    __device__ __forceinline__ void operator()(const f32x4 (&acc)[2][2][4][2], const Unit& u, int wr, int wc, int fr_in, int fq_in) const {
        int fr = fr_in, fq = fq_in; asm volatile("" : "+v"(fr), "+v"(fq));
        const int col0 = u.pn * 256 + wc * 32 + 8 * fq;
        f32x4 g[2][2], ig[2][2];
#pragma unroll
        for (int bj = 0; bj < 2; ++bj)
#pragma unroll
            for (int hh = 0; hh < 2; ++hh) { g[bj][hh] = *(const f32x4*)(gffn + col0 + bj * 128 + 4 * hh); const f32x4 gm = *(const f32x4*)(gmix + col0 + bj * 128 + 4 * hh);
#pragma unroll
                for (int i = 0; i < 4; ++i) ig[bj][hh][i] = __builtin_amdgcn_rcpf(gm[i]); }
#pragma unroll
        for (int ai = 0; ai < 2; ++ai) {
            u32x4 xn[4][2]; float ri[4];
#pragma unroll
            for (int m = 0; m < 4; ++m) {
                const int row = u.pm * 256 + ai * 128 + wr * 64 + m * 16 + fr;
                ri[m] = r0i[row];
#pragma unroll
                for (int bj = 0; bj < 2; ++bj) xn[m][bj] = *(const u32x4*)(XN + (size_t)row * 1024 + col0 + bj * 128);
            }
#pragma unroll
            for (int m = 0; m < 4; ++m) {
                const int row = u.pm * 256 + ai * 128 + wr * 64 + m * 16 + fr;
                const float rr = ri[m];
                float ss = 0.f;
#pragma unroll
                for (int bj = 0; bj < 2; ++bj) {
                    const u32x4 q = xn[m][bj];
                    f32x4 x0, x1;
                    x0[0] = bf_lo(q.x) * rr * ig[bj][0][0]; x0[1] = bf_hi(q.x) * rr * ig[bj][0][1]; x0[2] = bf_lo(q.y) * rr * ig[bj][0][2]; x0[3] = bf_hi(q.y) * rr * ig[bj][0][3];
                    x1[0] = bf_lo(q.z) * rr * ig[bj][1][0]; x1[1] = bf_hi(q.z) * rr * ig[bj][1][1]; x1[2] = bf_lo(q.w) * rr * ig[bj][1][2]; x1[3] = bf_hi(q.w) * rr * ig[bj][1][3];
                    const f32x4 v0 = acc[ai][bj][m][0] + x0, v1 = acc[ai][bj][m][1] + x1, g0 = g[bj][0], g1 = g[bj][1];
                    u32x4 w; w.x = pk2(v0[0] * g0[0], v0[1] * g0[1]); w.y = pk2(v0[2] * g0[2], v0[3] * g0[3]); w.z = pk2(v1[0] * g1[0], v1[1] * g1[1]); w.w = pk2(v1[2] * g1[2], v1[3] * g1[3]);
                    *(u32x4*)(XG + (size_t)row * 1024 + col0 + bj * 128) = w;
                    ss += (v0[0] * v0[0] + v0[1] * v0[1]) + (v0[2] * v0[2] + v0[3] * v0[3]) + (v1[0] * v1[0] + v1[1] * v1[1]) + (v1[2] * v1[2] + v1[3] * v1[3]);
                }
                ss += __shfl_xor(ss, 16); ss += __shfl_xor(ss, 32);
                if (fq == 0) ssq[(size_t)row * 16 + u.pn * 4 + wc] = ss;
            }
        }
    }
};
__device__ __forceinline__ float ror1(float x) { return __builtin_bit_cast(float, __builtin_amdgcn_mov_dpp(__builtin_bit_cast(int, x), 0x121, 0xf, 0xf, false)); }
__device__ __forceinline__ float ror2(float x) { return __builtin_bit_cast(float, __builtin_amdgcn_mov_dpp(__builtin_bit_cast(int, x), 0x122, 0xf, 0xf, false)); }
__device__ __forceinline__ float shr1(float old, float x) { return __builtin_bit_cast(float, __builtin_amdgcn_update_dpp(__builtin_bit_cast(int, old), __builtin_bit_cast(int, x), 0x111, 0xf, 0xf, false)); }
__device__ __forceinline__ float shr2(float old, float x) { return __builtin_bit_cast(float, __builtin_amdgcn_update_dpp(__builtin_bit_cast(int, old), __builtin_bit_cast(int, x), 0x112, 0xf, 0xf, false)); }
struct EpiUp {
    static constexpr bool PERM = true, AFTER_DRAIN = false;
    const float *ssq, *cw, *cb; bf16_t* ACT; float* HALO; float* UPT;
    __device__ __forceinline__ void operator()(const f32x4 (&acc)[2][2][4][2], const Unit& u, int wr, int wc, int fr_in, int fq_in) const {
        int fr = fr_in, fq = fq_in; asm volatile("" : "+v"(fr), "+v"(fq));
        const int jb = u.pn * 128 + wc * 32 + 8 * fq;
        float r1[2][4];
#pragma unroll
        for (int ai = 0; ai < 2; ++ai)
#pragma unroll
            for (int m = 0; m < 4; ++m) {
                const int row = u.pm * 256 + ai * 128 + wr * 64 + m * 16 + fr;
                const f32x4* sp = (const f32x4*)(ssq + (size_t)row * 16);
                const f32x4 a = sp[0], b = sp[1], c = sp[2], d = sp[3];
                const float s = ((a[0] + a[1]) + (a[2] + a[3])) + ((b[0] + b[1]) + (b[2] + b[3])) + ((c[0] + c[1]) + (c[2] + c[3])) + ((d[0] + d[1]) + (d[2] + d[3]));
                r1[ai][m] = rsqrtf(s * (1.0f / 1024.0f) + RMS_EPS);
            }
        if (u.pm == 128) {
#pragma unroll
            for (int ai = 0; ai < 2; ++ai)
#pragma unroll
                for (int m = 0; m < 4; ++m) {
                    const int lr = ai * 128 + wr * 64 + m * 16 + fr;
#pragma unroll
                    for (int bj = 0; bj < 2; ++bj)
#pragma unroll
                        for (int n = 0; n < 2; ++n) *(f32x4*)(UPT + (size_t)lr * FF2 + bj * FF + jb + 4 * n) = acc[ai][bj][m][n] * r1[ai][m];
                }
            return;
        }
#pragma unroll
        for (int n = 0; n < 2; ++n) {
            const int jg = jb + 4 * n;
            const f32x4 w0g = *(const f32x4*)(cw + jg), w1g = *(const f32x4*)(cw + FF2 + jg), w2g = *(const f32x4*)(cw + 2 * FF2 + jg), bg = *(const f32x4*)(cb + jg);
            const f32x4 w0v = *(const f32x4*)(cw + FF + jg), w1v = *(const f32x4*)(cw + FF2 + FF + jg), w2v = *(const f32x4*)(cw + 2 * FF2 + FF + jg), bv = *(const f32x4*)(cb + FF + jg);
#pragma unroll
            for (int ai = 0; ai < 2; ++ai) {
                const int slab = u.pm * 4 + ai * 2 + wr;
                f32x4 pg = {0.f, 0.f, 0.f, 0.f}, pv = {0.f, 0.f, 0.f, 0.f};
#pragma unroll
                for (int m = 0; m < 4; ++m) {
                    const int row = u.pm * 256 + ai * 128 + wr * 64 + m * 16 + fr;
                    const f32x4 ug = acc[ai][0][m][n] * r1[ai][m], uv = acc[ai][1][m][n] * r1[ai][m];
                    if (m == 0 && fr < 2) { *(f32x4*)(HALO + (size_t)(slab * 4 + fr) * FF2 + jg) = ug; *(f32x4*)(HALO + (size_t)(slab * 4 + fr) * FF2 + FF + jg) = uv; }
                    if (m == 3 && fr >= 14) { *(f32x4*)(HALO + (size_t)(slab * 4 + fr - 12) * FF2 + jg) = ug; *(f32x4*)(HALO + (size_t)(slab * 4 + fr - 12) * FF2 + FF + jg) = uv; }
                    f32x4 g1, g2, v1, v2;
#pragma unroll
                    for (int i = 0; i < 4; ++i) {
                        g1[i] = shr1(ror1(pg[i]), ug[i]); g2[i] = shr2(ror2(pg[i]), ug[i]);
                        v1[i] = shr1(ror1(pv[i]), uv[i]); v2[i] = shr2(ror2(pv[i]), uv[i]);
                    }
                    const f32x4 cg = bg + w0g * g2 + w1g * g1 + w2g * ug;
                    const f32x4 cv = bv + w0v * v2 + w1v * v1 + w2v * uv;
                    float a[4];
#pragma unroll
                    for (int i = 0; i < 4; ++i) a[i] = cg[i] * sigmoidf_(cg[i]) * cv[i];
                    if (!(m == 0 && fr < 2)) { u32x2 w; w.x = pk2(a[0], a[1]); w.y = pk2(a[2], a[3]); *(u32x2*)(ACT + (size_t)row * FF + jg) = w; }
                    pg = ug; pv = uv;
                }
            }
        }
    }
};
constexpr size_t WS_PCNT = 8 * MiB + 768 * 1024;
#define AG_LD(p) __hip_atomic_load((p), __ATOMIC_RELAXED, __HIP_MEMORY_SCOPE_AGENT)
#define AG_ST(p, v) __hip_atomic_store((p), (v), __ATOMIC_RELAXED, __HIP_MEMORY_SCOPE_AGENT)
struct EpiDown {
    static constexpr bool PERM = true, AFTER_DRAIN = false;
    const bf16_t* XG; const float* gffn; const float* gfin; float* out; float* ssq;
    __device__ __forceinline__ void operator()(const f32x4 (&acc_c)[2][2][4][2], const Unit& u, int wr, int wc, int fr_in, int fq_in) const {
        int fr = fr_in, fq = fq_in; asm volatile("" : "+v"(fr), "+v"(fq));
        f32x4 (&acc)[2][2][4][2] = const_cast<f32x4 (&)[2][2][4][2]>(acc_c);
        const int col0 = u.pn * 256 + wc * 32 + 8 * fq;
        f32x4 ig[2][2];
#pragma unroll
        for (int bj = 0; bj < 2; ++bj)
#pragma unroll
            for (int hh = 0; hh < 2; ++hh) { const f32x4 gg = *(const f32x4*)(gffn + col0 + bj * 128 + 4 * hh);
#pragma unroll
                for (int i = 0; i < 4; ++i) ig[bj][hh][i] = __builtin_amdgcn_rcpf(gg[i]); }
#pragma unroll
        for (int ai = 0; ai < 2; ++ai) {
            u32x4 xgv[4][2];
#pragma unroll
            for (int m = 0; m < 4; ++m)
#pragma unroll
                for (int bj = 0; bj < 2; ++bj) xgv[m][bj] = *(const u32x4*)(XG + (size_t)(u.pm * 256 + ai * 128 + wr * 64 + m * 16 + fr) * 1024 + col0 + bj * 128);
#pragma unroll
            for (int m = 0; m < 4; ++m) {
                const int row = u.pm * 256 + ai * 128 + wr * 64 + m * 16 + fr;
                float ss = 0.f;
#pragma unroll
                for (int bj = 0; bj < 2; ++bj) {
                    const u32x4 xg = xgv[m][bj];
                    f32x4 x0, x1;
                    x0[0] = bf_lo(xg.x) * ig[bj][0][0]; x0[1] = bf_hi(xg.x) * ig[bj][0][1]; x0[2] = bf_lo(xg.y) * ig[bj][0][2]; x0[3] = bf_hi(xg.y) * ig[bj][0][3];
                    x1[0] = bf_lo(xg.z) * ig[bj][1][0]; x1[1] = bf_hi(xg.z) * ig[bj][1][1]; x1[2] = bf_lo(xg.w) * ig[bj][1][2]; x1[3] = bf_hi(xg.w) * ig[bj][1][3];
                    const f32x4 v0 = acc[ai][bj][m][0] + x0, v1 = acc[ai][bj][m][1] + x1;
                    acc[ai][bj][m][0] = v0; acc[ai][bj][m][1] = v1;
                    ss += (v0[0] * v0[0] + v0[1] * v0[1]) + (v0[2] * v0[2] + v0[3] * v0[3]) + (v1[0] * v1[0] + v1[1] * v1[1]) + (v1[2] * v1[2] + v1[3] * v1[3]);
                }
                ss += __shfl_xor(ss, 16); ss += __shfl_xor(ss, 32);
                if (fq == 0) AG_ST(ssq + (size_t)row * 16 + u.pn * 4 + wc, ss);
            }
        }
        asm volatile("s_waitcnt vmcnt(0)" ::: "memory");
        unsigned* pc = (unsigned*)((char*)ssq + (WS_PCNT - WS_SSQ2)) + 64 * u.pm;
        if (fr == 0 && fq == 0) __hip_atomic_fetch_add(pc, 1u, __ATOMIC_RELAXED, __HIP_MEMORY_SCOPE_AGENT);
        for (int tries = 0; tries < (1 << 18); ++tries) {
            const unsigned c = (unsigned)__builtin_amdgcn_readfirstlane((int)AG_LD(pc));
            if (c >= 32u) break;
            __builtin_amdgcn_s_sleep(2);
        }
        float rs[2][4];
        {
            float* spb = ssq + (size_t)(u.pm * 256 + wr * 64 + fr) * 16 + 4 * fq;
#pragma unroll
            for (int ai = 0; ai < 2; ++ai)
#pragma unroll
                for (int m = 0; m < 4; ++m) {
                    float* sp = spb + (ai * 128 + m * 16) * 16;
                    const float a = AG_LD(sp), b = AG_LD(sp + 1), c = AG_LD(sp + 2), d = AG_LD(sp + 3);
                    rs[ai][m] = (a + b) + (c + d);
                }
        }
#pragma unroll
        for (int ai = 0; ai < 2; ++ai)
#pragma unroll
            for (int m = 0; m < 4; ++m) {
                const int row = u.pm * 256 + ai * 128 + wr * 64 + m * 16 + fr;
                float s = rs[ai][m]; s += __shfl_xor(s, 16); s += __shfl_xor(s, 32);
                const float r = rsqrtf(s * (1.0f / 1024.0f) + RMS_EPS);
                float* orow = out + O_YP + (size_t)row * D;
#pragma unroll
                for (int bj = 0; bj < 2; ++bj) {
                    const int col = u.pn * 256 + bj * 128 + wc * 32 + 8 * fq;
                    const f32x4 g0 = *(const f32x4*)(gfin + col), g1 = *(const f32x4*)(gfin + col + 4);
                    *(f32x4*)(orow + col) = acc[ai][bj][m][0] * r * g0; *(f32x4*)(orow + col + 4) = acc[ai][bj][m][1] * r * g1;
                }
            }
    }
};

struct MapId { __device__ __forceinline__ int operator()(int n) const { return n; } };
struct MapIn { __device__ __forceinline__ int operator()(int n) const { return n < 1152 ? ((n & ~63) + 2 * (n & 31) + ((n >> 5) & 1)) : n; } };
struct MapUp { __device__ __forceinline__ int operator()(int n) const { if (n < FF) return 256 * (n >> 7) + (n & 127); const int m = n - FF; return 256 * (m >> 7) + 128 + (m & 127); } };
template <class Map>
__device__ __forceinline__ void p0_transpose_item(const float* W, int K, int N, bf16_t* WT, LAS float* scr, int item, int lane, Map map) {
    const int nblk = N / 32, kb = item / nblk, nb = item % nblk, k0 = 64 * kb, n0 = 32 * nb;
#pragma unroll 8
    for (int i = 0; i < 32; ++i) { const int kk = 2 * i + (lane >> 5); scr[kk * 33 + (lane & 31)] = W[(size_t)(k0 + kk) * N + n0 + (lane & 31)]; }
    asm volatile("s_waitcnt lgkmcnt(0)" ::: "memory");
    const int c = lane & 7;
#pragma unroll
    for (int j = 0; j < 4; ++j) { const int n = (lane >> 3) + 8 * j; const LAS float* s = scr + (8 * c) * 33 + n;
        u32x4 o; o.x = pk2(s[0 * 33], s[1 * 33]); o.y = pk2(s[2 * 33], s[3 * 33]); o.z = pk2(s[4 * 33], s[5 * 33]); o.w = pk2(s[6 * 33], s[7 * 33]);
        *(u32x4*)(WT + (size_t)map(n0 + n) * K + k0 + 8 * c) = o; }
    asm volatile("s_waitcnt lgkmcnt(0)" ::: "memory");
}
__device__ __forceinline__ void p0_prologue(const Params& p, LAS unsigned char* lds, int wave, int lane) {
    unsigned char* ws = p.ws;
    if (wave < 4) {
        bf16_t* XN = (bf16_t*)(ws + WS_XN);
        const int gw = blockIdx.x * 4 + wave, NGW = gridDim.x * 4;
        f32x4 gv[4];
#pragma unroll
        for (int j = 0; j < 4; ++j) gv[j] = ((const f32x4*)p.g_norm_mix)[lane + 64 * j];
        for (int m0 = gw * 4; m0 < M; m0 += NGW * 4) {
            f32x4 v[4][4]; const float* xr[4];
#pragma unroll
            for (int q = 0; q < 4; ++q) {
                xr[q] = row_x(p.x_prompt, p.meta_tokens, p.x_sample, m0 + q);
#pragma unroll
                for (int j = 0; j < 4; ++j) v[q][j] = xr[q] ? ((const f32x4*)xr[q])[lane + 64 * j] : (f32x4){0.f, 0.f, 0.f, 0.f};
            }
#pragma unroll
            for (int q = 0; q < 4; ++q) {
                float s = 0.f;
#pragma unroll
                for (int j = 0; j < 4; ++j) s += (v[q][j][0] * v[q][j][0] + v[q][j][1] * v[q][j][1]) + (v[q][j][2] * v[q][j][2] + v[q][j][3] * v[q][j][3]);
                const float ms = wave_sum(s) * (1.0f / D) + RMS_EPS;
                const float r = rsqrtf(ms);
                if (lane == 0) ((float*)(ws + WS_R0I))[m0 + q] = sqrtf(ms);
                unsigned long long* o8 = (unsigned long long*)(XN + (size_t)(m0 + q) * D) + lane;
#pragma unroll
                for (int j = 0; j < 4; ++j) { const f32x4 w = v[q][j] * r * gv[j]; o8[64 * j] = (unsigned long long)pk2(w[0], w[1]) | ((unsigned long long)pk2(w[2], w[3]) << 32); }
            }
        }
        return;
    }
    LAS float* scr = (LAS float*)(lds + wave * 16384);
    const int gw = blockIdx.x * 4 + (wave - 4), NGW = gridDim.x * 4;
    const int gt = blockIdx.x * 256 + (int)threadIdx.x - 256, NT = gridDim.x * 256;
    constexpr int I_IN = 16 * (INW / 32), I_AO = 16 * 32, I_OUT = 16 * 32, I_UP = 16 * (FF2 / 32), I_DN = (FF / 64) * 32;
    constexpr int NITEMS = I_IN + I_AO + I_OUT + I_UP + I_DN;
    for (int it = gw; it < NITEMS; it += NGW) {
        int r = it;
        if (r < I_IN) { p0_transpose_item(p.w_in, D, INW, (bf16_t*)(ws + WS_WIN), scr, r, lane, MapIn()); continue; } r -= I_IN;
        if (r < I_AO) { p0_transpose_item(p.w_attn_o, D, D, (bf16_t*)(ws + WS_WAO), scr, r, lane, MapId()); continue; } r -= I_AO;
        if (r < I_OUT) { p0_transpose_item(p.w_out, D, D, (bf16_t*)(ws + WS_WOUT), scr, r, lane, MapId()); continue; } r -= I_OUT;
        if (r < I_UP) { p0_transpose_item(p.w_up, D, FF2, (bf16_t*)(ws + WS_WUP), scr, r, lane, MapUp()); continue; } r -= I_UP;
        p0_transpose_item(p.w_down, FF, D, (bf16_t*)(ws + WS_WDOWN), scr, r, lane, MapId());
    }
    {
        bf16_t* WP = (bf16_t*)(ws + WS_WPO);
        for (int idx = gt; idx < 1024 * 128; idx += NT) {
            const int n = idx & 1023, k0 = (idx >> 10) * 4, g = k0 >> 7;
            const float* wg = p.w_pool_grp + (size_t)k0 * 128;
            const float* sc = p.pool_scale + g * 128;
            const float* wo = p.w_pool_o + (size_t)(g * 128) * 1024 + n;
            float a[4] = {0.f, 0.f, 0.f, 0.f};
#pragma unroll 2
            for (int d = 0; d < 128; d += 4) {
                const f32x4 s4 = *(const f32x4*)(sc + d);
                float wv[4];
#pragma unroll
                for (int e = 0; e < 4; ++e) wv[e] = wo[(size_t)(d + e) * 1024] * s4[e];
#pragma unroll
                for (int j = 0; j < 4; ++j) { const f32x4 w4 = *(const f32x4*)(wg + j * 128 + d); a[j] += (w4[0] * wv[0] + w4[1] * wv[1]) + (w4[2] * wv[2] + w4[3] * wv[3]); }
            }
            u32x2 o; o.x = pk2(a[0], a[1]); o.y = pk2(a[2], a[3]);
            *(u32x2*)(WP + (size_t)n * 512 + k0) = o;
        }
    }
    float* rope = (float*)(ws + WS_ROPE);
    for (int i = gt; i < NPOS * 32; i += NT) {
        const int pos = i >> 5, d = i & 31;
        const float ang = (float)pos * p.inv_freq[d];
        const double rev = (double)ang * 0.15915494309189535;
        const float fr = (float)(rev - floor(rev));
        rope[2 * i] = __builtin_amdgcn_cosf(fr); rope[2 * i + 1] = __builtin_amdgcn_sinf(fr);
    }
}

constexpr int KS_PITCH = 144, VT_PITCH = 464, ATT_VT_OFF = 208 * KS_PITCH;
constexpr float LOG2E = 1.4426950408889634f, C2 = 0.125f * 1.4426950408889634f;

template <int NQ>
__device__ __forceinline__ void attn_load_q(bf16x8 (&qf)[NQ][2], const bf16_t* Qb, int qrow0, int h, int lane) {
    const int fr = lane & 15, fq = lane >> 4;
#pragma unroll
    for (int qb = 0; qb < NQ; ++qb)
#pragma unroll
        for (int ks = 0; ks < 2; ++ks) qf[qb][ks] = *(const bf16x8*)(Qb + (size_t)(qrow0 + 16 * qb + fr) * 1024 + h * 64 + 32 * ks + 8 * fq);
}
template <int NQ>
__device__ __forceinline__ void attn_compute(LAS unsigned char* lds, const bf16x8 (&qf)[NQ][2], bf16_t* ATT, int qrow0, int h, unsigned vmask, float sink2, int lane) {
    const int fr = lane & 15, fq = lane >> 4;
    f32x4 s[NQ][13];
    const LAS unsigned char* kp = lds + fr * KS_PITCH + fq * 16;
    bf16x8 kc0 = *(const LAS bf16x8*)kp, kc1 = *(const LAS bf16x8*)(kp + 64);
#pragma unroll
    for (int kb = 0; kb < 13; ++kb) {
        bf16x8 kn0 = kc0, kn1 = kc1;
        if (kb < 12) { kn0 = *(const LAS bf16x8*)(kp + (kb + 1) * 16 * KS_PITCH); kn1 = *(const LAS bf16x8*)(kp + (kb + 1) * 16 * KS_PITCH + 64); }
#pragma unroll
        for (int qb = 0; qb < NQ; ++qb) {
            f32x4 a = {0.f, 0.f, 0.f, 0.f};
            a = __builtin_amdgcn_mfma_f32_16x16x32_bf16(kc0, qf[qb][0], a, 0, 0, 0);
            a = __builtin_amdgcn_mfma_f32_16x16x32_bf16(kc1, qf[qb][1], a, 0, 0, 0);
            s[qb][kb] = a;
        }
        kc0 = kn0; kc1 = kn1;
        __builtin_amdgcn_sched_barrier(0);
    }
    float rl[NQ];
#pragma unroll
    for (int qb = 0; qb < NQ; ++qb) {
        float mr = -1e30f;
#pragma unroll
        for (int kb = 0; kb < 13; ++kb) {
            if (vmask != 0x1fffu) {
                const bool valid = (vmask >> kb) & 1u;
#pragma unroll
                for (int i = 0; i < 4; ++i) s[qb][kb][i] = valid ? s[qb][kb][i] : -1e30f;
            }
            mr = fmaxf(mr, fmaxf(fmaxf(s[qb][kb][0], s[qb][kb][1]), fmaxf(s[qb][kb][2], s[qb][kb][3])));
        }
        mr = fmaxf(mr, __shfl_xor(mr, 16)); mr = fmaxf(mr, __shfl_xor(mr, 32));
        const float mx = fmaxf(mr * C2, sink2), nmx = -mx;
        float l = 0.f;
#pragma unroll
        for (int kb = 0; kb < 13; ++kb)
#pragma unroll
            for (int i = 0; i < 4; ++i) { const float pv = __builtin_amdgcn_exp2f(fmaf(s[qb][kb][i], C2, nmx)); s[qb][kb][i] = pv; l += pv; }
        l += __shfl_xor(l, 16); l += __shfl_xor(l, 32);
        l += __builtin_amdgcn_exp2f(sink2 - mx);
        rl[qb] = __builtin_amdgcn_rcpf(l);
    }
    f32x4 o[NQ][4];
#pragma unroll
    for (int qb = 0; qb < NQ; ++qb)
#pragma unroll
        for (int db = 0; db < 4; ++db) o[qb][db] = (f32x4){0.f, 0.f, 0.f, 0.f};
    const LAS unsigned char* vp = lds + ATT_VT_OFF + fr * VT_PITCH + fq * 8;
    u32x2 vlo[4], vhi[4];
#pragma unroll
    for (int db = 0; db < 4; ++db) { vlo[db] = *(const LAS u32x2*)(vp + db * 16 * VT_PITCH); vhi[db] = *(const LAS u32x2*)(vp + db * 16 * VT_PITCH + 32); }
#pragma unroll
    for (int kk = 0; kk < 7; ++kk) {
        u32x2 nlo[4], nhi[4];
#pragma unroll
        for (int db = 0; db < 4; ++db) { nlo[db] = vlo[db]; nhi[db] = vhi[db]; }
        if (kk < 6) {
#pragma unroll
            for (int db = 0; db < 4; ++db) { nlo[db] = *(const LAS u32x2*)(vp + db * 16 * VT_PITCH + (kk + 1) * 64); nhi[db] = *(const LAS u32x2*)(vp + db * 16 * VT_PITCH + (kk + 1) * 64 + 32); }
        }
        bf16x8 pf[NQ];
#pragma unroll
        for (int qb = 0; qb < NQ; ++qb) {
            u32x4 w;
            w.x = pk2(s[qb][2 * kk][0], s[qb][2 * kk][1]); w.y = pk2(s[qb][2 * kk][2], s[qb][2 * kk][3]);
            if (2 * kk + 1 < 13) { w.z = pk2(s[qb][(2 * kk + 1) % 13][0], s[qb][(2 * kk + 1) % 13][1]); w.w = pk2(s[qb][(2 * kk + 1) % 13][2], s[qb][(2 * kk + 1) % 13][3]); }
            else { w.z = 0u; w.w = 0u; }
            pf[qb] = __builtin_bit_cast(bf16x8, w);
        }
#pragma unroll
        for (int db = 0; db < 4; ++db) {
            u32x4 vv; vv.x = vlo[db].x; vv.y = vlo[db].y; vv.z = vhi[db].x; vv.w = vhi[db].y;
            const bf16x8 vf = __builtin_bit_cast(bf16x8, vv);
#pragma unroll
            for (int qb = 0; qb < NQ; ++qb) o[qb][db] = __builtin_amdgcn_mfma_f32_16x16x32_bf16(vf, pf[qb], o[qb][db], 0, 0, 0);
        }
#pragma unroll
        for (int db = 0; db < 4; ++db) { vlo[db] = nlo[db]; vhi[db] = nhi[db]; }
        __builtin_amdgcn_sched_barrier(0);
    }
#pragma unroll
    for (int qb = 0; qb < NQ; ++qb)
#pragma unroll
        for (int db = 0; db < 4; ++db) {
            const f32x4 v = o[qb][db] * rl[qb];
            u32x2 w; w.x = pk2(v[0], v[1]); w.y = pk2(v[2], v[3]);
            *(u32x2*)(ATT + (size_t)(qrow0 + 16 * qb + fr) * 1024 + h * 64 + 16 * db + 4 * fq) = w;
        }
}
__device__ __forceinline__ void attn_zero_pad(LAS unsigned char* lds, int tid) {
    if (tid < 128) { const int row = tid >> 1, half = tid & 1; *(LAS u32x4*)(lds + ATT_VT_OFF + row * VT_PITCH + 416 + half * 16) = (u32x4){0u, 0u, 0u, 0u}; }
}
__device__ __forceinline__ void attn_fill_bf16(LAS unsigned char* lds, const bf16_t* Kb, const bf16_t* Vb, int srow, int n, int kk, int ch) {
    u32x4 kv = {0u, 0u, 0u, 0u}, vv = {0u, 0u, 0u, 0u};
    if (srow >= 0) { kv = *(const u32x4*)(Kb + (size_t)srow * 128 + n * 64 + ch * 8); vv = *(const u32x4*)(Vb + (size_t)srow * 128 + n * 64 + ch * 8); }
    *(LAS u32x4*)(lds + kk * KS_PITCH + ch * 16) = kv;
    LAS unsigned short* vt = (LAS unsigned short*)(lds + ATT_VT_OFF + (ch * 8) * VT_PITCH + kk * 2);
    vt[0 * (VT_PITCH / 2)] = (unsigned short)(vv.x & 0xffffu); vt[1 * (VT_PITCH / 2)] = (unsigned short)(vv.x >> 16);
    vt[2 * (VT_PITCH / 2)] = (unsigned short)(vv.y & 0xffffu); vt[3 * (VT_PITCH / 2)] = (unsigned short)(vv.y >> 16);
    vt[4 * (VT_PITCH / 2)] = (unsigned short)(vv.z & 0xffffu); vt[5 * (VT_PITCH / 2)] = (unsigned short)(vv.z >> 16);
    vt[6 * (VT_PITCH / 2)] = (unsigned short)(vv.w & 0xffffu); vt[7 * (VT_PITCH / 2)] = (unsigned short)(vv.w >> 16);
}
__device__ __forceinline__ void attn_fill_f32(LAS unsigned char* lds, const float* ksrc, const float* vsrc, int kk, int ch) {
    const f32x4 k0 = *(const f32x4*)(ksrc + ch * 8), k1 = *(const f32x4*)(ksrc + ch * 8 + 4);
    const f32x4 v0 = *(const f32x4*)(vsrc + ch * 8), v1 = *(const f32x4*)(vsrc + ch * 8 + 4);
    LAS unsigned short* kr = (LAS unsigned short*)(lds + kk * KS_PITCH);
    LAS unsigned short* vt = (LAS unsigned short*)(lds + ATT_VT_OFF + (ch * 8) * VT_PITCH + kk * 2);
#pragma unroll
    for (int e = 0; e < 8; ++e) {
        const int d = ch * 8 + e;
        const float kvv = e < 4 ? k0[e & 3] : k1[e & 3], vvv = e < 4 ? v0[e & 3] : v1[e & 3];
        kr[2 * (d & 31) + (d >> 5)] = (unsigned short)(pk2(kvv, 0.f) & 0xffffu);
        vt[e * (VT_PITCH / 2)] = (unsigned short)(pk2(vvv, 0.f) & 0xffffu);
    }
}
__device__ __forceinline__ void attn_chunk_unit(const Params& p, LAS unsigned char* lds, int unit, int tid, int wave, int lane) {
    unsigned char* ws = p.ws;
    const bf16_t *Qb = (const bf16_t*)(ws + WS_Q), *Kb = (const bf16_t*)(ws + WS_K), *Vb = (const bf16_t*)(ws + WS_V); bf16_t* ATT = (bf16_t*)(ws + WS_ATT);
    const int n = unit & 1, c = (unit >> 1) & 63, b = unit >> 7;
    asm volatile("" : "+v"(tid), "+v"(lane));
    const int h = n * 8 + wave, r0 = b * SEQ + c * 64;
    bf16x8 qa[2][2], qb2[2][2];
    attn_load_q<2>(qa, Qb, r0, h, lane);
#pragma unroll
    for (int jb = 0; jb < 2; ++jb) {
        u32x4 kv[2], vv[2];
#pragma unroll
        for (int j = 0; j < 2; ++j) {
            const int i = tid + 512 * (2 * jb + j), kk = i >> 3, ch = i & 7;
            int srow;
            if (kk < 16) srow = ROW_META + kk;
            else { const int t = (c - 2) * 64 + kk - 16; srow = t < 0 ? -1 : b * SEQ + t; }
            kv[j] = (u32x4){0u, 0u, 0u, 0u}; vv[j] = (u32x4){0u, 0u, 0u, 0u};
            if (i < 208 * 8 && srow >= 0) { kv[j] = *(const u32x4*)(Kb + (size_t)srow * 128 + n * 64 + ch * 8); vv[j] = *(const u32x4*)(Vb + (size_t)srow * 128 + n * 64 + ch * 8); }
        }
#pragma unroll
        for (int j = 0; j < 2; ++j) {
            const int i = tid + 512 * (2 * jb + j), kk = i >> 3, ch = i & 7;
            if (i < 208 * 8) {
                *(LAS u32x4*)(lds + kk * KS_PITCH + ch * 16) = kv[j];
                LAS unsigned short* vt = (LAS unsigned short*)(lds + ATT_VT_OFF + (ch * 8) * VT_PITCH + kk * 2);
                vt[0 * (VT_PITCH / 2)] = (unsigned short)(vv[j].x & 0xffffu); vt[1 * (VT_PITCH / 2)] = (unsigned short)(vv[j].x >> 16);
                vt[2 * (VT_PITCH / 2)] = (unsigned short)(vv[j].y & 0xffffu); vt[3 * (VT_PITCH / 2)] = (unsigned short)(vv[j].y >> 16);
                vt[4 * (VT_PITCH / 2)] = (unsigned short)(vv[j].z & 0xffffu); vt[5 * (VT_PITCH / 2)] = (unsigned short)(vv[j].z >> 16);
                vt[6 * (VT_PITCH / 2)] = (unsigned short)(vv[j].w & 0xffffu); vt[7 * (VT_PITCH / 2)] = (unsigned short)(vv[j].w >> 16);
            }
        }
    }
    attn_zero_pad(lds, tid);
    __syncthreads();
    unsigned vmask = 0x1fffu;
    if (c == 0) vmask = 0x1e01u; else if (c == 1) vmask = 0x1fe1u;
    const float sink2 = p.sinks[h] * LOG2E;
    attn_compute<2>(lds, qa, ATT, r0, h, vmask, sink2, lane);
    attn_load_q<2>(qb2, Qb, r0 + 32, h, lane);
    attn_compute<2>(lds, qb2, ATT, r0 + 32, h, vmask, sink2, lane);
    __syncthreads();
}
__device__ __forceinline__ void attn_small_unit(const Params& p, LAS unsigned char* lds, int unit, int tid, int wave, int lane) {
    unsigned char* ws = p.ws;
    const bf16_t *Qb = (const bf16_t*)(ws + WS_Q), *Kb = (const bf16_t*)(ws + WS_K), *Vb = (const bf16_t*)(ws + WS_V); bf16_t* ATT = (bf16_t*)(ws + WS_ATT);
    int n, qrow0; unsigned vmask;
    if (unit < 2) {
        n = unit; qrow0 = ROW_META; vmask = 1u;
        for (int i = tid; i < 208 * 8; i += 512) { const int kk = i >> 3, ch = i & 7; attn_fill_bf16(lds, Kb, Vb, kk < 16 ? ROW_META + kk : -1, n, kk, ch); }
    } else {
        const int b = (unit - 2) >> 1; n = (unit - 2) & 1; qrow0 = ROW_SAMP + b * 16; vmask = 0x3ffu;
        for (int i = tid; i < 208 * 8; i += 512) {
            const int kk = i >> 3, ch = i & 7;
            if (kk < 16) attn_fill_f32(lds, p.cache_meta_k + ((size_t)(b * 16 + kk) * 2 + n) * 64, p.cache_meta_v + ((size_t)(b * 16 + kk) * 2 + n) * 64, kk, ch);
            else if (kk < 144) attn_fill_f32(lds, p.cache_swa_k + ((size_t)(b * 128 + kk - 16) * 2 + n) * 64, p.cache_swa_v + ((size_t)(b * 128 + kk - 16) * 2 + n) * 64, kk, ch);
            else attn_fill_bf16(lds, Kb, Vb, kk < 160 ? ROW_SAMP + b * 16 + kk - 144 : -1, n, kk, ch);
        }
    }
    attn_zero_pad(lds, tid);
    __syncthreads();
    const int h = n * 8 + wave;
    bf16x8 q1[1][2]; attn_load_q<1>(q1, Qb, qrow0, h, lane);
    attn_compute<1>(lds, q1, ATT, qrow0, h, vmask, p.sinks[h] * LOG2E, lane);
    __syncthreads();
}
constexpr int PM_PITCH = 1040;
__device__ __forceinline__ void add8(float (&s)[8], const u32x4 v) {
    s[0] += bf_lo(v.x); s[1] += bf_hi(v.x); s[2] += bf_lo(v.y); s[3] += bf_hi(v.y); s[4] += bf_lo(v.z); s[5] += bf_hi(v.z); s[6] += bf_lo(v.w); s[7] += bf_hi(v.w);
}
__device__ __forceinline__ void unpack8(float (&s)[8], const u32x4 v) {
    s[0] = bf_lo(v.x); s[1] = bf_hi(v.x); s[2] = bf_lo(v.y); s[3] = bf_hi(v.y); s[4] = bf_lo(v.z); s[5] = bf_hi(v.z); s[6] = bf_lo(v.w); s[7] = bf_hi(v.w);
}
template <int W>
__device__ __forceinline__ void pool_pm_main(const bf16_t* Pb, bf16_t* POOL, int R0, int wave, int lane) {
    const int g = wave >> 1, col = (g * 16 + (lane & 15)) * 8, seg = (wave & 1) * 4 + (lane >> 4);
    const int sb = R0 & 4095, s0 = sb + seg * 8, base = R0 - sb;
    constexpr int NL = 8 + W - 1;
    u32x4 v[NL];
#pragma unroll
    for (int t = 0; t < NL; ++t) {
        const int sk = s0 + t - (W - 1);
        const int row = sk >= 0 ? base + sk : ROW_META + 16 + sk;
        v[t] = *(const u32x4*)(Pb + (size_t)row * PW + col);
    }
    float s[8] = {0.f, 0.f, 0.f, 0.f, 0.f, 0.f, 0.f, 0.f};
#pragma unroll
    for (int t = 0; t < W - 1; ++t) add8(s, v[t]);
#pragma unroll
    for (int j = 0; j < 8; ++j) {
        float cur[8], old[8];
        unpack8(cur, v[j + W - 1]); unpack8(old, v[j]);
#pragma unroll
        for (int e = 0; e < 8; ++e) s[e] += cur[e];
        constexpr float inv = 1.0f / (float)W;
        u32x4 o; o.x = pk2(s[0] * inv - cur[0], s[1] * inv - cur[1]); o.y = pk2(s[2] * inv - cur[2], s[3] * inv - cur[3]);
        o.z = pk2(s[4] * inv - cur[4], s[5] * inv - cur[5]); o.w = pk2(s[6] * inv - cur[6], s[7] * inv - cur[7]);
        *(u32x4*)(POOL + (size_t)(R0 + seg * 8 + j) * PW + col) = o;
#pragma unroll
        for (int e = 0; e < 8; ++e) s[e] -= old[e];
    }
}
__device__ __forceinline__ void pool_unit(const Params& p, LAS unsigned char* lds, int pt, int tid, int wave, int lane) {
    unsigned char* ws = p.ws;
    const bf16_t* Pb = (const bf16_t*)(ws + WS_P); bf16_t* POOL = (bf16_t*)(ws + WS_POOL);
    const bool tail = pt >= 512;
    const int R0 = tail ? MREAL + 16 * (pt - 512) : pt * 64;
    if (!tail) {
        switch (wave >> 1) {
            case 0: pool_pm_main<2>(Pb, POOL, R0, wave, lane); break;
            case 1: pool_pm_main<4>(Pb, POOL, R0, wave, lane); break;
            case 2: pool_pm_main<8>(Pb, POOL, R0, wave, lane); break;
            default: pool_pm_main<16>(Pb, POOL, R0, wave, lane); break;
        }
    } else
    for (int i = tid; i < 1024; i += 512) {
        const int rr = i >> 6, ch = i & 63, R = R0 + rr, g = ch >> 4, w = 2 << g, col = ch * 8;
        float s[8] = {0.f, 0.f, 0.f, 0.f, 0.f, 0.f, 0.f, 0.f}, cur[8] = {0.f, 0.f, 0.f, 0.f, 0.f, 0.f, 0.f, 0.f};
        float inv = 1.0f / (float)w;
        if (R < ROW_SAMP) {
            const int pos = R - ROW_META; const int cnt = w < pos + 1 ? w : pos + 1; inv = 1.0f / (float)cnt;
#pragma unroll
            for (int k = 0; k < 16; ++k) {
                const bool on = k < cnt;
                float t[8]; unpack8(t, *(const u32x4*)(Pb + (size_t)(on ? R - k : R) * PW + col));
#pragma unroll
                for (int e = 0; e < 8; ++e) { s[e] += on ? t[e] : 0.f; if (k == 0) cur[e] = t[e]; }
            }
        } else if (R < ROW_PAD) {
            const int q = R - ROW_SAMP, b = q >> 4, ii = q & 15;
#pragma unroll
            for (int k = 0; k < 16; ++k) {
                const bool on = k < w, frombuf = ii - k >= 0;
                float t[8]; unpack8(t, *(const u32x4*)(Pb + (size_t)(frombuf ? R - k : R) * PW + col));
                const float* sp = p.state_pool + ((size_t)b * 15 + (frombuf ? 0 : 15 + ii - k)) * PW + col; const f32x4 a = *(const f32x4*)sp, c2 = *(const f32x4*)(sp + 4);
                const float u[8] = {a[0], a[1], a[2], a[3], c2[0], c2[1], c2[2], c2[3]};
#pragma unroll
                for (int e = 0; e < 8; ++e) { const float x = frombuf ? t[e] : u[e]; s[e] += on ? x : 0.f; if (k == 0) cur[e] = t[e]; }
            }
        }
        u32x4 o; o.x = pk2(s[0] * inv - cur[0], s[1] * inv - cur[1]); o.y = pk2(s[2] * inv - cur[2], s[3] * inv - cur[3]);
        o.z = pk2(s[4] * inv - cur[4], s[5] * inv - cur[5]); o.w = pk2(s[6] * inv - cur[6], s[7] * inv - cur[7]);
        *(u32x4*)(POOL + (size_t)R * PW + col) = o;
    }
}
__device__ __forceinline__ int deinter(int d) { return 2 * (d & 31) + (d >> 5); }
__device__ __forceinline__ void small_outputs(const Params& p) {
    unsigned char* ws = p.ws;
    const bf16_t *Kb = (const bf16_t*)(ws + WS_K), *Vb = (const bf16_t*)(ws + WS_V), *Pb = (const bf16_t*)(ws + WS_P);
    float* out = p.out;
    const int gt = blockIdx.x * 512 + threadIdx.x, NT = gridDim.x * 512;
    for (int i = gt; i < 131072; i += NT) {
        const int d = i & 63, n = (i >> 6) & 1, w = (i >> 7) & 127, b = i >> 14; const size_t row = (size_t)b * SEQ + 3968 + w;
        out[O_PSK + i] = bf1(Kb[row * 128 + n * 64 + deinter(d)]); out[O_PSV + i] = bf1(Vb[row * 128 + n * 64 + d]);
    }
    for (int i = gt; i < 16384; i += NT) {
        const int d = i & 63, n = (i >> 6) & 1, t = (i >> 7) & 15, b = i >> 11;
        const size_t rm = (size_t)ROW_META + t, rs = (size_t)ROW_SAMP + b * 16 + t;
        out[O_KM + i] = bf1(Kb[rm * 128 + n * 64 + deinter(d)]); out[O_VM + i] = bf1(Vb[rm * 128 + n * 64 + d]);
        out[O_SSK + i] = bf1(Kb[rs * 128 + n * 64 + deinter(d)]); out[O_SSV + i] = bf1(Vb[rs * 128 + n * 64 + d]);
    }
    for (int i = gt; i < 61440; i += NT) {
        const int c = i & 511, r = (i >> 9) % 15, b = (i >> 9) / 15;
        out[O_PPOOL + i] = bf1(Pb[((size_t)b * SEQ + 4081 + r) * PW + c]);
        out[O_SPOOL + i] = bf1(Pb[((size_t)ROW_SAMP + b * 16 + 1 + r) * PW + c]);
    }
}


constexpr size_t WS_SSQT1 = 5 * MiB + 512 * 1024, WS_SSQT2 = 8 * MiB + 512 * 1024;
struct SkinnyOp { const bf16_t* A; const bf16_t* Bt; int K; };
__device__ __forceinline__ void skinny_accum(const SkinnyOp op, int n0, int wave, int lane, f32x4 (&acc)[9]) {
    const int fr = lane & 15, fq = lane >> 4;
    const bf16_t* bp = op.Bt + (size_t)(n0 + fr) * op.K + 8 * fq;
    const bf16_t* ap = op.A + (size_t)(ROW_META + fr) * op.K + 8 * fq;
    const int nks = op.K >> 5;
    for (int ks = wave; ks < nks; ks += 16) {
        const bool two = ks + 8 < nks;
        const int k0 = ks * 32, k1 = two ? (ks + 8) * 32 : k0;
        const bf16x8 b0 = *(const bf16x8*)(bp + k0), b1 = *(const bf16x8*)(bp + k1);
        bf16x8 a0[9], a1[9];
#pragma unroll
        for (int rb = 0; rb < 9; ++rb) { a0[rb] = *(const bf16x8*)(ap + (size_t)rb * 16 * op.K + k0); a1[rb] = *(const bf16x8*)(ap + (size_t)rb * 16 * op.K + k1); }
#pragma unroll
        for (int rb = 0; rb < 9; ++rb) acc[rb] = __builtin_amdgcn_mfma_f32_16x16x32_bf16(b0, a0[rb], acc[rb], 0, 0, 0);
        if (two) {
#pragma unroll
            for (int rb = 0; rb < 9; ++rb) acc[rb] = __builtin_amdgcn_mfma_f32_16x16x32_bf16(b1, a1[rb], acc[rb], 0, 0, 0);
        }
    }
}
__device__ __forceinline__ void skinny_reduce(LAS unsigned char* lds, const f32x4 (&acc)[9], int wave, int lane, f32x4& r0, f32x4& r8) {
    LAS f32x4* part = (LAS f32x4*)lds;
#pragma unroll
    for (int rb = 0; rb < 9; ++rb) part[(wave * 9 + rb) * 64 + lane] = acc[rb];
    __syncthreads();
    r0 = (f32x4){0.f, 0.f, 0.f, 0.f}; r8 = (f32x4){0.f, 0.f, 0.f, 0.f};
#pragma unroll
    for (int w = 0; w < 8; ++w) r0 += part[(w * 9 + wave) * 64 + lane];
    if (wave == 0) {
#pragma unroll
        for (int w = 0; w < 8; ++w) r8 += part[(w * 9 + 8) * 64 + lane];
    }
    __syncthreads();
}
#define ZERO9(a) _Pragma("unroll") for (int z_ = 0; z_ < 9; ++z_) a[z_] = (f32x4){0.f, 0.f, 0.f, 0.f}
__device__ __forceinline__ void tail_mix_unit(const Params& p, LAS unsigned char* lds, int unit, int wave, int lane) {
    unsigned char* ws = p.ws; const int n0 = unit * 16, fr = lane & 15, fq = lane >> 4;
    f32x4 acc[9], a0, a8, b0, b8;
    ZERO9(acc); skinny_accum(SkinnyOp{(const bf16_t*)(ws + WS_ATT), (const bf16_t*)(ws + WS_WAO), 1024}, n0, wave, lane, acc); skinny_reduce(lds, acc, wave, lane, a0, a8);
    ZERO9(acc); skinny_accum(SkinnyOp{(const bf16_t*)(ws + WS_POOL), (const bf16_t*)(ws + WS_WPO), 512}, n0, wave, lane, acc); skinny_reduce(lds, acc, wave, lane, b0, b8);
    const bf16_t *GA = (const bf16_t*)(ws + WS_GA), *GP = (const bf16_t*)(ws + WS_GP); bf16_t* MIX = (bf16_t*)(ws + WS_MIX);
#pragma unroll
    for (int t = 0; t < 2; ++t) {
        if (t == 1 && wave != 0) break;
        const int rb = t ? 8 : wave; const f32x4 va = t ? a8 : a0, vb = t ? b8 : b0;
        const size_t off = (size_t)(ROW_META + 16 * rb + fr) * 1024 + n0 + 4 * fq;
        const u32x2 ga = *(const u32x2*)(GA + off), gp = *(const u32x2*)(GP + off);
        u32x2 w; w.x = pk2(bf_lo(ga.x) * va[0] + bf_lo(gp.x) * vb[0], bf_hi(ga.x) * va[1] + bf_hi(gp.x) * vb[1]);
        w.y = pk2(bf_lo(ga.y) * va[2] + bf_lo(gp.y) * vb[2], bf_hi(ga.y) * va[3] + bf_hi(gp.y) * vb[3]);
        *(u32x2*)(MIX + off) = w;
    }
}
__device__ __forceinline__ void tail_x1_unit(const Params& p, LAS unsigned char* lds, int unit, int wave, int lane) {
    unsigned char* ws = p.ws; const int n0 = unit * 16, fr = lane & 15, fq = lane >> 4;
    f32x4 acc[9], a0, a8;
    ZERO9(acc); skinny_accum(SkinnyOp{(const bf16_t*)(ws + WS_MIX), (const bf16_t*)(ws + WS_WOUT), 1024}, n0, wave, lane, acc); skinny_reduce(lds, acc, wave, lane, a0, a8);
    bf16_t* XG = (bf16_t*)(ws + WS_XG); float* ssqt = (float*)(ws + WS_SSQT1);
#pragma unroll
    for (int t = 0; t < 2; ++t) {
        if (t == 1 && wave != 0) break;
        const int rb = t ? 8 : wave; const f32x4 va = t ? a8 : a0;
        const int lr = 16 * rb + fr, row = ROW_META + lr, col = n0 + 4 * fq;
        const f32x4 x = *(const f32x4*)(row_x(p.x_prompt, p.meta_tokens, p.x_sample, row) + col);
        const f32x4 v = va + x, g = *(const f32x4*)(p.g_norm_ffn + col);
        u32x2 w; w.x = pk2(v[0] * g[0], v[1] * g[1]); w.y = pk2(v[2] * g[2], v[3] * g[3]);
        *(u32x2*)(XG + (size_t)row * 1024 + col) = w;
        float ss = (v[0] * v[0] + v[1] * v[1]) + (v[2] * v[2] + v[3] * v[3]);
        ss += __shfl_xor(ss, 16); ss += __shfl_xor(ss, 32);
        if (fq == 0) ssqt[lr * 64 + unit] = ss;
    }
}
__device__ __forceinline__ float tail_row_sum64(const float* ssqt, int lr) {
    const f32x4* sp = (const f32x4*)(ssqt + lr * 64); float s = 0.f;
#pragma unroll
    for (int j = 0; j < 16; ++j) { const f32x4 a = sp[j]; s += (a[0] + a[1]) + (a[2] + a[3]); }
    return s;
}
__device__ __forceinline__ void tail_up_unit(const Params& p, LAS unsigned char* lds, int unit, int wave, int lane) {
    unsigned char* ws = p.ws; const int n0 = unit * 16, fr = lane & 15, fq = lane >> 4;
    f32x4 acc[9], a0, a8;
    ZERO9(acc); skinny_accum(SkinnyOp{(const bf16_t*)(ws + WS_XG), (const bf16_t*)(ws + WS_WUP), 1024}, n0, wave, lane, acc); skinny_reduce(lds, acc, wave, lane, a0, a8);
    float* UPT = (float*)(ws + WS_UPT); const float* ssqt = (const float*)(ws + WS_SSQT1);
    const int oc = ((n0 >> 7) & 1) * FF + 128 * (n0 >> 8) + (n0 & 127) + 4 * fq;
#pragma unroll
    for (int t = 0; t < 2; ++t) {
        if (t == 1 && wave != 0) break;
        const int rb = t ? 8 : wave; const f32x4 va = t ? a8 : a0;
        const int lr = 16 * rb + fr;
        const float r1 = rsqrtf(tail_row_sum64(ssqt, lr) * (1.0f / 1024.0f) + RMS_EPS);
        *(f32x4*)(UPT + (size_t)lr * FF2 + oc) = va * r1;
    }
}
__device__ __forceinline__ void tail_down_unit(const Params& p, LAS unsigned char* lds, int unit, int wave, int lane) {
    unsigned char* ws = p.ws; const int n0 = unit * 16, fr = lane & 15, fq = lane >> 4;
    f32x4 acc[9], a0, a8;
    ZERO9(acc); skinny_accum(SkinnyOp{(const bf16_t*)(ws + WS_ACT), (const bf16_t*)(ws + WS_WDOWN), FF}, n0, wave, lane, acc); skinny_reduce(lds, acc, wave, lane, a0, a8);
    const bf16_t* XG = (const bf16_t*)(ws + WS_XG); float* ssqt = (float*)(ws + WS_SSQT2);
    f32x4 vv[2];
#pragma unroll
    for (int t = 0; t < 2; ++t) {
        if (t == 1 && wave != 0) break;
        const int rb = t ? 8 : wave; const f32x4 va = t ? a8 : a0;
        const int lr = 16 * rb + fr, row = ROW_META + lr, col = n0 + 4 * fq;
        const u32x2 xg = *(const u32x2*)(XG + (size_t)row * 1024 + col); const f32x4 g = *(const f32x4*)(p.g_norm_ffn + col);
        f32x4 v;
        v[0] = va[0] + bf_lo(xg.x) * __builtin_amdgcn_rcpf(g[0]); v[1] = va[1] + bf_hi(xg.x) * __builtin_amdgcn_rcpf(g[1]);
        v[2] = va[2] + bf_lo(xg.y) * __builtin_amdgcn_rcpf(g[2]); v[3] = va[3] + bf_hi(xg.y) * __builtin_amdgcn_rcpf(g[3]);
        vv[t] = v;
        float ss = (v[0] * v[0] + v[1] * v[1]) + (v[2] * v[2] + v[3] * v[3]);
        ss += __shfl_xor(ss, 16); ss += __shfl_xor(ss, 32);
        if (fq == 0) AG_ST(ssqt + lr * 64 + unit, ss);
    }
#pragma unroll
    for (int t = 0; t < 2; ++t) {
        if (t == 1 && wave != 0) break;
        const int rb = t ? 8 : wave;
        const int lr = 16 * rb + fr, col = n0 + 4 * fq;
        float s = 0.f;
        for (int tries = 0; tries < (1 << 16); ++tries) {
            bool ready = true; s = 0.f;
#pragma unroll
            for (int j = 0; j < 16; ++j) { const float a = AG_LD(ssqt + lr * 64 + 16 * fq + j); ready = ready && (a >= 0.f); s += a; }
            if (__all(ready)) break;
            __builtin_amdgcn_s_sleep(8);
        }
        s += __shfl_xor(s, 16); s += __shfl_xor(s, 32);
        const float r = rsqrtf(s * (1.0f / 1024.0f) + RMS_EPS);
        if (lr >= 16) *(f32x4*)(p.out + O_YS + (size_t)(lr - 16) * D + col) = vv[t] * r * *(const f32x4*)(p.g_norm_final + col);
    }
}

__device__ __forceinline__ void skinny_accum3(const SkinnyOp op, int n0, int rb0, int wave, int lane, f32x4 (&acc)[3]) {
    const int fr = lane & 15, fq = lane >> 4;
    const bf16_t* bp = op.Bt + (size_t)(n0 + fr) * op.K + 8 * fq;
    const bf16_t* ap = op.A + (size_t)(ROW_META + 16 * rb0 + fr) * op.K + 8 * fq;
    const int nks = op.K >> 5;
    for (int ks0 = wave; ks0 < nks; ks0 += 32) {
        bf16x8 b[4], a[4][3];
#pragma unroll
        for (int j = 0; j < 4; ++j) {
            const int ks = ks0 + 8 * j; const int k = (ks < nks ? ks : ks0) * 32;
            b[j] = *(const bf16x8*)(bp + k);
#pragma unroll
            for (int rb = 0; rb < 3; ++rb) a[j][rb] = *(const bf16x8*)(ap + (size_t)rb * 16 * op.K + k);
        }
#pragma unroll
        for (int j = 0; j < 4; ++j) {
            if (ks0 + 8 * j < nks) {
#pragma unroll
                for (int rb = 0; rb < 3; ++rb) acc[rb] = __builtin_amdgcn_mfma_f32_16x16x32_bf16(b[j], a[j][rb], acc[rb], 0, 0, 0);
            }
        }
    }
}
__device__ __forceinline__ f32x4 skinny_reduce3(LAS unsigned char* lds, const f32x4 (&acc)[3], int wave, int lane) {
    LAS f32x4* part = (LAS f32x4*)lds;
#pragma unroll
    for (int rb = 0; rb < 3; ++rb) part[(wave * 3 + rb) * 64 + lane] = acc[rb];
    __syncthreads();
    f32x4 r = {0.f, 0.f, 0.f, 0.f};
    if (wave < 3) {
#pragma unroll
        for (int w = 0; w < 8; ++w) r += part[(w * 3 + wave) * 64 + lane];
    }
    __syncthreads();
    return r;
}
#define ZERO3(a) _Pragma("unroll") for (int z_ = 0; z_ < 3; ++z_) a[z_] = (f32x4){0.f, 0.f, 0.f, 0.f}
__device__ __forceinline__ void tail_mix_unit3(const Params& p, LAS unsigned char* lds, int unit, int wave, int lane) {
    unsigned char* ws = p.ws; const int n0 = (unit & 63) * 16, rb0 = 3 * (unit >> 6), fr = lane & 15, fq = lane >> 4;
    f32x4 acc[3];
    ZERO3(acc); skinny_accum3(SkinnyOp{(const bf16_t*)(ws + WS_ATT), (const bf16_t*)(ws + WS_WAO), 1024}, n0, rb0, wave, lane, acc); const f32x4 va = skinny_reduce3(lds, acc, wave, lane);
    ZERO3(acc); skinny_accum3(SkinnyOp{(const bf16_t*)(ws + WS_POOL), (const bf16_t*)(ws + WS_WPO), 512}, n0, rb0, wave, lane, acc); const f32x4 vb = skinny_reduce3(lds, acc, wave, lane);
    if (wave < 3) {
        const bf16_t *GA = (const bf16_t*)(ws + WS_GA), *GP = (const bf16_t*)(ws + WS_GP); bf16_t* MIX = (bf16_t*)(ws + WS_MIX);
        const size_t off = (size_t)(ROW_META + 16 * (rb0 + wave) + fr) * 1024 + n0 + 4 * fq;
        const u32x2 ga = *(const u32x2*)(GA + off), gp = *(const u32x2*)(GP + off);
        u32x2 w; w.x = pk2(bf_lo(ga.x) * va[0] + bf_lo(gp.x) * vb[0], bf_hi(ga.x) * va[1] + bf_hi(gp.x) * vb[1]);
        w.y = pk2(bf_lo(ga.y) * va[2] + bf_lo(gp.y) * vb[2], bf_hi(ga.y) * va[3] + bf_hi(gp.y) * vb[3]);
        *(u32x2*)(MIX + off) = w;
    }
}
__device__ __forceinline__ void tail_x1_unit3(const Params& p, LAS unsigned char* lds, int unit, int wave, int lane) {
    unsigned char* ws = p.ws; const int cu = unit & 63, n0 = cu * 16, rb0 = 3 * (unit >> 6), fr = lane & 15, fq = lane >> 4;
    f32x4 acc[3];
    ZERO3(acc); skinny_accum3(SkinnyOp{(const bf16_t*)(ws + WS_MIX), (const bf16_t*)(ws + WS_WOUT), 1024}, n0, rb0, wave, lane, acc); const f32x4 va = skinny_reduce3(lds, acc, wave, lane);
    if (wave < 3) {
        bf16_t* XG = (bf16_t*)(ws + WS_XG); float* ssqt = (float*)(ws + WS_SSQT1);
        const int lr = 16 * (rb0 + wave) + fr, row = ROW_META + lr, col = n0 + 4 * fq;
        const f32x4 x = *(const f32x4*)(row_x(p.x_prompt, p.meta_tokens, p.x_sample, row) + col);
        const f32x4 v = va + x, g = *(const f32x4*)(p.g_norm_ffn + col);
        u32x2 w; w.x = pk2(v[0] * g[0], v[1] * g[1]); w.y = pk2(v[2] * g[2], v[3] * g[3]);
        *(u32x2*)(XG + (size_t)row * 1024 + col) = w;
        float ss = (v[0] * v[0] + v[1] * v[1]) + (v[2] * v[2] + v[3] * v[3]);
        ss += __shfl_xor(ss, 16); ss += __shfl_xor(ss, 32);
        if (fq == 0) ssqt[lr * 64 + cu] = ss;
    }
}
__device__ __forceinline__ void tail_down_unit3(const Params& p, LAS unsigned char* lds, int unit, int wave, int lane) {
    unsigned char* ws = p.ws; const int cu = unit & 63, n0 = cu * 16, rb0 = 3 * (unit >> 6), fr = lane & 15, fq = lane >> 4;
    f32x4 acc[3];
    ZERO3(acc); skinny_accum3(SkinnyOp{(const bf16_t*)(ws + WS_ACT), (const bf16_t*)(ws + WS_WDOWN), FF}, n0, rb0, wave, lane, acc); const f32x4 va = skinny_reduce3(lds, acc, wave, lane);
    if (wave < 3) {
        const bf16_t* XG = (const bf16_t*)(ws + WS_XG); float* ssqt = (float*)(ws + WS_SSQT2);
        const int lr = 16 * (rb0 + wave) + fr, row = ROW_META + lr, col = n0 + 4 * fq;
        const u32x2 xg = *(const u32x2*)(XG + (size_t)row * 1024 + col); const f32x4 g = *(const f32x4*)(p.g_norm_ffn + col);
        f32x4 v;
        v[0] = va[0] + bf_lo(xg.x) * __builtin_amdgcn_rcpf(g[0]); v[1] = va[1] + bf_hi(xg.x) * __builtin_amdgcn_rcpf(g[1]);
        v[2] = va[2] + bf_lo(xg.y) * __builtin_amdgcn_rcpf(g[2]); v[3] = va[3] + bf_hi(xg.y) * __builtin_amdgcn_rcpf(g[3]);
        float ss = (v[0] * v[0] + v[1] * v[1]) + (v[2] * v[2] + v[3] * v[3]);
        ss += __shfl_xor(ss, 16); ss += __shfl_xor(ss, 32);
        if (fq == 0) AG_ST(ssqt + lr * 64 + cu, ss);
        float s = 0.f;
        for (int tries = 0; tries < (1 << 16); ++tries) {
            bool ready = true; s = 0.f;
#pragma unroll
            for (int j = 0; j < 16; ++j) { const float a = AG_LD(ssqt + lr * 64 + 16 * fq + j); ready = ready && (a >= 0.f); s += a; }
            if (__all(ready)) break;
            __builtin_amdgcn_s_sleep(2);
        }
        s += __shfl_xor(s, 16); s += __shfl_xor(s, 32);
        const float r = rsqrtf(s * (1.0f / 1024.0f) + RMS_EPS);
        if (lr >= 16) *(f32x4*)(p.out + O_YS + (size_t)(lr - 16) * D + col) = v * r * *(const f32x4*)(p.g_norm_final + col);
    }
}

__device__ __forceinline__ void conv_fix(const Params& p) {
    unsigned char* ws = p.ws;
    const float* HALO = (const float*)(ws + WS_HALO); const float* UPT = (const float*)(ws + WS_UPT); bf16_t* ACT = (bf16_t*)(ws + WS_ACT);
    const float *cw = p.conv_w, *cb = p.conv_b;
    const int gt = blockIdx.x * 512 + threadIdx.x, NT = gridDim.x * 512;
    constexpr int NCH = FF / 4;
    constexpr int N_SLAB = 512 * 2 * NCH, N_SAMP = 128 * NCH;
    for (int it = gt; it < N_SLAB + N_SAMP; it += NT) {
        const float *u0, *u1, *u2; int row, j;
        if (it < N_SLAB) {
            const int ch = it % NCH, sr = it / NCH, rr = sr & 1, s = sr >> 1; j = ch * 4;
            row = s * 64 + rr;
            const float* l1 = (s & 63) ? HALO + (size_t)((s - 1) * 4 + 3) * FF2 : UPT + (size_t)15 * FF2;
            const float* l0 = (s & 63) ? HALO + (size_t)((s - 1) * 4 + 2) * FF2 : UPT + (size_t)14 * FF2;
            u0 = HALO + (size_t)(s * 4 + rr) * FF2;
            if (rr == 0) { u1 = l1; u2 = l0; } else { u1 = HALO + (size_t)(s * 4) * FF2; u2 = l1; }
        } else {
            const int t = it - N_SLAB, ch = t % NCH, q = t / NCH, b = q >> 4, i = q & 15; j = ch * 4;
            row = ROW_SAMP + q;
            u0 = UPT + (size_t)(16 + q) * FF2;
            u1 = (i >= 1) ? UPT + (size_t)(16 + q - 1) * FF2 : p.state_conv + ((size_t)b * 2 + 1) * FF2;
            u2 = (i >= 2) ? UPT + (size_t)(16 + q - 2) * FF2 : p.state_conv + ((size_t)b * 2 + i) * FF2;
        }
        const f32x4 g0 = *(const f32x4*)(u0 + j), g1 = *(const f32x4*)(u1 + j), g2 = *(const f32x4*)(u2 + j);
        const f32x4 v0 = *(const f32x4*)(u0 + FF + j), v1 = *(const f32x4*)(u1 + FF + j), v2 = *(const f32x4*)(u2 + FF + j);
        const f32x4 cg = *(const f32x4*)(cb + j) + *(const f32x4*)(cw + j) * g2 + *(const f32x4*)(cw + FF2 + j) * g1 + *(const f32x4*)(cw + 2 * FF2 + j) * g0;
        const f32x4 cv = *(const f32x4*)(cb + FF + j) + *(const f32x4*)(cw + FF + j) * v2 + *(const f32x4*)(cw + FF2 + FF + j) * v1 + *(const f32x4*)(cw + 2 * FF2 + FF + j) * v0;
        float a[4];
#pragma unroll
        for (int i = 0; i < 4; ++i) a[i] = cg[i] * sigmoidf_(cg[i]) * cv[i];
        u32x2 w; w.x = pk2(a[0], a[1]); w.y = pk2(a[2], a[3]);
        *(u32x2*)(ACT + (size_t)row * FF + j) = w;
    }
    { f32x4* q4 = (f32x4*)(ws + WS_SSQ2); for (int i = gt; i < MREAL * 4; i += NT) q4[i] = (f32x4){-1.f, -1.f, -1.f, -1.f};
      f32x4* t4 = (f32x4*)(ws + WS_SSQT2); for (int i = gt; i < 144 * 16; i += NT) t4[i] = (f32x4){-1.f, -1.f, -1.f, -1.f};
      unsigned* pc = (unsigned*)(ws + WS_PCNT); for (int i = gt; i < 128; i += NT) pc[64 * i] = 0u; }
    for (int i = gt; i < 8 * 2 * FF2; i += NT) {
        const int c = i % FF2, k = (i / FF2) & 1, b = i / (2 * FF2);
        p.out[O_PCONV + i] = HALO[(size_t)((b * 64 + 63) * 4 + 2 + k) * FF2 + c];
        p.out[O_SCONV + i] = UPT[(size_t)(16 + b * 16 + 14 + k) * FF2 + c];
    }
}
__device__ __forceinline__ void final_norm(const Params& p, int wave, int lane) {
    const float* ssq = (const float*)(p.ws + WS_SSQ2);
    const int gw = blockIdx.x * 8 + wave, NGW = gridDim.x * 8;
    f32x4 gv[4];
#pragma unroll
    for (int j = 0; j < 4; ++j) gv[j] = ((const f32x4*)p.g_norm_final)[lane + 64 * j];
    for (int m0 = gw * 4; m0 < MREAL + 128; m0 += NGW * 4) {
        float sv[4]; f32x4 x[4][4]; float* orow[4];
#pragma unroll
        for (int q = 0; q < 4; ++q) {
            const int m = m0 + q;
            orow[q] = m < MREAL ? p.out + O_YP + (size_t)m * D : p.out + O_YS + (size_t)(m - MREAL) * D;
            if (m < MREAL) sv[q] = ssq[(size_t)m * 16 + (lane & 15)];
            else { const float* st = (const float*)(p.ws + WS_SSQT2) + (16 + m - MREAL) * 64; sv[q] = (st[lane & 15] + st[16 + (lane & 15)]) + (st[32 + (lane & 15)] + st[48 + (lane & 15)]); }
#pragma unroll
            for (int j = 0; j < 4; ++j) x[q][j] = ((const f32x4*)orow[q])[lane + 64 * j];
        }
#pragma unroll
        for (int q = 0; q < 4; ++q) {
            float s = sv[q];
            s += __shfl_xor(s, 1); s += __shfl_xor(s, 2); s += __shfl_xor(s, 4); s += __shfl_xor(s, 8);
            const float r = rsqrtf(s * (1.0f / D) + RMS_EPS);
#pragma unroll
            for (int j = 0; j < 4; ++j) ((f32x4*)orow[q])[lane + 64 * j] = x[q][j] * r * gv[j];
        }
    }
}


struct EpiNull {
    static constexpr bool PERM = true, AFTER_DRAIN = false;
    float* sink;
    __device__ __forceinline__ void operator()(const f32x4 (&acc)[2][2][4][2], const Unit& u, int wr, int wc, int fr, int fq) const {
        f32x4 t = {0.f, 0.f, 0.f, 0.f};
#pragma unroll
        for (int a = 0; a < 2; ++a)
#pragma unroll
            for (int b = 0; b < 2; ++b)
#pragma unroll
                for (int m = 0; m < 4; ++m)
#pragma unroll
                    for (int n = 0; n < 2; ++n) t += acc[a][b][m][n];
        if (t[0] + t[1] + t[2] + t[3] == 123456.789f) sink[threadIdx.x] = t[0];
    }
};
struct SamePanelOrder {
    int G, c, nr;
    __device__ bool next(int i, Unit& u) const { if (i >= nr) return false; u.pm = 0; u.pn = (c >> 6) & 3; return true; }
    __device__ __forceinline__ void a_ready(const Unit&) const {}
    __device__ __forceinline__ void done(const Unit&) const {}
};

typedef unsigned v4u_unused_t;
#define XB_TMO      128
#define XB_XCNT(j)  (256  + 64 * (j))
#define XB_XSUB(j)  (1280 + 64 * (j))
#define XB_XGEN(j)  (2304 + 64 * (j))
#define XB_TOP      3328
#define XB_TOPGEN   3392
#define XCD_BAR_WORDS 3456
#define XB_SPIN_CAP (1u << 18)

__device__ __forceinline__ unsigned xb_ld(unsigned* p)              { return __hip_atomic_load(p, __ATOMIC_RELAXED, __HIP_MEMORY_SCOPE_AGENT); }
__device__ __forceinline__ unsigned xb_add(unsigned* p, unsigned v) { return __hip_atomic_fetch_add(p, v, __ATOMIC_RELAXED, __HIP_MEMORY_SCOPE_AGENT); }
__device__ __forceinline__ unsigned xb_xcc_id() { return (unsigned)__builtin_amdgcn_s_getreg((3 << 11) | 20) & 0xFu; }
#define XB_SPIN(cond, bar) do { unsigned _sp = 0; while (cond) { __builtin_amdgcn_s_sleep(1); \
    if ((++_sp & 255u) == 0u) { if (xb_ld(&(bar)[XB_TMO])) break; if (_sp > XB_SPIN_CAP) { atomicAdd(&(bar)[XB_TMO], 1u); break; } } } } while (0)

struct XcdBarrier {
    unsigned* bar; unsigned x;
    volatile LAS unsigned* st;
};

__device__ __forceinline__ XcdBarrier xcd_barrier_post(unsigned* bar, volatile LAS unsigned* st) {
    XcdBarrier b; b.bar = bar; b.x = xb_xcc_id(); b.st = st;
    if (threadIdx.x == 0) (void)xb_add(&bar[XB_XCNT(b.x)], 1u);
    return b;
}
__device__ __forceinline__ void xcd_barrier_complete(unsigned* bar, unsigned x, unsigned& nloc, unsigned& nx) {
    const unsigned G = gridDim.x * gridDim.y * gridDim.z;
    unsigned sum, cnt, mine, sp = 0u;
    for (;;) {
        sum = 0u; cnt = 0u; mine = 0u;
#pragma unroll
        for (unsigned j = 0; j < 16; ++j) { const unsigned c = xb_ld(&bar[XB_XCNT(j)]); sum += c; cnt += (c > 0u) ? 1u : 0u; mine = (j == x) ? c : mine; }
        if (sum == G) break;
        __builtin_amdgcn_s_sleep(1);
        if ((++sp & 255u) == 0u) { if (xb_ld(&bar[XB_TMO])) break; if (sp > XB_SPIN_CAP) { atomicAdd(&bar[XB_TMO], 1u); break; } }
    }
    nloc = mine > 0u ? mine : 1u; nx = cnt > 0u ? cnt : 1u;
}

__device__ __forceinline__ void xcd_barrier(const XcdBarrier& b) {
    asm volatile("s_waitcnt vmcnt(0)" ::: "memory");
    __syncthreads();
    if (threadIdx.x == 0) {
        unsigned* bar = b.bar;
        __builtin_amdgcn_s_waitcnt(0);
        unsigned nloc = b.st[0], nx = b.st[1];
        if (nloc == 0u) { xcd_barrier_complete(bar, b.x, nloc, nx); b.st[0] = nloc; b.st[1] = nx; }
        const unsigned old = xb_add(&bar[XB_XSUB(b.x)], 1u);
        const unsigned gen = old / nloc;
        if (old + 1u == (gen + 1u) * nloc) {
            __builtin_amdgcn_fence(__ATOMIC_RELEASE, "agent");
            asm volatile("s_waitcnt vmcnt(0)" ::: "memory");
            const unsigned og = xb_add(&bar[XB_TOP], 1u);
            const unsigned tg = og / nx;
            if (og + 1u == (tg + 1u) * nx) xb_add(&bar[XB_TOPGEN], 1u);
            else XB_SPIN(xb_ld(&bar[XB_TOPGEN]) == tg, bar);
            __builtin_amdgcn_fence(__ATOMIC_ACQUIRE, "agent");
            xb_add(&bar[XB_XGEN(b.x)], 1u);
            asm volatile("s_waitcnt vmcnt(0)" ::: "memory");
        } else {
            XB_SPIN(xb_ld(&bar[XB_XGEN(b.x)]) == gen, bar);
            __builtin_amdgcn_fence(__ATOMIC_ACQUIRE, "agent");
            asm volatile("s_waitcnt vmcnt(0)" ::: "memory");
        }
    }
    __syncthreads();
}

__device__ __forceinline__ void grid_bar(unsigned* ctr, unsigned target) {
    asm volatile("s_waitcnt vmcnt(0) lgkmcnt(0)" ::: "memory");
    __syncthreads();
    if (threadIdx.x == 0) {
        __hip_atomic_fetch_add(ctr, 1u, __ATOMIC_RELEASE, __HIP_MEMORY_SCOPE_AGENT);
        unsigned spins = 0;
        while (__hip_atomic_load(ctr, __ATOMIC_RELAXED, __HIP_MEMORY_SCOPE_AGENT) < target) { __builtin_amdgcn_s_sleep(2); if (++spins > (1u << 24)) break; }
        __builtin_amdgcn_fence(__ATOMIC_ACQUIRE, "agent");
        asm volatile("s_waitcnt vmcnt(0)" ::: "memory");
    }
    __syncthreads();
}
__global__ void __launch_bounds__(512, 2) fwd_megakernel(Params p) {
    extern __shared__ __attribute__((aligned(16))) unsigned char lds_raw[];
    LAS unsigned char* lds = (LAS unsigned char*)lds_raw;
    cg::grid_group grid = cg::this_grid();
    const int wave = __builtin_amdgcn_readfirstlane(threadIdx.x >> 6);
#define TIDLANE() int tid = threadIdx.x; asm volatile("" : "+v"(tid)); const int lane = tid & 63
    unsigned char* ws = p.ws;
    const int lo = p.ph_lo, hi = p.ph_hi, G = gridDim.x;
#define IN(k) (lo <= (k) && (k) < hi)
#define SEAM(k) do { if (IN(k) && IN((k) + 1)) xcd_barrier(xbar); } while (0)
    if (lo < 0) grid.sync();
    volatile LAS unsigned* xst = (volatile LAS unsigned*)(lds + LDS_BYTES - 32);
    if (threadIdx.x < 2) xst[threadIdx.x] = 0u;
    __syncthreads();
    XcdBarrier xbar = xcd_barrier_post((unsigned*)(ws + 4096), xst);
    if (IN(0)) { TIDLANE(); (void)tid; p0_prologue(p, lds, wave, lane); __syncthreads(); }
    SEAM(0);
    if (IN(1)) {
        pg8::Gemm g{(const bf16_t*)(ws + WS_XN), (const bf16_t*)(ws + WS_WIN), M, INW, D}; pg8::StaticOrder S; S.init(M, INW, G, (int)blockIdx.x);
        EpiZ E{(bf16_t*)(ws + WS_Q), (bf16_t*)(ws + WS_K), (bf16_t*)(ws + WS_V), (bf16_t*)(ws + WS_P), (bf16_t*)(ws + WS_GA), (bf16_t*)(ws + WS_GP), p.b_gate, (const float*)(ws + WS_ROPE)};
        pg8::gemm_phase<EpiZ, pg8::StaticOrder, true, true>(lds, g, S, E);
    }
    SEAM(1);
    if (IN(2)) {
        TIDLANE();
        for (int unit = blockIdx.x; unit < 1024; unit += G) attn_chunk_unit(p, lds, unit, tid, wave, lane);
        constexpr int N_EXTRA = 27;
        if (G > 2 * N_EXTRA) {
            if ((int)blockIdx.x < N_EXTRA) { const int e = blockIdx.x; if (e < 18) attn_small_unit(p, lds, e, tid, wave, lane); else pool_unit(p, lds, 512 + e - 18, tid, wave, lane); }
            else for (int unit = blockIdx.x - N_EXTRA; unit < 512; unit += G - N_EXTRA) pool_unit(p, lds, unit, tid, wave, lane);
        } else {
            for (int unit = blockIdx.x; unit < 18 + 521; unit += G) { if (unit < 18) attn_small_unit(p, lds, unit, tid, wave, lane); else pool_unit(p, lds, unit - 18, tid, wave, lane); }
        }
        small_outputs(p);
    }
    SEAM(2);
    if (IN(3)) {
        { TIDLANE(); (void)tid; for (int unit = blockIdx.x; unit < 192; unit += G) tail_mix_unit3(p, lds, unit, wave, lane); }
        { pg8::Gemm g{(const bf16_t*)(ws + WS_ATT), (const bf16_t*)(ws + WS_WAO), MREAL, D, D}; pg8::StaticOrder S; S.init(MREAL, D, G, (int)blockIdx.x);
          EpiT1 E{(const bf16_t*)(ws + WS_GA), (bf16_t*)(ws + WS_MIX)};
          pg8::gemm_phase<EpiT1, pg8::StaticOrder, true, true>(lds, g, S, E); }
        __syncthreads();
        { pg8::Gemm g{(const bf16_t*)(ws + WS_POOL), (const bf16_t*)(ws + WS_WPO), MREAL, D, PW}; pg8::StaticOrder S; S.init(MREAL, D, G, (int)blockIdx.x);
          EpiMix E{(const bf16_t*)(ws + WS_GP), (bf16_t*)(ws + WS_MIX)};
          pg8::gemm_phase<EpiMix, pg8::StaticOrder, true, true>(lds, g, S, E); }
    }
    SEAM(3);
    if (IN(4)) {
        { TIDLANE(); (void)tid; for (int unit = blockIdx.x; unit < 192; unit += G) tail_x1_unit3(p, lds, unit, wave, lane); }
        pg8::Gemm g{(const bf16_t*)(ws + WS_MIX), (const bf16_t*)(ws + WS_WOUT), MREAL, D, D}; pg8::StaticOrder S; S.init(MREAL, D, G, (int)blockIdx.x);
        EpiX1 E{(const bf16_t*)(ws + WS_XN), (const float*)(ws + WS_R0I), p.g_norm_mix, p.g_norm_ffn, (bf16_t*)(ws + WS_XG), (float*)(ws + WS_SSQ1)};
        pg8::gemm_phase<EpiX1, pg8::StaticOrder, true, true>(lds, g, S, E);
    }
    SEAM(4);
    if (IN(5)) {
        { TIDLANE(); (void)tid; for (int unit = blockIdx.x; unit < FF2 / 16; unit += G) tail_up_unit(p, lds, unit, wave, lane); }
        pg8::Gemm g{(const bf16_t*)(ws + WS_XG), (const bf16_t*)(ws + WS_WUP), MREAL, FF2, D}; pg8::StaticOrder S; S.init(MREAL, FF2, G, (int)blockIdx.x);
        EpiUp E{(const float*)(ws + WS_SSQ1), p.conv_w, p.conv_b, (bf16_t*)(ws + WS_ACT), (float*)(ws + WS_HALO), (float*)(ws + WS_UPT)};
        pg8::gemm_phase<EpiUp, pg8::StaticOrder, true, true>(lds, g, S, E);
    }
    SEAM(5);
    if (IN(6)) conv_fix(p);
    SEAM(6);
    if (IN(7)) {
        { TIDLANE(); (void)tid; for (int unit = blockIdx.x; unit < 192; unit += G) tail_down_unit3(p, lds, unit, wave, lane); }
        pg8::Gemm g{(const bf16_t*)(ws + WS_ACT), (const bf16_t*)(ws + WS_WDOWN), MREAL, D, FF}; pg8::StaticOrder S; S.init(MREAL, D, G, (int)blockIdx.x, 1);
        EpiDown E{(const bf16_t*)(ws + WS_XG), p.g_norm_ffn, p.g_norm_final, p.out, (float*)(ws + WS_SSQ2)};
        pg8::gemm_phase<EpiDown, pg8::StaticOrder, true, true>(lds, g, S, E);
    }
    if (IN(8)) { TIDLANE(); for (int unit = blockIdx.x; unit < 1024; unit += G) attn_chunk_unit(p, lds, unit, tid, wave, lane); }
    if (IN(9)) { TIDLANE(); for (int unit = blockIdx.x; unit < 512; unit += G) pool_unit(p, lds, unit, tid, wave, lane); }
    if (IN(12)) { TIDLANE(); for (int unit = 512 + blockIdx.x; unit < 521; unit += G) pool_unit(p, lds, unit, tid, wave, lane); }
    if (IN(10)) { TIDLANE(); for (int unit = blockIdx.x; unit < 18; unit += G) attn_small_unit(p, lds, unit, tid, wave, lane); }
    if (IN(11)) { small_outputs(p); }
    if (IN(17)) { pg8::Gemm g{(const bf16_t*)(ws + WS_ACT), (const bf16_t*)(ws + WS_WDOWN), MREAL, D, FF}; pg8::StaticOrder S; S.init(MREAL, D, G, (int)blockIdx.x, 1);
        EpiDown E{(const bf16_t*)(ws + WS_XG), p.g_norm_ffn, p.g_norm_final, p.out, (float*)(ws + WS_SSQ2)};
        pg8::gemm_phase<EpiDown, pg8::StaticOrder, true, true>(lds, g, S, E); }
    if (IN(18)) { TIDLANE(); (void)tid; for (int unit = blockIdx.x; unit < 192; unit += G) tail_down_unit3(p, lds, unit, wave, lane); }
    if (IN(14)) { pg8::Gemm g{(const bf16_t*)(ws + WS_ACT), (const bf16_t*)(ws + WS_WDOWN), MREAL, D, FF}; pg8::StaticOrder S; S.init(MREAL, D, G, (int)blockIdx.x, 1); EpiNull E{(float*)(ws + WS_SSQ1)};
        pg8::gemm_phase<EpiNull, pg8::StaticOrder, true, true>(lds, g, S, E); }
    if (IN(15)) { pg8::Gemm g{(const bf16_t*)(ws + WS_ACT), (const bf16_t*)(ws + WS_WDOWN), MREAL, D, FF}; SamePanelOrder S{G, (int)blockIdx.x, 2}; EpiNull E{(float*)(ws + WS_SSQ1)};
        pg8::gemm_phase<EpiNull, SamePanelOrder, true, true>(lds, g, S, E); }
    if (IN(16)) { pg8::Gemm g{(const bf16_t*)(ws + WS_MIX), (const bf16_t*)(ws + WS_WOUT), MREAL, D, D}; pg8::StaticOrder S; S.init(MREAL, D, G, (int)blockIdx.x); EpiNull E{(float*)(ws + WS_SSQ1)};
        pg8::gemm_phase<EpiNull, pg8::StaticOrder, true, true>(lds, g, S, E); }
#undef IN
#undef SEAM
}

#ifndef MK_N_LAUNCHES
#define MK_N_LAUNCHES 1
#endif
#ifndef PROBE_PHASE
#define PROBE_PHASE -1
#endif
extern "C" void kernel_launch(void* const* d_in, const int* in_sizes, int n_in, void* d_out, int out_size, void* d_ws, size_t ws_size, hipStream_t stream) {
    static int grid = 0;
    if (grid == 0) {
        if (n_in != 24 || (size_t)out_size != O_END || ws_size < WS_END) { fprintf(stderr, "kernel_launch: unexpected shapes: n_in %d out %d ws %zu (need %zu)\n", n_in, out_size, ws_size, (size_t)WS_END); grid = -1; return; }
        int dev = 0, cus = 0, per_cu = 0;
        hipGetDevice(&dev); hipDeviceGetAttribute(&cus, hipDeviceAttributeMultiprocessorCount, dev);
        if (hipFuncSetAttribute((const void*)fwd_megakernel, hipFuncAttributeMaxDynamicSharedMemorySize, LDS_BYTES) != hipSuccess) { fprintf(stderr, "kernel_launch: hipFuncSetAttribute failed\n"); grid = -1; return; }
        if (hipOccupancyMaxActiveBlocksPerMultiprocessor(&per_cu, (const void*)fwd_megakernel, 512, LDS_BYTES) != hipSuccess || per_cu < 1) { fprintf(stderr, "kernel_launch: occupancy query gave %d\n", per_cu); per_cu = 1; }
        (void)hipGetLastError();
        grid = cus;
        fprintf(stderr, "kernel_launch: grid %d (per_cu %d)\n", grid, per_cu);
    }
    if (grid < 0) return;
    Params p{};
    const float** pp = (const float**)&p;
    for (int i = 0; i < 24; ++i) pp[i] = (const float*)d_in[i];
    p.out = (float*)d_out; p.ws = (unsigned char*)d_ws;
    for (int i = 0; i < 32; ++i) p.inv_freq[i] = powf(10000.0f, -(float)i / 32.0f);
    const int NPH = 8;
    int seq[8][2]; int nseq = 0;
    if (PROBE_PHASE >= NPH) { seq[0][0] = 0; seq[0][1] = NPH; seq[1][0] = PROBE_PHASE; seq[1][1] = PROBE_PHASE + 1; nseq = 2; }
    else if (PROBE_PHASE >= 0) { seq[0][0] = 0; seq[0][1] = PROBE_PHASE + 1; seq[1][0] = PROBE_PHASE; seq[1][1] = PROBE_PHASE + 1; nseq = 2; if (PROBE_PHASE + 1 < NPH) { seq[2][0] = PROBE_PHASE + 1; seq[2][1] = NPH; nseq = 3; } }
    else { seq[0][0] = 0; seq[0][1] = NPH; nseq = 1; }
    for (int k = 0; k < nseq; ++k) {
        if (hipMemsetAsync(d_ws, 0, 32768, stream) != hipSuccess) fprintf(stderr, "kernel_launch: memset failed\n");
        p.ph_lo = seq[k][0]; p.ph_hi = seq[k][1];
        void* args[] = {&p}; hipError_t e = hipLaunchCooperativeKernel((const void*)fwd_megakernel, dim3(grid), dim3(512), args, LDS_BYTES, stream);
        if (e != hipSuccess) fprintf(stderr, "kernel_launch: cooperative launch %d failed: %s\n", k, hipGetErrorString(e));
    }
}
```

```cpp
#include <hip/hip_runtime.h>
#include <hip/hip_cooperative_groups.h>
#include <cstdio>
#include <cstdint>
#include <cmath>
namespace cg = cooperative_groups;
namespace pg8 {
#define PG8_LAS __attribute__((address_space(3)))
typedef unsigned short bf16_t;
typedef short bf16x8 __attribute__((ext_vector_type(8)));
typedef float f32x4 __attribute__((ext_vector_type(4)));
typedef unsigned u32x4 __attribute__((ext_vector_type(4)));
constexpr int BM = 256, BK = 64, HALF = 128, HTB = HALF * BK * 2  , STAGE_BYTES = 8 * HTB, NXCD = 8, WGM = 8;

__host__ __device__ __forceinline__ int lds_byte(int r, int c) { const int st = (r >> 4) * 2 + (c >> 5), rr = r & 15, cc = c & 31, ob = rr * 64 + cc * 2; return st * 1024 + (ob ^ (((ob >> 9) & 1) << 5)); }
__host__ __device__ __forceinline__ void stage_rc(int b, int& R, int& C) { const int st = b / 1024, sb = b % 1024, swz = sb ^ (((sb >> 9) & 1) << 5); R = (st >> 1) * 16 + swz / 64; C = (st & 1) * 32 + (swz % 64) / 2; }
__host__ __device__ __forceinline__ int perm32(int rho) { const int n = rho >> 4, i = rho & 15; return 8 * (i >> 2) + 4 * n + (i & 3); }

struct Unit { int pm, pn; };
struct Gemm { const bf16_t* A; const bf16_t* Bt; int M, N, K; };

struct StaticOrder {
    int nM, nN, nwg, G, c, rev;
    __host__ __device__ void init(int M, int N, int G_, int c_, int rev_ = 0) { nM = M / BM; nN = N / BM; nwg = nM * nN; G = G_; c = c_; rev = rev_; }
    __host__ __device__ bool next(int i, Unit& u) const {
        const int nr = (nwg + G - 1) / G;
        if (i >= nr) return false;
        const long L = (long)((rev && nwg % G == 0) ? nr - 1 - i : i) * G + c; if (L >= nwg) return false;
        int wgid = (int)L; { const int q = nwg / NXCD, r = nwg % NXCD, xcd = wgid % NXCD, off = wgid / NXCD; wgid = (xcd < r ? xcd * (q + 1) : r * (q + 1) + (xcd - r) * q) + off; }
        const int nig = WGM * nN, gid = wgid / nig, fm = gid * WGM, gsz = (nM - fm) < WGM ? (nM - fm) : WGM;
        u.pm = fm + ((wgid % nig) % gsz); u.pn = (wgid % nig) / gsz; return true;
    }
    __device__ __forceinline__ void a_ready(const Unit&) const {}
    __device__ __forceinline__ void done(const Unit&) const {}
};

__device__ __forceinline__ unsigned cvt_pk_bf16(float lo, float hi) { unsigned r; asm volatile("v_cvt_pk_bf16_f32 %0, %1, %2" : "=v"(r) : "v"(lo), "v"(hi)); return r; }
template <class Epi, class Sched, bool ALIGN_EPI = false, bool SP2 = false>
__device__ __forceinline__ void gemm_phase(PG8_LAS unsigned char* lds, const Gemm g, const Sched& S, const Epi& E) {
    const int tid = threadIdx.x, wid = __builtin_amdgcn_readfirstlane(tid >> 6), lane = tid & 63, wr = wid >> 2, wc = wid & 3, fr = lane & 15, fq = lane >> 4;
    const int K = g.K, nt = K / BK;
    unsigned voffA[2], voffB[2];
#pragma unroll
    for (int i = 0; i < 2; ++i) { int R, C; stage_rc(tid * 16 + i * 8192, R, C); const int Rb = Epi::PERM ? ((R & ~31) + perm32(R & 31)) : R;
        const int Ra = Epi::APERM ? ((R >> 6) * 128 + (R & 63)) : R;
        voffA[i] = (unsigned)(Ra * K + C) * 2u; voffB[i] = (unsigned)(Rb * K + C) * 2u; }
    const size_t kstep = (size_t)(BK * 2);
    const size_t hstep = (size_t)HALF * K * 2;
    const size_t tstep = 2 * hstep;
    const size_t hstepA = Epi::APERM ? (size_t)64 * K * 2 : hstep;
    const unsigned ldsw = (unsigned)wid * 1024u;
    const int aoff = lds_byte(wr * 64 + fr, fq * 8), boff = lds_byte(wc * 32 + fr, fq * 8);
#define PG8_SA(b, h) (((b) * 2 + (h)) * HTB)
#define PG8_SB(b, h) ((4 + (b) * 2 + (h)) * HTB)
#define PG8_STAGE(bufoff, gbase, voff) do { _Pragma("unroll") for (int _i = 0; _i < 2; ++_i) \
        __builtin_amdgcn_global_load_lds((const unsigned*)((const char*)(gbase) + (voff)[_i]), (PG8_LAS unsigned*)(lds + (bufoff) + ldsw + _i * 8192), 16, 0, 0); } while (0)
#define PG8_LDA(dst, b, h) do { _Pragma("unroll") for (int m = 0; m < 4; ++m) _Pragma("unroll") for (int k = 0; k < 2; ++k) dst[m][k] = *(const PG8_LAS bf16x8*)(lds + PG8_SA(b, h) + aoff + m * 2048 + k * 1024); } while (0)
#define PG8_LDB(dst, b, h) do { _Pragma("unroll") for (int n = 0; n < 2; ++n) _Pragma("unroll") for (int k = 0; k < 2; ++k) dst[n][k] = *(const PG8_LAS bf16x8*)(lds + PG8_SB(b, h) + boff + n * 2048 + k * 1024); } while (0)
#define PG8_MMA(ai, bj, At, Bt) do { __builtin_amdgcn_s_setprio(1); _Pragma("unroll") for (int m = 0; m < 4; ++m) _Pragma("unroll") for (int n = 0; n < 2; ++n) _Pragma("unroll") for (int k = 0; k < 2; ++k) \
        acc[ai][bj][m][n] = __builtin_amdgcn_mfma_f32_16x16x32_bf16(Bt[n][k], At[m][k], acc[ai][bj][m][n], 0, 0, 0); __builtin_amdgcn_s_setprio(0); } while (0)
#define PG8_WAIT_V(n) asm volatile("s_waitcnt vmcnt(" #n ")" ::: "memory")
#define PG8_WAIT_L(n) asm volatile("s_waitcnt lgkmcnt(" #n ")" ::: "memory")
#define PG8_BAR __builtin_amdgcn_s_barrier()
#define PG8_SCHED __builtin_amdgcn_sched_barrier(0)
    Unit cur, nxt; int ui = 0;
    if (!S.next(0, cur)) return;
    f32x4 acc[2][2][4][2];
#pragma unroll
    for (int a = 0; a < 2; ++a)
#pragma unroll
        for (int b = 0; b < 2; ++b)
#pragma unroll
            for (int m = 0; m < 4; ++m)
#pragma unroll
                for (int n = 0; n < 2; ++n) acc[a][b][m][n] = (f32x4){0.f, 0.f, 0.f, 0.f};
    bf16x8 At[4][2], B0[2][2], B1[2][2];
    const char* cA = (const char*)g.A + (size_t)cur.pm * tstep; const char* cB = (const char*)g.Bt + (size_t)cur.pn * tstep;
    S.a_ready(cur);
    if constexpr (SP2) {
        PG8_STAGE(PG8_SB(0, 0), cB, voffB); PG8_STAGE(PG8_SB(0, 1), cB + hstep, voffB); PG8_STAGE(PG8_SA(0, 0), cA, voffA); PG8_STAGE(PG8_SA(0, 1), cA + hstepA, voffA);
        if (wr == 1) PG8_BAR;
        PG8_WAIT_V(2); PG8_BAR;
        PG8_STAGE(PG8_SB(1, 0), cB + kstep, voffB); PG8_STAGE(PG8_SA(1, 0), cA + kstep, voffA); PG8_STAGE(PG8_SB(1, 1), cB + hstep + kstep, voffB);
        PG8_WAIT_V(6); PG8_BAR;
    } else {
        PG8_STAGE(PG8_SB(0, 0), cB, voffB); PG8_STAGE(PG8_SA(0, 0), cA, voffA); PG8_STAGE(PG8_SB(0, 1), cB + hstep, voffB); PG8_STAGE(PG8_SA(0, 1), cA + hstepA, voffA);
        if (wr == 1) PG8_BAR;
        PG8_WAIT_V(4); PG8_BAR;
        PG8_STAGE(PG8_SB(1, 0), cB + kstep, voffB); PG8_STAGE(PG8_SA(1, 0), cA + kstep, voffA); PG8_STAGE(PG8_SB(1, 1), cB + hstep + kstep, voffB);
        PG8_WAIT_V(6); PG8_BAR;
    }
    for (;;) {
        const bool has_next = S.next(ui + 1, nxt);
        const char* nA = has_next ? (const char*)g.A + (size_t)nxt.pm * tstep : cA; const char* nB = has_next ? (const char*)g.Bt + (size_t)nxt.pn * tstep : cB;
        for (int t = 0; t < nt; t += 2) {
            const bool last = (t == nt - 2);
            const char* a1 = cA + (size_t)(t + 1) * kstep;
            const char* a2 = last ? nA : cA + (size_t)(t + 2) * kstep; const char* b2 = last ? nB : cB + (size_t)(t + 2) * kstep;
            const char* a3 = a2 + kstep; const char* b3 = b2 + kstep;
            if (last && has_next) S.a_ready(nxt);
            if constexpr (SP2) {
            PG8_LDB(B0, 0, 0); PG8_LDB(B1, 0, 1); PG8_SCHED; PG8_LDA(At, 0, 0); PG8_STAGE(PG8_SA(1, 1), a1 + hstepA, voffA);
            PG8_WAIT_V(8); PG8_WAIT_L(0); PG8_BAR; PG8_MMA(0, 0, At, B0); PG8_MMA(0, 1, At, B1); PG8_BAR; PG8_SCHED;
            PG8_LDA(At, 0, 1); PG8_STAGE(PG8_SB(0, 0), b2, voffB); PG8_STAGE(PG8_SB(0, 1), b2 + hstep, voffB); PG8_STAGE(PG8_SA(0, 0), a2, voffA);
            PG8_WAIT_V(8); PG8_WAIT_L(0); PG8_BAR; PG8_MMA(1, 0, At, B0); PG8_MMA(1, 1, At, B1); PG8_BAR; PG8_SCHED;
            PG8_LDB(B0, 1, 0); PG8_LDB(B1, 1, 1); PG8_SCHED; PG8_LDA(At, 1, 0); PG8_STAGE(PG8_SA(0, 1), a2 + hstepA, voffA);
            PG8_WAIT_V(8); PG8_WAIT_L(0); PG8_BAR; PG8_MMA(0, 0, At, B0); PG8_MMA(0, 1, At, B1); PG8_BAR; PG8_SCHED;
            PG8_LDA(At, 1, 1); PG8_STAGE(PG8_SB(1, 0), b3, voffB); PG8_STAGE(PG8_SB(1, 1), b3 + hstep, voffB); PG8_STAGE(PG8_SA(1, 0), a3, voffA);
            PG8_WAIT_V(8); PG8_WAIT_L(0); PG8_BAR; PG8_MMA(1, 0, At, B0); PG8_MMA(1, 1, At, B1); PG8_BAR; PG8_SCHED;
            } else {
            PG8_LDB(B0, 0, 0); PG8_SCHED; PG8_LDA(At, 0, 0); PG8_STAGE(PG8_SA(1, 1), a1 + hstepA, voffA);
            PG8_WAIT_L(8); PG8_BAR; PG8_WAIT_L(0); PG8_MMA(0, 0, At, B0); PG8_BAR; PG8_SCHED;
            PG8_LDB(B1, 0, 1); PG8_STAGE(PG8_SB(0, 0), b2, voffB);
            PG8_BAR; PG8_WAIT_L(0); PG8_MMA(0, 1, At, B1); PG8_BAR;
            PG8_LDA(At, 0, 1); PG8_STAGE(PG8_SA(0, 0), a2, voffA);
            PG8_BAR; PG8_WAIT_L(0); PG8_MMA(1, 0, At, B0); PG8_BAR; PG8_SCHED;
            PG8_STAGE(PG8_SB(0, 1), b2 + hstep, voffB);
            PG8_WAIT_V(6); PG8_BAR; PG8_MMA(1, 1, At, B1); PG8_BAR;
            PG8_LDB(B0, 1, 0); PG8_SCHED; PG8_LDA(At, 1, 0); PG8_STAGE(PG8_SA(0, 1), a2 + hstepA, voffA);
            PG8_WAIT_L(8); PG8_BAR; PG8_WAIT_L(0); PG8_MMA(0, 0, At, B0); PG8_BAR; PG8_SCHED;
            PG8_LDB(B1, 1, 1); PG8_STAGE(PG8_SB(1, 0), b3, voffB);
            PG8_BAR; PG8_WAIT_L(0); PG8_MMA(0, 1, At, B1); PG8_BAR;
            PG8_LDA(At, 1, 1); PG8_STAGE(PG8_SA(1, 0), a3, voffA);
            PG8_BAR; PG8_WAIT_L(0); PG8_MMA(1, 0, At, B0); PG8_BAR; PG8_SCHED;
            PG8_STAGE(PG8_SB(1, 1), b3 + hstep, voffB);
            PG8_WAIT_V(6); PG8_BAR; PG8_MMA(1, 1, At, B1); PG8_BAR;
            }
        }
        if constexpr (ALIGN_EPI) { if (wr == 0) PG8_BAR; }
        if constexpr (!Epi::AFTER_DRAIN) { E(acc, cur, wr, wc, fr, fq); S.done(cur); }
        if (!has_next) break;
#pragma unroll
        for (int a = 0; a < 2; ++a)
#pragma unroll
            for (int b = 0; b < 2; ++b)
#pragma unroll
                for (int m = 0; m < 4; ++m)
#pragma unroll
                    for (int n = 0; n < 2; ++n) acc[a][b][m][n] = (f32x4){0.f, 0.f, 0.f, 0.f};
        cur = nxt; cA = nA; cB = nB; ++ui;
        if constexpr (ALIGN_EPI) { if (wr == 1) PG8_BAR; }
    }
    PG8_WAIT_V(0);
    if constexpr (!ALIGN_EPI) { if (wr == 0) PG8_BAR; }
    PG8_BAR;
    if constexpr (Epi::AFTER_DRAIN) { E.fused(acc, cur, wr, wc, fr, fq, lds, wid, lane); S.done(cur); }
#undef PG8_SA
#undef PG8_SB
#undef PG8_STAGE
#undef PG8_LDA
#undef PG8_LDB
#undef PG8_MMA
#undef PG8_WAIT_V
#undef PG8_WAIT_L
#undef PG8_BAR
#undef PG8_SCHED
}
}

using pg8::bf16_t; using pg8::bf16x8; using pg8::f32x4; using pg8::u32x4; using pg8::Unit;
#define LAS __attribute__((address_space(3)))
typedef float f32x2v __attribute__((ext_vector_type(2)));
typedef __bf16 bf16x2v __attribute__((ext_vector_type(2)));
typedef unsigned u32x2 __attribute__((ext_vector_type(2)));

constexpr int D = 1024, NBATCH = 8, SEQ = 4096;
constexpr int MREAL = NBATCH * SEQ;
constexpr int ROW_META = MREAL;
constexpr int ROW_SAMP = MREAL + 16;
constexpr int ROW_PAD = ROW_SAMP + 128;
constexpr int M = MREAL + 256;
constexpr int INW = 3840, FF = 2816, FF2 = 5632, PW = 512;
constexpr float RMS_EPS = 1e-6f;
constexpr int NPOS = 4112;

constexpr size_t MiB = 1u << 20;
constexpr size_t WS_ROPE = 1 * MiB, WS_SSQ1 = 3 * MiB, WS_SSQ2 = 6 * MiB;
constexpr size_t WS_WIN = 9 * MiB, WS_WAO = 17 * MiB, WS_WPO = 19 * MiB, WS_WOUT = 20 * MiB, WS_WUP = 22 * MiB, WS_WDOWN = 33 * MiB, WS_WGRP = 39 * MiB;
constexpr size_t WS_XN = 40 * MiB, WS_MIX = 105 * MiB  , WS_HALO = 40 * MiB, WS_UPT = 84 * MiB;
constexpr size_t WS_R0I = 64 * 1024;
constexpr size_t WS_Q = 105 * MiB, WS_K = 170 * MiB, WS_V = 179 * MiB, WS_P = 188 * MiB, WS_GA = 221 * MiB, WS_GP = 286 * MiB, WS_ATT = 351 * MiB, WS_POOL = 416 * MiB;
constexpr size_t WS_X1 = 105 * MiB, WS_XG = 234 * MiB, WS_ACT = 299 * MiB, WS_END = 477 * MiB;

constexpr int LDS_BYTES = 147456;

struct Params {
    const float *x_prompt, *x_sample, *cache_swa_k, *cache_swa_v, *cache_meta_k, *cache_meta_v, *state_pool, *state_conv, *meta_tokens, *g_norm_mix, *w_in, *b_gate, *sinks,
        *w_attn_o, *w_pool_grp, *pool_scale, *w_pool_o, *w_out, *g_norm_ffn, *w_up, *conv_w, *conv_b, *w_down, *g_norm_final;
    float* out; unsigned char* ws;
    float inv_freq[32];
    int ph_lo, ph_hi;
};
constexpr size_t O_YP = 0, O_YS = O_YP + (size_t)MREAL * D, O_PSK = O_YS + 128 * D, O_PSV = O_PSK + 131072, O_KM = O_PSV + 131072, O_VM = O_KM + 16384,
    O_PPOOL = O_VM + 16384, O_PCONV = O_PPOOL + 61440, O_SSK = O_PCONV + 90112, O_SSV = O_SSK + 16384, O_SPOOL = O_SSV + 16384, O_SCONV = O_SPOOL + 61440, O_END = O_SCONV + 90112;

__device__ __forceinline__ unsigned pk2(float lo, float hi) { f32x2v v = {lo, hi}; bf16x2v b = __builtin_convertvector(v, bf16x2v); return __builtin_bit_cast(unsigned, b); }
__device__ __forceinline__ float bf_lo(unsigned u) { return __uint_as_float(u << 16); }
__device__ __forceinline__ float bf_hi(unsigned u) { return __uint_as_float(u & 0xffff0000u); }
__device__ __forceinline__ float bf1(bf16_t h) { return __uint_as_float((unsigned)h << 16); }
__device__ __forceinline__ int row_pos(int r) {
    if (r < MREAL) return 16 + (r & 4095);
    if (r < ROW_SAMP) return r - ROW_META;
    if (r < ROW_PAD) return 16 + 1024 + ((r - ROW_SAMP) & 15);
    return 0;
}
__device__ __forceinline__ const float* row_x(const float* xp, const float* mt, const float* xs, int r) {
    if (r < MREAL) return xp + (size_t)r * D;
    if (r < ROW_SAMP) return mt + (size_t)(r - ROW_META) * D;
    if (r < ROW_PAD) return xs + (size_t)(r - ROW_SAMP) * D;
    return nullptr;
}
__device__ __forceinline__ float wave_sum(float v) {
#pragma unroll
    for (int o = 1; o < 64; o <<= 1) v += __shfl_xor(v, o);
    return v;
}
__device__ __forceinline__ float sigmoidf_(float x) { return __builtin_amdgcn_rcpf(1.0f + __builtin_amdgcn_exp2f(x * -1.4426950408889634f)); }

struct EpiZ {
    static constexpr bool PERM = true, AFTER_DRAIN = false, APERM = false;
    bf16_t *Q, *Kb, *Vb, *Pb, *GA, *GP; const float* b_gate; const float* rope;
    __device__ __forceinline__ void operator()(const f32x4 (&acc)[2][2][4][2], const Unit& u, int wr, int wc, int fr_in, int fq_in) const {
        int fr = fr_in, fq = fq_in; asm volatile("" : "+v"(fr), "+v"(fq));
        const int pn = u.pn, cw = wc * 32 + 8 * fq;
        if (pn < 4) {
#pragma unroll
            for (int ai = 0; ai < 2; ++ai) {
                f32x4 t[4][2][2];
#pragma unroll
                for (int m = 0; m < 4; ++m) {
                    const int row = u.pm * 256 + ai * 128 + wr * 64 + m * 16 + fr; const int pos = row_pos(row);
#pragma unroll
                    for (int bj = 0; bj < 2; ++bj) { const f32x4* tp = (const f32x4*)(rope + ((size_t)pos * 32 + (((bj * 128 + cw) & 63) >> 1)) * 2); t[m][bj][0] = tp[0]; t[m][bj][1] = tp[1]; }
                }
#pragma unroll
                for (int m = 0; m < 4; ++m) {
                    const int row = u.pm * 256 + ai * 128 + wr * 64 + m * 16 + fr;
#pragma unroll
                    for (int bj = 0; bj < 2; ++bj) {
                        const f32x4 v0 = acc[ai][bj][m][0], v1 = acc[ai][bj][m][1], t0 = t[m][bj][0], t1 = t[m][bj][1];
                        u32x4 w;
                        w.x = pk2(v0[0] * t0[0] - v0[1] * t0[1], v0[1] * t0[0] + v0[0] * t0[1]); w.y = pk2(v0[2] * t0[2] - v0[3] * t0[3], v0[3] * t0[2] + v0[2] * t0[3]);
                        w.z = pk2(v1[0] * t1[0] - v1[1] * t1[1], v1[1] * t1[0] + v1[0] * t1[1]); w.w = pk2(v1[2] * t1[2] - v1[3] * t1[3], v1[3] * t1[2] + v1[2] * t1[3]);
                        *(u32x4*)(Q + (size_t)row * 1024 + pn * 256 + bj * 128 + cw) = w;
                    }
                }
            }
        } else if (pn == 4) {
            f32x4 t[2][4][2];
#pragma unroll
            for (int ai = 0; ai < 2; ++ai)
#pragma unroll
                for (int m = 0; m < 4; ++m) {
                    const int row = u.pm * 256 + ai * 128 + wr * 64 + m * 16 + fr; const int pos = row_pos(row);
                    const f32x4* tp = (const f32x4*)(rope + ((size_t)pos * 32 + ((cw & 63) >> 1)) * 2); t[ai][m][0] = tp[0]; t[ai][m][1] = tp[1];
                }
#pragma unroll
            for (int ai = 0; ai < 2; ++ai)
#pragma unroll
                for (int m = 0; m < 4; ++m) {
                    const int row = u.pm * 256 + ai * 128 + wr * 64 + m * 16 + fr;
                    { const f32x4 v0 = acc[ai][0][m][0], v1 = acc[ai][0][m][1], t0 = t[ai][m][0], t1 = t[ai][m][1];
                      u32x4 w;
                      w.x = pk2(v0[0] * t0[0] - v0[1] * t0[1], v0[1] * t0[0] + v0[0] * t0[1]); w.y = pk2(v0[2] * t0[2] - v0[3] * t0[3], v0[3] * t0[2] + v0[2] * t0[3]);
                      w.z = pk2(v1[0] * t1[0] - v1[1] * t1[1], v1[1] * t1[0] + v1[0] * t1[1]); w.w = pk2(v1[2] * t1[2] - v1[3] * t1[3], v1[3] * t1[2] + v1[2] * t1[3]);
                      *(u32x4*)(Kb + (size_t)row * 128 + cw) = w; }
                    { const f32x4 v0 = acc[ai][1][m][0], v1 = acc[ai][1][m][1];
                      u32x4 w; w.x = pk2(v0[0], v0[1]); w.y = pk2(v0[2], v0[3]); w.z = pk2(v1[0], v1[1]); w.w = pk2(v1[2], v1[3]);
                      *(u32x4*)(Vb + (size_t)row * 128 + cw) = w; }
                }
        } else if (pn < 7) {
#pragma unroll
            for (int ai = 0; ai < 2; ++ai)
#pragma unroll
                for (int m = 0; m < 4; ++m) {
                    const int row = u.pm * 256 + ai * 128 + wr * 64 + m * 16 + fr;
#pragma unroll
                    for (int bj = 0; bj < 2; ++bj) {
                        const f32x4 v0 = acc[ai][bj][m][0], v1 = acc[ai][bj][m][1];
                        u32x4 w; w.x = pk2(v0[0], v0[1]); w.y = pk2(v0[2], v0[3]); w.z = pk2(v1[0], v1[1]); w.w = pk2(v1[2], v1[3]);
                        *(u32x4*)(Pb + (size_t)row * 512 + (pn - 5) * 256 + bj * 128 + cw) = w;
                    }
                }
        } else {
            const int gc = pn * 256 - 1792 + cw;
            f32x4 b[2][2];
#pragma unroll
            for (int bj = 0; bj < 2; ++bj) { b[bj][0] = *(const f32x4*)(b_gate + gc + bj * 128); b[bj][1] = *(const f32x4*)(b_gate + gc + bj * 128 + 4); }
            bf16_t* dstb = (pn < 11) ? GA + gc : GP + (gc - 1024);
#pragma unroll
            for (int ai = 0; ai < 2; ++ai)
#pragma unroll
                for (int m = 0; m < 4; ++m) {
                    const int row = u.pm * 256 + ai * 128 + wr * 64 + m * 16 + fr;
#pragma unroll
                    for (int bj = 0; bj < 2; ++bj) {
                        f32x4 v0 = acc[ai][bj][m][0] + b[bj][0], v1 = acc[ai][bj][m][1] + b[bj][1];
#pragma unroll
                        for (int i = 0; i < 4; ++i) { v0[i] = sigmoidf_(v0[i]); v1[i] = sigmoidf_(v1[i]); }
                        u32x4 w; w.x = pk2(v0[0], v0[1]); w.y = pk2(v0[2], v0[3]); w.z = pk2(v1[0], v1[1]); w.w = pk2(v1[2], v1[3]);
                        *(u32x4*)(dstb + (size_t)row * 1024 + bj * 128) = w;
                    }
                }
        }
    }
};
struct EpiT1 {
    static constexpr bool PERM = true, AFTER_DRAIN = false, APERM = false;
    const bf16_t* G; bf16_t* O;
    __device__ __forceinline__ void operator()(const f32x4 (&acc)[2][2][4][2], const Unit& u, int wr, int wc, int fr_in, int fq_in) const {
        int fr = fr_in, fq = fq_in; asm volatile("" : "+v"(fr), "+v"(fq));
        const size_t base = (size_t)(u.pm * 256 + wr * 64 + fr) * 1024 + u.pn * 256 + wc * 32 + 8 * fq;
        u32x4 g[2][4][2];
#pragma unroll
        for (int ai = 0; ai < 2; ++ai)
#pragma unroll
            for (int m = 0; m < 4; ++m)
#pragma unroll
                for (int bj = 0; bj < 2; ++bj) g[ai][m][bj] = *(const u32x4*)(G + base + (size_t)(ai * 128 + m * 16) * 1024 + bj * 128);
#pragma unroll
        for (int ai = 0; ai < 2; ++ai)
#pragma unroll
            for (int m = 0; m < 4; ++m)
#pragma unroll
                for (int bj = 0; bj < 2; ++bj) {
                    const u32x4 gg = g[ai][m][bj]; const f32x4 v0 = acc[ai][bj][m][0], v1 = acc[ai][bj][m][1];
                    u32x4 w; w.x = pk2(v0[0] * bf_lo(gg.x), v0[1] * bf_hi(gg.x)); w.y = pk2(v0[2] * bf_lo(gg.y), v0[3] * bf_hi(gg.y));
                    w.z = pk2(v1[0] * bf_lo(gg.z), v1[1] * bf_hi(gg.z)); w.w = pk2(v1[2] * bf_lo(gg.w), v1[3] * bf_hi(gg.w));
                    *(u32x4*)(O + base + (size_t)(ai * 128 + m * 16) * 1024 + bj * 128) = w;
                }
    }
};
struct EpiMix {
    static constexpr bool PERM = true, AFTER_DRAIN = false, APERM = false;
    const bf16_t* G; bf16_t* O;
    __device__ __forceinline__ void operator()(const f32x4 (&acc)[2][2][4][2], const Unit& u, int wr, int wc, int fr_in, int fq_in) const {
        int fr = fr_in, fq = fq_in; asm volatile("" : "+v"(fr), "+v"(fq));
        const size_t base = (size_t)(u.pm * 256 + wr * 64 + fr) * 1024 + u.pn * 256 + wc * 32 + 8 * fq;
#pragma unroll
        for (int ai = 0; ai < 2; ++ai) {
            u32x4 g[4][2], t[4][2];
#pragma unroll
            for (int m = 0; m < 4; ++m)
#pragma unroll
                for (int bj = 0; bj < 2; ++bj) { g[m][bj] = *(const u32x4*)(G + base + (size_t)(ai * 128 + m * 16) * 1024 + bj * 128); t[m][bj] = *(const u32x4*)(O + base + (size_t)(ai * 128 + m * 16) * 1024 + bj * 128); }
#pragma unroll
            for (int m = 0; m < 4; ++m)
#pragma unroll
                for (int bj = 0; bj < 2; ++bj) {
                    const u32x4 gg = g[m][bj], tt = t[m][bj]; const f32x4 v0 = acc[ai][bj][m][0], v1 = acc[ai][bj][m][1];
                    u32x4 w; w.x = pk2(bf_lo(tt.x) + v0[0] * bf_lo(gg.x), bf_hi(tt.x) + v0[1] * bf_hi(gg.x)); w.y = pk2(bf_lo(tt.y) + v0[2] * bf_lo(gg.y), bf_hi(tt.y) + v0[3] * bf_hi(gg.y));
                    w.z = pk2(bf_lo(tt.z) + v1[0] * bf_lo(gg.z), bf_hi(tt.z) + v1[1] * bf_hi(gg.z)); w.w = pk2(bf_lo(tt.w) + v1[2] * bf_lo(gg.w), bf_hi(tt.w) + v1[3] * bf_hi(gg.w));
                    *(u32x4*)(O + base + (size_t)(ai * 128 + m * 16) * 1024 + bj * 128) = w;
                }
        }
    }
};
struct EpiX1 {
    static constexpr bool PERM = true, AFTER_DRAIN = false, APERM = false;
    const bf16_t* XN; const float *r0i, *gmix, *gffn; bf16_t* XG; float* ssq;
    __device__ __forceinline__ void operator()(const f32x4 (&acc)[2][2][4][2], const Unit& u, int wr, int wc, int fr_in, int fq_in) const {
        int fr = fr_in, fq = fq_in; asm volatile("" : "+v"(fr), "+v"(fq));
        const int col0 = u.pn * 256 + wc * 32 + 8 * fq;
        f32x4 g[2][2], ig[2][2];
#pragma unroll
        for (int bj = 0; bj < 2; ++bj)
#pragma unroll
            for (int hh = 0; hh < 2; ++hh) { g[bj][hh] = *(const f32x4*)(gffn + col0 + bj * 128 + 4 * hh); const f32x4 gm = *(const f32x4*)(gmix + col0 + bj * 128 + 4 * hh);
#pragma unroll
                for (int i = 0; i < 4; ++i) ig[bj][hh][i] = __builtin_amdgcn_rcpf(gm[i]); }
#pragma unroll
        for (int ai = 0; ai < 2; ++ai) {
            u32x4 xn[4][2]; float ri[4];
#pragma unroll
            for (int m = 0; m < 4; ++m) {
                const int row = u.pm * 256 + ai * 128 + wr * 64 + m * 16 + fr;
                ri[m] = r0i[row];
#pragma unroll
                for (int bj = 0; bj < 2; ++bj) xn[m][bj] = *(const u32x4*)(XN + (size_t)row * 1024 + col0 + bj * 128);
            }
#pragma unroll
            for (int m = 0; m < 4; ++m) {
                const int row = u.pm * 256 + ai * 128 + wr * 64 + m * 16 + fr;
                const float rr = ri[m];
                float ss = 0.f;
#pragma unroll
                for (int bj = 0; bj < 2; ++bj) {
                    const u32x4 q = xn[m][bj];
                    f32x4 x0, x1;
                    x0[0] = bf_lo(q.x) * rr * ig[bj][0][0]; x0[1] = bf_hi(q.x) * rr * ig[bj][0][1]; x0[2] = bf_lo(q.y) * rr * ig[bj][0][2]; x0[3] = bf_hi(q.y) * rr * ig[bj][0][3];
                    x1[0] = bf_lo(q.z) * rr * ig[bj][1][0]; x1[1] = bf_hi(q.z) * rr * ig[bj][1][1]; x1[2] = bf_lo(q.w) * rr * ig[bj][1][2]; x1[3] = bf_hi(q.w) * rr * ig[bj][1][3];
                    const f32x4 v0 = acc[ai][bj][m][0] + x0, v1 = acc[ai][bj][m][1] + x1, g0 = g[bj][0], g1 = g[bj][1];
                    u32x4 w; w.x = pk2(v0[0] * g0[0], v0[1] * g0[1]); w.y = pk2(v0[2] * g0[2], v0[3] * g0[3]); w.z = pk2(v1[0] * g1[0], v1[1] * g1[1]); w.w = pk2(v1[2] * g1[2], v1[3] * g1[3]);
                    *(u32x4*)(XG + (size_t)row * 1024 + col0 + bj * 128) = w;
                    ss += (v0[0] * v0[0] + v0[1] * v0[1]) + (v0[2] * v0[2] + v0[3] * v0[3]) + (v1[0] * v1[0] + v1[1] * v1[1]) + (v1[2] * v1[2] + v1[3] * v1[3]);
                }
                ss += __shfl_xor(ss, 16); ss += __shfl_xor(ss, 32);
                if (fq == 0) ssq[(size_t)row * 16 + u.pn * 4 + wc] = ss;
            }
        }
    }
};
__device__ __forceinline__ float ror1(float x) { return __builtin_bit_cast(float, __builtin_amdgcn_mov_dpp(__builtin_bit_cast(int, x), 0x121, 0xf, 0xf, false)); }
__device__ __forceinline__ float ror2(float x) { return __builtin_bit_cast(float, __builtin_amdgcn_mov_dpp(__builtin_bit_cast(int, x), 0x122, 0xf, 0xf, false)); }
__device__ __forceinline__ float shr1(float old, float x) { return __builtin_bit_cast(float, __builtin_amdgcn_update_dpp(__builtin_bit_cast(int, old), __builtin_bit_cast(int, x), 0x111, 0xf, 0xf, false)); }
__device__ __forceinline__ float shr2(float old, float x) { return __builtin_bit_cast(float, __builtin_amdgcn_update_dpp(__builtin_bit_cast(int, old), __builtin_bit_cast(int, x), 0x112, 0xf, 0xf, false)); }
struct EpiUp {
    static constexpr bool PERM = true, AFTER_DRAIN = false, APERM = true;
    const float *ssq, *cw, *cb; bf16_t* ACT; float* HALO; float* UPT;
    __device__ __forceinline__ void operator()(const f32x4 (&acc)[2][2][4][2], const Unit& u, int wr, int wc, int fr_in, int fq_in) const {
        int fr = fr_in, fq = fq_in; asm volatile("" : "+v"(fr), "+v"(fq));
        const int jb = u.pn * 128 + wc * 32 + 8 * fq;
        const int row0 = u.pm * 256 + wr * 128 + fr;
        float r1[2][4];
#pragma unroll
        for (int ai = 0; ai < 2; ++ai)
#pragma unroll
            for (int m = 0; m < 4; ++m) {
                const f32x4* sp = (const f32x4*)(ssq + (size_t)(row0 + ai * 64 + m * 16) * 16);
                const f32x4 a = sp[0], b = sp[1], c = sp[2], d = sp[3];
                const float s = ((a[0] + a[1]) + (a[2] + a[3])) + ((b[0] + b[1]) + (b[2] + b[3])) + ((c[0] + c[1]) + (c[2] + c[3])) + ((d[0] + d[1]) + (d[2] + d[3]));
                r1[ai][m] = rsqrtf(s * (1.0f / 1024.0f) + RMS_EPS);
            }
#pragma unroll
        for (int ai = 0; ai < 2; ++ai)
#pragma unroll
            for (int m = 0; m < 4; ++m) asm volatile("" : "+v"(r1[ai][m]));
        __builtin_amdgcn_sched_barrier(0);
        const int slab = u.pm * 2 + wr;
#pragma unroll
        for (int n = 0; n < 2; ++n) {
            int jg = jb + 4 * n; asm volatile("" : "+v"(jg) :: "memory");
            const f32x4 w0g = *(const f32x4*)(cw + jg), w1g = *(const f32x4*)(cw + FF2 + jg), w2g = *(const f32x4*)(cw + 2 * FF2 + jg), bg = *(const f32x4*)(cb + jg);
            const f32x4 w0v = *(const f32x4*)(cw + FF + jg), w1v = *(const f32x4*)(cw + FF2 + FF + jg), w2v = *(const f32x4*)(cw + 2 * FF2 + FF + jg), bv = *(const f32x4*)(cb + FF + jg);
            f32x4 pg = {0.f, 0.f, 0.f, 0.f}, pv = {0.f, 0.f, 0.f, 0.f};
#pragma unroll
            for (int ai = 0; ai < 2; ++ai) {
#pragma unroll
                for (int m = 0; m < 4; ++m) {
                    const int row = row0 + ai * 64 + m * 16;
                    const f32x4 ug = acc[ai][0][m][n] * r1[ai][m], uv = acc[ai][1][m][n] * r1[ai][m];
                    const bool first = (ai == 0 && m == 0), last = (ai == 1 && m == 3);
                    if (first && fr < 2) { *(f32x4*)(HALO + (size_t)(slab * 4 + fr) * FF2 + jg) = ug; *(f32x4*)(HALO + (size_t)(slab * 4 + fr) * FF2 + FF + jg) = uv; }
                    if (last && fr >= 14) { *(f32x4*)(HALO + (size_t)(slab * 4 + fr - 12) * FF2 + jg) = ug; *(f32x4*)(HALO + (size_t)(slab * 4 + fr - 12) * FF2 + FF + jg) = uv; }
                    f32x4 g1, g2, v1, v2;
#pragma unroll
                    for (int i = 0; i < 4; ++i) {
                        g1[i] = shr1(ror1(pg[i]), ug[i]); g2[i] = shr2(ror2(pg[i]), ug[i]);
                        v1[i] = shr1(ror1(pv[i]), uv[i]); v2[i] = shr2(ror2(pv[i]), uv[i]);
                    }
                    const f32x4 cg = bg + w0g * g2 + w1g * g1 + w2g * ug;
                    const f32x4 cv = bv + w0v * v2 + w1v * v1 + w2v * uv;
                    float a[4];
#pragma unroll
                    for (int i = 0; i < 4; ++i) a[i] = cg[i] * sigmoidf_(cg[i]) * cv[i];
                    if (!(first && fr < 2)) { u32x2 w; w.x = pk2(a[0], a[1]); w.y = pk2(a[2], a[3]); *(u32x2*)(ACT + (size_t)row * FF + jg) = w; }
                    pg = ug; pv = uv;
                }
            }
        }
    }
};
constexpr size_t WS_PCNT = 8 * MiB + 768 * 1024;
#define AG_LD(p) __hip_atomic_load((p), __ATOMIC_RELAXED, __HIP_MEMORY_SCOPE_AGENT)
#define AG_ST(p, v) __hip_atomic_store((p), (v), __ATOMIC_RELAXED, __HIP_MEMORY_SCOPE_AGENT)
struct EpiDown {
    static constexpr bool PERM = true, AFTER_DRAIN = false, APERM = false;
    const bf16_t* XG; const float* gffn; const float* gfin; float* out; float* ssq;
    __device__ __forceinline__ void operator()(const f32x4 (&acc_c)[2][2][4][2], const Unit& u, int wr, int wc, int fr_in, int fq_in) const {
        int fr = fr_in, fq = fq_in; asm volatile("" : "+v"(fr), "+v"(fq));
        f32x4 (&acc)[2][2][4][2] = const_cast<f32x4 (&)[2][2][4][2]>(acc_c);
        const int col0 = u.pn * 256 + wc * 32 + 8 * fq;
        f32x4 ig[2][2];
#pragma unroll
        for (int bj = 0; bj < 2; ++bj)
#pragma unroll
            for (int hh = 0; hh < 2; ++hh) { const f32x4 gg = *(const f32x4*)(gffn + col0 + bj * 128 + 4 * hh);
#pragma unroll
                for (int i = 0; i < 4; ++i) ig[bj][hh][i] = __builtin_amdgcn_rcpf(gg[i]); }
#pragma unroll
        for (int ai = 0; ai < 2; ++ai) {
            u32x4 xgv[4][2];
#pragma unroll
            for (int m = 0; m < 4; ++m)
#pragma unroll
                for (int bj = 0; bj < 2; ++bj) xgv[m][bj] = *(const u32x4*)(XG + (size_t)(u.pm * 256 + ai * 128 + wr * 64 + m * 16 + fr) * 1024 + col0 + bj * 128);
#pragma unroll
            for (int m = 0; m < 4; ++m) {
                const int row = u.pm * 256 + ai * 128 + wr * 64 + m * 16 + fr;
                float ss = 0.f;
#pragma unroll
                for (int bj = 0; bj < 2; ++bj) {
                    const u32x4 xg = xgv[m][bj];
                    f32x4 x0, x1;
                    x0[0] = bf_lo(xg.x) * ig[bj][0][0]; x0[1] = bf_hi(xg.x) * ig[bj][0][1]; x0[2] = bf_lo(xg.y) * ig[bj][0][2]; x0[3] = bf_hi(xg.y) * ig[bj][0][3];
                    x1[0] = bf_lo(xg.z) * ig[bj][1][0]; x1[1] = bf_hi(xg.z) * ig[bj][1][1]; x1[2] = bf_lo(xg.w) * ig[bj][1][2]; x1[3] = bf_hi(xg.w) * ig[bj][1][3];
                    const f32x4 v0 = acc[ai][bj][m][0] + x0, v1 = acc[ai][bj][m][1] + x1;
                    acc[ai][bj][m][0] = v0; acc[ai][bj][m][1] = v1;
                    ss += (v0[0] * v0[0] + v0[1] * v0[1]) + (v0[2] * v0[2] + v0[3] * v0[3]) + (v1[0] * v1[0] + v1[1] * v1[1]) + (v1[2] * v1[2] + v1[3] * v1[3]);
                }
                ss += __shfl_xor(ss, 16); ss += __shfl_xor(ss, 32);
                if (fq == 0) AG_ST(ssq + (size_t)row * 16 + u.pn * 4 + wc, ss);
            }
        }
        asm volatile("s_waitcnt vmcnt(0)" ::: "memory");
        unsigned* pc = (unsigned*)((char*)ssq + (WS_PCNT - WS_SSQ2)) + 64 * u.pm;
        if (fr == 0 && fq == 0) __hip_atomic_fetch_add(pc, 1u, __ATOMIC_RELAXED, __HIP_MEMORY_SCOPE_AGENT);
        for (int tries = 0; tries < (1 << 18); ++tries) {
            const unsigned c = (unsigned)__builtin_amdgcn_readfirstlane((int)AG_LD(pc));
            if (c >= 32u) break;
            __builtin_amdgcn_s_sleep(2);
        }
        float rs[2][4];
        {
            float* spb = ssq + (size_t)(u.pm * 256 + wr * 64 + fr) * 16 + 4 * fq;
#pragma unroll
            for (int ai = 0; ai < 2; ++ai)
#pragma unroll
                for (int m = 0; m < 4; ++m) {
                    float* sp = spb + (ai * 128 + m * 16) * 16;
                    const float a = AG_LD(sp), b = AG_LD(sp + 1), c = AG_LD(sp + 2), d = AG_LD(sp + 3);
                    rs[ai][m] = (a + b) + (c + d);
                }
        }
#pragma unroll
        for (int ai = 0; ai < 2; ++ai)
#pragma unroll
            for (int m = 0; m < 4; ++m) {
                const int row = u.pm * 256 + ai * 128 + wr * 64 + m * 16 + fr;
                float s = rs[ai][m]; s += __shfl_xor(s, 16); s += __shfl_xor(s, 32);
                const float r = rsqrtf(s * (1.0f / 1024.0f) + RMS_EPS);
                float* orow = out + O_YP + (size_t)row * D;
#pragma unroll
                for (int bj = 0; bj < 2; ++bj) {
                    const int col = u.pn * 256 + bj * 128 + wc * 32 + 8 * fq;
                    const f32x4 g0 = *(const f32x4*)(gfin + col), g1 = *(const f32x4*)(gfin + col + 4);
                    *(f32x4*)(orow + col) = acc[ai][bj][m][0] * r * g0; *(f32x4*)(orow + col + 4) = acc[ai][bj][m][1] * r * g1;
                }
            }
    }
};

struct MapId { __device__ __forceinline__ int operator()(int n) const { return n; } };
struct MapIn { __device__ __forceinline__ int operator()(int n) const { return n < 1152 ? ((n & ~63) + 2 * (n & 31) + ((n >> 5) & 1)) : n; } };
struct MapUp { __device__ __forceinline__ int operator()(int n) const { if (n < FF) return 256 * (n >> 7) + (n & 127); const int m = n - FF; return 256 * (m >> 7) + 128 + (m & 127); } };
template <class Map>
__device__ __forceinline__ void p0_transpose_item(const float* W, int K, int N, bf16_t* WT, LAS float* scr, int item, int lane, Map map) {
    const int nblk = N / 32, kb = item / nblk, nb = item % nblk, k0 = 64 * kb, n0 = 32 * nb;
#pragma unroll 8
    for (int i = 0; i < 32; ++i) { const int kk = 2 * i + (lane >> 5); scr[kk * 33 + (lane & 31)] = W[(size_t)(k0 + kk) * N + n0 + (lane & 31)]; }
    asm volatile("s_waitcnt lgkmcnt(0)" ::: "memory");
    const int c = lane & 7;
#pragma unroll
    for (int j = 0; j < 4; ++j) { const int n = (lane >> 3) + 8 * j; const LAS float* s = scr + (8 * c) * 33 + n;
        u32x4 o; o.x = pk2(s[0 * 33], s[1 * 33]); o.y = pk2(s[2 * 33], s[3 * 33]); o.z = pk2(s[4 * 33], s[5 * 33]); o.w = pk2(s[6 * 33], s[7 * 33]);
        *(u32x4*)(WT + (size_t)map(n0 + n) * K + k0 + 8 * c) = o; }
    asm volatile("s_waitcnt lgkmcnt(0)" ::: "memory");
}
__device__ __forceinline__ void p0_prologue(const Params& p, LAS unsigned char* lds, int wave, int lane) {
    unsigned char* ws = p.ws;
    if (wave < 4) {
        bf16_t* XN = (bf16_t*)(ws + WS_XN);
        const int gw = blockIdx.x * 4 + wave, NGW = gridDim.x * 4;
        f32x4 gv[4];
#pragma unroll
        for (int j = 0; j < 4; ++j) gv[j] = ((const f32x4*)p.g_norm_mix)[lane + 64 * j];
        for (int m0 = gw * 4; m0 < M; m0 += NGW * 4) {
            f32x4 v[4][4]; const float* xr[4];
#pragma unroll
            for (int q = 0; q < 4; ++q) {
                xr[q] = row_x(p.x_prompt, p.meta_tokens, p.x_sample, m0 + q);
#pragma unroll
                for (int j = 0; j < 4; ++j) v[q][j] = xr[q] ? ((const f32x4*)xr[q])[lane + 64 * j] : (f32x4){0.f, 0.f, 0.f, 0.f};
            }
#pragma unroll
            for (int q = 0; q < 4; ++q) {
                float s = 0.f;
#pragma unroll
                for (int j = 0; j < 4; ++j) s += (v[q][j][0] * v[q][j][0] + v[q][j][1] * v[q][j][1]) + (v[q][j][2] * v[q][j][2] + v[q][j][3] * v[q][j][3]);
                const float ms = wave_sum(s) * (1.0f / D) + RMS_EPS;
                const float r = rsqrtf(ms);
                if (lane == 0) ((float*)(ws + WS_R0I))[m0 + q] = sqrtf(ms);
                unsigned long long* o8 = (unsigned long long*)(XN + (size_t)(m0 + q) * D) + lane;
#pragma unroll
                for (int j = 0; j < 4; ++j) { const f32x4 w = v[q][j] * r * gv[j]; o8[64 * j] = (unsigned long long)pk2(w[0], w[1]) | ((unsigned long long)pk2(w[2], w[3]) << 32); }
            }
        }
        return;
    }
    LAS float* scr = (LAS float*)(lds + wave * 16384);
    const int gw = blockIdx.x * 4 + (wave - 4), NGW = gridDim.x * 4;
    const int gt = blockIdx.x * 256 + (int)threadIdx.x - 256, NT = gridDim.x * 256;
    constexpr int I_IN = 16 * (INW / 32), I_AO = 16 * 32, I_OUT = 16 * 32, I_UP = 16 * (FF2 / 32), I_DN = (FF / 64) * 32;
    constexpr int NITEMS = I_IN + I_AO + I_OUT + I_UP + I_DN;
    for (int it = gw; it < NITEMS; it += NGW) {
        int r = it;
        if (r < I_IN) { p0_transpose_item(p.w_in, D, INW, (bf16_t*)(ws + WS_WIN), scr, r, lane, MapIn()); continue; } r -= I_IN;
        if (r < I_AO) { p0_transpose_item(p.w_attn_o, D, D, (bf16_t*)(ws + WS_WAO), scr, r, lane, MapId()); continue; } r -= I_AO;
        if (r < I_OUT) { p0_transpose_item(p.w_out, D, D, (bf16_t*)(ws + WS_WOUT), scr, r, lane, MapId()); continue; } r -= I_OUT;
        if (r < I_UP) { p0_transpose_item(p.w_up, D, FF2, (bf16_t*)(ws + WS_WUP), scr, r, lane, MapUp()); continue; } r -= I_UP;
        p0_transpose_item(p.w_down, FF, D, (bf16_t*)(ws + WS_WDOWN), scr, r, lane, MapId());
    }
    {
        bf16_t* WP = (bf16_t*)(ws + WS_WPO);
        for (int idx = gt; idx < 1024 * 128; idx += NT) {
            const int n = idx & 1023, k0 = (idx >> 10) * 4, g = k0 >> 7;
            const float* wg = p.w_pool_grp + (size_t)k0 * 128;
            const float* sc = p.pool_scale + g * 128;
            const float* wo = p.w_pool_o + (size_t)(g * 128) * 1024 + n;
            float a[4] = {0.f, 0.f, 0.f, 0.f};
#pragma unroll 2
            for (int d = 0; d < 128; d += 4) {
                const f32x4 s4 = *(const f32x4*)(sc + d);
                float wv[4];
#pragma unroll
                for (int e = 0; e < 4; ++e) wv[e] = wo[(size_t)(d + e) * 1024] * s4[e];
#pragma unroll
                for (int j = 0; j < 4; ++j) { const f32x4 w4 = *(const f32x4*)(wg + j * 128 + d); a[j] += (w4[0] * wv[0] + w4[1] * wv[1]) + (w4[2] * wv[2] + w4[3] * wv[3]); }
            }
            u32x2 o; o.x = pk2(a[0], a[1]); o.y = pk2(a[2], a[3]);
            *(u32x2*)(WP + (size_t)n * 512 + k0) = o;
        }
    }
    float* rope = (float*)(ws + WS_ROPE);
    for (int i = gt; i < NPOS * 32; i += NT) {
        const int pos = i >> 5, d = i & 31;
        const float ang = (float)pos * p.inv_freq[d];
        const double rev = (double)ang * 0.15915494309189535;
        const float fr = (float)(rev - floor(rev));
        rope[2 * i] = __builtin_amdgcn_cosf(fr); rope[2 * i + 1] = __builtin_amdgcn_sinf(fr);
    }
}

constexpr int KS_PITCH = 144, VT_PITCH = 464, ATT_VT_OFF = 208 * KS_PITCH;
constexpr float LOG2E = 1.4426950408889634f, C2 = 0.125f * 1.4426950408889634f;

template <int NQ>
__device__ __forceinline__ void attn_load_q(bf16x8 (&qf)[NQ][2], const bf16_t* Qb, int qrow0, int h, int lane) {
    const int fr = lane & 15, fq = lane >> 4;
#pragma unroll
    for (int qb = 0; qb < NQ; ++qb)
#pragma unroll
        for (int ks = 0; ks < 2; ++ks) qf[qb][ks] = *(const bf16x8*)(Qb + (size_t)(qrow0 + 16 * qb + fr) * 1024 + h * 64 + 32 * ks + 8 * fq);
}
template <int NQ>
__device__ __forceinline__ void attn_compute(LAS unsigned char* lds, const bf16x8 (&qf)[NQ][2], bf16_t* ATT, int qrow0, int h, unsigned vmask, float sink2, int lane) {
    const int fr = lane & 15, fq = lane >> 4;
    f32x4 s[NQ][13];
    const LAS unsigned char* kp = lds + fr * KS_PITCH + fq * 16;
    bf16x8 kc0 = *(const LAS bf16x8*)kp, kc1 = *(const LAS bf16x8*)(kp + 64);
#pragma unroll
    for (int kb = 0; kb < 13; ++kb) {
        bf16x8 kn0 = kc0, kn1 = kc1;
        if (kb < 12) { kn0 = *(const LAS bf16x8*)(kp + (kb + 1) * 16 * KS_PITCH); kn1 = *(const LAS bf16x8*)(kp + (kb + 1) * 16 * KS_PITCH + 64); }
#pragma unroll
        for (int qb = 0; qb < NQ; ++qb) {
            f32x4 a = {0.f, 0.f, 0.f, 0.f};
            a = __builtin_amdgcn_mfma_f32_16x16x32_bf16(kc0, qf[qb][0], a, 0, 0, 0);
            a = __builtin_amdgcn_mfma_f32_16x16x32_bf16(kc1, qf[qb][1], a, 0, 0, 0);
            s[qb][kb] = a;
        }
        kc0 = kn0; kc1 = kn1;
        __builtin_amdgcn_sched_barrier(0);
    }
    float rl[NQ];
#pragma unroll
    for (int qb = 0; qb < NQ; ++qb) {
        float mr = -1e30f;
#pragma unroll
        for (int kb = 0; kb < 13; ++kb) {
            if (vmask != 0x1fffu) {
                const bool valid = (vmask >> kb) & 1u;
#pragma unroll
                for (int i = 0; i < 4; ++i) s[qb][kb][i] = valid ? s[qb][kb][i] : -1e30f;
            }
            mr = fmaxf(mr, fmaxf(fmaxf(s[qb][kb][0], s[qb][kb][1]), fmaxf(s[qb][kb][2], s[qb][kb][3])));
        }
        mr = fmaxf(mr, __shfl_xor(mr, 16)); mr = fmaxf(mr, __shfl_xor(mr, 32));
        const float mx = fmaxf(mr * C2, sink2), nmx = -mx;
        float l = 0.f;
#pragma unroll
        for (int kb = 0; kb < 13; ++kb)
#pragma unroll
            for (int i = 0; i < 4; ++i) { const float pv = __builtin_amdgcn_exp2f(fmaf(s[qb][kb][i], C2, nmx)); s[qb][kb][i] = pv; l += pv; }
        l += __shfl_xor(l, 16); l += __shfl_xor(l, 32);
        l += __builtin_amdgcn_exp2f(sink2 - mx);
        rl[qb] = __builtin_amdgcn_rcpf(l);
    }
    f32x4 o[NQ][4];
#pragma unroll
    for (int qb = 0; qb < NQ; ++qb)
#pragma unroll
        for (int db = 0; db < 4; ++db) o[qb][db] = (f32x4){0.f, 0.f, 0.f, 0.f};
    const LAS unsigned char* vp = lds + ATT_VT_OFF + fr * VT_PITCH + fq * 8;
    u32x2 vlo[4], vhi[4];
#pragma unroll
    for (int db = 0; db < 4; ++db) { vlo[db] = *(const LAS u32x2*)(vp + db * 16 * VT_PITCH); vhi[db] = *(const LAS u32x2*)(vp + db * 16 * VT_PITCH + 32); }
#pragma unroll
    for (int kk = 0; kk < 7; ++kk) {
        u32x2 nlo[4], nhi[4];
#pragma unroll
        for (int db = 0; db < 4; ++db) { nlo[db] = vlo[db]; nhi[db] = vhi[db]; }
        if (kk < 6) {
#pragma unroll
            for (int db = 0; db < 4; ++db) { nlo[db] = *(const LAS u32x2*)(vp + db * 16 * VT_PITCH + (kk + 1) * 64); nhi[db] = *(const LAS u32x2*)(vp + db * 16 * VT_PITCH + (kk + 1) * 64 + 32); }
        }
        bf16x8 pf[NQ];
#pragma unroll
        for (int qb = 0; qb < NQ; ++qb) {
            u32x4 w;
            w.x = pk2(s[qb][2 * kk][0], s[qb][2 * kk][1]); w.y = pk2(s[qb][2 * kk][2], s[qb][2 * kk][3]);
            if (2 * kk + 1 < 13) { w.z = pk2(s[qb][(2 * kk + 1) % 13][0], s[qb][(2 * kk + 1) % 13][1]); w.w = pk2(s[qb][(2 * kk + 1) % 13][2], s[qb][(2 * kk + 1) % 13][3]); }
            else { w.z = 0u; w.w = 0u; }
            pf[qb] = __builtin_bit_cast(bf16x8, w);
        }
#pragma unroll
        for (int db = 0; db < 4; ++db) {
            u32x4 vv; vv.x = vlo[db].x; vv.y = vlo[db].y; vv.z = vhi[db].x; vv.w = vhi[db].y;
            const bf16x8 vf = __builtin_bit_cast(bf16x8, vv);
#pragma unroll
            for (int qb = 0; qb < NQ; ++qb) o[qb][db] = __builtin_amdgcn_mfma_f32_16x16x32_bf16(vf, pf[qb], o[qb][db], 0, 0, 0);
        }
#pragma unroll
        for (int db = 0; db < 4; ++db) { vlo[db] = nlo[db]; vhi[db] = nhi[db]; }
        __builtin_amdgcn_sched_barrier(0);
    }
#pragma unroll
    for (int qb = 0; qb < NQ; ++qb)
#pragma unroll
        for (int db = 0; db < 4; ++db) {
            const f32x4 v = o[qb][db] * rl[qb];
            u32x2 w; w.x = pk2(v[0], v[1]); w.y = pk2(v[2], v[3]);
            *(u32x2*)(ATT + (size_t)(qrow0 + 16 * qb + fr) * 1024 + h * 64 + 16 * db + 4 * fq) = w;
        }
}
__device__ __forceinline__ void attn_zero_pad(LAS unsigned char* lds, int tid) {
    if (tid < 128) { const int row = tid >> 1, half = tid & 1; *(LAS u32x4*)(lds + ATT_VT_OFF + row * VT_PITCH + 416 + half * 16) = (u32x4){0u, 0u, 0u, 0u}; }
}
__device__ __forceinline__ void attn_fill_bf16(LAS unsigned char* lds, const bf16_t* Kb, const bf16_t* Vb, int srow, int n, int kk, int ch) {
    u32x4 kv = {0u, 0u, 0u, 0u}, vv = {0u, 0u, 0u, 0u};
    if (srow >= 0) { kv = *(const u32x4*)(Kb + (size_t)srow * 128 + n * 64 + ch * 8); vv = *(const u32x4*)(Vb + (size_t)srow * 128 + n * 64 + ch * 8); }
    *(LAS u32x4*)(lds + kk * KS_PITCH + ch * 16) = kv;
    LAS unsigned short* vt = (LAS unsigned short*)(lds + ATT_VT_OFF + (ch * 8) * VT_PITCH + kk * 2);
    vt[0 * (VT_PITCH / 2)] = (unsigned short)(vv.x & 0xffffu); vt[1 * (VT_PITCH / 2)] = (unsigned short)(vv.x >> 16);
    vt[2 * (VT_PITCH / 2)] = (unsigned short)(vv.y & 0xffffu); vt[3 * (VT_PITCH / 2)] = (unsigned short)(vv.y >> 16);
    vt[4 * (VT_PITCH / 2)] = (unsigned short)(vv.z & 0xffffu); vt[5 * (VT_PITCH / 2)] = (unsigned short)(vv.z >> 16);
    vt[6 * (VT_PITCH / 2)] = (unsigned short)(vv.w & 0xffffu); vt[7 * (VT_PITCH / 2)] = (unsigned short)(vv.w >> 16);
}
__device__ __forceinline__ void attn_fill_f32(LAS unsigned char* lds, const float* ksrc, const float* vsrc, int kk, int ch) {
    const f32x4 k0 = *(const f32x4*)(ksrc + ch * 8), k1 = *(const f32x4*)(ksrc + ch * 8 + 4);
    const f32x4 v0 = *(const f32x4*)(vsrc + ch * 8), v1 = *(const f32x4*)(vsrc + ch * 8 + 4);
    LAS unsigned short* kr = (LAS unsigned short*)(lds + kk * KS_PITCH);
    LAS unsigned short* vt = (LAS unsigned short*)(lds + ATT_VT_OFF + (ch * 8) * VT_PITCH + kk * 2);
#pragma unroll
    for (int e = 0; e < 8; ++e) {
        const int d = ch * 8 + e;
        const float kvv = e < 4 ? k0[e & 3] : k1[e & 3], vvv = e < 4 ? v0[e & 3] : v1[e & 3];
        kr[2 * (d & 31) + (d >> 5)] = (unsigned short)(pk2(kvv, 0.f) & 0xffffu);
        vt[e * (VT_PITCH / 2)] = (unsigned short)(pk2(vvv, 0.f) & 0xffffu);
    }
}
__device__ __forceinline__ void attn_chunk_unit(const Params& p, LAS unsigned char* lds, int unit, int tid, int wave, int lane) {
    unsigned char* ws = p.ws;
    const bf16_t *Qb = (const bf16_t*)(ws + WS_Q), *Kb = (const bf16_t*)(ws + WS_K), *Vb = (const bf16_t*)(ws + WS_V); bf16_t* ATT = (bf16_t*)(ws + WS_ATT);
    const int n = unit & 1, c = (unit >> 1) & 63, b = unit >> 7;
    asm volatile("" : "+v"(tid), "+v"(lane));
    const int h = n * 8 + wave, r0 = b * SEQ + c * 64;
    bf16x8 qa[2][2], qb2[2][2];
    attn_load_q<2>(qa, Qb, r0, h, lane);
#pragma unroll
    for (int jb = 0; jb < 2; ++jb) {
        u32x4 kv[2], vv[2];
#pragma unroll
        for (int j = 0; j < 2; ++j) {
            const int i = tid + 512 * (2 * jb + j), kk = i >> 3, ch = i & 7;
            int srow;
            if (kk < 16) srow = ROW_META + kk;
            else { const int t = (c - 2) * 64 + kk - 16; srow = t < 0 ? -1 : b * SEQ + t; }
            kv[j] = (u32x4){0u, 0u, 0u, 0u}; vv[j] = (u32x4){0u, 0u, 0u, 0u};
            if (i < 208 * 8 && srow >= 0) { kv[j] = *(const u32x4*)(Kb + (size_t)srow * 128 + n * 64 + ch * 8); vv[j] = *(const u32x4*)(Vb + (size_t)srow * 128 + n * 64 + ch * 8); }
        }
#pragma unroll
        for (int j = 0; j < 2; ++j) {
            const int i = tid + 512 * (2 * jb + j), kk = i >> 3, ch = i & 7;
            if (i < 208 * 8) {
                *(LAS u32x4*)(lds + kk * KS_PITCH + ch * 16) = kv[j];
                LAS unsigned short* vt = (LAS unsigned short*)(lds + ATT_VT_OFF + (ch * 8) * VT_PITCH + kk * 2);
                vt[0 * (VT_PITCH / 2)] = (unsigned short)(vv[j].x & 0xffffu); vt[1 * (VT_PITCH / 2)] = (unsigned short)(vv[j].x >> 16);
                vt[2 * (VT_PITCH / 2)] = (unsigned short)(vv[j].y & 0xffffu); vt[3 * (VT_PITCH / 2)] = (unsigned short)(vv[j].y >> 16);
                vt[4 * (VT_PITCH / 2)] = (unsigned short)(vv[j].z & 0xffffu); vt[5 * (VT_PITCH / 2)] = (unsigned short)(vv[j].z >> 16);
                vt[6 * (VT_PITCH / 2)] = (unsigned short)(vv[j].w & 0xffffu); vt[7 * (VT_PITCH / 2)] = (unsigned short)(vv[j].w >> 16);
            }
        }
    }
    attn_zero_pad(lds, tid);
    __syncthreads();
    unsigned vmask = 0x1fffu;
    if (c == 0) vmask = 0x1e01u; else if (c == 1) vmask = 0x1fe1u;
    const float sink2 = p.sinks[h] * LOG2E;
    attn_compute<2>(lds, qa, ATT, r0, h, vmask, sink2, lane);
    attn_load_q<2>(qb2, Qb, r0 + 32, h, lane);
    attn_compute<2>(lds, qb2, ATT, r0 + 32, h, vmask, sink2, lane);
    __syncthreads();
}
__device__ __forceinline__ void attn_small_unit(const Params& p, LAS unsigned char* lds, int unit, int tid, int wave, int lane) {
    unsigned char* ws = p.ws;
    const bf16_t *Qb = (const bf16_t*)(ws + WS_Q), *Kb = (const bf16_t*)(ws + WS_K), *Vb = (const bf16_t*)(ws + WS_V); bf16_t* ATT = (bf16_t*)(ws + WS_ATT);
    int n, qrow0; unsigned vmask;
    if (unit < 2) {
        n = unit; qrow0 = ROW_META; vmask = 1u;
        for (int i = tid; i < 208 * 8; i += 512) { const int kk = i >> 3, ch = i & 7; attn_fill_bf16(lds, Kb, Vb, kk < 16 ? ROW_META + kk : -1, n, kk, ch); }
    } else {
        const int b = (unit - 2) >> 1; n = (unit - 2) & 1; qrow0 = ROW_SAMP + b * 16; vmask = 0x3ffu;
        for (int i = tid; i < 208 * 8; i += 512) {
            const int kk = i >> 3, ch = i & 7;
            if (kk < 16) attn_fill_f32(lds, p.cache_meta_k + ((size_t)(b * 16 + kk) * 2 + n) * 64, p.cache_meta_v + ((size_t)(b * 16 + kk) * 2 + n) * 64, kk, ch);
            else if (kk < 144) attn_fill_f32(lds, p.cache_swa_k + ((size_t)(b * 128 + kk - 16) * 2 + n) * 64, p.cache_swa_v + ((size_t)(b * 128 + kk - 16) * 2 + n) * 64, kk, ch);
            else attn_fill_bf16(lds, Kb, Vb, kk < 160 ? ROW_SAMP + b * 16 + kk - 144 : -1, n, kk, ch);
        }
    }
    attn_zero_pad(lds, tid);
    __syncthreads();
    const int h = n * 8 + wave;
    bf16x8 q1[1][2]; attn_load_q<1>(q1, Qb, qrow0, h, lane);
    attn_compute<1>(lds, q1, ATT, qrow0, h, vmask, p.sinks[h] * LOG2E, lane);
    __syncthreads();
}
constexpr int PM_PITCH = 1040;
__device__ __forceinline__ void add8(float (&s)[8], const u32x4 v) {
    s[0] += bf_lo(v.x); s[1] += bf_hi(v.x); s[2] += bf_lo(v.y); s[3] += bf_hi(v.y); s[4] += bf_lo(v.z); s[5] += bf_hi(v.z); s[6] += bf_lo(v.w); s[7] += bf_hi(v.w);
}
__device__ __forceinline__ void unpack8(float (&s)[8], const u32x4 v) {
    s[0] = bf_lo(v.x); s[1] = bf_hi(v.x); s[2] = bf_lo(v.y); s[3] = bf_hi(v.y); s[4] = bf_lo(v.z); s[5] = bf_hi(v.z); s[6] = bf_lo(v.w); s[7] = bf_hi(v.w);
}
template <int W>
__device__ __forceinline__ void pool_pm_main(const bf16_t* Pb, bf16_t* POOL, int R0, int wave, int lane) {
    const int g = wave >> 1, col = (g * 16 + (lane & 15)) * 8, seg = (wave & 1) * 4 + (lane >> 4);
    const int sb = R0 & 4095, s0 = sb + seg * 8, base = R0 - sb;
    constexpr int NL = 8 + W - 1;
    u32x4 v[NL];
#pragma unroll
    for (int t = 0; t < NL; ++t) {
        const int sk = s0 + t - (W - 1);
        const int row = sk >= 0 ? base + sk : ROW_META + 16 + sk;
        v[t] = *(const u32x4*)(Pb + (size_t)row * PW + col);
    }
    float s[8] = {0.f, 0.f, 0.f, 0.f, 0.f, 0.f, 0.f, 0.f};
#pragma unroll
    for (int t = 0; t < W - 1; ++t) add8(s, v[t]);
#pragma unroll
    for (int j = 0; j < 8; ++j) {
        float cur[8], old[8];
        unpack8(cur, v[j + W - 1]); unpack8(old, v[j]);
#pragma unroll
        for (int e = 0; e < 8; ++e) s[e] += cur[e];
        constexpr float inv = 1.0f / (float)W;
        u32x4 o; o.x = pk2(s[0] * inv - cur[0], s[1] * inv - cur[1]); o.y = pk2(s[2] * inv - cur[2], s[3] * inv - cur[3]);
        o.z = pk2(s[4] * inv - cur[4], s[5] * inv - cur[5]); o.w = pk2(s[6] * inv - cur[6], s[7] * inv - cur[7]);
        *(u32x4*)(POOL + (size_t)(R0 + seg * 8 + j) * PW + col) = o;
#pragma unroll
        for (int e = 0; e < 8; ++e) s[e] -= old[e];
    }
}
__device__ __forceinline__ void pool_unit(const Params& p, LAS unsigned char* lds, int pt, int tid, int wave, int lane) {
    unsigned char* ws = p.ws;
    const bf16_t* Pb = (const bf16_t*)(ws + WS_P); bf16_t* POOL = (bf16_t*)(ws + WS_POOL);
    const bool tail = pt >= 512;
    const int R0 = tail ? MREAL + 16 * (pt - 512) : pt * 64;
    if (!tail) {
        switch (wave >> 1) {
            case 0: pool_pm_main<2>(Pb, POOL, R0, wave, lane); break;
            case 1: pool_pm_main<4>(Pb, POOL, R0, wave, lane); break;
            case 2: pool_pm_main<8>(Pb, POOL, R0, wave, lane); break;
            default: pool_pm_main<16>(Pb, POOL, R0, wave, lane); break;
        }
    } else
    for (int i = tid; i < 1024; i += 512) {
        const int rr = i >> 6, ch = i & 63, R = R0 + rr, g = ch >> 4, w = 2 << g, col = ch * 8;
        float s[8] = {0.f, 0.f, 0.f, 0.f, 0.f, 0.f, 0.f, 0.f}, cur[8] = {0.f, 0.f, 0.f, 0.f, 0.f, 0.f, 0.f, 0.f};
        float inv = 1.0f / (float)w;
        if (R < ROW_SAMP) {
            const int pos = R - ROW_META; const int cnt = w < pos + 1 ? w : pos + 1; inv = 1.0f / (float)cnt;
#pragma unroll
            for (int k = 0; k < 16; ++k) {
                const bool on = k < cnt;
                float t[8]; unpack8(t, *(const u32x4*)(Pb + (size_t)(on ? R - k : R) * PW + col));
#pragma unroll
                for (int e = 0; e < 8; ++e) { s[e] += on ? t[e] : 0.f; if (k == 0) cur[e] = t[e]; }
            }
        } else if (R < ROW_PAD) {
            const int q = R - ROW_SAMP, b = q >> 4, ii = q & 15;
#pragma unroll
            for (int k = 0; k < 16; ++k) {
                const bool on = k < w, frombuf = ii - k >= 0;
                float t[8]; unpack8(t, *(const u32x4*)(Pb + (size_t)(frombuf ? R - k : R) * PW + col));
                const float* sp = p.state_pool + ((size_t)b * 15 + (frombuf ? 0 : 15 + ii - k)) * PW + col; const f32x4 a = *(const f32x4*)sp, c2 = *(const f32x4*)(sp + 4);
                const float u[8] = {a[0], a[1], a[2], a[3], c2[0], c2[1], c2[2], c2[3]};
#pragma unroll
                for (int e = 0; e < 8; ++e) { const float x = frombuf ? t[e] : u[e]; s[e] += on ? x : 0.f; if (k == 0) cur[e] = t[e]; }
            }
        }
        u32x4 o; o.x = pk2(s[0] * inv - cur[0], s[1] * inv - cur[1]); o.y = pk2(s[2] * inv - cur[2], s[3] * inv - cur[3]);
        o.z = pk2(s[4] * inv - cur[4], s[5] * inv - cur[5]); o.w = pk2(s[6] * inv - cur[6], s[7] * inv - cur[7]);
        *(u32x4*)(POOL + (size_t)R * PW + col) = o;
    }
}
__device__ __forceinline__ int deinter(int d) { return 2 * (d & 31) + (d >> 5); }
__device__ __forceinline__ void small_outputs(const Params& p) {
    unsigned char* ws = p.ws;
    const bf16_t *Kb = (const bf16_t*)(ws + WS_K), *Vb = (const bf16_t*)(ws + WS_V), *Pb = (const bf16_t*)(ws + WS_P);
    float* out = p.out;
    const int gt = blockIdx.x * 512 + threadIdx.x, NT = gridDim.x * 512;
    for (int i = gt; i < 131072; i += NT) {
        const int d = i & 63, n = (i >> 6) & 1, w = (i >> 7) & 127, b = i >> 14; const size_t row = (size_t)b * SEQ + 3968 + w;
        out[O_PSK + i] = bf1(Kb[row * 128 + n * 64 + deinter(d)]); out[O_PSV + i] = bf1(Vb[row * 128 + n * 64 + d]);
    }
    for (int i = gt; i < 16384; i += NT) {
        const int d = i & 63, n = (i >> 6) & 1, t = (i >> 7) & 15, b = i >> 11;
        const size_t rm = (size_t)ROW_META + t, rs = (size_t)ROW_SAMP + b * 16 + t;
        out[O_KM + i] = bf1(Kb[rm * 128 + n * 64 + deinter(d)]); out[O_VM + i] = bf1(Vb[rm * 128 + n * 64 + d]);
        out[O_SSK + i] = bf1(Kb[rs * 128 + n * 64 + deinter(d)]); out[O_SSV + i] = bf1(Vb[rs * 128 + n * 64 + d]);
    }
    for (int i = gt; i < 61440; i += NT) {
        const int c = i & 511, r = (i >> 9) % 15, b = (i >> 9) / 15;
        out[O_PPOOL + i] = bf1(Pb[((size_t)b * SEQ + 4081 + r) * PW + c]);
        out[O_SPOOL + i] = bf1(Pb[((size_t)ROW_SAMP + b * 16 + 1 + r) * PW + c]);
    }
}


constexpr size_t WS_SSQT1 = 5 * MiB + 512 * 1024, WS_SSQT2 = 8 * MiB + 512 * 1024;
struct SkinnyOp { const bf16_t* A; const bf16_t* Bt; int K; };
__device__ __forceinline__ void skinny_accum(const SkinnyOp op, int n0, int wave, int lane, f32x4 (&acc)[9]) {
    const int fr = lane & 15, fq = lane >> 4;
    const bf16_t* bp = op.Bt + (size_t)(n0 + fr) * op.K + 8 * fq;
    const bf16_t* ap = op.A + (size_t)(ROW_META + fr) * op.K + 8 * fq;
    const int nks = op.K >> 5;
    for (int ks = wave; ks < nks; ks += 16) {
        const bool two = ks + 8 < nks;
        const int k0 = ks * 32, k1 = two ? (ks + 8) * 32 : k0;
        const bf16x8 b0 = *(const bf16x8*)(bp + k0), b1 = *(const bf16x8*)(bp + k1);
        bf16x8 a0[9], a1[9];
#pragma unroll
        for (int rb = 0; rb < 9; ++rb) { a0[rb] = *(const bf16x8*)(ap + (size_t)rb * 16 * op.K + k0); a1[rb] = *(const bf16x8*)(ap + (size_t)rb * 16 * op.K + k1); }
#pragma unroll
        for (int rb = 0; rb < 9; ++rb) acc[rb] = __builtin_amdgcn_mfma_f32_16x16x32_bf16(b0, a0[rb], acc[rb], 0, 0, 0);
        if (two) {
#pragma unroll
            for (int rb = 0; rb < 9; ++rb) acc[rb] = __builtin_amdgcn_mfma_f32_16x16x32_bf16(b1, a1[rb], acc[rb], 0, 0, 0);
        }
    }
}
__device__ __forceinline__ void skinny_reduce(LAS unsigned char* lds, const f32x4 (&acc)[9], int wave, int lane, f32x4& r0, f32x4& r8) {
    LAS f32x4* part = (LAS f32x4*)lds;
#pragma unroll
    for (int rb = 0; rb < 9; ++rb) part[(wave * 9 + rb) * 64 + lane] = acc[rb];
    __syncthreads();
    r0 = (f32x4){0.f, 0.f, 0.f, 0.f}; r8 = (f32x4){0.f, 0.f, 0.f, 0.f};
#pragma unroll
    for (int w = 0; w < 8; ++w) r0 += part[(w * 9 + wave) * 64 + lane];
    if (wave == 0) {
#pragma unroll
        for (int w = 0; w < 8; ++w) r8 += part[(w * 9 + 8) * 64 + lane];
    }
    __syncthreads();
}
#define ZERO9(a) _Pragma("unroll") for (int z_ = 0; z_ < 9; ++z_) a[z_] = (f32x4){0.f, 0.f, 0.f, 0.f}
__device__ __forceinline__ void tail_mix_unit(const Params& p, LAS unsigned char* lds, int unit, int wave, int lane) {
    unsigned char* ws = p.ws; const int n0 = unit * 16, fr = lane & 15, fq = lane >> 4;
    f32x4 acc[9], a0, a8, b0, b8;
    ZERO9(acc); skinny_accum(SkinnyOp{(const bf16_t*)(ws + WS_ATT), (const bf16_t*)(ws + WS_WAO), 1024}, n0, wave, lane, acc); skinny_reduce(lds, acc, wave, lane, a0, a8);
    ZERO9(acc); skinny_accum(SkinnyOp{(const bf16_t*)(ws + WS_POOL), (const bf16_t*)(ws + WS_WPO), 512}, n0, wave, lane, acc); skinny_reduce(lds, acc, wave, lane, b0, b8);
    const bf16_t *GA = (const bf16_t*)(ws + WS_GA), *GP = (const bf16_t*)(ws + WS_GP); bf16_t* MIX = (bf16_t*)(ws + WS_MIX);
#pragma unroll
    for (int t = 0; t < 2; ++t) {
        if (t == 1 && wave != 0) break;
        const int rb = t ? 8 : wave; const f32x4 va = t ? a8 : a0, vb = t ? b8 : b0;
        const size_t off = (size_t)(ROW_META + 16 * rb + fr) * 1024 + n0 + 4 * fq;
        const u32x2 ga = *(const u32x2*)(GA + off), gp = *(const u32x2*)(GP + off);
        u32x2 w; w.x = pk2(bf_lo(ga.x) * va[0] + bf_lo(gp.x) * vb[0], bf_hi(ga.x) * va[1] + bf_hi(gp.x) * vb[1]);
        w.y = pk2(bf_lo(ga.y) * va[2] + bf_lo(gp.y) * vb[2], bf_hi(ga.y) * va[3] + bf_hi(gp.y) * vb[3]);
        *(u32x2*)(MIX + off) = w;
    }
}
__device__ __forceinline__ void tail_x1_unit(const Params& p, LAS unsigned char* lds, int unit, int wave, int lane) {
    unsigned char* ws = p.ws; const int n0 = unit * 16, fr = lane & 15, fq = lane >> 4;
    f32x4 acc[9], a0, a8;
    ZERO9(acc); skinny_accum(SkinnyOp{(const bf16_t*)(ws + WS_MIX), (const bf16_t*)(ws + WS_WOUT), 1024}, n0, wave, lane, acc); skinny_reduce(lds, acc, wave, lane, a0, a8);
    bf16_t* XG = (bf16_t*)(ws + WS_XG); float* ssqt = (float*)(ws + WS_SSQT1);
#pragma unroll
    for (int t = 0; t < 2; ++t) {
        if (t == 1 && wave != 0) break;
        const int rb = t ? 8 : wave; const f32x4 va = t ? a8 : a0;
        const int lr = 16 * rb + fr, row = ROW_META + lr, col = n0 + 4 * fq;
        const f32x4 x = *(const f32x4*)(row_x(p.x_prompt, p.meta_tokens, p.x_sample, row) + col);
        const f32x4 v = va + x, g = *(const f32x4*)(p.g_norm_ffn + col);
        u32x2 w; w.x = pk2(v[0] * g[0], v[1] * g[1]); w.y = pk2(v[2] * g[2], v[3] * g[3]);
        *(u32x2*)(XG + (size_t)row * 1024 + col) = w;
        float ss = (v[0] * v[0] + v[1] * v[1]) + (v[2] * v[2] + v[3] * v[3]);
        ss += __shfl_xor(ss, 16); ss += __shfl_xor(ss, 32);
        if (fq == 0) ssqt[lr * 64 + unit] = ss;
    }
}
__device__ __forceinline__ float tail_row_sum64(const float* ssqt, int lr) {
    const f32x4* sp = (const f32x4*)(ssqt + lr * 64); float s = 0.f;
#pragma unroll
    for (int j = 0; j < 16; ++j) { const f32x4 a = sp[j]; s += (a[0] + a[1]) + (a[2] + a[3]); }
    return s;
}
__device__ __forceinline__ void tail_up_unit(const Params& p, LAS unsigned char* lds, int unit, int wave, int lane) {
    unsigned char* ws = p.ws; const int n0 = unit * 16, fr = lane & 15, fq = lane >> 4;
    f32x4 acc[9], a0, a8;
    ZERO9(acc); skinny_accum(SkinnyOp{(const bf16_t*)(ws + WS_XG), (const bf16_t*)(ws + WS_WUP), 1024}, n0, wave, lane, acc); skinny_reduce(lds, acc, wave, lane, a0, a8);
    float* UPT = (float*)(ws + WS_UPT); const float* ssqt = (const float*)(ws + WS_SSQT1);
    const int oc = ((n0 >> 7) & 1) * FF + 128 * (n0 >> 8) + (n0 & 127) + 4 * fq;
#pragma unroll
    for (int t = 0; t < 2; ++t) {
        if (t == 1 && wave != 0) break;
        const int rb = t ? 8 : wave; const f32x4 va = t ? a8 : a0;
        const int lr = 16 * rb + fr;
        const float r1 = rsqrtf(tail_row_sum64(ssqt, lr) * (1.0f / 1024.0f) + RMS_EPS);
        *(f32x4*)(UPT + (size_t)lr * FF2 + oc) = va * r1;
    }
}
__device__ __forceinline__ void tail_down_unit(const Params& p, LAS unsigned char* lds, int unit, int wave, int lane) {
    unsigned char* ws = p.ws; const int n0 = unit * 16, fr = lane & 15, fq = lane >> 4;
    f32x4 acc[9], a0, a8;
    ZERO9(acc); skinny_accum(SkinnyOp{(const bf16_t*)(ws + WS_ACT), (const bf16_t*)(ws + WS_WDOWN), FF}, n0, wave, lane, acc); skinny_reduce(lds, acc, wave, lane, a0, a8);
    const bf16_t* XG = (const bf16_t*)(ws + WS_XG); float* ssqt = (float*)(ws + WS_SSQT2);
    f32x4 vv[2];
#pragma unroll
    for (int t = 0; t < 2; ++t) {
        if (t == 1 && wave != 0) break;
        const int rb = t ? 8 : wave; const f32x4 va = t ? a8 : a0;
        const int lr = 16 * rb + fr, row = ROW_META + lr, col = n0 + 4 * fq;
        const u32x2 xg = *(const u32x2*)(XG + (size_t)row * 1024 + col); const f32x4 g = *(const f32x4*)(p.g_norm_ffn + col);
        f32x4 v;
        v[0] = va[0] + bf_lo(xg.x) * __builtin_amdgcn_rcpf(g[0]); v[1] = va[1] + bf_hi(xg.x) * __builtin_amdgcn_rcpf(g[1]);
        v[2] = va[2] + bf_lo(xg.y) * __builtin_amdgcn_rcpf(g[2]); v[3] = va[3] + bf_hi(xg.y) * __builtin_amdgcn_rcpf(g[3]);
        vv[t] = v;
        float ss = (v[0] * v[0] + v[1] * v[1]) + (v[2] * v[2] + v[3] * v[3]);
        ss += __shfl_xor(ss, 16); ss += __shfl_xor(ss, 32);
        if (fq == 0) AG_ST(ssqt + lr * 64 + unit, ss);
    }
#pragma unroll
    for (int t = 0; t < 2; ++t) {
        if (t == 1 && wave != 0) break;
        const int rb = t ? 8 : wave;
        const int lr = 16 * rb + fr, col = n0 + 4 * fq;
        float s = 0.f;
        for (int tries = 0; tries < (1 << 16); ++tries) {
            bool ready = true; s = 0.f;
#pragma unroll
            for (int j = 0; j < 16; ++j) { const float a = AG_LD(ssqt + lr * 64 + 16 * fq + j); ready = ready && (a >= 0.f); s += a; }
            if (__all(ready)) break;
            __builtin_amdgcn_s_sleep(8);
        }
        s += __shfl_xor(s, 16); s += __shfl_xor(s, 32);
        const float r = rsqrtf(s * (1.0f / 1024.0f) + RMS_EPS);
        if (lr >= 16) *(f32x4*)(p.out + O_YS + (size_t)(lr - 16) * D + col) = vv[t] * r * *(const f32x4*)(p.g_norm_final + col);
    }
}

__device__ __forceinline__ void skinny_accum3(const SkinnyOp op, int n0, int rb0, int wave, int lane, f32x4 (&acc)[3]) {
    const int fr = lane & 15, fq = lane >> 4;
    const bf16_t* bp = op.Bt + (size_t)(n0 + fr) * op.K + 8 * fq;
    const bf16_t* ap = op.A + (size_t)(ROW_META + 16 * rb0 + fr) * op.K + 8 * fq;
    const int nks = op.K >> 5;
    for (int ks0 = wave; ks0 < nks; ks0 += 32) {
        bf16x8 b[4], a[4][3];
#pragma unroll
        for (int j = 0; j < 4; ++j) {
            const int ks = ks0 + 8 * j; const int k = (ks < nks ? ks : ks0) * 32;
            b[j] = *(const bf16x8*)(bp + k);
#pragma unroll
            for (int rb = 0; rb < 3; ++rb) a[j][rb] = *(const bf16x8*)(ap + (size_t)rb * 16 * op.K + k);
        }
#pragma unroll
        for (int j = 0; j < 4; ++j) {
            if (ks0 + 8 * j < nks) {
#pragma unroll
                for (int rb = 0; rb < 3; ++rb) acc[rb] = __builtin_amdgcn_mfma_f32_16x16x32_bf16(b[j], a[j][rb], acc[rb], 0, 0, 0);
            }
        }
    }
}
__device__ __forceinline__ f32x4 skinny_reduce3(LAS unsigned char* lds, const f32x4 (&acc)[3], int wave, int lane) {
    LAS f32x4* part = (LAS f32x4*)lds;
#pragma unroll
    for (int rb = 0; rb < 3; ++rb) part[(wave * 3 + rb) * 64 + lane] = acc[rb];
    __syncthreads();
    f32x4 r = {0.f, 0.f, 0.f, 0.f};
    if (wave < 3) {
#pragma unroll
        for (int w = 0; w < 8; ++w) r += part[(w * 3 + wave) * 64 + lane];
    }
    __syncthreads();
    return r;
}
#define ZERO3(a) _Pragma("unroll") for (int z_ = 0; z_ < 3; ++z_) a[z_] = (f32x4){0.f, 0.f, 0.f, 0.f}
__device__ __forceinline__ void tail_mix_unit3(const Params& p, LAS unsigned char* lds, int unit, int wave, int lane) {
    unsigned char* ws = p.ws; const int n0 = (unit & 63) * 16, rb0 = 3 * (unit >> 6), fr = lane & 15, fq = lane >> 4;
    f32x4 acc[3];
    ZERO3(acc); skinny_accum3(SkinnyOp{(const bf16_t*)(ws + WS_ATT), (const bf16_t*)(ws + WS_WAO), 1024}, n0, rb0, wave, lane, acc); const f32x4 va = skinny_reduce3(lds, acc, wave, lane);
    ZERO3(acc); skinny_accum3(SkinnyOp{(const bf16_t*)(ws + WS_POOL), (const bf16_t*)(ws + WS_WPO), 512}, n0, rb0, wave, lane, acc); const f32x4 vb = skinny_reduce3(lds, acc, wave, lane);
    if (wave < 3) {
        const bf16_t *GA = (const bf16_t*)(ws + WS_GA), *GP = (const bf16_t*)(ws + WS_GP); bf16_t* MIX = (bf16_t*)(ws + WS_MIX);
        const size_t off = (size_t)(ROW_META + 16 * (rb0 + wave) + fr) * 1024 + n0 + 4 * fq;
        const u32x2 ga = *(const u32x2*)(GA + off), gp = *(const u32x2*)(GP + off);
        u32x2 w; w.x = pk2(bf_lo(ga.x) * va[0] + bf_lo(gp.x) * vb[0], bf_hi(ga.x) * va[1] + bf_hi(gp.x) * vb[1]);
        w.y = pk2(bf_lo(ga.y) * va[2] + bf_lo(gp.y) * vb[2], bf_hi(ga.y) * va[3] + bf_hi(gp.y) * vb[3]);
        *(u32x2*)(MIX + off) = w;
    }
}
__device__ __forceinline__ void tail_x1_unit3(const Params& p, LAS unsigned char* lds, int unit, int wave, int lane) {
    unsigned char* ws = p.ws; const int cu = unit & 63, n0 = cu * 16, rb0 = 3 * (unit >> 6), fr = lane & 15, fq = lane >> 4;
    f32x4 acc[3];
    ZERO3(acc); skinny_accum3(SkinnyOp{(const bf16_t*)(ws + WS_MIX), (const bf16_t*)(ws + WS_WOUT), 1024}, n0, rb0, wave, lane, acc); const f32x4 va = skinny_reduce3(lds, acc, wave, lane);
    if (wave < 3) {
        bf16_t* XG = (bf16_t*)(ws + WS_XG); float* ssqt = (float*)(ws + WS_SSQT1);
        const int lr = 16 * (rb0 + wave) + fr, row = ROW_META + lr, col = n0 + 4 * fq;
        const f32x4 x = *(const f32x4*)(row_x(p.x_prompt, p.meta_tokens, p.x_sample, row) + col);
        const f32x4 v = va + x, g = *(const f32x4*)(p.g_norm_ffn + col);
        u32x2 w; w.x = pk2(v[0] * g[0], v[1] * g[1]); w.y = pk2(v[2] * g[2], v[3] * g[3]);
        *(u32x2*)(XG + (size_t)row * 1024 + col) = w;
        float ss = (v[0] * v[0] + v[1] * v[1]) + (v[2] * v[2] + v[3] * v[3]);
        ss += __shfl_xor(ss, 16); ss += __shfl_xor(ss, 32);
        if (fq == 0) ssqt[lr * 64 + cu] = ss;
    }
}
__device__ __forceinline__ void tail_down_unit3(const Params& p, LAS unsigned char* lds, int unit, int wave, int lane) {
    unsigned char* ws = p.ws; const int cu = unit & 63, n0 = cu * 16, rb0 = 3 * (unit >> 6), fr = lane & 15, fq = lane >> 4;
    f32x4 acc[3];
    ZERO3(acc); skinny_accum3(SkinnyOp{(const bf16_t*)(ws + WS_ACT), (const bf16_t*)(ws + WS_WDOWN), FF}, n0, rb0, wave, lane, acc); const f32x4 va = skinny_reduce3(lds, acc, wave, lane);
    if (wave < 3) {
        const bf16_t* XG = (const bf16_t*)(ws + WS_XG); float* ssqt = (float*)(ws + WS_SSQT2);
        const int lr = 16 * (rb0 + wave) + fr, row = ROW_META + lr, col = n0 + 4 * fq;
        const u32x2 xg = *(const u32x2*)(XG + (size_t)row * 1024 + col); const f32x4 g = *(const f32x4*)(p.g_norm_ffn + col);
        f32x4 v;
        v[0] = va[0] + bf_lo(xg.x) * __builtin_amdgcn_rcpf(g[0]); v[1] = va[1] + bf_hi(xg.x) * __builtin_amdgcn_rcpf(g[1]);
        v[2] = va[2] + bf_lo(xg.y) * __builtin_amdgcn_rcpf(g[2]); v[3] = va[3] + bf_hi(xg.y) * __builtin_amdgcn_rcpf(g[3]);
        float ss = (v[0] * v[0] + v[1] * v[1]) + (v[2] * v[2] + v[3] * v[3]);
        ss += __shfl_xor(ss, 16); ss += __shfl_xor(ss, 32);
        if (fq == 0) AG_ST(ssqt + lr * 64 + cu, ss);
        float s = 0.f;
        for (int tries = 0; tries < (1 << 16); ++tries) {
            bool ready = true; s = 0.f;
#pragma unroll
            for (int j = 0; j < 16; ++j) { const float a = AG_LD(ssqt + lr * 64 + 16 * fq + j); ready = ready && (a >= 0.f); s += a; }
            if (__all(ready)) break;
            __builtin_amdgcn_s_sleep(2);
        }
        s += __shfl_xor(s, 16); s += __shfl_xor(s, 32);
        const float r = rsqrtf(s * (1.0f / 1024.0f) + RMS_EPS);
        if (lr >= 16) *(f32x4*)(p.out + O_YS + (size_t)(lr - 16) * D + col) = v * r * *(const f32x4*)(p.g_norm_final + col);
    }
}

__device__ __forceinline__ void conv_fix(const Params& p) {
    unsigned char* ws = p.ws;
    const float* HALO = (const float*)(ws + WS_HALO); const float* UPT = (const float*)(ws + WS_UPT); bf16_t* ACT = (bf16_t*)(ws + WS_ACT);
    const float *cw = p.conv_w, *cb = p.conv_b;
    const int gt = blockIdx.x * 512 + threadIdx.x, NT = gridDim.x * 512;
    constexpr int NCH = FF / 4;
    constexpr int N_SLAB = 256 * 2 * NCH, N_SAMP = 128 * NCH;
    for (int it = gt; it < N_SLAB + N_SAMP; it += NT) {
        const float *u0, *u1, *u2; int row, j;
        if (it < N_SLAB) {
            const int ch = it % NCH, sr = it / NCH, rr = sr & 1, s = sr >> 1; j = ch * 4;
            row = s * 128 + rr;
            const float* l1 = (s & 31) ? HALO + (size_t)((s - 1) * 4 + 3) * FF2 : UPT + (size_t)15 * FF2;
            const float* l0 = (s & 31) ? HALO + (size_t)((s - 1) * 4 + 2) * FF2 : UPT + (size_t)14 * FF2;
            u0 = HALO + (size_t)(s * 4 + rr) * FF2;
            if (rr == 0) { u1 = l1; u2 = l0; } else { u1 = HALO + (size_t)(s * 4) * FF2; u2 = l1; }
        } else {
            const int t = it - N_SLAB, ch = t % NCH, q = t / NCH, b = q >> 4, i = q & 15; j = ch * 4;
            row = ROW_SAMP + q;
            u0 = UPT + (size_t)(16 + q) * FF2;
            u1 = (i >= 1) ? UPT + (size_t)(16 + q - 1) * FF2 : p.state_conv + ((size_t)b * 2 + 1) * FF2;
            u2 = (i >= 2) ? UPT + (size_t)(16 + q - 2) * FF2 : p.state_conv + ((size_t)b * 2 + i) * FF2;
        }
        const f32x4 g0 = *(const f32x4*)(u0 + j), g1 = *(const f32x4*)(u1 + j), g2 = *(const f32x4*)(u2 + j);
        const f32x4 v0 = *(const f32x4*)(u0 + FF + j), v1 = *(const f32x4*)(u1 + FF + j), v2 = *(const f32x4*)(u2 + FF + j);
        const f32x4 cg = *(const f32x4*)(cb + j) + *(const f32x4*)(cw + j) * g2 + *(const f32x4*)(cw + FF2 + j) * g1 + *(const f32x4*)(cw + 2 * FF2 + j) * g0;
        const f32x4 cv = *(const f32x4*)(cb + FF + j) + *(const f32x4*)(cw + FF + j) * v2 + *(const f32x4*)(cw + FF2 + FF + j) * v1 + *(const f32x4*)(cw + 2 * FF2 + FF + j) * v0;
        float a[4];
#pragma unroll
        for (int i = 0; i < 4; ++i) a[i] = cg[i] * sigmoidf_(cg[i]) * cv[i];
        u32x2 w; w.x = pk2(a[0], a[1]); w.y = pk2(a[2], a[3]);
        *(u32x2*)(ACT + (size_t)row * FF + j) = w;
    }
    { f32x4* q4 = (f32x4*)(ws + WS_SSQ2); for (int i = gt; i < MREAL * 4; i += NT) q4[i] = (f32x4){-1.f, -1.f, -1.f, -1.f};
      f32x4* t4 = (f32x4*)(ws + WS_SSQT2); for (int i = gt; i < 144 * 16; i += NT) t4[i] = (f32x4){-1.f, -1.f, -1.f, -1.f};
      unsigned* pc = (unsigned*)(ws + WS_PCNT); for (int i = gt; i < 128; i += NT) pc[64 * i] = 0u; }
    for (int i = gt; i < 8 * 2 * FF2; i += NT) {
        const int c = i % FF2, k = (i / FF2) & 1, b = i / (2 * FF2);
        p.out[O_PCONV + i] = HALO[(size_t)((b * 32 + 31) * 4 + 2 + k) * FF2 + c];
        p.out[O_SCONV + i] = UPT[(size_t)(16 + b * 16 + 14 + k) * FF2 + c];
    }
}
__device__ __forceinline__ void final_norm(const Params& p, int wave, int lane) {
    const float* ssq = (const float*)(p.ws + WS_SSQ2);
    const int gw = blockIdx.x * 8 + wave, NGW = gridDim.x * 8;
    f32x4 gv[4];
#pragma unroll
    for (int j = 0; j < 4; ++j) gv[j] = ((const f32x4*)p.g_norm_final)[lane + 64 * j];
    for (int m0 = gw * 4; m0 < MREAL + 128; m0 += NGW * 4) {
        float sv[4]; f32x4 x[4][4]; float* orow[4];
#pragma unroll
        for (int q = 0; q < 4; ++q) {
            const int m = m0 + q;
            orow[q] = m < MREAL ? p.out + O_YP + (size_t)m * D : p.out + O_YS + (size_t)(m - MREAL) * D;
            if (m < MREAL) sv[q] = ssq[(size_t)m * 16 + (lane & 15)];
            else { const float* st = (const float*)(p.ws + WS_SSQT2) + (16 + m - MREAL) * 64; sv[q] = (st[lane & 15] + st[16 + (lane & 15)]) + (st[32 + (lane & 15)] + st[48 + (lane & 15)]); }
#pragma unroll
            for (int j = 0; j < 4; ++j) x[q][j] = ((const f32x4*)orow[q])[lane + 64 * j];
        }
#pragma unroll
        for (int q = 0; q < 4; ++q) {
            float s = sv[q];
            s += __shfl_xor(s, 1); s += __shfl_xor(s, 2); s += __shfl_xor(s, 4); s += __shfl_xor(s, 8);
            const float r = rsqrtf(s * (1.0f / D) + RMS_EPS);
#pragma unroll
            for (int j = 0; j < 4; ++j) ((f32x4*)orow[q])[lane + 64 * j] = x[q][j] * r * gv[j];
        }
    }
}


struct EpiNull {
    static constexpr bool PERM = true, AFTER_DRAIN = false, APERM = false;
    float* sink;
    __device__ __forceinline__ void operator()(const f32x4 (&acc)[2][2][4][2], const Unit& u, int wr, int wc, int fr, int fq) const {
        f32x4 t = {0.f, 0.f, 0.f, 0.f};
#pragma unroll
        for (int a = 0; a < 2; ++a)
#pragma unroll
            for (int b = 0; b < 2; ++b)
#pragma unroll
                for (int m = 0; m < 4; ++m)
#pragma unroll
                    for (int n = 0; n < 2; ++n) t += acc[a][b][m][n];
        if (t[0] + t[1] + t[2] + t[3] == 123456.789f) sink[threadIdx.x] = t[0];
    }
};
struct SamePanelOrder {
    int G, c, nr;
    __device__ bool next(int i, Unit& u) const { if (i >= nr) return false; u.pm = 0; u.pn = (c >> 6) & 3; return true; }
    __device__ __forceinline__ void a_ready(const Unit&) const {}
    __device__ __forceinline__ void done(const Unit&) const {}
};

typedef unsigned v4u_unused_t;
#define XB_TMO      128
#define XB_XCNT(j)  (256  + 64 * (j))
#define XB_XSUB(j)  (1280 + 64 * (j))
#define XB_XGEN(j)  (2304 + 64 * (j))
#define XB_TOP      3328
#define XB_TOPGEN   3392
#define XCD_BAR_WORDS 3456
#define XB_SPIN_CAP (1u << 18)

__device__ __forceinline__ unsigned xb_ld(unsigned* p)              { return __hip_atomic_load(p, __ATOMIC_RELAXED, __HIP_MEMORY_SCOPE_AGENT); }
__device__ __forceinline__ unsigned xb_add(unsigned* p, unsigned v) { return __hip_atomic_fetch_add(p, v, __ATOMIC_RELAXED, __HIP_MEMORY_SCOPE_AGENT); }
__device__ __forceinline__ unsigned xb_xcc_id() { return (unsigned)__builtin_amdgcn_s_getreg((3 << 11) | 20) & 0xFu; }
#define XB_SPIN(cond, bar) do { unsigned _sp = 0; while (cond) { __builtin_amdgcn_s_sleep(1); \
    if ((++_sp & 255u) == 0u) { if (xb_ld(&(bar)[XB_TMO])) break; if (_sp > XB_SPIN_CAP) { atomicAdd(&(bar)[XB_TMO], 1u); break; } } } } while (0)

struct XcdBarrier {
    unsigned* bar; unsigned x;
    volatile LAS unsigned* st;
};

__device__ __forceinline__ XcdBarrier xcd_barrier_post(unsigned* bar, volatile LAS unsigned* st) {
    XcdBarrier b; b.bar = bar; b.x = xb_xcc_id(); b.st = st;
    if (threadIdx.x == 0) (void)xb_add(&bar[XB_XCNT(b.x)], 1u);
    return b;
}
__device__ __forceinline__ void xcd_barrier_complete(unsigned* bar, unsigned x, unsigned& nloc, unsigned& nx) {
    const unsigned G = gridDim.x * gridDim.y * gridDim.z;
    unsigned sum, cnt, mine, sp = 0u;
    for (;;) {
        sum = 0u; cnt = 0u; mine = 0u;
#pragma unroll
        for (unsigned j = 0; j < 16; ++j) { const unsigned c = xb_ld(&bar[XB_XCNT(j)]); sum += c; cnt += (c > 0u) ? 1u : 0u; mine = (j == x) ? c : mine; }
        if (sum == G) break;
        __builtin_amdgcn_s_sleep(1);
        if ((++sp & 255u) == 0u) { if (xb_ld(&bar[XB_TMO])) break; if (sp > XB_SPIN_CAP) { atomicAdd(&bar[XB_TMO], 1u); break; } }
    }
    nloc = mine > 0u ? mine : 1u; nx = cnt > 0u ? cnt : 1u;
}

__device__ __forceinline__ void xcd_barrier(const XcdBarrier& b) {
    asm volatile("s_waitcnt vmcnt(0)" ::: "memory");
    __syncthreads();
    if (threadIdx.x == 0) {
        unsigned* bar = b.bar;
        __builtin_amdgcn_s_waitcnt(0);
        unsigned nloc = b.st[0], nx = b.st[1];
        if (nloc == 0u) { xcd_barrier_complete(bar, b.x, nloc, nx); b.st[0] = nloc; b.st[1] = nx; }
        const unsigned old = xb_add(&bar[XB_XSUB(b.x)], 1u);
        const unsigned gen = old / nloc;
        if (old + 1u == (gen + 1u) * nloc) {
            __builtin_amdgcn_fence(__ATOMIC_RELEASE, "agent");
            asm volatile("s_waitcnt vmcnt(0)" ::: "memory");
            const unsigned og = xb_add(&bar[XB_TOP], 1u);
            const unsigned tg = og / nx;
            if (og + 1u == (tg + 1u) * nx) xb_add(&bar[XB_TOPGEN], 1u);
            else XB_SPIN(xb_ld(&bar[XB_TOPGEN]) == tg, bar);
            __builtin_amdgcn_fence(__ATOMIC_ACQUIRE, "agent");
            xb_add(&bar[XB_XGEN(b.x)], 1u);
            asm volatile("s_waitcnt vmcnt(0)" ::: "memory");
        } else {
            XB_SPIN(xb_ld(&bar[XB_XGEN(b.x)]) == gen, bar);
            __builtin_amdgcn_fence(__ATOMIC_ACQUIRE, "agent");
            asm volatile("s_waitcnt vmcnt(0)" ::: "memory");
        }
    }
    __syncthreads();
}

__device__ __forceinline__ void grid_bar(unsigned* ctr, unsigned target) {
    asm volatile("s_waitcnt vmcnt(0) lgkmcnt(0)" ::: "memory");
    __syncthreads();
    if (threadIdx.x == 0) {
        __hip_atomic_fetch_add(ctr, 1u, __ATOMIC_RELEASE, __HIP_MEMORY_SCOPE_AGENT);
        unsigned spins = 0;
        while (__hip_atomic_load(ctr, __ATOMIC_RELAXED, __HIP_MEMORY_SCOPE_AGENT) < target) { __builtin_amdgcn_s_sleep(2); if (++spins > (1u << 24)) break; }
        __builtin_amdgcn_fence(__ATOMIC_ACQUIRE, "agent");
        asm volatile("s_waitcnt vmcnt(0)" ::: "memory");
    }
    __syncthreads();
}
__global__ void __launch_bounds__(512, 2) fwd_megakernel(Params p) {
    extern __shared__ __attribute__((aligned(16))) unsigned char lds_raw[];
    LAS unsigned char* lds = (LAS unsigned char*)lds_raw;
    cg::grid_group grid = cg::this_grid();
    const int wave = __builtin_amdgcn_readfirstlane(threadIdx.x >> 6);
#define TIDLANE() int tid = threadIdx.x; asm volatile("" : "+v"(tid)); const int lane = tid & 63
    unsigned char* ws = p.ws;
    const int lo = p.ph_lo, hi = p.ph_hi, G = gridDim.x;
#define IN(k) (lo <= (k) && (k) < hi)
#define SEAM(k) do { if (IN(k) && IN((k) + 1)) xcd_barrier(xbar); } while (0)
    if (lo < 0) grid.sync();
    volatile LAS unsigned* xst = (volatile LAS unsigned*)(lds + LDS_BYTES - 32);
    if (threadIdx.x < 2) xst[threadIdx.x] = 0u;
    __syncthreads();
    XcdBarrier xbar = xcd_barrier_post((unsigned*)(ws + 4096), xst);
    if (IN(0)) { TIDLANE(); (void)tid; p0_prologue(p, lds, wave, lane); __syncthreads(); }
    SEAM(0);
    if (IN(1)) {
        pg8::Gemm g{(const bf16_t*)(ws + WS_XN), (const bf16_t*)(ws + WS_WIN), M, INW, D}; pg8::StaticOrder S; S.init(M, INW, G, (int)blockIdx.x);
        EpiZ E{(bf16_t*)(ws + WS_Q), (bf16_t*)(ws + WS_K), (bf16_t*)(ws + WS_V), (bf16_t*)(ws + WS_P), (bf16_t*)(ws + WS_GA), (bf16_t*)(ws + WS_GP), p.b_gate, (const float*)(ws + WS_ROPE)};
        pg8::gemm_phase<EpiZ, pg8::StaticOrder, true, true>(lds, g, S, E);
    }
    SEAM(1);
    if (IN(2)) {
        TIDLANE();
        for (int unit = blockIdx.x; unit < 1024; unit += G) attn_chunk_unit(p, lds, unit, tid, wave, lane);
        constexpr int N_EXTRA = 27;
        if (G > 2 * N_EXTRA) {
            if ((int)blockIdx.x < N_EXTRA) { const int e = blockIdx.x; if (e < 18) attn_small_unit(p, lds, e, tid, wave, lane); else pool_unit(p, lds, 512 + e - 18, tid, wave, lane); }
            else for (int unit = blockIdx.x - N_EXTRA; unit < 512; unit += G - N_EXTRA) pool_unit(p, lds, unit, tid, wave, lane);
        } else {
            for (int unit = blockIdx.x; unit < 18 + 521; unit += G) { if (unit < 18) attn_small_unit(p, lds, unit, tid, wave, lane); else pool_unit(p, lds, unit - 18, tid, wave, lane); }
        }
        small_outputs(p);
    }
    SEAM(2);
    if (IN(3)) {
        { TIDLANE(); (void)tid; for (int unit = blockIdx.x; unit < 192; unit += G) tail_mix_unit3(p, lds, unit, wave, lane); }
        { pg8::Gemm g{(const bf16_t*)(ws + WS_ATT), (const bf16_t*)(ws + WS_WAO), MREAL, D, D}; pg8::StaticOrder S; S.init(MREAL, D, G, (int)blockIdx.x);
          EpiT1 E{(const bf16_t*)(ws + WS_GA), (bf16_t*)(ws + WS_MIX)};
          pg8::gemm_phase<EpiT1, pg8::StaticOrder, true, true>(lds, g, S, E); }
        __syncthreads();
        { pg8::Gemm g{(const bf16_t*)(ws + WS_POOL), (const bf16_t*)(ws + WS_WPO), MREAL, D, PW}; pg8::StaticOrder S; S.init(MREAL, D, G, (int)blockIdx.x);
          EpiMix E{(const bf16_t*)(ws + WS_GP), (bf16_t*)(ws + WS_MIX)};
          pg8::gemm_phase<EpiMix, pg8::StaticOrder, true, true>(lds, g, S, E); }
    }
    SEAM(3);
    if (IN(4)) {
        { TIDLANE(); (void)tid; for (int unit = blockIdx.x; unit < 192; unit += G) tail_x1_unit3(p, lds, unit, wave, lane); }
        pg8::Gemm g{(const bf16_t*)(ws + WS_MIX), (const bf16_t*)(ws + WS_WOUT), MREAL, D, D}; pg8::StaticOrder S; S.init(MREAL, D, G, (int)blockIdx.x);
        EpiX1 E{(const bf16_t*)(ws + WS_XN), (const float*)(ws + WS_R0I), p.g_norm_mix, p.g_norm_ffn, (bf16_t*)(ws + WS_XG), (float*)(ws + WS_SSQ1)};
        pg8::gemm_phase<EpiX1, pg8::StaticOrder, true, true>(lds, g, S, E);
    }
    SEAM(4);
    if (IN(5)) {
        { TIDLANE(); (void)tid; for (int unit = blockIdx.x; unit < FF2 / 16; unit += G) tail_up_unit(p, lds, unit, wave, lane); }
        pg8::Gemm g{(const bf16_t*)(ws + WS_XG), (const bf16_t*)(ws + WS_WUP), MREAL, FF2, D}; pg8::StaticOrder S; S.init(MREAL, FF2, G, (int)blockIdx.x);
        EpiUp E{(const float*)(ws + WS_SSQ1), p.conv_w, p.conv_b, (bf16_t*)(ws + WS_ACT), (float*)(ws + WS_HALO), (float*)(ws + WS_UPT)};
        pg8::gemm_phase<EpiUp, pg8::StaticOrder, true, true>(lds, g, S, E);
    }
    SEAM(5);
    if (IN(6)) conv_fix(p);
    SEAM(6);
    if (IN(7)) {
        { TIDLANE(); (void)tid; for (int unit = blockIdx.x; unit < 192; unit += G) tail_down_unit3(p, lds, unit, wave, lane); }
        pg8::Gemm g{(const bf16_t*)(ws + WS_ACT), (const bf16_t*)(ws + WS_WDOWN), MREAL, D, FF}; pg8::StaticOrder S; S.init(MREAL, D, G, (int)blockIdx.x, 1);
        EpiDown E{(const bf16_t*)(ws + WS_XG), p.g_norm_ffn, p.g_norm_final, p.out, (float*)(ws + WS_SSQ2)};
        pg8::gemm_phase<EpiDown, pg8::StaticOrder, true, true>(lds, g, S, E);
    }
    if (IN(8)) { TIDLANE(); for (int unit = blockIdx.x; unit < 1024; unit += G) attn_chunk_unit(p, lds, unit, tid, wave, lane); }
    if (IN(9)) { TIDLANE(); for (int unit = blockIdx.x; unit < 512; unit += G) pool_unit(p, lds, unit, tid, wave, lane); }
    if (IN(12)) { TIDLANE(); for (int unit = 512 + blockIdx.x; unit < 521; unit += G) pool_unit(p, lds, unit, tid, wave, lane); }
    if (IN(10)) { TIDLANE(); for (int unit = blockIdx.x; unit < 18; unit += G) attn_small_unit(p, lds, unit, tid, wave, lane); }
    if (IN(11)) { small_outputs(p); }
    if (IN(17)) { pg8::Gemm g{(const bf16_t*)(ws + WS_ACT), (const bf16_t*)(ws + WS_WDOWN), MREAL, D, FF}; pg8::StaticOrder S; S.init(MREAL, D, G, (int)blockIdx.x, 1);
        EpiDown E{(const bf16_t*)(ws + WS_XG), p.g_norm_ffn, p.g_norm_final, p.out, (float*)(ws + WS_SSQ2)};
        pg8::gemm_phase<EpiDown, pg8::StaticOrder, true, true>(lds, g, S, E); }
    if (IN(18)) { TIDLANE(); (void)tid; for (int unit = blockIdx.x; unit < 192; unit += G) tail_down_unit3(p, lds, unit, wave, lane); }
    if (IN(14)) { pg8::Gemm g{(const bf16_t*)(ws + WS_ACT), (const bf16_t*)(ws + WS_WDOWN), MREAL, D, FF}; pg8::StaticOrder S; S.init(MREAL, D, G, (int)blockIdx.x, 1); EpiNull E{(float*)(ws + WS_SSQ1)};
        pg8::gemm_phase<EpiNull, pg8::StaticOrder, true, true>(lds, g, S, E); }
    if (IN(15)) { pg8::Gemm g{(const bf16_t*)(ws + WS_ACT), (const bf16_t*)(ws + WS_WDOWN), MREAL, D, FF}; SamePanelOrder S{G, (int)blockIdx.x, 2}; EpiNull E{(float*)(ws + WS_SSQ1)};
        pg8::gemm_phase<EpiNull, SamePanelOrder, true, true>(lds, g, S, E); }
    if (IN(16)) { pg8::Gemm g{(const bf16_t*)(ws + WS_MIX), (const bf16_t*)(ws + WS_WOUT), MREAL, D, D}; pg8::StaticOrder S; S.init(MREAL, D, G, (int)blockIdx.x); EpiNull E{(float*)(ws + WS_SSQ1)};
        pg8::gemm_phase<EpiNull, pg8::StaticOrder, true, true>(lds, g, S, E); }
#undef IN
#undef SEAM
}

#ifndef MK_N_LAUNCHES
#define MK_N_LAUNCHES 1
#endif
#ifndef PROBE_PHASE
#define PROBE_PHASE -1
#endif
extern "C" void kernel_launch(void* const* d_in, const int* in_sizes, int n_in, void* d_out, int out_size, void* d_ws, size_t ws_size, hipStream_t stream) {
    static int grid = 0;
    if (grid == 0) {
        if (n_in != 24 || (size_t)out_size != O_END || ws_size < WS_END) { fprintf(stderr, "kernel_launch: unexpected shapes: n_in %d out %d ws %zu (need %zu)\n", n_in, out_size, ws_size, (size_t)WS_END); grid = -1; return; }
        int dev = 0, cus = 0, per_cu = 0;
        hipGetDevice(&dev); hipDeviceGetAttribute(&cus, hipDeviceAttributeMultiprocessorCount, dev);
        if (hipFuncSetAttribute((const void*)fwd_megakernel, hipFuncAttributeMaxDynamicSharedMemorySize, LDS_BYTES) != hipSuccess) { fprintf(stderr, "kernel_launch: hipFuncSetAttribute failed\n"); grid = -1; return; }
        if (hipOccupancyMaxActiveBlocksPerMultiprocessor(&per_cu, (const void*)fwd_megakernel, 512, LDS_BYTES) != hipSuccess || per_cu < 1) { fprintf(stderr, "kernel_launch: occupancy query gave %d\n", per_cu); per_cu = 1; }
        (void)hipGetLastError();
        grid = cus;
        fprintf(stderr, "kernel_launch: grid %d (per_cu %d)\n", grid, per_cu);
    }
    if (grid < 0) return;
    Params p{};
    const float** pp = (const float**)&p;
    for (int i = 0; i < 24; ++i) pp[i] = (const float*)d_in[i];
    p.out = (float*)d_out; p.ws = (unsigned char*)d_ws;
    for (int i = 0; i < 32; ++i) p.inv_freq[i] = powf(10000.0f, -(float)i / 32.0f);
    const int NPH = 8;
    int seq[8][2]; int nseq = 0;
    if (PROBE_PHASE >= NPH) { seq[0][0] = 0; seq[0][1] = NPH; seq[1][0] = PROBE_PHASE; seq[1][1] = PROBE_PHASE + 1; nseq = 2; }
    else if (PROBE_PHASE >= 0) { seq[0][0] = 0; seq[0][1] = PROBE_PHASE + 1; seq[1][0] = PROBE_PHASE; seq[1][1] = PROBE_PHASE + 1; nseq = 2; if (PROBE_PHASE + 1 < NPH) { seq[2][0] = PROBE_PHASE + 1; seq[2][1] = NPH; nseq = 3; } }
    else { seq[0][0] = 0; seq[0][1] = NPH; nseq = 1; }
    for (int k = 0; k < nseq; ++k) {
        if (hipMemsetAsync(d_ws, 0, 32768, stream) != hipSuccess) fprintf(stderr, "kernel_launch: memset failed\n");
        p.ph_lo = seq[k][0]; p.ph_hi = seq[k][1];
        void* args[] = {&p}; hipError_t e = hipLaunchCooperativeKernel((const void*)fwd_megakernel, dim3(grid), dim3(512), args, LDS_BYTES, stream);
        if (e != hipSuccess) fprintf(stderr, "kernel_launch: cooperative launch %d failed: %s\n", k, hipGetErrorString(e));
    }
}
```

```cpp
#include <hip/hip_runtime.h>
#include <hip/hip_cooperative_groups.h>
#include <cstdio>
#include <cstdint>
#include <cmath>
namespace cg = cooperative_groups;
namespace pg8 {
#define PG8_LAS __attribute__((address_space(3)))
typedef unsigned short bf16_t;
typedef short bf16x8 __attribute__((ext_vector_type(8)));
typedef float f32x4 __attribute__((ext_vector_type(4)));
typedef unsigned u32x4 __attribute__((ext_vector_type(4)));
constexpr int BM = 256, BK = 64, HALF = 128, HTB = HALF * BK * 2  , STAGE_BYTES = 8 * HTB, NXCD = 8, WGM = 8;

__host__ __device__ __forceinline__ int lds_byte(int r, int c) { const int st = (r >> 4) * 2 + (c >> 5), rr = r & 15, cc = c & 31, ob = rr * 64 + cc * 2; return st * 1024 + (ob ^ (((ob >> 9) & 1) << 5)); }
__host__ __device__ __forceinline__ void stage_rc(int b, int& R, int& C) { const int st = b / 1024, sb = b % 1024, swz = sb ^ (((sb >> 9) & 1) << 5); R = (st >> 1) * 16 + swz / 64; C = (st & 1) * 32 + (swz % 64) / 2; }
__host__ __device__ __forceinline__ int perm32(int rho) { const int n = rho >> 4, i = rho & 15; return 8 * (i >> 2) + 4 * n + (i & 3); }

struct Unit { int pm, pn; };
struct Gemm { const bf16_t* A; const bf16_t* Bt; int M, N, K; };

struct StaticOrder {
    int nM, nN, nwg, G, c, rev;
    __host__ __device__ void init(int M, int N, int G_, int c_, int rev_ = 0) { nM = M / BM; nN = N / BM; nwg = nM * nN; G = G_; c = c_; rev = rev_; }
    __host__ __device__ bool next(int i, Unit& u) const {
        const int nr = (nwg + G - 1) / G;
        if (i >= nr) return false;
        const long L = (long)((rev && nwg % G == 0) ? nr - 1 - i : i) * G + c; if (L >= nwg) return false;
        int wgid = (int)L; { const int q = nwg / NXCD, r = nwg % NXCD, xcd = wgid % NXCD, off = wgid / NXCD; wgid = (xcd < r ? xcd * (q + 1) : r * (q + 1) + (xcd - r) * q) + off; }
        const int nig = WGM * nN, gid = wgid / nig, fm = gid * WGM, gsz = (nM - fm) < WGM ? (nM - fm) : WGM;
        u.pm = fm + ((wgid % nig) % gsz); u.pn = (wgid % nig) / gsz; return true;
    }
    __device__ __forceinline__ void a_ready(const Unit&) const {}
    __device__ __forceinline__ void done(const Unit&) const {}
};

__device__ __forceinline__ unsigned cvt_pk_bf16(float lo, float hi) { unsigned r; asm volatile("v_cvt_pk_bf16_f32 %0, %1, %2" : "=v"(r) : "v"(lo), "v"(hi)); return r; }
template <class Epi, class Sched, bool ALIGN_EPI = false, bool SP2 = false>
__device__ __forceinline__ void gemm_phase(PG8_LAS unsigned char* lds, const Gemm g, const Sched& S, const Epi& E) {
    const int tid = threadIdx.x, wid = __builtin_amdgcn_readfirstlane(tid >> 6), lane = tid & 63, wr = wid >> 2, wc = wid & 3, fr = lane & 15, fq = lane >> 4;
    const int K = g.K, nt = K / BK;
    unsigned voffA[2], voffB[2];
#pragma unroll
    for (int i = 0; i < 2; ++i) { int R, C; stage_rc(tid * 16 + i * 8192, R, C); const int Rb = Epi::PERM ? ((R & ~31) + perm32(R & 31)) : R;
        const int Ra = Epi::APERM ? ((R >> 6) * 128 + (R & 63)) : R;
        voffA[i] = (unsigned)(Ra * K + C) * 2u; voffB[i] = (unsigned)(Rb * K + C) * 2u; }
    const size_t kstep = (size_t)(BK * 2);
    const size_t hstep = (size_t)HALF * K * 2;
    const size_t tstep = 2 * hstep;
    const size_t hstepA = Epi::APERM ? (size_t)64 * K * 2 : hstep;
    const unsigned ldsw = (unsigned)wid * 1024u;
    const int aoff = lds_byte(wr * 64 + fr, fq * 8), boff = lds_byte(wc * 32 + fr, fq * 8);
#define PG8_SA(b, h) (((b) * 2 + (h)) * HTB)
#define PG8_SB(b, h) ((4 + (b) * 2 + (h)) * HTB)
#define PG8_STAGE(bufoff, gbase, voff) do { _Pragma("unroll") for (int _i = 0; _i < 2; ++_i) \
        __builtin_amdgcn_global_load_lds((const unsigned*)((const char*)(gbase) + (voff)[_i]), (PG8_LAS unsigned*)(lds + (bufoff) + ldsw + _i * 8192), 16, 0, 0); } while (0)
#define PG8_LDA(dst, b, h) do { _Pragma("unroll") for (int m = 0; m < 4; ++m) _Pragma("unroll") for (int k = 0; k < 2; ++k) dst[m][k] = *(const PG8_LAS bf16x8*)(lds + PG8_SA(b, h) + aoff + m * 2048 + k * 1024); } while (0)
#define PG8_LDB(dst, b, h) do { _Pragma("unroll") for (int n = 0; n < 2; ++n) _Pragma("unroll") for (int k = 0; k < 2; ++k) dst[n][k] = *(const PG8_LAS bf16x8*)(lds + PG8_SB(b, h) + boff + n * 2048 + k * 1024); } while (0)
#define PG8_MMA(ai, bj, At, Bt) do { __builtin_amdgcn_s_setprio(1); _Pragma("unroll") for (int m = 0; m < 4; ++m) _Pragma("unroll") for (int n = 0; n < 2; ++n) _Pragma("unroll") for (int k = 0; k < 2; ++k) \
        acc[ai][bj][m][n] = __builtin_amdgcn_mfma_f32_16x16x32_bf16(Bt[n][k], At[m][k], acc[ai][bj][m][n], 0, 0, 0); __builtin_amdgcn_s_setprio(0); } while (0)
#define PG8_WAIT_V(n) asm volatile("s_waitcnt vmcnt(" #n ")" ::: "memory")
#define PG8_WAIT_L(n) asm volatile("s_waitcnt lgkmcnt(" #n ")" ::: "memory")
#define PG8_BAR __builtin_amdgcn_s_barrier()
#define PG8_SCHED __builtin_amdgcn_sched_barrier(0)
    Unit cur, nxt; int ui = 0;
    if (!S.next(0, cur)) return;
    f32x4 acc[2][2][4][2];
#pragma unroll
    for (int a = 0; a < 2; ++a)
#pragma unroll
        for (int b = 0; b < 2; ++b)
#pragma unroll
            for (int m = 0; m < 4; ++m)
#pragma unroll
                for (int n = 0; n < 2; ++n) acc[a][b][m][n] = (f32x4){0.f, 0.f, 0.f, 0.f};
    bf16x8 At[4][2], B0[2][2], B1[2][2];
    const char* cA = (const char*)g.A + (size_t)cur.pm * tstep; const char* cB = (const char*)g.Bt + (size_t)cur.pn * tstep;
    S.a_ready(cur);
    if constexpr (SP2) {
        PG8_STAGE(PG8_SB(0, 0), cB, voffB); PG8_STAGE(PG8_SB(0, 1), cB + hstep, voffB); PG8_STAGE(PG8_SA(0, 0), cA, voffA); PG8_STAGE(PG8_SA(0, 1), cA + hstepA, voffA);
        if (wr == 1) PG8_BAR;
        PG8_WAIT_V(2); PG8_BAR;
        PG8_STAGE(PG8_SB(1, 0), cB + kstep, voffB); PG8_STAGE(PG8_SA(1, 0), cA + kstep, voffA); PG8_STAGE(PG8_SB(1, 1), cB + hstep + kstep, voffB);
        PG8_WAIT_V(6); PG8_BAR;
    } else {
        PG8_STAGE(PG8_SB(0, 0), cB, voffB); PG8_STAGE(PG8_SA(0, 0), cA, voffA); PG8_STAGE(PG8_SB(0, 1), cB + hstep, voffB); PG8_STAGE(PG8_SA(0, 1), cA + hstepA, voffA);
        if (wr == 1) PG8_BAR;
        PG8_WAIT_V(4); PG8_BAR;
        PG8_STAGE(PG8_SB(1, 0), cB + kstep, voffB); PG8_STAGE(PG8_SA(1, 0), cA + kstep, voffA); PG8_STAGE(PG8_SB(1, 1), cB + hstep + kstep, voffB);
        PG8_WAIT_V(6); PG8_BAR;
    }
    for (;;) {
        const bool has_next = S.next(ui + 1, nxt);
        const char* nA = has_next ? (const char*)g.A + (size_t)nxt.pm * tstep : cA; const char* nB = has_next ? (const char*)g.Bt + (size_t)nxt.pn * tstep : cB;
        for (int t = 0; t < nt; t += 2) {
            const bool last = (t == nt - 2);
            const char* a1 = cA + (size_t)(t + 1) * kstep;
            const char* a2 = last ? nA : cA + (size_t)(t + 2) * kstep; const char* b2 = last ? nB : cB + (size_t)(t + 2) * kstep;
            const char* a3 = a2 + kstep; const char* b3 = b2 + kstep;
            if (last && has_next) S.a_ready(nxt);
            if constexpr (SP2) {
            PG8_LDB(B0, 0, 0); PG8_LDB(B1, 0, 1); PG8_SCHED; PG8_LDA(At, 0, 0); PG8_STAGE(PG8_SA(1, 1), a1 + hstepA, voffA);
            PG8_WAIT_V(8); PG8_WAIT_L(0); PG8_BAR; PG8_MMA(0, 0, At, B0); PG8_MMA(0, 1, At, B1); PG8_BAR; PG8_SCHED;
            PG8_LDA(At, 0, 1); PG8_STAGE(PG8_SB(0, 0), b2, voffB); PG8_STAGE(PG8_SB(0, 1), b2 + hstep, voffB); PG8_STAGE(PG8_SA(0, 0), a2, voffA);
            PG8_WAIT_V(8); PG8_WAIT_L(0); PG8_BAR; PG8_MMA(1, 0, At, B0); PG8_MMA(1, 1, At, B1); PG8_BAR; PG8_SCHED;
            PG8_LDB(B0, 1, 0); PG8_LDB(B1, 1, 1); PG8_SCHED; PG8_LDA(At, 1, 0); PG8_STAGE(PG8_SA(0, 1), a2 + hstepA, voffA);
            PG8_WAIT_V(8); PG8_WAIT_L(0); PG8_BAR; PG8_MMA(0, 0, At, B0); PG8_MMA(0, 1, At, B1); PG8_BAR; PG8_SCHED;
            PG8_LDA(At, 1, 1); PG8_STAGE(PG8_SB(1, 0), b3, voffB); PG8_STAGE(PG8_SB(1, 1), b3 + hstep, voffB); PG8_STAGE(PG8_SA(1, 0), a3, voffA);
            PG8_WAIT_V(8); PG8_WAIT_L(0); PG8_BAR; PG8_MMA(1, 0, At, B0); PG8_MMA(1, 1, At, B1); PG8_BAR; PG8_SCHED;
            } else {
            PG8_LDB(B0, 0, 0); PG8_SCHED; PG8_LDA(At, 0, 0); PG8_STAGE(PG8_SA(1, 1), a1 + hstepA, voffA);
            PG8_WAIT_L(8); PG8_BAR; PG8_WAIT_L(0); PG8_MMA(0, 0, At, B0); PG8_BAR; PG8_SCHED;
            PG8_LDB(B1, 0, 1); PG8_STAGE(PG8_SB(0, 0), b2, voffB);
            PG8_BAR; PG8_WAIT_L(0); PG8_MMA(0, 1, At, B1); PG8_BAR;
            PG8_LDA(At, 0, 1); PG8_STAGE(PG8_SA(0, 0), a2, voffA);
            PG8_BAR; PG8_WAIT_L(0); PG8_MMA(1, 0, At, B0); PG8_BAR; PG8_SCHED;
            PG8_STAGE(PG8_SB(0, 1), b2 + hstep, voffB);
            PG8_WAIT_V(6); PG8_BAR; PG8_MMA(1, 1, At, B1); PG8_BAR;
            PG8_LDB(B0, 1, 0); PG8_SCHED; PG8_LDA(At, 1, 0); PG8_STAGE(PG8_SA(0, 1), a2 + hstepA, voffA);
            PG8_WAIT_L(8); PG8_BAR; PG8_WAIT_L(0); PG8_MMA(0, 0, At, B0); PG8_BAR; PG8_SCHED;
            PG8_LDB(B1, 1, 1); PG8_STAGE(PG8_SB(1, 0), b3, voffB);
            PG8_BAR; PG8_WAIT_L(0); PG8_MMA(0, 1, At, B1); PG8_BAR;
            PG8_LDA(At, 1, 1); PG8_STAGE(PG8_SA(1, 0), a3, voffA);
            PG8_BAR; PG8_WAIT_L(0); PG8_MMA(1, 0, At, B0); PG8_BAR; PG8_SCHED;
            PG8_STAGE(PG8_SB(1, 1), b3 + hstep, voffB);
            PG8_WAIT_V(6); PG8_BAR; PG8_MMA(1, 1, At, B1); PG8_BAR;
            }
        }
        if constexpr (ALIGN_EPI) { if (wr == 0) PG8_BAR; }
        if constexpr (!Epi::AFTER_DRAIN) { E(acc, cur, wr, wc, fr, fq); S.done(cur); }
        if (!has_next) break;
#pragma unroll
        for (int a = 0; a < 2; ++a)
#pragma unroll
            for (int b = 0; b < 2; ++b)
#pragma unroll
                for (int m = 0; m < 4; ++m)
#pragma unroll
                    for (int n = 0; n < 2; ++n) acc[a][b][m][n] = (f32x4){0.f, 0.f, 0.f, 0.f};
        cur = nxt; cA = nA; cB = nB; ++ui;
        if constexpr (ALIGN_EPI) { if (wr == 1) PG8_BAR; }
    }
    PG8_WAIT_V(0);
    if constexpr (!ALIGN_EPI) { if (wr == 0) PG8_BAR; }
    PG8_BAR;
    if constexpr (Epi::AFTER_DRAIN) { E.fused(acc, cur, wr, wc, fr, fq, lds, wid, lane); S.done(cur); }
#undef PG8_SA
#undef PG8_SB
#undef PG8_STAGE
#undef PG8_LDA
#undef PG8_LDB
#undef PG8_MMA
#undef PG8_WAIT_V
#undef PG8_WAIT_L
#undef PG8_BAR
#undef PG8_SCHED
}
}

using pg8::bf16_t; using pg8::bf16x8; using pg8::f32x4; using pg8::u32x4; using pg8::Unit;
#define LAS __attribute__((address_space(3)))
typedef float f32x2v __attribute__((ext_vector_type(2)));
typedef __bf16 bf16x2v __attribute__((ext_vector_type(2)));
typedef unsigned u32x2 __attribute__((ext_vector_type(2)));

constexpr int D = 1024, NBATCH = 8, SEQ = 4096;
constexpr int MREAL = NBATCH * SEQ;
constexpr int ROW_META = MREAL;
constexpr int ROW_SAMP = MREAL + 16;
constexpr int ROW_PAD = ROW_SAMP + 128;
constexpr int M = MREAL + 256;
constexpr int INW = 3840, FF = 2816, FF2 = 5632, PW = 512;
constexpr float RMS_EPS = 1e-6f;
constexpr int NPOS = 4112;

constexpr size_t MiB = 1u << 20;
constexpr size_t WS_ROPE = 1 * MiB, WS_SSQ1 = 3 * MiB, WS_SSQ2 = 6 * MiB;
constexpr size_t WS_WIN = 9 * MiB, WS_WAO = 17 * MiB, WS_WPO = 19 * MiB, WS_WOUT = 20 * MiB, WS_WUP = 22 * MiB, WS_WDOWN = 33 * MiB, WS_WGRP = 39 * MiB;
constexpr size_t WS_XN = 40 * MiB, WS_MIX = 105 * MiB  , WS_HALO = 40 * MiB, WS_UPT = 84 * MiB;
constexpr size_t WS_R0I = 64 * 1024;
constexpr size_t WS_Q = 105 * MiB, WS_K = 170 * MiB, WS_V = 179 * MiB, WS_P = 188 * MiB, WS_GA = 221 * MiB, WS_GP = 286 * MiB, WS_ATT = 351 * MiB, WS_POOL = 416 * MiB;
constexpr size_t WS_X1 = 105 * MiB, WS_XG = 234 * MiB, WS_ACT = 299 * MiB, WS_END = 477 * MiB;

constexpr int LDS_BYTES = 147456;

struct Params {
    const float *x_prompt, *x_sample, *cache_swa_k, *cache_swa_v, *cache_meta_k, *cache_meta_v, *state_pool, *state_conv, *meta_tokens, *g_norm_mix, *w_in, *b_gate, *sinks,
        *w_attn_o, *w_pool_grp, *pool_scale, *w_pool_o, *w_out, *g_norm_ffn, *w_up, *conv_w, *conv_b, *w_down, *g_norm_final;
    float* out; unsigned char* ws;
    float inv_freq[32];
    int ph_lo, ph_hi;
};
constexpr size_t O_YP = 0, O_YS = O_YP + (size_t)MREAL * D, O_PSK = O_YS + 128 * D, O_PSV = O_PSK + 131072, O_KM = O_PSV + 131072, O_VM = O_KM + 16384,
    O_PPOOL = O_VM + 16384, O_PCONV = O_PPOOL + 61440, O_SSK = O_PCONV + 90112, O_SSV = O_SSK + 16384, O_SPOOL = O_SSV + 16384, O_SCONV = O_SPOOL + 61440, O_END = O_SCONV + 90112;

__device__ __forceinline__ unsigned pk2(float lo, float hi) { f32x2v v = {lo, hi}; bf16x2v b = __builtin_convertvector(v, bf16x2v); return __builtin_bit_cast(unsigned, b); }
__device__ __forceinline__ float bf_lo(unsigned u) { return __uint_as_float(u << 16); }
__device__ __forceinline__ float bf_hi(unsigned u) { return __uint_as_float(u & 0xffff0000u); }
__device__ __forceinline__ float bf1(bf16_t h) { return __uint_as_float((unsigned)h << 16); }
__device__ __forceinline__ int row_pos(int r) {
    if (r < MREAL) return 16 + (r & 4095);
    if (r < ROW_SAMP) return r - ROW_META;
    if (r < ROW_PAD) return 16 + 1024 + ((r - ROW_SAMP) & 15);
    return 0;
}
__device__ __forceinline__ const float* row_x(const float* xp, const float* mt, const float* xs, int r) {
    if (r < MREAL) return xp + (size_t)r * D;
    if (r < ROW_SAMP) return mt + (size_t)(r - ROW_META) * D;
    if (r < ROW_PAD) return xs + (size_t)(r - ROW_SAMP) * D;
    return nullptr;
}
__device__ __forceinline__ float wave_sum(float v) {
#pragma unroll
    for (int o = 1; o < 64; o <<= 1) v += __shfl_xor(v, o);
    return v;
}
__device__ __forceinline__ float sigmoidf_(float x) { return __builtin_amdgcn_rcpf(1.0f + __builtin_amdgcn_exp2f(x * -1.4426950408889634f)); }

struct EpiZ {
    static constexpr bool PERM = true, AFTER_DRAIN = false, APERM = false;
    bf16_t *Q, *Kb, *Vb, *Pb, *GA, *GP; const float* b_gate; const float* rope;
    __device__ __forceinline__ void operator()(const f32x4 (&acc)[2][2][4][2], const Unit& u, int wr, int wc, int fr_in, int fq_in) const {
        int fr = fr_in, fq = fq_in; asm volatile("" : "+v"(fr), "+v"(fq));
        const int pn = u.pn, cw = wc * 32 + 8 * fq;
        if (pn < 4) {
#pragma unroll
            for (int ai = 0; ai < 2; ++ai) {
                f32x4 t[4][2][2];
#pragma unroll
                for (int m = 0; m < 4; ++m) {
                    const int row = u.pm * 256 + ai * 128 + wr * 64 + m * 16 + fr; const int pos = row_pos(row);
#pragma unroll
                    for (int bj = 0; bj < 2; ++bj) { const f32x4* tp = (const f32x4*)(rope + ((size_t)pos * 32 + (((bj * 128 + cw) & 63) >> 1)) * 2); t[m][bj][0] = tp[0]; t[m][bj][1] = tp[1]; }
                }
#pragma unroll
                for (int m = 0; m < 4; ++m) {
                    const int row = u.pm * 256 + ai * 128 + wr * 64 + m * 16 + fr;
#pragma unroll
                    for (int bj = 0; bj < 2; ++bj) {
                        const f32x4 v0 = acc[ai][bj][m][0], v1 = acc[ai][bj][m][1], t0 = t[m][bj][0], t1 = t[m][bj][1];
                        u32x4 w;
                        w.x = pk2(v0[0] * t0[0] - v0[1] * t0[1], v0[1] * t0[0] + v0[0] * t0[1]); w.y = pk2(v0[2] * t0[2] - v0[3] * t0[3], v0[3] * t0[2] + v0[2] * t0[3]);
                        w.z = pk2(v1[0] * t1[0] - v1[1] * t1[1], v1[1] * t1[0] + v1[0] * t1[1]); w.w = pk2(v1[2] * t1[2] - v1[3] * t1[3], v1[3] * t1[2] + v1[2] * t1[3]);
                        *(u32x4*)(Q + (size_t)row * 1024 + pn * 256 + bj * 128 + cw) = w;
                    }
                }
            }
        } else if (pn == 4) {
            f32x4 t[2][4][2];
#pragma unroll
            for (int ai = 0; ai < 2; ++ai)
#pragma unroll
                for (int m = 0; m < 4; ++m) {
                    const int row = u.pm * 256 + ai * 128 + wr * 64 + m * 16 + fr; const int pos = row_pos(row);
                    const f32x4* tp = (const f32x4*)(rope + ((size_t)pos * 32 + ((cw & 63) >> 1)) * 2); t[ai][m][0] = tp[0]; t[ai][m][1] = tp[1];
                }
#pragma unroll
            for (int ai = 0; ai < 2; ++ai)
#pragma unroll
                for (int m = 0; m < 4; ++m) {
                    const int row = u.pm * 256 + ai * 128 + wr * 64 + m * 16 + fr;
                    { const f32x4 v0 = acc[ai][0][m][0], v1 = acc[ai][0][m][1], t0 = t[ai][m][0], t1 = t[ai][m][1];
                      u32x4 w;
                      w.x = pk2(v0[0] * t0[0] - v0[1] * t0[1], v0[1] * t0[0] + v0[0] * t0[1]); w.y = pk2(v0[2] * t0[2] - v0[3] * t0[3], v0[3] * t0[2] + v0[2] * t0[3]);
                      w.z = pk2(v1[0] * t1[0] - v1[1] * t1[1], v1[1] * t1[0] + v1[0] * t1[1]); w.w = pk2(v1[2] * t1[2] - v1[3] * t1[3], v1[3] * t1[2] + v1[2] * t1[3]);
                      *(u32x4*)(Kb + (size_t)row * 128 + cw) = w; }
                    { const f32x4 v0 = acc[ai][1][m][0], v1 = acc[ai][1][m][1];
                      u32x4 w; w.x = pk2(v0[0], v0[1]); w.y = pk2(v0[2], v0[3]); w.z = pk2(v1[0], v1[1]); w.w = pk2(v1[2], v1[3]);
                      *(u32x4*)(Vb + (size_t)row * 128 + cw) = w; }
                }
        } else if (pn < 7) {
#pragma unroll
            for (int ai = 0; ai < 2; ++ai)
#pragma unroll
                for (int m = 0; m < 4; ++m) {
                    const int row = u.pm * 256 + ai * 128 + wr * 64 + m * 16 + fr;
#pragma unroll
                    for (int bj = 0; bj < 2; ++bj) {
                        const f32x4 v0 = acc[ai][bj][m][0], v1 = acc[ai][bj][m][1];
                        u32x4 w; w.x = pk2(v0[0], v0[1]); w.y = pk2(v0[2], v0[3]); w.z = pk2(v1[0], v1[1]); w.w = pk2(v1[2], v1[3]);
                        *(u32x4*)(Pb + (size_t)row * 512 + (pn - 5) * 256 + bj * 128 + cw) = w;
                    }
                }
        } else {
            const int gc = pn * 256 - 1792 + cw;
            f32x4 b[2][2];
#pragma unroll
            for (int bj = 0; bj < 2; ++bj) { b[bj][0] = *(const f32x4*)(b_gate + gc + bj * 128); b[bj][1] = *(const f32x4*)(b_gate + gc + bj * 128 + 4); }
            bf16_t* dstb = (pn < 11) ? GA + gc : GP + (gc - 1024);
#pragma unroll
            for (int ai = 0; ai < 2; ++ai)
#pragma unroll
                for (int m = 0; m < 4; ++m) {
                    const int row = u.pm * 256 + ai * 128 + wr * 64 + m * 16 + fr;
#pragma unroll
                    for (int bj = 0; bj < 2; ++bj) {
                        f32x4 v0 = acc[ai][bj][m][0] + b[bj][0], v1 = acc[ai][bj][m][1] + b[bj][1];
#pragma unroll
                        for (int i = 0; i < 4; ++i) { v0[i] = sigmoidf_(v0[i]); v1[i] = sigmoidf_(v1[i]); }
                        u32x4 w; w.x = pk2(v0[0], v0[1]); w.y = pk2(v0[2], v0[3]); w.z = pk2(v1[0], v1[1]); w.w = pk2(v1[2], v1[3]);
                        *(u32x4*)(dstb + (size_t)row * 1024 + bj * 128) = w;
                    }
                }
        }
    }
};
struct EpiT1 {
    static constexpr bool PERM = true, AFTER_DRAIN = false, APERM = false;
    const bf16_t* G; bf16_t* O;
    __device__ __forceinline__ void operator()(const f32x4 (&acc)[2][2][4][2], const Unit& u, int wr, int wc, int fr_in, int fq_in) const {
        int fr = fr_in, fq = fq_in; asm volatile("" : "+v"(fr), "+v"(fq));
        const size_t base = (size_t)(u.pm * 256 + wr * 64 + fr) * 1024 + u.pn * 256 + wc * 32 + 8 * fq;
        u32x4 g[2][4][2];
#pragma unroll
        for (int ai = 0; ai < 2; ++ai)
#pragma unroll
            for (int m = 0; m < 4; ++m)
#pragma unroll
                for (int bj = 0; bj < 2; ++bj) g[ai][m][bj] = *(const u32x4*)(G + base + (size_t)(ai * 128 + m * 16) * 1024 + bj * 128);
#pragma unroll
        for (int ai = 0; ai < 2; ++ai)
#pragma unroll
            for (int m = 0; m < 4; ++m)
#pragma unroll
                for (int bj = 0; bj < 2; ++bj) {
                    const u32x4 gg = g[ai][m][bj]; const f32x4 v0 = acc[ai][bj][m][0], v1 = acc[ai][bj][m][1];
                    u32x4 w; w.x = pk2(v0[0] * bf_lo(gg.x), v0[1] * bf_hi(gg.x)); w.y = pk2(v0[2] * bf_lo(gg.y), v0[3] * bf_hi(gg.y));
                    w.z = pk2(v1[0] * bf_lo(gg.z), v1[1] * bf_hi(gg.z)); w.w = pk2(v1[2] * bf_lo(gg.w), v1[3] * bf_hi(gg.w));
                    *(u32x4*)(O + base + (size_t)(ai * 128 + m * 16) * 1024 + bj * 128) = w;
                }
    }
};
struct EpiMix {
    static constexpr bool PERM = true, AFTER_DRAIN = false, APERM = false;
    const bf16_t* G; bf16_t* O;
    __device__ __forceinline__ void operator()(const f32x4 (&acc)[2][2][4][2], const Unit& u, int wr, int wc, int fr_in, int fq_in) const {
        int fr = fr_in, fq = fq_in; asm volatile("" : "+v"(fr), "+v"(fq));
        const size_t base = (size_t)(u.pm * 256 + wr * 64 + fr) * 1024 + u.pn * 256 + wc * 32 + 8 * fq;
#pragma unroll
        for (int ai = 0; ai < 2; ++ai) {
            u32x4 g[4][2], t[4][2];
#pragma unroll
            for (int m = 0; m < 4; ++m)
#pragma unroll
                for (int bj = 0; bj < 2; ++bj) { g[m][bj] = *(const u32x4*)(G + base + (size_t)(ai * 128 + m * 16) * 1024 + bj * 128); t[m][bj] = *(const u32x4*)(O + base + (size_t)(ai * 128 + m * 16) * 1024 + bj * 128); }
#pragma unroll
            for (int m = 0; m < 4; ++m)
#pragma unroll
                for (int bj = 0; bj < 2; ++bj) {
                    const u32x4 gg = g[m][bj], tt = t[m][bj]; const f32x4 v0 = acc[ai][bj][m][0], v1 = acc[ai][bj][m][1];
                    u32x4 w; w.x = pk2(bf_lo(tt.x) + v0[0] * bf_lo(gg.x), bf_hi(tt.x) + v0[1] * bf_hi(gg.x)); w.y = pk2(bf_lo(tt.y) + v0[2] * bf_lo(gg.y), bf_hi(tt.y) + v0[3] * bf_hi(gg.y));
                    w.z = pk2(bf_lo(tt.z) + v1[0] * bf_lo(gg.z), bf_hi(tt.z) + v1[1] * bf_hi(gg.z)); w.w = pk2(bf_lo(tt.w) + v1[2] * bf_lo(gg.w), bf_hi(tt.w) + v1[3] * bf_hi(gg.w));
                    *(u32x4*)(O + base + (size_t)(ai * 128 + m * 16) * 1024 + bj * 128) = w;
                }
        }
    }
};
struct EpiX1 {
    static constexpr bool PERM = true, AFTER_DRAIN = false, APERM = false;
    const bf16_t* XN; const float *r0i, *gmix, *gffn; bf16_t* XG; float* ssq;
    __device__ __forceinline__ void operator()(const f32x4 (&acc)[2][2][4][2], const Unit& u, int wr, int wc, int fr_in, int fq_in) const {
        int fr = fr_in, fq = fq_in; asm volatile("" : "+v"(fr), "+v"(fq));
        const int col0 = u.pn * 256 + wc * 32 + 8 * fq;
        f32x4 g[2][2], ig[2][2];
#pragma unroll
        for (int bj = 0; bj < 2; ++bj)
#pragma unroll
            for (int hh = 0; hh < 2; ++hh) { g[bj][hh] = *(const f32x4*)(gffn + col0 + bj * 128 + 4 * hh); const f32x4 gm = *(const f32x4*)(gmix + col0 + bj * 128 + 4 * hh);
#pragma unroll
                for (int i = 0; i < 4; ++i) ig[bj][hh][i] = __builtin_amdgcn_rcpf(gm[i]); }
#pragma unroll
        for (int ai = 0; ai < 2; ++ai) {
            u32x4 xn[4][2]; float ri[4];
#pragma unroll
            for (int m = 0; m < 4; ++m) {
                const int row = u.pm * 256 + ai * 128 + wr * 64 + m * 16 + fr;
                ri[m] = r0i[row];
#pragma unroll
                for (int bj = 0; bj < 2; ++bj) xn[m][bj] = *(const u32x4*)(XN + (size_t)row * 1024 + col0 + bj * 128);
            }
#pragma unroll
            for (int m = 0; m < 4; ++m) {
                const int row = u.pm * 256 + ai * 128 + wr * 64 + m * 16 + fr;
                const float rr = ri[m];
                float ss = 0.f;
#pragma unroll
                for (int bj = 0; bj < 2; ++bj) {
                    const u32x4 q = xn[m][bj];
                    f32x4 x0, x1;
                    x0[0] = bf_lo(q.x) * rr * ig[bj][0][0]; x0[1] = bf_hi(q.x) * rr * ig[bj][0][1]; x0[2] = bf_lo(q.y) * rr * ig[bj][0][2]; x0[3] = bf_hi(q.y) * rr * ig[bj][0][3];
                    x1[0] = bf_lo(q.z) * rr * ig[bj][1][0]; x1[1] = bf_hi(q.z) * rr * ig[bj][1][1]; x1[2] = bf_lo(q.w) * rr * ig[bj][1][2]; x1[3] = bf_hi(q.w) * rr * ig[bj][1][3];
                    const f32x4 v0 = acc[ai][bj][m][0] + x0, v1 = acc[ai][bj][m][1] + x1, g0 = g[bj][0], g1 = g[bj][1];
                    u32x4 w; w.x = pk2(v0[0] * g0[0], v0[1] * g0[1]); w.y = pk2(v0[2] * g0[2], v0[3] * g0[3]); w.z = pk2(v1[0] * g1[0], v1[1] * g1[1]); w.w = pk2(v1[2] * g1[2], v1[3] * g1[3]);
                    *(u32x4*)(XG + (size_t)row * 1024 + col0 + bj * 128) = w;
                    ss += (v0[0] * v0[0] + v0[1] * v0[1]) + (v0[2] * v0[2] + v0[3] * v0[3]) + (v1[0] * v1[0] + v1[1] * v1[1]) + (v1[2] * v1[2] + v1[3] * v1[3]);
                }
                ss += __shfl_xor(ss, 16); ss += __shfl_xor(ss, 32);
                if (fq == 0) ssq[(size_t)row * 16 + u.pn * 4 + wc] = ss;
            }
        }
    }
};
__device__ __forceinline__ float ror1(float x) { return __builtin_bit_cast(float, __builtin_amdgcn_mov_dpp(__builtin_bit_cast(int, x), 0x121, 0xf, 0xf, false)); }
__device__ __forceinline__ float ror2(float x) { return __builtin_bit_cast(float, __builtin_amdgcn_mov_dpp(__builtin_bit_cast(int, x), 0x122, 0xf, 0xf, false)); }
__device__ __forceinline__ float shr1(float old, float x) { return __builtin_bit_cast(float, __builtin_amdgcn_update_dpp(__builtin_bit_cast(int, old), __builtin_bit_cast(int, x), 0x111, 0xf, 0xf, false)); }
__device__ __forceinline__ float shr2(float old, float x) { return __builtin_bit_cast(float, __builtin_amdgcn_update_dpp(__builtin_bit_cast(int, old), __builtin_bit_cast(int, x), 0x112, 0xf, 0xf, false)); }
struct EpiUp {
    static constexpr bool PERM = true, AFTER_DRAIN = false, APERM = true;
    const float *ssq, *cw, *cb; bf16_t* ACT; float* HALO; float* UPT;
    __device__ __forceinline__ void operator()(const f32x4 (&acc)[2][2][4][2], const Unit& u, int wr, int wc, int fr_in, int fq_in) const {
        int fr = fr_in, fq = fq_in; asm volatile("" : "+v"(fr), "+v"(fq));
        const int jb = u.pn * 128 + wc * 32 + 8 * fq;
        const int row0 = u.pm * 256 + wr * 128 + fr;
        float r1[2][4];
#pragma unroll
        for (int ai = 0; ai < 2; ++ai)
#pragma unroll
            for (int m = 0; m < 4; ++m) {
                const f32x4* sp = (const f32x4*)(ssq + (size_t)(row0 + ai * 64 + m * 16) * 16);
                const f32x4 a = sp[0], b = sp[1], c = sp[2], d = sp[3];
                const float s = ((a[0] + a[1]) + (a[2] + a[3])) + ((b[0] + b[1]) + (b[2] + b[3])) + ((c[0] + c[1]) + (c[2] + c[3])) + ((d[0] + d[1]) + (d[2] + d[3]));
                r1[ai][m] = rsqrtf(s * (1.0f / 1024.0f) + RMS_EPS);
            }
#pragma unroll
        for (int ai = 0; ai < 2; ++ai)
#pragma unroll
            for (int m = 0; m < 4; ++m) asm volatile("" : "+v"(r1[ai][m]));
        __builtin_amdgcn_sched_barrier(0);
        const int slab = u.pm * 2 + wr;
#pragma unroll
        for (int n = 0; n < 2; ++n) {
            int jg = jb + 4 * n; asm volatile("" : "+v"(jg) :: "memory");
            const f32x4 w0g = *(const f32x4*)(cw + jg), w1g = *(const f32x4*)(cw + FF2 + jg), w2g = *(const f32x4*)(cw + 2 * FF2 + jg), bg = *(const f32x4*)(cb + jg);
            const f32x4 w0v = *(const f32x4*)(cw + FF + jg), w1v = *(const f32x4*)(cw + FF2 + FF + jg), w2v = *(const f32x4*)(cw + 2 * FF2 + FF + jg), bv = *(const f32x4*)(cb + FF + jg);
            f32x4 pg = {0.f, 0.f, 0.f, 0.f}, pv = {0.f, 0.f, 0.f, 0.f};
#pragma unroll
            for (int ai = 0; ai < 2; ++ai) {
#pragma unroll
                for (int m = 0; m < 4; ++m) {
                    const int row = row0 + ai * 64 + m * 16;
                    const f32x4 ug = acc[ai][0][m][n] * r1[ai][m], uv = acc[ai][1][m][n] * r1[ai][m];
                    const bool first = (ai == 0 && m == 0), last = (ai == 1 && m == 3);
                    if (first && fr < 2) { *(f32x4*)(HALO + (size_t)(slab * 4 + fr) * FF2 + jg) = ug; *(f32x4*)(HALO + (size_t)(slab * 4 + fr) * FF2 + FF + jg) = uv; }
                    if (last && fr >= 14) { *(f32x4*)(HALO + (size_t)(slab * 4 + fr - 12) * FF2 + jg) = ug; *(f32x4*)(HALO + (size_t)(slab * 4 + fr - 12) * FF2 + FF + jg) = uv; }
                    f32x4 g1, g2, v1, v2;
#pragma unroll
                    for (int i = 0; i < 4; ++i) {
                        g1[i] = shr1(ror1(pg[i]), ug[i]); g2[i] = shr2(ror2(pg[i]), ug[i]);
                        v1[i] = shr1(ror1(pv[i]), uv[i]); v2[i] = shr2(ror2(pv[i]), uv[i]);
                    }
                    const f32x4 cg = bg + w0g * g2 + w1g * g1 + w2g * ug;
                    const f32x4 cv = bv + w0v * v2 + w1v * v1 + w2v * uv;
                    float a[4];
#pragma unroll
                    for (int i = 0; i < 4; ++i) a[i] = cg[i] * sigmoidf_(cg[i]) * cv[i];
                    if (!(first && fr < 2)) { u32x2 w; w.x = pk2(a[0], a[1]); w.y = pk2(a[2], a[3]); *(u32x2*)(ACT + (size_t)row * FF + jg) = w; }
                    pg = ug; pv = uv;
                }
            }
        }
    }
};
constexpr size_t WS_PCNT = 8 * MiB + 768 * 1024;
#define AG_LD(p) __hip_atomic_load((p), __ATOMIC_RELAXED, __HIP_MEMORY_SCOPE_AGENT)
#define AG_ST(p, v) __hip_atomic_store((p), (v), __ATOMIC_RELAXED, __HIP_MEMORY_SCOPE_AGENT)
struct EpiDown {
    static constexpr bool PERM = true, AFTER_DRAIN = false, APERM = false;
    const bf16_t* XG; const float* gffn; const float* gfin; float* out; float* ssq;
    __device__ __forceinline__ void operator()(const f32x4 (&acc_c)[2][2][4][2], const Unit& u, int wr, int wc, int fr_in, int fq_in) const {
        int fr = fr_in, fq = fq_in; asm volatile("" : "+v"(fr), "+v"(fq));
        f32x4 (&acc)[2][2][4][2] = const_cast<f32x4 (&)[2][2][4][2]>(acc_c);
        const int col0 = u.pn * 256 + wc * 32 + 8 * fq;
        f32x4 ig[2][2];
#pragma unroll
        for (int bj = 0; bj < 2; ++bj)
#pragma unroll
            for (int hh = 0; hh < 2; ++hh) { const f32x4 gg = *(const f32x4*)(gffn + col0 + bj * 128 + 4 * hh);
#pragma unroll
                for (int i = 0; i < 4; ++i) ig[bj][hh][i] = __builtin_amdgcn_rcpf(gg[i]); }
#pragma unroll
        for (int ai = 0; ai < 2; ++ai) {
            u32x4 xgv[4][2];
#pragma unroll
            for (int m = 0; m < 4; ++m)
#pragma unroll
                for (int bj = 0; bj < 2; ++bj) xgv[m][bj] = *(const u32x4*)(XG + (size_t)(u.pm * 256 + ai * 128 + wr * 64 + m * 16 + fr) * 1024 + col0 + bj * 128);
#pragma unroll
            for (int m = 0; m < 4; ++m) {
                const int row = u.pm * 256 + ai * 128 + wr * 64 + m * 16 + fr;
                float ss = 0.f;
#pragma unroll
                for (int bj = 0; bj < 2; ++bj) {
                    const u32x4 xg = xgv[m][bj];
                    f32x4 x0, x1;
                    x0[0] = bf_lo(xg.x) * ig[bj][0][0]; x0[1] = bf_hi(xg.x) * ig[bj][0][1]; x0[2] = bf_lo(xg.y) * ig[bj][0][2]; x0[3] = bf_hi(xg.y) * ig[bj][0][3];
                    x1[0] = bf_lo(xg.z) * ig[bj][1][0]; x1[1] = bf_hi(xg.z) * ig[bj][1][1]; x1[2] = bf_lo(xg.w) * ig[bj][1][2]; x1[3] = bf_hi(xg.w) * ig[bj][1][3];
                    const f32x4 v0 = acc[ai][bj][m][0] + x0, v1 = acc[ai][bj][m][1] + x1;
                    acc[ai][bj][m][0] = v0; acc[ai][bj][m][1] = v1;
                    ss += (v0[0] * v0[0] + v0[1] * v0[1]) + (v0[2] * v0[2] + v0[3] * v0[3]) + (v1[0] * v1[0] + v1[1] * v1[1]) + (v1[2] * v1[2] + v1[3] * v1[3]);
                }
                ss += __shfl_xor(ss, 16); ss += __shfl_xor(ss, 32);
                if (fq == 0) AG_ST(ssq + (size_t)row * 16 + u.pn * 4 + wc, ss);
            }
        }
        asm volatile("s_waitcnt vmcnt(0)" ::: "memory");
        unsigned* pc = (unsigned*)((char*)ssq + (WS_PCNT - WS_SSQ2)) + 64 * u.pm;
        if (fr == 0 && fq == 0) __hip_atomic_fetch_add(pc, 1u, __ATOMIC_RELAXED, __HIP_MEMORY_SCOPE_AGENT);
        for (int tries = 0; tries < (1 << 18); ++tries) {
            const unsigned c = (unsigned)__builtin_amdgcn_readfirstlane((int)AG_LD(pc));
            if (c >= 32u) break;
            __builtin_amdgcn_s_sleep(2);
        }
        float rs[2][4];
        {
            float* spb = ssq + (size_t)(u.pm * 256 + wr * 64 + fr) * 16 + 4 * fq;
#pragma unroll
            for (int ai = 0; ai < 2; ++ai)
#pragma unroll
                for (int m = 0; m < 4; ++m) {
                    float* sp = spb + (ai * 128 + m * 16) * 16;
                    const float a = AG_LD(sp), b = AG_LD(sp + 1), c = AG_LD(sp + 2), d = AG_LD(sp + 3);
                    rs[ai][m] = (a + b) + (c + d);
                }
        }
#pragma unroll
        for (int ai = 0; ai < 2; ++ai)
#pragma unroll
            for (int m = 0; m < 4; ++m) {
                const int row = u.pm * 256 + ai * 128 + wr * 64 + m * 16 + fr;
                float s = rs[ai][m]; s += __shfl_xor(s, 16); s += __shfl_xor(s, 32);
                const float r = rsqrtf(s * (1.0f / 1024.0f) + RMS_EPS);
                float* orow = out + O_YP + (size_t)row * D;
#pragma unroll
                for (int bj = 0; bj < 2; ++bj) {
                    const int col = u.pn * 256 + bj * 128 + wc * 32 + 8 * fq;
                    const f32x4 g0 = *(const f32x4*)(gfin + col), g1 = *(const f32x4*)(gfin + col + 4);
                    *(f32x4*)(orow + col) = acc[ai][bj][m][0] * r * g0; *(f32x4*)(orow + col + 4) = acc[ai][bj][m][1] * r * g1;
                }
            }
    }
};

struct MapId { __device__ __forceinline__ int operator()(int n) const { return n; } };
struct MapIn { __device__ __forceinline__ int operator()(int n) const { return n < 1152 ? ((n & ~63) + 2 * (n & 31) + ((n >> 5) & 1)) : n; } };
struct MapUp { __device__ __forceinline__ int operator()(int n) const { if (n < FF) return 256 * (n >> 7) + (n & 127); const int m = n - FF; return 256 * (m >> 7) + 128 + (m & 127); } };
template <class Map>
__device__ __forceinline__ void p0_transpose_item(const float* W, int K, int N, bf16_t* WT, LAS float* scr, int item, int lane, Map map) {
    const int nblk = N / 32, kb = item / nblk, nb = item % nblk, k0 = 64 * kb, n0 = 32 * nb;
#pragma unroll 8
    for (int i = 0; i < 32; ++i) { const int kk = 2 * i + (lane >> 5); scr[kk * 33 + (lane & 31)] = W[(size_t)(k0 + kk) * N + n0 + (lane & 31)]; }
    asm volatile("s_waitcnt lgkmcnt(0)" ::: "memory");
    const int c = lane & 7;
#pragma unroll
    for (int j = 0; j < 4; ++j) { const int n = (lane >> 3) + 8 * j; const LAS float* s = scr + (8 * c) * 33 + n;
        u32x4 o; o.x = pk2(s[0 * 33], s[1 * 33]); o.y = pk2(s[2 * 33], s[3 * 33]); o.z = pk2(s[4 * 33], s[5 * 33]); o.w = pk2(s[6 * 33], s[7 * 33]);
        *(u32x4*)(WT + (size_t)map(n0 + n) * K + k0 + 8 * c) = o; }
    asm volatile("s_waitcnt lgkmcnt(0)" ::: "memory");
}
__device__ __forceinline__ void p0_prologue(const Params& p, LAS unsigned char* lds, int wave, int lane) {
    unsigned char* ws = p.ws;
    if (wave < 4) {
        bf16_t* XN = (bf16_t*)(ws + WS_XN);
        const int gw = blockIdx.x * 4 + wave, NGW = gridDim.x * 4;
        f32x4 gv[4];
#pragma unroll
        for (int j = 0; j < 4; ++j) gv[j] = ((const f32x4*)p.g_norm_mix)[lane + 64 * j];
        for (int m0 = gw * 4; m0 < M; m0 += NGW * 4) {
            f32x4 v[4][4]; const float* xr[4];
#pragma unroll
            for (int q = 0; q < 4; ++q) {
                xr[q] = row_x(p.x_prompt, p.meta_tokens, p.x_sample, m0 + q);
#pragma unroll
                for (int j = 0; j < 4; ++j) v[q][j] = xr[q] ? __builtin_nontemporal_load((const f32x4*)xr[q] + lane + 64 * j) : (f32x4){0.f, 0.f, 0.f, 0.f};
            }
#pragma unroll
            for (int q = 0; q < 4; ++q) {
                float s = 0.f;
#pragma unroll
                for (int j = 0; j < 4; ++j) s += (v[q][j][0] * v[q][j][0] + v[q][j][1] * v[q][j][1]) + (v[q][j][2] * v[q][j][2] + v[q][j][3] * v[q][j][3]);
                const float ms = wave_sum(s) * (1.0f / D) + RMS_EPS;
                const float r = rsqrtf(ms);
                if (lane == 0) ((float*)(ws + WS_R0I))[m0 + q] = sqrtf(ms);
                unsigned long long* o8 = (unsigned long long*)(XN + (size_t)(m0 + q) * D) + lane;
#pragma unroll
                for (int j = 0; j < 4; ++j) { const f32x4 w = v[q][j] * r * gv[j]; o8[64 * j] = (unsigned long long)pk2(w[0], w[1]) | ((unsigned long long)pk2(w[2], w[3]) << 32); }
            }
        }
        return;
    }
    LAS float* scr = (LAS float*)(lds + wave * 16384);
    const int gw = blockIdx.x * 4 + (wave - 4), NGW = gridDim.x * 4;
    const int gt = blockIdx.x * 256 + (int)threadIdx.x - 256, NT = gridDim.x * 256;
    constexpr int I_IN = 16 * (INW / 32), I_AO = 16 * 32, I_OUT = 16 * 32, I_UP = 16 * (FF2 / 32), I_DN = (FF / 64) * 32;
    constexpr int NITEMS = I_IN + I_AO + I_OUT + I_UP + I_DN;
    for (int it = gw; it < NITEMS; it += NGW) {
        int r = it;
        if (r < I_IN) { p0_transpose_item(p.w_in, D, INW, (bf16_t*)(ws + WS_WIN), scr, r, lane, MapIn()); continue; } r -= I_IN;
        if (r < I_AO) { p0_transpose_item(p.w_attn_o, D, D, (bf16_t*)(ws + WS_WAO), scr, r, lane, MapId()); continue; } r -= I_AO;
        if (r < I_OUT) { p0_transpose_item(p.w_out, D, D, (bf16_t*)(ws + WS_WOUT), scr, r, lane, MapId()); continue; } r -= I_OUT;
        if (r < I_UP) { p0_transpose_item(p.w_up, D, FF2, (bf16_t*)(ws + WS_WUP), scr, r, lane, MapUp()); continue; } r -= I_UP;
        p0_transpose_item(p.w_down, FF, D, (bf16_t*)(ws + WS_WDOWN), scr, r, lane, MapId());
    }
    {
        bf16_t* WP = (bf16_t*)(ws + WS_WPO);
        for (int idx = gt; idx < 1024 * 128; idx += NT) {
            const int n = idx & 1023, k0 = (idx >> 10) * 4, g = k0 >> 7;
            const float* wg = p.w_pool_grp + (size_t)k0 * 128;
            const float* sc = p.pool_scale + g * 128;
            const float* wo = p.w_pool_o + (size_t)(g * 128) * 1024 + n;
            float a[4] = {0.f, 0.f, 0.f, 0.f};
#pragma unroll 2
            for (int d = 0; d < 128; d += 4) {
                const f32x4 s4 = *(const f32x4*)(sc + d);
                float wv[4];
#pragma unroll
                for (int e = 0; e < 4; ++e) wv[e] = wo[(size_t)(d + e) * 1024] * s4[e];
#pragma unroll
                for (int j = 0; j < 4; ++j) { const f32x4 w4 = *(const f32x4*)(wg + j * 128 + d); a[j] += (w4[0] * wv[0] + w4[1] * wv[1]) + (w4[2] * wv[2] + w4[3] * wv[3]); }
            }
            u32x2 o; o.x = pk2(a[0], a[1]); o.y = pk2(a[2], a[3]);
            *(u32x2*)(WP + (size_t)n * 512 + k0) = o;
        }
    }
    float* rope = (float*)(ws + WS_ROPE);
    for (int i = gt; i < NPOS * 32; i += NT) {
        const int pos = i >> 5, d = i & 31;
        const float ang = (float)pos * p.inv_freq[d];
        const double rev = (double)ang * 0.15915494309189535;
        const float fr = (float)(rev - floor(rev));
        rope[2 * i] = __builtin_amdgcn_cosf(fr); rope[2 * i + 1] = __builtin_amdgcn_sinf(fr);
    }
}

constexpr int KS_PITCH = 144, VT_PITCH = 464, ATT_VT_OFF = 208 * KS_PITCH;
constexpr float LOG2E = 1.4426950408889634f, C2 = 0.125f * 1.4426950408889634f;

template <int NQ>
__device__ __forceinline__ void attn_load_q(bf16x8 (&qf)[NQ][2], const bf16_t* Qb, int qrow0, int h, int lane) {
    const int fr = lane & 15, fq = lane >> 4;
#pragma unroll
    for (int qb = 0; qb < NQ; ++qb)
#pragma unroll
        for (int ks = 0; ks < 2; ++ks) qf[qb][ks] = *(const bf16x8*)(Qb + (size_t)(qrow0 + 16 * qb + fr) * 1024 + h * 64 + 32 * ks + 8 * fq);
}
template <int NQ>
__device__ __forceinline__ void attn_compute(LAS unsigned char* lds, const bf16x8 (&qf)[NQ][2], bf16_t* ATT, int qrow0, int h, unsigned vmask, float sink2, int lane) {
    const int fr = lane & 15, fq = lane >> 4;
    f32x4 s[NQ][13];
    const LAS unsigned char* kp = lds + fr * KS_PITCH + fq * 16;
    bf16x8 kc0 = *(const LAS bf16x8*)kp, kc1 = *(const LAS bf16x8*)(kp + 64);
#pragma unroll
    for (int kb = 0; kb < 13; ++kb) {
        bf16x8 kn0 = kc0, kn1 = kc1;
        if (kb < 12) { kn0 = *(const LAS bf16x8*)(kp + (kb + 1) * 16 * KS_PITCH); kn1 = *(const LAS bf16x8*)(kp + (kb + 1) * 16 * KS_PITCH + 64); }
#pragma unroll
        for (int qb = 0; qb < NQ; ++qb) {
            f32x4 a = {0.f, 0.f, 0.f, 0.f};
            a = __builtin_amdgcn_mfma_f32_16x16x32_bf16(kc0, qf[qb][0], a, 0, 0, 0);
            a = __builtin_amdgcn_mfma_f32_16x16x32_bf16(kc1, qf[qb][1], a, 0, 0, 0);
            s[qb][kb] = a;
        }
        kc0 = kn0; kc1 = kn1;
        __builtin_amdgcn_sched_barrier(0);
    }
    float rl[NQ];
#pragma unroll
    for (int qb = 0; qb < NQ; ++qb) {
        float mr = -1e30f;
#pragma unroll
        for (int kb = 0; kb < 13; ++kb) {
            if (vmask != 0x1fffu) {
                const bool valid = (vmask >> kb) & 1u;
#pragma unroll
                for (int i = 0; i < 4; ++i) s[qb][kb][i] = valid ? s[qb][kb][i] : -1e30f;
            }
            mr = fmaxf(mr, fmaxf(fmaxf(s[qb][kb][0], s[qb][kb][1]), fmaxf(s[qb][kb][2], s[qb][kb][3])));
        }
        mr = fmaxf(mr, __shfl_xor(mr, 16)); mr = fmaxf(mr, __shfl_xor(mr, 32));
        const float mx = fmaxf(mr * C2, sink2), nmx = -mx;
        float l = 0.f;
#pragma unroll
        for (int kb = 0; kb < 13; ++kb)
#pragma unroll
            for (int i = 0; i < 4; ++i) { const float pv = __builtin_amdgcn_exp2f(fmaf(s[qb][kb][i], C2, nmx)); s[qb][kb][i] = pv; l += pv; }
        l += __shfl_xor(l, 16); l += __shfl_xor(l, 32);
        l += __builtin_amdgcn_exp2f(sink2 - mx);
        rl[qb] = __builtin_amdgcn_rcpf(l);
    }
    f32x4 o[NQ][4];
#pragma unroll
    for (int qb = 0; qb < NQ; ++qb)
#pragma unroll
        for (int db = 0; db < 4; ++db) o[qb][db] = (f32x4){0.f, 0.f, 0.f, 0.f};
    const LAS unsigned char* vp = lds + ATT_VT_OFF + fr * VT_PITCH + fq * 8;
    u32x2 vlo[4], vhi[4];
#pragma unroll
    for (int db = 0; db < 4; ++db) { vlo[db] = *(const LAS u32x2*)(vp + db * 16 * VT_PITCH); vhi[db] = *(const LAS u32x2*)(vp + db * 16 * VT_PITCH + 32); }
#pragma unroll
    for (int kk = 0; kk < 7; ++kk) {
        u32x2 nlo[4], nhi[4];
#pragma unroll
        for (int db = 0; db < 4; ++db) { nlo[db] = vlo[db]; nhi[db] = vhi[db]; }
        if (kk < 6) {
#pragma unroll
            for (int db = 0; db < 4; ++db) { nlo[db] = *(const LAS u32x2*)(vp + db * 16 * VT_PITCH + (kk + 1) * 64); nhi[db] = *(const LAS u32x2*)(vp + db * 16 * VT_PITCH + (kk + 1) * 64 + 32); }
        }
        bf16x8 pf[NQ];
#pragma unroll
        for (int qb = 0; qb < NQ; ++qb) {
            u32x4 w;
            w.x = pk2(s[qb][2 * kk][0], s[qb][2 * kk][1]); w.y = pk2(s[qb][2 * kk][2], s[qb][2 * kk][3]);
            if (2 * kk + 1 < 13) { w.z = pk2(s[qb][(2 * kk + 1) % 13][0], s[qb][(2 * kk + 1) % 13][1]); w.w = pk2(s[qb][(2 * kk + 1) % 13][2], s[qb][(2 * kk + 1) % 13][3]); }
            else { w.z = 0u; w.w = 0u; }
            pf[qb] = __builtin_bit_cast(bf16x8, w);
        }
#pragma unroll
        for (int db = 0; db < 4; ++db) {
            u32x4 vv; vv.x = vlo[db].x; vv.y = vlo[db].y; vv.z = vhi[db].x; vv.w = vhi[db].y;
            const bf16x8 vf = __builtin_bit_cast(bf16x8, vv);
#pragma unroll
            for (int qb = 0; qb < NQ; ++qb) o[qb][db] = __builtin_amdgcn_mfma_f32_16x16x32_bf16(vf, pf[qb], o[qb][db], 0, 0, 0);
        }
#pragma unroll
        for (int db = 0; db < 4; ++db) { vlo[db] = nlo[db]; vhi[db] = nhi[db]; }
        __builtin_amdgcn_sched_barrier(0);
    }
#pragma unroll
    for (int qb = 0; qb < NQ; ++qb)
#pragma unroll
        for (int db = 0; db < 4; ++db) {
            const f32x4 v = o[qb][db] * rl[qb];
            u32x2 w; w.x = pk2(v[0], v[1]); w.y = pk2(v[2], v[3]);
            *(u32x2*)(ATT + (size_t)(qrow0 + 16 * qb + fr) * 1024 + h * 64 + 16 * db + 4 * fq) = w;
        }
}
__device__ __forceinline__ void attn_zero_pad(LAS unsigned char* lds, int tid) {
    if (tid < 128) { const int row = tid >> 1, half = tid & 1; *(LAS u32x4*)(lds + ATT_VT_OFF + row * VT_PITCH + 416 + half * 16) = (u32x4){0u, 0u, 0u, 0u}; }
}
__device__ __forceinline__ void attn_fill_bf16(LAS unsigned char* lds, const bf16_t* Kb, const bf16_t* Vb, int srow, int n, int kk, int ch) {
    u32x4 kv = {0u, 0u, 0u, 0u}, vv = {0u, 0u, 0u, 0u};
    if (srow >= 0) { kv = *(const u32x4*)(Kb + (size_t)srow * 128 + n * 64 + ch * 8); vv = *(const u32x4*)(Vb + (size_t)srow * 128 + n * 64 + ch * 8); }
    *(LAS u32x4*)(lds + kk * KS_PITCH + ch * 16) = kv;
    LAS unsigned short* vt = (LAS unsigned short*)(lds + ATT_VT_OFF + (ch * 8) * VT_PITCH + kk * 2);
    vt[0 * (VT_PITCH / 2)] = (unsigned short)(vv.x & 0xffffu); vt[1 * (VT_PITCH / 2)] = (unsigned short)(vv.x >> 16);
    vt[2 * (VT_PITCH / 2)] = (unsigned short)(vv.y & 0xffffu); vt[3 * (VT_PITCH / 2)] = (unsigned short)(vv.y >> 16);
    vt[4 * (VT_PITCH / 2)] = (unsigned short)(vv.z & 0xffffu); vt[5 * (VT_PITCH / 2)] = (unsigned short)(vv.z >> 16);
    vt[6 * (VT_PITCH / 2)] = (unsigned short)(vv.w & 0xffffu); vt[7 * (VT_PITCH / 2)] = (unsigned short)(vv.w >> 16);
}
__device__ __forceinline__ void attn_fill_f32(LAS unsigned char* lds, const float* ksrc, const float* vsrc, int kk, int ch) {
    const f32x4 k0 = *(const f32x4*)(ksrc + ch * 8), k1 = *(const f32x4*)(ksrc + ch * 8 + 4);
    const f32x4 v0 = *(const f32x4*)(vsrc + ch * 8), v1 = *(const f32x4*)(vsrc + ch * 8 + 4);
    LAS unsigned short* kr = (LAS unsigned short*)(lds + kk * KS_PITCH);
    LAS unsigned short* vt = (LAS unsigned short*)(lds + ATT_VT_OFF + (ch * 8) * VT_PITCH + kk * 2);
#pragma unroll
    for (int e = 0; e < 8; ++e) {
        const int d = ch * 8 + e;
        const float kvv = e < 4 ? k0[e & 3] : k1[e & 3], vvv = e < 4 ? v0[e & 3] : v1[e & 3];
        kr[2 * (d & 31) + (d >> 5)] = (unsigned short)(pk2(kvv, 0.f) & 0xffffu);
        vt[e * (VT_PITCH / 2)] = (unsigned short)(pk2(vvv, 0.f) & 0xffffu);
    }
}
__device__ __forceinline__ void attn_chunk_unit(const Params& p, LAS unsigned char* lds, int unit, int tid, int wave, int lane) {
    unsigned char* ws = p.ws;
    const bf16_t *Qb = (const bf16_t*)(ws + WS_Q), *Kb = (const bf16_t*)(ws + WS_K), *Vb = (const bf16_t*)(ws + WS_V); bf16_t* ATT = (bf16_t*)(ws + WS_ATT);
    const int n = unit & 1, c = (unit >> 1) & 63, b = unit >> 7;
    asm volatile("" : "+v"(tid), "+v"(lane));
    const int h = n * 8 + wave, r0 = b * SEQ + c * 64;
    bf16x8 qa[2][2], qb2[2][2];
    attn_load_q<2>(qa, Qb, r0, h, lane);
#pragma unroll
    for (int jb = 0; jb < 2; ++jb) {
        u32x4 kv[2], vv[2];
#pragma unroll
        for (int j = 0; j < 2; ++j) {
            const int i = tid + 512 * (2 * jb + j), kk = i >> 3, ch = i & 7;
            int srow;
            if (kk < 16) srow = ROW_META + kk;
            else { const int t = (c - 2) * 64 + kk - 16; srow = t < 0 ? -1 : b * SEQ + t; }
            kv[j] = (u32x4){0u, 0u, 0u, 0u}; vv[j] = (u32x4){0u, 0u, 0u, 0u};
            if (i < 208 * 8 && srow >= 0) { kv[j] = *(const u32x4*)(Kb + (size_t)srow * 128 + n * 64 + ch * 8); vv[j] = *(const u32x4*)(Vb + (size_t)srow * 128 + n * 64 + ch * 8); }
        }
#pragma unroll
        for (int j = 0; j < 2; ++j) {
            const int i = tid + 512 * (2 * jb + j), kk = i >> 3, ch = i & 7;
            if (i < 208 * 8) {
                *(LAS u32x4*)(lds + kk * KS_PITCH + ch * 16) = kv[j];
                LAS unsigned short* vt = (LAS unsigned short*)(lds + ATT_VT_OFF + (ch * 8) * VT_PITCH + kk * 2);
                vt[0 * (VT_PITCH / 2)] = (unsigned short)(vv[j].x & 0xffffu); vt[1 * (VT_PITCH / 2)] = (unsigned short)(vv[j].x >> 16);
                vt[2 * (VT_PITCH / 2)] = (unsigned short)(vv[j].y & 0xffffu); vt[3 * (VT_PITCH / 2)] = (unsigned short)(vv[j].y >> 16);
                vt[4 * (VT_PITCH / 2)] = (unsigned short)(vv[j].z & 0xffffu); vt[5 * (VT_PITCH / 2)] = (unsigned short)(vv[j].z >> 16);
                vt[6 * (VT_PITCH / 2)] = (unsigned short)(vv[j].w & 0xffffu); vt[7 * (VT_PITCH / 2)] = (unsigned short)(vv[j].w >> 16);
            }
        }
    }
    attn_zero_pad(lds, tid);
    __syncthreads();
    unsigned vmask = 0x1fffu;
    if (c == 0) vmask = 0x1e01u; else if (c == 1) vmask = 0x1fe1u;
    const float sink2 = p.sinks[h] * LOG2E;
    attn_compute<2>(lds, qa, ATT, r0, h, vmask, sink2, lane);
    attn_load_q<2>(qb2, Qb, r0 + 32, h, lane);
    attn_compute<2>(lds, qb2, ATT, r0 + 32, h, vmask, sink2, lane);
    __syncthreads();
}
__device__ __forceinline__ void attn_small_unit(const Params& p, LAS unsigned char* lds, int unit, int tid, int wave, int lane) {
    unsigned char* ws = p.ws;
    const bf16_t *Qb = (const bf16_t*)(ws + WS_Q), *Kb = (const bf16_t*)(ws + WS_K), *Vb = (const bf16_t*)(ws + WS_V); bf16_t* ATT = (bf16_t*)(ws + WS_ATT);
    int n, qrow0; unsigned vmask;
    if (unit < 2) {
        n = unit; qrow0 = ROW_META; vmask = 1u;
        for (int i = tid; i < 208 * 8; i += 512) { const int kk = i >> 3, ch = i & 7; attn_fill_bf16(lds, Kb, Vb, kk < 16 ? ROW_META + kk : -1, n, kk, ch); }
    } else {
        const int b = (unit - 2) >> 1; n = (unit - 2) & 1; qrow0 = ROW_SAMP + b * 16; vmask = 0x3ffu;
        for (int i = tid; i < 208 * 8; i += 512) {
            const int kk = i >> 3, ch = i & 7;
            if (kk < 16) attn_fill_f32(lds, p.cache_meta_k + ((size_t)(b * 16 + kk) * 2 + n) * 64, p.cache_meta_v + ((size_t)(b * 16 + kk) * 2 + n) * 64, kk, ch);
            else if (kk < 144) attn_fill_f32(lds, p.cache_swa_k + ((size_t)(b * 128 + kk - 16) * 2 + n) * 64, p.cache_swa_v + ((size_t)(b * 128 + kk - 16) * 2 + n) * 64, kk, ch);
            else attn_fill_bf16(lds, Kb, Vb, kk < 160 ? ROW_SAMP + b * 16 + kk - 144 : -1, n, kk, ch);
        }
    }
    attn_zero_pad(lds, tid);
    __syncthreads();
    const int h = n * 8 + wave;
    bf16x8 q1[1][2]; attn_load_q<1>(q1, Qb, qrow0, h, lane);
    attn_compute<1>(lds, q1, ATT, qrow0, h, vmask, p.sinks[h] * LOG2E, lane);
    __syncthreads();
}
constexpr int PM_PITCH = 1040;
__device__ __forceinline__ void add8(float (&s)[8], const u32x4 v) {
    s[0] += bf_lo(v.x); s[1] += bf_hi(v.x); s[2] += bf_lo(v.y); s[3] += bf_hi(v.y); s[4] += bf_lo(v.z); s[5] += bf_hi(v.z); s[6] += bf_lo(v.w); s[7] += bf_hi(v.w);
}
__device__ __forceinline__ void unpack8(float (&s)[8], const u32x4 v) {
    s[0] = bf_lo(v.x); s[1] = bf_hi(v.x); s[2] = bf_lo(v.y); s[3] = bf_hi(v.y); s[4] = bf_lo(v.z); s[5] = bf_hi(v.z); s[6] = bf_lo(v.w); s[7] = bf_hi(v.w);
}
template <int W>
__device__ __forceinline__ void pool_pm_main(const bf16_t* Pb, bf16_t* POOL, int R0, int wave, int lane) {
    const int g = wave >> 1, col = (g * 16 + (lane & 15)) * 8, seg = (wave & 1) * 4 + (lane >> 4);
    const int sb = R0 & 4095, s0 = sb + seg * 8, base = R0 - sb;
    constexpr int NL = 8 + W - 1;
    u32x4 v[NL];
#pragma unroll
    for (int t = 0; t < NL; ++t) {
        const int sk = s0 + t - (W - 1);
        const int row = sk >= 0 ? base + sk : ROW_META + 16 + sk;
        v[t] = *(const u32x4*)(Pb + (size_t)row * PW + col);
    }
    float s[8] = {0.f, 0.f, 0.f, 0.f, 0.f, 0.f, 0.f, 0.f};
#pragma unroll
    for (int t = 0; t < W - 1; ++t) add8(s, v[t]);
#pragma unroll
    for (int j = 0; j < 8; ++j) {
        float cur[8], old[8];
        unpack8(cur, v[j + W - 1]); unpack8(old, v[j]);
#pragma unroll
        for (int e = 0; e < 8; ++e) s[e] += cur[e];
        constexpr float inv = 1.0f / (float)W;
        u32x4 o; o.x = pk2(s[0] * inv - cur[0], s[1] * inv - cur[1]); o.y = pk2(s[2] * inv - cur[2], s[3] * inv - cur[3]);
        o.z = pk2(s[4] * inv - cur[4], s[5] * inv - cur[5]); o.w = pk2(s[6] * inv - cur[6], s[7] * inv - cur[7]);
        *(u32x4*)(POOL + (size_t)(R0 + seg * 8 + j) * PW + col) = o;
#pragma unroll
        for (int e = 0; e < 8; ++e) s[e] -= old[e];
    }
}
__device__ __forceinline__ void pool_unit(const Params& p, LAS unsigned char* lds, int pt, int tid, int wave, int lane) {
    unsigned char* ws = p.ws;
    const bf16_t* Pb = (const bf16_t*)(ws + WS_P); bf16_t* POOL = (bf16_t*)(ws + WS_POOL);
    const bool tail = pt >= 512;
    const int R0 = tail ? MREAL + 16 * (pt - 512) : pt * 64;
    if (!tail) {
        switch (wave >> 1) {
            case 0: pool_pm_main<2>(Pb, POOL, R0, wave, lane); break;
            case 1: pool_pm_main<4>(Pb, POOL, R0, wave, lane); break;
            case 2: pool_pm_main<8>(Pb, POOL, R0, wave, lane); break;
            default: pool_pm_main<16>(Pb, POOL, R0, wave, lane); break;
        }
    } else
    for (int i = tid; i < 1024; i += 512) {
        const int rr = i >> 6, ch = i & 63, R = R0 + rr, g = ch >> 4, w = 2 << g, col = ch * 8;
        float s[8] = {0.f, 0.f, 0.f, 0.f, 0.f, 0.f, 0.f, 0.f}, cur[8] = {0.f, 0.f, 0.f, 0.f, 0.f, 0.f, 0.f, 0.f};
        float inv = 1.0f / (float)w;
        if (R < ROW_SAMP) {
            const int pos = R - ROW_META; const int cnt = w < pos + 1 ? w : pos + 1; inv = 1.0f / (float)cnt;
#pragma unroll
            for (int k = 0; k < 16; ++k) {
                const bool on = k < cnt;
                float t[8]; unpack8(t, *(const u32x4*)(Pb + (size_t)(on ? R - k : R) * PW + col));
#pragma unroll
                for (int e = 0; e < 8; ++e) { s[e] += on ? t[e] : 0.f; if (k == 0) cur[e] = t[e]; }
            }
        } else if (R < ROW_PAD) {
            const int q = R - ROW_SAMP, b = q >> 4, ii = q & 15;
#pragma unroll
            for (int k = 0; k < 16; ++k) {
                const bool on = k < w, frombuf = ii - k >= 0;
                float t[8]; unpack8(t, *(const u32x4*)(Pb + (size_t)(frombuf ? R - k : R) * PW + col));
                const float* sp = p.state_pool + ((size_t)b * 15 + (frombuf ? 0 : 15 + ii - k)) * PW + col; const f32x4 a = *(const f32x4*)sp, c2 = *(const f32x4*)(sp + 4);
                const float u[8] = {a[0], a[1], a[2], a[3], c2[0], c2[1], c2[2], c2[3]};
#pragma unroll
                for (int e = 0; e < 8; ++e) { const float x = frombuf ? t[e] : u[e]; s[e] += on ? x : 0.f; if (k == 0) cur[e] = t[e]; }
            }
        }
        u32x4 o; o.x = pk2(s[0] * inv - cur[0], s[1] * inv - cur[1]); o.y = pk2(s[2] * inv - cur[2], s[3] * inv - cur[3]);
        o.z = pk2(s[4] * inv - cur[4], s[5] * inv - cur[5]); o.w = pk2(s[6] * inv - cur[6], s[7] * inv - cur[7]);
        *(u32x4*)(POOL + (size_t)R * PW + col) = o;
    }
}
__device__ __forceinline__ int deinter(int d) { return 2 * (d & 31) + (d >> 5); }
__device__ __forceinline__ void small_outputs(const Params& p) {
    unsigned char* ws = p.ws;
    const bf16_t *Kb = (const bf16_t*)(ws + WS_K), *Vb = (const bf16_t*)(ws + WS_V), *Pb = (const bf16_t*)(ws + WS_P);
    float* out = p.out;
    const int gt = blockIdx.x * 512 + threadIdx.x, NT = gridDim.x * 512;
    for (int i = gt; i < 131072; i += NT) {
        const int d = i & 63, n = (i >> 6) & 1, w = (i >> 7) & 127, b = i >> 14; const size_t row = (size_t)b * SEQ + 3968 + w;
        out[O_PSK + i] = bf1(Kb[row * 128 + n * 64 + deinter(d)]); out[O_PSV + i] = bf1(Vb[row * 128 + n * 64 + d]);
    }
    for (int i = gt; i < 16384; i += NT) {
        const int d = i & 63, n = (i >> 6) & 1, t = (i >> 7) & 15, b = i >> 11;
        const size_t rm = (size_t)ROW_META + t, rs = (size_t)ROW_SAMP + b * 16 + t;
        out[O_KM + i] = bf1(Kb[rm * 128 + n * 64 + deinter(d)]); out[O_VM + i] = bf1(Vb[rm * 128 + n * 64 + d]);
        out[O_SSK + i] = bf1(Kb[rs * 128 + n * 64 + deinter(d)]); out[O_SSV + i] = bf1(Vb[rs * 128 + n * 64 + d]);
    }
    for (int i = gt; i < 61440; i += NT) {
        const int c = i & 511, r = (i >> 9) % 15, b = (i >> 9) / 15;
        out[O_PPOOL + i] = bf1(Pb[((size_t)b * SEQ + 4081 + r) * PW + c]);
        out[O_SPOOL + i] = bf1(Pb[((size_t)ROW_SAMP + b * 16 + 1 + r) * PW + c]);
    }
}


constexpr size_t WS_SSQT1 = 5 * MiB + 512 * 1024, WS_SSQT2 = 8 * MiB + 512 * 1024;
struct SkinnyOp { const bf16_t* A; const bf16_t* Bt; int K; };
__device__ __forceinline__ void skinny_accum(const SkinnyOp op, int n0, int wave, int lane, f32x4 (&acc)[9]) {
    const int fr = lane & 15, fq = lane >> 4;
    const bf16_t* bp = op.Bt + (size_t)(n0 + fr) * op.K + 8 * fq;
    const bf16_t* ap = op.A + (size_t)(ROW_META + fr) * op.K + 8 * fq;
    const int nks = op.K >> 5;
    for (int ks = wave; ks < nks; ks += 16) {
        const bool two = ks + 8 < nks;
        const int k0 = ks * 32, k1 = two ? (ks + 8) * 32 : k0;
        const bf16x8 b0 = *(const bf16x8*)(bp + k0), b1 = *(const bf16x8*)(bp + k1);
        bf16x8 a0[9], a1[9];
#pragma unroll
        for (int rb = 0; rb < 9; ++rb) { a0[rb] = *(const bf16x8*)(ap + (size_t)rb * 16 * op.K + k0); a1[rb] = *(const bf16x8*)(ap + (size_t)rb * 16 * op.K + k1); }
#pragma unroll
        for (int rb = 0; rb < 9; ++rb) acc[rb] = __builtin_amdgcn_mfma_f32_16x16x32_bf16(b0, a0[rb], acc[rb], 0, 0, 0);
        if (two) {
#pragma unroll
            for (int rb = 0; rb < 9; ++rb) acc[rb] = __builtin_amdgcn_mfma_f32_16x16x32_bf16(b1, a1[rb], acc[rb], 0, 0, 0);
        }
    }
}
__device__ __forceinline__ void skinny_reduce(LAS unsigned char* lds, const f32x4 (&acc)[9], int wave, int lane, f32x4& r0, f32x4& r8) {
    LAS f32x4* part = (LAS f32x4*)lds;
#pragma unroll
    for (int rb = 0; rb < 9; ++rb) part[(wave * 9 + rb) * 64 + lane] = acc[rb];
    __syncthreads();
    r0 = (f32x4){0.f, 0.f, 0.f, 0.f}; r8 = (f32x4){0.f, 0.f, 0.f, 0.f};
#pragma unroll
    for (int w = 0; w < 8; ++w) r0 += part[(w * 9 + wave) * 64 + lane];
    if (wave == 0) {
#pragma unroll
        for (int w = 0; w < 8; ++w) r8 += part[(w * 9 + 8) * 64 + lane];
    }
    __syncthreads();
}
#define ZERO9(a) _Pragma("unroll") for (int z_ = 0; z_ < 9; ++z_) a[z_] = (f32x4){0.f, 0.f, 0.f, 0.f}
__device__ __forceinline__ void tail_mix_unit(const Params& p, LAS unsigned char* lds, int unit, int wave, int lane) {
    unsigned char* ws = p.ws; const int n0 = unit * 16, fr = lane & 15, fq = lane >> 4;
    f32x4 acc[9], a0, a8, b0, b8;
    ZERO9(acc); skinny_accum(SkinnyOp{(const bf16_t*)(ws + WS_ATT), (const bf16_t*)(ws + WS_WAO), 1024}, n0, wave, lane, acc); skinny_reduce(lds, acc, wave, lane, a0, a8);
    ZERO9(acc); skinny_accum(SkinnyOp{(const bf16_t*)(ws + WS_POOL), (const bf16_t*)(ws + WS_WPO), 512}, n0, wave, lane, acc); skinny_reduce(lds, acc, wave, lane, b0, b8);
    const bf16_t *GA = (const bf16_t*)(ws + WS_GA), *GP = (const bf16_t*)(ws + WS_GP); bf16_t* MIX = (bf16_t*)(ws + WS_MIX);
#pragma unroll
    for (int t = 0; t < 2; ++t) {
        if (t == 1 && wave != 0) break;
        const int rb = t ? 8 : wave; const f32x4 va = t ? a8 : a0, vb = t ? b8 : b0;
        const size_t off = (size_t)(ROW_META + 16 * rb + fr) * 1024 + n0 + 4 * fq;
        const u32x2 ga = *(const u32x2*)(GA + off), gp = *(const u32x2*)(GP + off);
        u32x2 w; w.x = pk2(bf_lo(ga.x) * va[0] + bf_lo(gp.x) * vb[0], bf_hi(ga.x) * va[1] + bf_hi(gp.x) * vb[1]);
        w.y = pk2(bf_lo(ga.y) * va[2] + bf_lo(gp.y) * vb[2], bf_hi(ga.y) * va[3] + bf_hi(gp.y) * vb[3]);
        *(u32x2*)(MIX + off) = w;
    }
}
__device__ __forceinline__ void tail_x1_unit(const Params& p, LAS unsigned char* lds, int unit, int wave, int lane) {
    unsigned char* ws = p.ws; const int n0 = unit * 16, fr = lane & 15, fq = lane >> 4;
    f32x4 acc[9], a0, a8;
    ZERO9(acc); skinny_accum(SkinnyOp{(const bf16_t*)(ws + WS_MIX), (const bf16_t*)(ws + WS_WOUT), 1024}, n0, wave, lane, acc); skinny_reduce(lds, acc, wave, lane, a0, a8);
    bf16_t* XG = (bf16_t*)(ws + WS_XG); float* ssqt = (float*)(ws + WS_SSQT1);
#pragma unroll
    for (int t = 0; t < 2; ++t) {
        if (t == 1 && wave != 0) break;
        const int rb = t ? 8 : wave; const f32x4 va = t ? a8 : a0;
        const int lr = 16 * rb + fr, row = ROW_META + lr, col = n0 + 4 * fq;
        const f32x4 x = *(const f32x4*)(row_x(p.x_prompt, p.meta_tokens, p.x_sample, row) + col);
        const f32x4 v = va + x, g = *(const f32x4*)(p.g_norm_ffn + col);
        u32x2 w; w.x = pk2(v[0] * g[0], v[1] * g[1]); w.y = pk2(v[2] * g[2], v[3] * g[3]);
        *(u32x2*)(XG + (size_t)row * 1024 + col) = w;
        float ss = (v[0] * v[0] + v[1] * v[1]) + (v[2] * v[2] + v[3] * v[3]);
        ss += __shfl_xor(ss, 16); ss += __shfl_xor(ss, 32);
        if (fq == 0) ssqt[lr * 64 + unit] = ss;
    }
}
__device__ __forceinline__ float tail_row_sum64(const float* ssqt, int lr) {
    const f32x4* sp = (const f32x4*)(ssqt + lr * 64); float s = 0.f;
#pragma unroll
    for (int j = 0; j < 16; ++j) { const f32x4 a = sp[j]; s += (a[0] + a[1]) + (a[2] + a[3]); }
    return s;
}
__device__ __forceinline__ void tail_up_unit(const Params& p, LAS unsigned char* lds, int unit, int wave, int lane) {
    unsigned char* ws = p.ws; const int n0 = unit * 16, fr = lane & 15, fq = lane >> 4;
    f32x4 acc[9], a0, a8;
    ZERO9(acc); skinny_accum(SkinnyOp{(const bf16_t*)(ws + WS_XG), (const bf16_t*)(ws + WS_WUP), 1024}, n0, wave, lane, acc); skinny_reduce(lds, acc, wave, lane, a0, a8);
    float* UPT = (float*)(ws + WS_UPT); const float* ssqt = (const float*)(ws + WS_SSQT1);
    const int oc = ((n0 >> 7) & 1) * FF + 128 * (n0 >> 8) + (n0 & 127) + 4 * fq;
#pragma unroll
    for (int t = 0; t < 2; ++t) {
        if (t == 1 && wave != 0) break;
        const int rb = t ? 8 : wave; const f32x4 va = t ? a8 : a0;
        const int lr = 16 * rb + fr;
        const float r1 = rsqrtf(tail_row_sum64(ssqt, lr) * (1.0f / 1024.0f) + RMS_EPS);
        *(f32x4*)(UPT + (size_t)lr * FF2 + oc) = va * r1;
    }
}
__device__ __forceinline__ void tail_down_unit(const Params& p, LAS unsigned char* lds, int unit, int wave, int lane) {
    unsigned char* ws = p.ws; const int n0 = unit * 16, fr = lane & 15, fq = lane >> 4;
    f32x4 acc[9], a0, a8;
    ZERO9(acc); skinny_accum(SkinnyOp{(const bf16_t*)(ws + WS_ACT), (const bf16_t*)(ws + WS_WDOWN), FF}, n0, wave, lane, acc); skinny_reduce(lds, acc, wave, lane, a0, a8);
    const bf16_t* XG = (const bf16_t*)(ws + WS_XG); float* ssqt = (float*)(ws + WS_SSQT2);
    f32x4 vv[2];
#pragma unroll
    for (int t = 0; t < 2; ++t) {
        if (t == 1 && wave != 0) break;
        const int rb = t ? 8 : wave; const f32x4 va = t ? a8 : a0;
        const int lr = 16 * rb + fr, row = ROW_META + lr, col = n0 + 4 * fq;
        const u32x2 xg = *(const u32x2*)(XG + (size_t)row * 1024 + col); const f32x4 g = *(const f32x4*)(p.g_norm_ffn + col);
        f32x4 v;
        v[0] = va[0] + bf_lo(xg.x) * __builtin_amdgcn_rcpf(g[0]); v[1] = va[1] + bf_hi(xg.x) * __builtin_amdgcn_rcpf(g[1]);
        v[2] = va[2] + bf_lo(xg.y) * __builtin_amdgcn_rcpf(g[2]); v[3] = va[3] + bf_hi(xg.y) * __builtin_amdgcn_rcpf(g[3]);
        vv[t] = v;
        float ss = (v[0] * v[0] + v[1] * v[1]) + (v[2] * v[2] + v[3] * v[3]);
        ss += __shfl_xor(ss, 16); ss += __shfl_xor(ss, 32);
        if (fq == 0) AG_ST(ssqt + lr * 64 + unit, ss);
    }
#pragma unroll
    for (int t = 0; t < 2; ++t) {
        if (t == 1 && wave != 0) break;
        const int rb = t ? 8 : wave;
        const int lr = 16 * rb + fr, col = n0 + 4 * fq;
        float s = 0.f;
        for (int tries = 0; tries < (1 << 16); ++tries) {
            bool ready = true; s = 0.f;
#pragma unroll
            for (int j = 0; j < 16; ++j) { const float a = AG_LD(ssqt + lr * 64 + 16 * fq + j); ready = ready && (a >= 0.f); s += a; }
            if (__all(ready)) break;
            __builtin_amdgcn_s_sleep(8);
        }
        s += __shfl_xor(s, 16); s += __shfl_xor(s, 32);
        const float r = rsqrtf(s * (1.0f / 1024.0f) + RMS_EPS);
        if (lr >= 16) *(f32x4*)(p.out + O_YS + (size_t)(lr - 16) * D + col) = vv[t] * r * *(const f32x4*)(p.g_norm_final + col);
    }
}

__device__ __forceinline__ void skinny_accum3(const SkinnyOp op, int n0, int rb0, int wave, int lane, f32x4 (&acc)[3]) {
    const int fr = lane & 15, fq = lane >> 4;
    const bf16_t* bp = op.Bt + (size_t)(n0 + fr) * op.K + 8 * fq;
    const bf16_t* ap = op.A + (size_t)(ROW_META + 16 * rb0 + fr) * op.K + 8 * fq;
    const int nks = op.K >> 5;
    for (int ks0 = wave; ks0 < nks; ks0 += 32) {
        bf16x8 b[4], a[4][3];
#pragma unroll
        for (int j = 0; j < 4; ++j) {
            const int ks = ks0 + 8 * j; const int k = (ks < nks ? ks : ks0) * 32;
            b[j] = *(const bf16x8*)(bp + k);
#pragma unroll
            for (int rb = 0; rb < 3; ++rb) a[j][rb] = *(const bf16x8*)(ap + (size_t)rb * 16 * op.K + k);
        }
#pragma unroll
        for (int j = 0; j < 4; ++j) {
            if (ks0 + 8 * j < nks) {
#pragma unroll
                for (int rb = 0; rb < 3; ++rb) acc[rb] = __builtin_amdgcn_mfma_f32_16x16x32_bf16(b[j], a[j][rb], acc[rb], 0, 0, 0);
            }
        }
    }
}
__device__ __forceinline__ f32x4 skinny_reduce3(LAS unsigned char* lds, const f32x4 (&acc)[3], int wave, int lane) {
    LAS f32x4* part = (LAS f32x4*)lds;
#pragma unroll
    for (int rb = 0; rb < 3; ++rb) part[(wave * 3 + rb) * 64 + lane] = acc[rb];
    __syncthreads();
    f32x4 r = {0.f, 0.f, 0.f, 0.f};
    if (wave < 3) {
#pragma unroll
        for (int w = 0; w < 8; ++w) r += part[(w * 3 + wave) * 64 + lane];
    }
    __syncthreads();
    return r;
}
#define ZERO3(a) _Pragma("unroll") for (int z_ = 0; z_ < 3; ++z_) a[z_] = (f32x4){0.f, 0.f, 0.f, 0.f}
__device__ __forceinline__ void tail_mix_unit3(const Params& p, LAS unsigned char* lds, int unit, int wave, int lane) {
    unsigned char* ws = p.ws; const int n0 = (unit & 63) * 16, rb0 = 3 * (unit >> 6), fr = lane & 15, fq = lane >> 4;
    f32x4 acc[3];
    ZERO3(acc); skinny_accum3(SkinnyOp{(const bf16_t*)(ws + WS_ATT), (const bf16_t*)(ws + WS_WAO), 1024}, n0, rb0, wave, lane, acc); const f32x4 va = skinny_reduce3(lds, acc, wave, lane);
    ZERO3(acc); skinny_accum3(SkinnyOp{(const bf16_t*)(ws + WS_POOL), (const bf16_t*)(ws + WS_WPO), 512}, n0, rb0, wave, lane, acc); const f32x4 vb = skinny_reduce3(lds, acc, wave, lane);
    if (wave < 3) {
        const bf16_t *GA = (const bf16_t*)(ws + WS_GA), *GP = (const bf16_t*)(ws + WS_GP); bf16_t* MIX = (bf16_t*)(ws + WS_MIX);
        const size_t off = (size_t)(ROW_META + 16 * (rb0 + wave) + fr) * 1024 + n0 + 4 * fq;
        const u32x2 ga = *(const u32x2*)(GA + off), gp = *(const u32x2*)(GP + off);
        u32x2 w; w.x = pk2(bf_lo(ga.x) * va[0] + bf_lo(gp.x) * vb[0], bf_hi(ga.x) * va[1] + bf_hi(gp.x) * vb[1]);
        w.y = pk2(bf_lo(ga.y) * va[2] + bf_lo(gp.y) * vb[2], bf_hi(ga.y) * va[3] + bf_hi(gp.y) * vb[3]);
        *(u32x2*)(MIX + off) = w;
    }
}
__device__ __forceinline__ void tail_x1_unit3(const Params& p, LAS unsigned char* lds, int unit, int wave, int lane) {
    unsigned char* ws = p.ws; const int cu = unit & 63, n0 = cu * 16, rb0 = 3 * (unit >> 6), fr = lane & 15, fq = lane >> 4;
    f32x4 acc[3];
    ZERO3(acc); skinny_accum3(SkinnyOp{(const bf16_t*)(ws + WS_MIX), (const bf16_t*)(ws + WS_WOUT), 1024}, n0, rb0, wave, lane, acc); const f32x4 va = skinny_reduce3(lds, acc, wave, lane);
    if (wave < 3) {
        bf16_t* XG = (bf16_t*)(ws + WS_XG); float* ssqt = (float*)(ws + WS_SSQT1);
        const int lr = 16 * (rb0 + wave) + fr, row = ROW_META + lr, col = n0 + 4 * fq;
        const f32x4 x = *(const f32x4*)(row_x(p.x_prompt, p.meta_tokens, p.x_sample, row) + col);
        const f32x4 v = va + x, g = *(const f32x4*)(p.g_norm_ffn + col);
        u32x2 w; w.x = pk2(v[0] * g[0], v[1] * g[1]); w.y = pk2(v[2] * g[2], v[3] * g[3]);
        *(u32x2*)(XG + (size_t)row * 1024 + col) = w;
        float ss = (v[0] * v[0] + v[1] * v[1]) + (v[2] * v[2] + v[3] * v[3]);
        ss += __shfl_xor(ss, 16); ss += __shfl_xor(ss, 32);
        if (fq == 0) ssqt[lr * 64 + cu] = ss;
    }
}
__device__ __forceinline__ void tail_down_unit3(const Params& p, LAS unsigned char* lds, int unit, int wave, int lane) {
    unsigned char* ws = p.ws; const int cu = unit & 63, n0 = cu * 16, rb0 = 3 * (unit >> 6), fr = lane & 15, fq = lane >> 4;
    f32x4 acc[3];
    ZERO3(acc); skinny_accum3(SkinnyOp{(const bf16_t*)(ws + WS_ACT), (const bf16_t*)(ws + WS_WDOWN), FF}, n0, rb0, wave, lane, acc); const f32x4 va = skinny_reduce3(lds, acc, wave, lane);
    if (wave < 3) {
        const bf16_t* XG = (const bf16_t*)(ws + WS_XG); float* ssqt = (float*)(ws + WS_SSQT2);
        const int lr = 16 * (rb0 + wave) + fr, row = ROW_META + lr, col = n0 + 4 * fq;
        const u32x2 xg = *(const u32x2*)(XG + (size_t)row * 1024 + col); const f32x4 g = *(const f32x4*)(p.g_norm_ffn + col);
        f32x4 v;
        v[0] = va[0] + bf_lo(xg.x) * __builtin_amdgcn_rcpf(g[0]); v[1] = va[1] + bf_hi(xg.x) * __builtin_amdgcn_rcpf(g[1]);
        v[2] = va[2] + bf_lo(xg.y) * __builtin_amdgcn_rcpf(g[2]); v[3] = va[3] + bf_hi(xg.y) * __builtin_amdgcn_rcpf(g[3]);
        float ss = (v[0] * v[0] + v[1] * v[1]) + (v[2] * v[2] + v[3] * v[3]);
        ss += __shfl_xor(ss, 16); ss += __shfl_xor(ss, 32);
        if (fq == 0) AG_ST(ssqt + lr * 64 + cu, ss);
        float s = 0.f;
        for (int tries = 0; tries < (1 << 16); ++tries) {
            bool ready = true; s = 0.f;
#pragma unroll
            for (int j = 0; j < 16; ++j) { const float a = AG_LD(ssqt + lr * 64 + 16 * fq + j); ready = ready && (a >= 0.f); s += a; }
            if (__all(ready)) break;
            __builtin_amdgcn_s_sleep(2);
        }
        s += __shfl_xor(s, 16); s += __shfl_xor(s, 32);
        const float r = rsqrtf(s * (1.0f / 1024.0f) + RMS_EPS);
        if (lr >= 16) *(f32x4*)(p.out + O_YS + (size_t)(lr - 16) * D + col) = v * r * *(const f32x4*)(p.g_norm_final + col);
    }
}

__device__ __forceinline__ void conv_fix(const Params& p) {
    unsigned char* ws = p.ws;
    const float* HALO = (const float*)(ws + WS_HALO); const float* UPT = (const float*)(ws + WS_UPT); bf16_t* ACT = (bf16_t*)(ws + WS_ACT);
    const float *cw = p.conv_w, *cb = p.conv_b;
    const int gt = blockIdx.x * 512 + threadIdx.x, NT = gridDim.x * 512;
    constexpr int NCH = FF / 4;
    constexpr int N_SLAB = 256 * 2 * NCH, N_SAMP = 128 * NCH;
    for (int it = gt; it < N_SLAB + N_SAMP; it += NT) {
        const float *u0, *u1, *u2; int row, j;
        if (it < N_SLAB) {
            const int ch = it % NCH, sr = it / NCH, rr = sr & 1, s = sr >> 1; j = ch * 4;
            row = s * 128 + rr;
            const float* l1 = (s & 31) ? HALO + (size_t)((s - 1) * 4 + 3) * FF2 : UPT + (size_t)15 * FF2;
            const float* l0 = (s & 31) ? HALO + (size_t)((s - 1) * 4 + 2) * FF2 : UPT + (size_t)14 * FF2;
            u0 = HALO + (size_t)(s * 4 + rr) * FF2;
            if (rr == 0) { u1 = l1; u2 = l0; } else { u1 = HALO + (size_t)(s * 4) * FF2; u2 = l1; }
        } else {
            const int t = it - N_SLAB, ch = t % NCH, q = t / NCH, b = q >> 4, i = q & 15; j = ch * 4;
            row = ROW_SAMP + q;
            u0 = UPT + (size_t)(16 + q) * FF2;
            u1 = (i >= 1) ? UPT + (size_t)(16 + q - 1) * FF2 : p.state_conv + ((size_t)b * 2 + 1) * FF2;
            u2 = (i >= 2) ? UPT + (size_t)(16 + q - 2) * FF2 : p.state_conv + ((size_t)b * 2 + i) * FF2;
        }
        const f32x4 g0 = *(const f32x4*)(u0 + j), g1 = *(const f32x4*)(u1 + j), g2 = *(const f32x4*)(u2 + j);
        const f32x4 v0 = *(const f32x4*)(u0 + FF + j), v1 = *(const f32x4*)(u1 + FF + j), v2 = *(const f32x4*)(u2 + FF + j);
        const f32x4 cg = *(const f32x4*)(cb + j) + *(const f32x4*)(cw + j) * g2 + *(const f32x4*)(cw + FF2 + j) * g1 + *(const f32x4*)(cw + 2 * FF2 + j) * g0;
        const f32x4 cv = *(const f32x4*)(cb + FF + j) + *(const f32x4*)(cw + FF + j) * v2 + *(const f32x4*)(cw + FF2 + FF + j) * v1 + *(const f32x4*)(cw + 2 * FF2 + FF + j) * v0;
        float a[4];
#pragma unroll
        for (int i = 0; i < 4; ++i) a[i] = cg[i] * sigmoidf_(cg[i]) * cv[i];
        u32x2 w; w.x = pk2(a[0], a[1]); w.y = pk2(a[2], a[3]);
        *(u32x2*)(ACT + (size_t)row * FF + j) = w;
    }
    { f32x4* q4 = (f32x4*)(ws + WS_SSQ2); for (int i = gt; i < MREAL * 4; i += NT) q4[i] = (f32x4){-1.f, -1.f, -1.f, -1.f};
      f32x4* t4 = (f32x4*)(ws + WS_SSQT2); for (int i = gt; i < 144 * 16; i += NT) t4[i] = (f32x4){-1.f, -1.f, -1.f, -1.f};
      unsigned* pc = (unsigned*)(ws + WS_PCNT); for (int i = gt; i < 128; i += NT) pc[64 * i] = 0u; }
    for (int i = gt; i < 8 * 2 * FF2; i += NT) {
        const int c = i % FF2, k = (i / FF2) & 1, b = i / (2 * FF2);
        p.out[O_PCONV + i] = HALO[(size_t)((b * 32 + 31) * 4 + 2 + k) * FF2 + c];
        p.out[O_SCONV + i] = UPT[(size_t)(16 + b * 16 + 14 + k) * FF2 + c];
    }
}
__device__ __forceinline__ void final_norm(const Params& p, int wave, int lane) {
    const float* ssq = (const float*)(p.ws + WS_SSQ2);
    const int gw = blockIdx.x * 8 + wave, NGW = gridDim.x * 8;
    f32x4 gv[4];
#pragma unroll
    for (int j = 0; j < 4; ++j) gv[j] = ((const f32x4*)p.g_norm_final)[lane + 64 * j];
    for (int m0 = gw * 4; m0 < MREAL + 128; m0 += NGW * 4) {
        float sv[4]; f32x4 x[4][4]; float* orow[4];
#pragma unroll
        for (int q = 0; q < 4; ++q) {
            const int m = m0 + q;
            orow[q] = m < MREAL ? p.out + O_YP + (size_t)m * D : p.out + O_YS + (size_t)(m - MREAL) * D;
            if (m < MREAL) sv[q] = ssq[(size_t)m * 16 + (lane & 15)];
            else { const float* st = (const float*)(p.ws + WS_SSQT2) + (16 + m - MREAL) * 64; sv[q] = (st[lane & 15] + st[16 + (lane & 15)]) + (st[32 + (lane & 15)] + st[48 + (lane & 15)]); }
#pragma unroll
            for (int j = 0; j < 4; ++j) x[q][j] = ((const f32x4*)orow[q])[lane + 64 * j];
        }
#pragma unroll
        for (int q = 0; q < 4; ++q) {
            float s = sv[q];
            s += __shfl_xor(s, 1); s += __shfl_xor(s, 2); s += __shfl_xor(s, 4); s += __shfl_xor(s, 8);
            const float r = rsqrtf(s * (1.0f / D) + RMS_EPS);
#pragma unroll
            for (int j = 0; j < 4; ++j) ((f32x4*)orow[q])[lane + 64 * j] = x[q][j] * r * gv[j];
        }
    }
}


struct EpiNull {
    static constexpr bool PERM = true, AFTER_DRAIN = false, APERM = false;
    float* sink;
    __device__ __forceinline__ void operator()(const f32x4 (&acc)[2][2][4][2], const Unit& u, int wr, int wc, int fr, int fq) const {
        f32x4 t = {0.f, 0.f, 0.f, 0.f};
#pragma unroll
        for (int a = 0; a < 2; ++a)
#pragma unroll
            for (int b = 0; b < 2; ++b)
#pragma unroll
                for (int m = 0; m < 4; ++m)
#pragma unroll
                    for (int n = 0; n < 2; ++n) t += acc[a][b][m][n];
        if (t[0] + t[1] + t[2] + t[3] == 123456.789f) sink[threadIdx.x] = t[0];
    }
};
struct SamePanelOrder {
    int G, c, nr;
    __device__ bool next(int i, Unit& u) const { if (i >= nr) return false; u.pm = 0; u.pn = (c >> 6) & 3; return true; }
    __device__ __forceinline__ void a_ready(const Unit&) const {}
    __device__ __forceinline__ void done(const Unit&) const {}
};

typedef unsigned v4u_unused_t;
#define XB_TMO      128
#define XB_XCNT(j)  (256  + 64 * (j))
#define XB_XSUB(j)  (1280 + 64 * (j))
#define XB_XGEN(j)  (2304 + 64 * (j))
#define XB_TOP      3328
#define XB_TOPGEN   3392
#define XCD_BAR_WORDS 3456
#define XB_SPIN_CAP (1u << 18)

__device__ __forceinline__ unsigned xb_ld(unsigned* p)              { return __hip_atomic_load(p, __ATOMIC_RELAXED, __HIP_MEMORY_SCOPE_AGENT); }
__device__ __forceinline__ unsigned xb_add(unsigned* p, unsigned v) { return __hip_atomic_fetch_add(p, v, __ATOMIC_RELAXED, __HIP_MEMORY_SCOPE_AGENT); }
__device__ __forceinline__ unsigned xb_xcc_id() { return (unsigned)__builtin_amdgcn_s_getreg((3 << 11) | 20) & 0xFu; }
#define XB_SPIN(cond, bar) do { unsigned _sp = 0; while (cond) { __builtin_amdgcn_s_sleep(1); \
    if ((++_sp & 255u) == 0u) { if (xb_ld(&(bar)[XB_TMO])) break; if (_sp > XB_SPIN_CAP) { atomicAdd(&(bar)[XB_TMO], 1u); break; } } } } while (0)

struct XcdBarrier {
    unsigned* bar; unsigned x;
    volatile LAS unsigned* st;
};

__device__ __forceinline__ XcdBarrier xcd_barrier_post(unsigned* bar, volatile LAS unsigned* st) {
    XcdBarrier b; b.bar = bar; b.x = xb_xcc_id(); b.st = st;
    if (threadIdx.x == 0) (void)xb_add(&bar[XB_XCNT(b.x)], 1u);
    return b;
}
__device__ __forceinline__ void xcd_barrier_complete(unsigned* bar, unsigned x, unsigned& nloc, unsigned& nx) {
    const unsigned G = gridDim.x * gridDim.y * gridDim.z;
    unsigned sum, cnt, mine, sp = 0u;
    for (;;) {
        sum = 0u; cnt = 0u; mine = 0u;
#pragma unroll
        for (unsigned j = 0; j < 16; ++j) { const unsigned c = xb_ld(&bar[XB_XCNT(j)]); sum += c; cnt += (c > 0u) ? 1u : 0u; mine = (j == x) ? c : mine; }
        if (sum == G) break;
        __builtin_amdgcn_s_sleep(1);
        if ((++sp & 255u) == 0u) { if (xb_ld(&bar[XB_TMO])) break; if (sp > XB_SPIN_CAP) { atomicAdd(&bar[XB_TMO], 1u); break; } }
    }
    nloc = mine > 0u ? mine : 1u; nx = cnt > 0u ? cnt : 1u;
}

__device__ __forceinline__ void xcd_barrier(const XcdBarrier& b) {
    asm volatile("s_waitcnt vmcnt(0)" ::: "memory");
    __syncthreads();
    if (threadIdx.x == 0) {
        unsigned* bar = b.bar;
        __builtin_amdgcn_s_waitcnt(0);
        unsigned nloc = b.st[0], nx = b.st[1];
        if (nloc == 0u) { xcd_barrier_complete(bar, b.x, nloc, nx); b.st[0] = nloc; b.st[1] = nx; }
        const unsigned old = xb_add(&bar[XB_XSUB(b.x)], 1u);
        const unsigned gen = old / nloc;
        if (old + 1u == (gen + 1u) * nloc) {
            __builtin_amdgcn_fence(__ATOMIC_RELEASE, "agent");
            asm volatile("s_waitcnt vmcnt(0)" ::: "memory");
            const unsigned og = xb_add(&bar[XB_TOP], 1u);
            const unsigned tg = og / nx;
            if (og + 1u == (tg + 1u) * nx) xb_add(&bar[XB_TOPGEN], 1u);
            else XB_SPIN(xb_ld(&bar[XB_TOPGEN]) == tg, bar);
            __builtin_amdgcn_fence(__ATOMIC_ACQUIRE, "agent");
            xb_add(&bar[XB_XGEN(b.x)], 1u);
            asm volatile("s_waitcnt vmcnt(0)" ::: "memory");
        } else {
            XB_SPIN(xb_ld(&bar[XB_XGEN(b.x)]) == gen, bar);
            __builtin_amdgcn_fence(__ATOMIC_ACQUIRE, "agent");
            asm volatile("s_waitcnt vmcnt(0)" ::: "memory");
        }
    }
    __syncthreads();
}

__device__ __forceinline__ void grid_bar(unsigned* ctr, unsigned target) {
    asm volatile("s_waitcnt vmcnt(0) lgkmcnt(0)" ::: "memory");
    __syncthreads();
    if (threadIdx.x == 0) {
        __hip_atomic_fetch_add(ctr, 1u, __ATOMIC_RELEASE, __HIP_MEMORY_SCOPE_AGENT);
        unsigned spins = 0;
        while (__hip_atomic_load(ctr, __ATOMIC_RELAXED, __HIP_MEMORY_SCOPE_AGENT) < target) { __builtin_amdgcn_s_sleep(2); if (++spins > (1u << 24)) break; }
        __builtin_amdgcn_fence(__ATOMIC_ACQUIRE, "agent");
        asm volatile("s_waitcnt vmcnt(0)" ::: "memory");
    }
    __syncthreads();
}
__global__ void __launch_bounds__(512, 2) fwd_megakernel(Params p) {
    extern __shared__ __attribute__((aligned(16))) unsigned char lds_raw[];
    LAS unsigned char* lds = (LAS unsigned char*)lds_raw;
    cg::grid_group grid = cg::this_grid();
    const int wave = __builtin_amdgcn_readfirstlane(threadIdx.x >> 6);
#define TIDLANE() int tid = threadIdx.x; asm volatile("" : "+v"(tid)); const int lane = tid & 63
    unsigned char* ws = p.ws;
    const int lo = p.ph_lo, hi = p.ph_hi, G = gridDim.x;
#define IN(k) (lo <= (k) && (k) < hi)
#define SEAM(k) do { if (IN(k) && IN((k) + 1)) xcd_barrier(xbar); } while (0)
    if (lo < 0) grid.sync();
    volatile LAS unsigned* xst = (volatile LAS unsigned*)(lds + LDS_BYTES - 32);
    if (threadIdx.x < 2) xst[threadIdx.x] = 0u;
    __syncthreads();
    XcdBarrier xbar = xcd_barrier_post((unsigned*)(ws + 4096), xst);
    if (IN(0)) { TIDLANE(); (void)tid; p0_prologue(p, lds, wave, lane); __syncthreads(); }
    SEAM(0);
    if (IN(1)) {
        pg8::Gemm g{(const bf16_t*)(ws + WS_XN), (const bf16_t*)(ws + WS_WIN), M, INW, D}; pg8::StaticOrder S; S.init(M, INW, G, (int)blockIdx.x);
        EpiZ E{(bf16_t*)(ws + WS_Q), (bf16_t*)(ws + WS_K), (bf16_t*)(ws + WS_V), (bf16_t*)(ws + WS_P), (bf16_t*)(ws + WS_GA), (bf16_t*)(ws + WS_GP), p.b_gate, (const float*)(ws + WS_ROPE)};
        pg8::gemm_phase<EpiZ, pg8::StaticOrder, true, true>(lds, g, S, E);
    }
    SEAM(1);
    if (IN(2)) {
        TIDLANE();
        for (int unit = blockIdx.x; unit < 1024; unit += G) attn_chunk_unit(p, lds, unit, tid, wave, lane);
        constexpr int N_EXTRA = 27;
        if (G > 2 * N_EXTRA) {
            if ((int)blockIdx.x < N_EXTRA) { const int e = blockIdx.x; if (e < 18) attn_small_unit(p, lds, e, tid, wave, lane); else pool_unit(p, lds, 512 + e - 18, tid, wave, lane); }
            else for (int unit = blockIdx.x - N_EXTRA; unit < 512; unit += G - N_EXTRA) pool_unit(p, lds, unit, tid, wave, lane);
        } else {
            for (int unit = blockIdx.x; unit < 18 + 521; unit += G) { if (unit < 18) attn_small_unit(p, lds, unit, tid, wave, lane); else pool_unit(p, lds, unit - 18, tid, wave, lane); }
        }
        small_outputs(p);
    }
    SEAM(2);
    if (IN(3)) {
        { TIDLANE(); (void)tid; for (int unit = blockIdx.x; unit < 192; unit += G) tail_mix_unit3(p, lds, unit, wave, lane); }
        { pg8::Gemm g{(const bf16_t*)(ws + WS_ATT), (const bf16_t*)(ws + WS_WAO), MREAL, D, D}; pg8::StaticOrder S; S.init(MREAL, D, G, (int)blockIdx.x);
          EpiT1 E{(const bf16_t*)(ws + WS_GA), (bf16_t*)(ws + WS_MIX)};
          pg8::gemm_phase<EpiT1, pg8::StaticOrder, true, true>(lds, g, S, E); }
        __syncthreads();
        { pg8::Gemm g{(const bf16_t*)(ws + WS_POOL), (const bf16_t*)(ws + WS_WPO), MREAL, D, PW}; pg8::StaticOrder S; S.init(MREAL, D, G, (int)blockIdx.x);
          EpiMix E{(const bf16_t*)(ws + WS_GP), (bf16_t*)(ws + WS_MIX)};
          pg8::gemm_phase<EpiMix, pg8::StaticOrder, true, true>(lds, g, S, E); }
    }
    SEAM(3);
    if (IN(4)) {
        { TIDLANE(); (void)tid; for (int unit = blockIdx.x; unit < 192; unit += G) tail_x1_unit3(p, lds, unit, wave, lane); }
        pg8::Gemm g{(const bf16_t*)(ws + WS_MIX), (const bf16_t*)(ws + WS_WOUT), MREAL, D, D}; pg8::StaticOrder S; S.init(MREAL, D, G, (int)blockIdx.x);
        EpiX1 E{(const bf16_t*)(ws + WS_XN), (const float*)(ws + WS_R0I), p.g_norm_mix, p.g_norm_ffn, (bf16_t*)(ws + WS_XG), (float*)(ws + WS_SSQ1)};
        pg8::gemm_phase<EpiX1, pg8::StaticOrder, true, true>(lds, g, S, E);
    }
    SEAM(4);
    if (IN(5)) {
        { TIDLANE(); (void)tid; for (int unit = blockIdx.x; unit < FF2 / 16; unit += G) tail_up_unit(p, lds, unit, wave, lane); }
        pg8::Gemm g{(const bf16_t*)(ws + WS_XG), (const bf16_t*)(ws + WS_WUP), MREAL, FF2, D}; pg8::StaticOrder S; S.init(MREAL, FF2, G, (int)blockIdx.x);
        EpiUp E{(const float*)(ws + WS_SSQ1), p.conv_w, p.conv_b, (bf16_t*)(ws + WS_ACT), (float*)(ws + WS_HALO), (float*)(ws + WS_UPT)};
        pg8::gemm_phase<EpiUp, pg8::StaticOrder, true, true>(lds, g, S, E);
    }
    SEAM(5);
    if (IN(6)) conv_fix(p);
    SEAM(6);
    if (IN(7)) {
        { TIDLANE(); (void)tid; for (int unit = blockIdx.x; unit < 192; unit += G) tail_down_unit3(p, lds, unit, wave, lane); }
        pg8::Gemm g{(const bf16_t*)(ws + WS_ACT), (const bf16_t*)(ws + WS_WDOWN), MREAL, D, FF}; pg8::StaticOrder S; S.init(MREAL, D, G, (int)blockIdx.x, 1);
        EpiDown E{(const bf16_t*)(ws + WS_XG), p.g_norm_ffn, p.g_norm_final, p.out, (float*)(ws + WS_SSQ2)};
        pg8::gemm_phase<EpiDown, pg8::StaticOrder, true, true>(lds, g, S, E);
    }
    if (IN(8)) { TIDLANE(); for (int unit = blockIdx.x; unit < 1024; unit += G) attn_chunk_unit(p, lds, unit, tid, wave, lane); }
    if (IN(9)) { TIDLANE(); for (int unit = blockIdx.x; unit < 512; unit += G) pool_unit(p, lds, unit, tid, wave, lane); }
    if (IN(12)) { TIDLANE(); for (int unit = 512 + blockIdx.x; unit < 521; unit += G) pool_unit(p, lds, unit, tid, wave, lane); }
    if (IN(10)) { TIDLANE(); for (int unit = blockIdx.x; unit < 18; unit += G) attn_small_unit(p, lds, unit, tid, wave, lane); }
    if (IN(11)) { small_outputs(p); }
    if (IN(17)) { pg8::Gemm g{(const bf16_t*)(ws + WS_ACT), (const bf16_t*)(ws + WS_WDOWN), MREAL, D, FF}; pg8::StaticOrder S; S.init(MREAL, D, G, (int)blockIdx.x, 1);
        EpiDown E{(const bf16_t*)(ws + WS_XG), p.g_norm_ffn, p.g_norm_final, p.out, (float*)(ws + WS_SSQ2)};
        pg8::gemm_phase<EpiDown, pg8::StaticOrder, true, true>(lds, g, S, E); }
    if (IN(18)) { TIDLANE(); (void)tid; for (int unit = blockIdx.x; unit < 192; unit += G) tail_down_unit3(p, lds, unit, wave, lane); }
    if (IN(14)) { pg8::Gemm g{(const bf16_t*)(ws + WS_ACT), (const bf16_t*)(ws + WS_WDOWN), MREAL, D, FF}; pg8::StaticOrder S; S.init(MREAL, D, G, (int)blockIdx.x, 1); EpiNull E{(float*)(ws + WS_SSQ1)};
        pg8::gemm_phase<EpiNull, pg8::StaticOrder, true, true>(lds, g, S, E); }
    if (IN(15)) { pg8::Gemm g{(const bf16_t*)(ws + WS_ACT), (const bf16_t*)(ws + WS_WDOWN), MREAL, D, FF}; SamePanelOrder S{G, (int)blockIdx.x, 2}; EpiNull E{(float*)(ws + WS_SSQ1)};
        pg8::gemm_phase<EpiNull, SamePanelOrder, true, true>(lds, g, S, E); }
    if (IN(16)) { pg8::Gemm g{(const bf16_t*)(ws + WS_MIX), (const bf16_t*)(ws + WS_WOUT), MREAL, D, D}; pg8::StaticOrder S; S.init(MREAL, D, G, (int)blockIdx.x); EpiNull E{(float*)(ws + WS_SSQ1)};
        pg8::gemm_phase<EpiNull, pg8::StaticOrder, true, true>(lds, g, S, E); }
#undef IN
#undef SEAM
}

#ifndef MK_N_LAUNCHES
#define MK_N_LAUNCHES 1
#endif
#ifndef PROBE_PHASE
#define PROBE_PHASE -1
#endif
extern "C" void kernel_launch(void* const* d_in, const int* in_sizes, int n_in, void* d_out, int out_size, void* d_ws, size_t ws_size, hipStream_t stream) {
    static int grid = 0;
    if (grid == 0) {
        if (n_in != 24 || (size_t)out_size != O_END || ws_size < WS_END) { fprintf(stderr, "kernel_launch: unexpected shapes: n_in %d out %d ws %zu (need %zu)\n", n_in, out_size, ws_size, (size_t)WS_END); grid = -1; return; }
        int dev = 0, cus = 0, per_cu = 0;
        hipGetDevice(&dev); hipDeviceGetAttribute(&cus, hipDeviceAttributeMultiprocessorCount, dev);
        if (hipFuncSetAttribute((const void*)fwd_megakernel, hipFuncAttributeMaxDynamicSharedMemorySize, LDS_BYTES) != hipSuccess) { fprintf(stderr, "kernel_launch: hipFuncSetAttribute failed\n"); grid = -1; return; }
        if (hipOccupancyMaxActiveBlocksPerMultiprocessor(&per_cu, (const void*)fwd_megakernel, 512, LDS_BYTES) != hipSuccess || per_cu < 1) { fprintf(stderr, "kernel_launch: occupancy query gave %d\n", per_cu); per_cu = 1; }
        (void)hipGetLastError();
        grid = cus;
        fprintf(stderr, "kernel_launch: grid %d (per_cu %d)\n", grid, per_cu);
    }
    if (grid < 0) return;
    Params p{};
    const float** pp = (const float**)&p;
    for (int i = 0; i < 24; ++i) pp[i] = (const float*)d_in[i];
    p.out = (float*)d_out; p.ws = (unsigned char*)d_ws;
    for (int i = 0; i < 32; ++i) p.inv_freq[i] = powf(10000.0f, -(float)i / 32.0f);
    const int NPH = 8;
    int seq[8][2]; int nseq = 0;
    if (PROBE_PHASE >= NPH) { seq[0][0] = 0; seq[0][1] = NPH; seq[1][0] = PROBE_PHASE; seq[1][1] = PROBE_PHASE + 1; nseq = 2; }
    else if (PROBE_PHASE >= 0) { seq[0][0] = 0; seq[0][1] = PROBE_PHASE + 1; seq[1][0] = PROBE_PHASE; seq[1][1] = PROBE_PHASE + 1; nseq = 2; if (PROBE_PHASE + 1 < NPH) { seq[2][0] = PROBE_PHASE + 1; seq[2][1] = NPH; nseq = 3; } }
    else { seq[0][0] = 0; seq[0][1] = NPH; nseq = 1; }
    for (int k = 0; k < nseq; ++k) {
        if (hipMemsetAsync(d_ws, 0, 32768, stream) != hipSuccess) fprintf(stderr, "kernel_launch: memset failed\n");
        p.ph_lo = seq[k][0]; p.ph_hi = seq[k][1];
        void* args[] = {&p}; hipError_t e = hipLaunchCooperativeKernel((const void*)fwd_megakernel, dim3(grid), dim3(512), args, LDS_BYTES, stream);
        if (e != hipSuccess) fprintf(stderr, "kernel_launch: cooperative launch %d failed: %s\n", k, hipGetErrorString(e));
    }
}
```

```cpp
#include <hip/hip_runtime.h>
#include <hip/hip_cooperative_groups.h>
#include <cstdio>
#include <cstdint>
#include <cmath>
namespace cg = cooperative_groups;
namespace pg8 {
#define PG8_LAS __attribute__((address_space(3)))
typedef unsigned short bf16_t;
typedef short bf16x8 __attribute__((ext_vector_type(8)));
typedef float f32x4 __attribute__((ext_vector_type(4)));
typedef unsigned u32x4 __attribute__((ext_vector_type(4)));
constexpr int BM = 256, BK = 64, HALF = 128, HTB = HALF * BK * 2  , STAGE_BYTES = 8 * HTB, NXCD = 8, WGM = 8;

__host__ __device__ __forceinline__ int lds_byte(int r, int c) { const int st = (r >> 4) * 2 + (c >> 5), rr = r & 15, cc = c & 31, ob = rr * 64 + cc * 2; return st * 1024 + (ob ^ (((ob >> 9) & 1) << 5)); }
__host__ __device__ __forceinline__ void stage_rc(int b, int& R, int& C) { const int st = b / 1024, sb = b % 1024, swz = sb ^ (((sb >> 9) & 1) << 5); R = (st >> 1) * 16 + swz / 64; C = (st & 1) * 32 + (swz % 64) / 2; }
__host__ __device__ __forceinline__ int perm32(int rho) { const int n = rho >> 4, i = rho & 15; return 8 * (i >> 2) + 4 * n + (i & 3); }

struct Unit { int pm, pn; };
struct Gemm { const bf16_t* A; const bf16_t* Bt; int M, N, K; };

struct StaticOrder {
    int nM, nN, nwg, G, c, rev;
    __host__ __device__ void init(int M, int N, int G_, int c_, int rev_ = 0) { nM = M / BM; nN = N / BM; nwg = nM * nN; G = G_; c = c_; rev = rev_; }
    __host__ __device__ bool next(int i, Unit& u) const {
        const int nr = (nwg + G - 1) / G;
        if (i >= nr) return false;
        const long L = (long)((rev && nwg % G == 0) ? nr - 1 - i : i) * G + c; if (L >= nwg) return false;
        int wgid = (int)L; { const int q = nwg / NXCD, r = nwg % NXCD, xcd = wgid % NXCD, off = wgid / NXCD; wgid = (xcd < r ? xcd * (q + 1) : r * (q + 1) + (xcd - r) * q) + off; }
        const int nig = WGM * nN, gid = wgid / nig, fm = gid * WGM, gsz = (nM - fm) < WGM ? (nM - fm) : WGM;
        u.pm = fm + ((wgid % nig) % gsz); u.pn = (wgid % nig) / gsz; return true;
    }
    __device__ __forceinline__ void a_ready(const Unit&) const {}
    __device__ __forceinline__ void done(const Unit&) const {}
};

__device__ __forceinline__ unsigned cvt_pk_bf16(float lo, float hi) { unsigned r; asm volatile("v_cvt_pk_bf16_f32 %0, %1, %2" : "=v"(r) : "v"(lo), "v"(hi)); return r; }
template <class Epi, class Sched, bool ALIGN_EPI = false, bool SP2 = false>
__device__ __forceinline__ void gemm_phase(PG8_LAS unsigned char* lds, const Gemm g, const Sched& S, const Epi& E) {
    const int tid = threadIdx.x, wid = __builtin_amdgcn_readfirstlane(tid >> 6), lane = tid & 63, wr = wid >> 2, wc = wid & 3, fr = lane & 15, fq = lane >> 4;
    const int K = g.K, nt = K / BK;
    unsigned voffA[2], voffB[2];
#pragma unroll
    for (int i = 0; i < 2; ++i) { int R, C; stage_rc(tid * 16 + i * 8192, R, C); const int Rb = Epi::PERM ? ((R & ~31) + perm32(R & 31)) : R;
        const int Ra = Epi::APERM ? ((R >> 6) * 128 + (R & 63)) : R;
        voffA[i] = (unsigned)(Ra * K + C) * 2u; voffB[i] = (unsigned)(Rb * K + C) * 2u; }
    const size_t kstep = (size_t)(BK * 2);
    const size_t hstep = (size_t)HALF * K * 2;
    const size_t tstep = 2 * hstep;
    const size_t hstepA = Epi::APERM ? (size_t)64 * K * 2 : hstep;
    const unsigned ldsw = (unsigned)wid * 1024u;
    const int aoff = lds_byte(wr * 64 + fr, fq * 8), boff = lds_byte(wc * 32 + fr, fq * 8);
#define PG8_SA(b, h) (((b) * 2 + (h)) * HTB)
#define PG8_SB(b, h) ((4 + (b) * 2 + (h)) * HTB)
#define PG8_STAGE(bufoff, gbase, voff) do { _Pragma("unroll") for (int _i = 0; _i < 2; ++_i) \
        __builtin_amdgcn_global_load_lds((const unsigned*)((const char*)(gbase) + (voff)[_i]), (PG8_LAS unsigned*)(lds + (bufoff) + ldsw + _i * 8192), 16, 0, 0); } while (0)
#define PG8_LDA(dst, b, h) do { _Pragma("unroll") for (int m = 0; m < 4; ++m) _Pragma("unroll") for (int k = 0; k < 2; ++k) dst[m][k] = *(const PG8_LAS bf16x8*)(lds + PG8_SA(b, h) + aoff + m * 2048 + k * 1024); } while (0)
#define PG8_LDB(dst, b, h) do { _Pragma("unroll") for (int n = 0; n < 2; ++n) _Pragma("unroll") for (int k = 0; k < 2; ++k) dst[n][k] = *(const PG8_LAS bf16x8*)(lds + PG8_SB(b, h) + boff + n * 2048 + k * 1024); } while (0)
#define PG8_MMA(ai, bj, At, Bt) do { __builtin_amdgcn_s_setprio(1); _Pragma("unroll") for (int m = 0; m < 4; ++m) _Pragma("unroll") for (int n = 0; n < 2; ++n) _Pragma("unroll") for (int k = 0; k < 2; ++k) \
        acc[ai][bj][m][n] = __builtin_amdgcn_mfma_f32_16x16x32_bf16(Bt[n][k], At[m][k], acc[ai][bj][m][n], 0, 0, 0); __builtin_amdgcn_s_setprio(0); } while (0)
#define PG8_WAIT_V(n) asm volatile("s_waitcnt vmcnt(" #n ")" ::: "memory")
#define PG8_WAIT_L(n) asm volatile("s_waitcnt lgkmcnt(" #n ")" ::: "memory")
#define PG8_BAR __builtin_amdgcn_s_barrier()
#define PG8_SCHED __builtin_amdgcn_sched_barrier(0)
    Unit cur, nxt; int ui = 0;
    if (!S.next(0, cur)) return;
    f32x4 acc[2][2][4][2];
#pragma unroll
    for (int a = 0; a < 2; ++a)
#pragma unroll
        for (int b = 0; b < 2; ++b)
#pragma unroll
            for (int m = 0; m < 4; ++m)
#pragma unroll
                for (int n = 0; n < 2; ++n) acc[a][b][m][n] = (f32x4){0.f, 0.f, 0.f, 0.f};
    bf16x8 At[4][2], B0[2][2], B1[2][2];
    const char* cA = (const char*)g.A + (size_t)cur.pm * tstep; const char* cB = (const char*)g.Bt + (size_t)cur.pn * tstep;
    S.a_ready(cur);
    if constexpr (SP2) {
        PG8_STAGE(PG8_SB(0, 0), cB, voffB); PG8_STAGE(PG8_SB(0, 1), cB + hstep, voffB); PG8_STAGE(PG8_SA(0, 0), cA, voffA); PG8_STAGE(PG8_SA(0, 1), cA + hstepA, voffA);
        if (wr == 1) PG8_BAR;
        PG8_WAIT_V(2); PG8_BAR;
        PG8_STAGE(PG8_SB(1, 0), cB + kstep, voffB); PG8_STAGE(PG8_SA(1, 0), cA + kstep, voffA); PG8_STAGE(PG8_SB(1, 1), cB + hstep + kstep, voffB);
        PG8_WAIT_V(6); PG8_BAR;
    } else {
        PG8_STAGE(PG8_SB(0, 0), cB, voffB); PG8_STAGE(PG8_SA(0, 0), cA, voffA); PG8_STAGE(PG8_SB(0, 1), cB + hstep, voffB); PG8_STAGE(PG8_SA(0, 1), cA + hstepA, voffA);
        if (wr == 1) PG8_BAR;
        PG8_WAIT_V(4); PG8_BAR;
        PG8_STAGE(PG8_SB(1, 0), cB + kstep, voffB); PG8_STAGE(PG8_SA(1, 0), cA + kstep, voffA); PG8_STAGE(PG8_SB(1, 1), cB + hstep + kstep, voffB);
        PG8_WAIT_V(6); PG8_BAR;
    }
    for (;;) {
        const bool has_next = S.next(ui + 1, nxt);
        const char* nA = has_next ? (const char*)g.A + (size_t)nxt.pm * tstep : cA; const char* nB = has_next ? (const char*)g.Bt + (size_t)nxt.pn * tstep : cB;
        for (int t = 0; t < nt; t += 2) {
            const bool last = (t == nt - 2);
            const char* a1 = cA + (size_t)(t + 1) * kstep;
            const char* a2 = last ? nA : cA + (size_t)(t + 2) * kstep; const char* b2 = last ? nB : cB + (size_t)(t + 2) * kstep;
            const char* a3 = a2 + kstep; const char* b3 = b2 + kstep;
            if (last && has_next) S.a_ready(nxt);
            if constexpr (SP2) {
            PG8_LDB(B0, 0, 0); PG8_LDB(B1, 0, 1); PG8_SCHED; PG8_LDA(At, 0, 0); PG8_STAGE(PG8_SA(1, 1), a1 + hstepA, voffA);
            PG8_WAIT_V(8); PG8_WAIT_L(0); PG8_BAR; PG8_MMA(0, 0, At, B0); PG8_MMA(0, 1, At, B1); PG8_BAR; PG8_SCHED;
            PG8_LDA(At, 0, 1); PG8_STAGE(PG8_SB(0, 0), b2, voffB); PG8_STAGE(PG8_SB(0, 1), b2 + hstep, voffB); PG8_STAGE(PG8_SA(0, 0), a2, voffA);
            PG8_WAIT_V(8); PG8_WAIT_L(0); PG8_BAR; PG8_MMA(1, 0, At, B0); PG8_MMA(1, 1, At, B1); PG8_BAR; PG8_SCHED;
            PG8_LDB(B0, 1, 0); PG8_LDB(B1, 1, 1); PG8_SCHED; PG8_LDA(At, 1, 0); PG8_STAGE(PG8_SA(0, 1), a2 + hstepA, voffA);
            PG8_WAIT_V(8); PG8_WAIT_L(0); PG8_BAR; PG8_MMA(0, 0, At, B0); PG8_MMA(0, 1, At, B1); PG8_BAR; PG8_SCHED;
            PG8_LDA(At, 1, 1); PG8_STAGE(PG8_SB(1, 0), b3, voffB); PG8_STAGE(PG8_SB(1, 1), b3 + hstep, voffB); PG8_STAGE(PG8_SA(1, 0), a3, voffA);
            PG8_WAIT_V(8); PG8_WAIT_L(0); PG8_BAR; PG8_MMA(1, 0, At, B0); PG8_MMA(1, 1, At, B1); PG8_BAR; PG8_SCHED;
            } else {
            PG8_LDB(B0, 0, 0); PG8_SCHED; PG8_LDA(At, 0, 0); PG8_STAGE(PG8_SA(1, 1), a1 + hstepA, voffA);
            PG8_WAIT_L(8); PG8_BAR; PG8_WAIT_L(0); PG8_MMA(0, 0, At, B0); PG8_BAR; PG8_SCHED;
            PG8_LDB(B1, 0, 1); PG8_STAGE(PG8_SB(0, 0), b2, voffB);
            PG8_BAR; PG8_WAIT_L(0); PG8_MMA(0, 1, At, B1); PG8_BAR;
            PG8_LDA(At, 0, 1); PG8_STAGE(PG8_SA(0, 0), a2, voffA);
            PG8_BAR; PG8_WAIT_L(0); PG8_MMA(1, 0, At, B0); PG8_BAR; PG8_SCHED;
            PG8_STAGE(PG8_SB(0, 1), b2 + hstep, voffB);
            PG8_WAIT_V(6); PG8_BAR; PG8_MMA(1, 1, At, B1); PG8_BAR;
            PG8_LDB(B0, 1, 0); PG8_SCHED; PG8_LDA(At, 1, 0); PG8_STAGE(PG8_SA(0, 1), a2 + hstepA, voffA);
            PG8_WAIT_L(8); PG8_BAR; PG8_WAIT_L(0); PG8_MMA(0, 0, At, B0); PG8_BAR; PG8_SCHED;
            PG8_LDB(B1, 1, 1); PG8_STAGE(PG8_SB(1, 0), b3, voffB);
            PG8_BAR; PG8_WAIT_L(0); PG8_MMA(0, 1, At, B1); PG8_BAR;
            PG8_LDA(At, 1, 1); PG8_STAGE(PG8_SA(1, 0), a3, voffA);
            PG8_BAR; PG8_WAIT_L(0); PG8_MMA(1, 0, At, B0); PG8_BAR; PG8_SCHED;
            PG8_STAGE(PG8_SB(1, 1), b3 + hstep, voffB);
            PG8_WAIT_V(6); PG8_BAR; PG8_MMA(1, 1, At, B1); PG8_BAR;
            }
        }
        if constexpr (ALIGN_EPI) { if (wr == 0) PG8_BAR; }
        if constexpr (!Epi::AFTER_DRAIN) { E(acc, cur, wr, wc, fr, fq); S.done(cur); }
        if (!has_next) break;
#pragma unroll
        for (int a = 0; a < 2; ++a)
#pragma unroll
            for (int b = 0; b < 2; ++b)
#pragma unroll
                for (int m = 0; m < 4; ++m)
#pragma unroll
                    for (int n = 0; n < 2; ++n) acc[a][b][m][n] = (f32x4){0.f, 0.f, 0.f, 0.f};
        cur = nxt; cA = nA; cB = nB; ++ui;
        if constexpr (ALIGN_EPI) { if (wr == 1) PG8_BAR; }
    }
    PG8_WAIT_V(0);
    if constexpr (!ALIGN_EPI) { if (wr == 0) PG8_BAR; }
    PG8_BAR;
    if constexpr (Epi::AFTER_DRAIN) { E.fused(acc, cur, wr, wc, fr, fq, lds, wid, lane); S.done(cur); }
#undef PG8_SA
#undef PG8_SB
#undef PG8_STAGE
#undef PG8_LDA
#undef PG8_LDB
#undef PG8_MMA
#undef PG8_WAIT_V
#undef PG8_WAIT_L
#undef PG8_BAR
#undef PG8_SCHED
}
}

using pg8::bf16_t; using pg8::bf16x8; using pg8::f32x4; using pg8::u32x4; using pg8::Unit;
#define LAS __attribute__((address_space(3)))
typedef float f32x2v __attribute__((ext_vector_type(2)));
typedef __bf16 bf16x2v __attribute__((ext_vector_type(2)));
typedef unsigned u32x2 __attribute__((ext_vector_type(2)));

constexpr int D = 1024, NBATCH = 8, SEQ = 4096;
constexpr int MREAL = NBATCH * SEQ;
constexpr int ROW_META = MREAL;
constexpr int ROW_SAMP = MREAL + 16;
constexpr int ROW_PAD = ROW_SAMP + 128;
constexpr int M = MREAL + 256;
constexpr int INW = 3840, FF = 2816, FF2 = 5632, PW = 512;
constexpr float RMS_EPS = 1e-6f;
constexpr int NPOS = 4112;

constexpr size_t MiB = 1u << 20;
constexpr size_t WS_ROPE = 1 * MiB, WS_SSQ1 = 3 * MiB, WS_SSQ2 = 6 * MiB;
constexpr size_t WS_WIN = 9 * MiB, WS_WAO = 17 * MiB, WS_WPO = 19 * MiB, WS_WOUT = 20 * MiB, WS_WUP = 22 * MiB, WS_WDOWN = 33 * MiB, WS_WGRP = 39 * MiB;
constexpr size_t WS_XN = 40 * MiB, WS_MIX = 105 * MiB  , WS_HALO = 40 * MiB, WS_UPT = 84 * MiB;
constexpr size_t WS_R0I = 64 * 1024;
constexpr size_t WS_Q = 105 * MiB, WS_K = 170 * MiB, WS_V = 179 * MiB, WS_P = 188 * MiB, WS_GA = 221 * MiB, WS_GP = 286 * MiB, WS_ATT = 351 * MiB, WS_POOL = 416 * MiB;
constexpr size_t WS_X1 = 105 * MiB, WS_XG = 234 * MiB, WS_ACT = 299 * MiB, WS_END = 477 * MiB;

constexpr int LDS_BYTES = 147456;

struct Params {
    const float *x_prompt, *x_sample, *cache_swa_k, *cache_swa_v, *cache_meta_k, *cache_meta_v, *state_pool, *state_conv, *meta_tokens, *g_norm_mix, *w_in, *b_gate, *sinks,
        *w_attn_o, *w_pool_grp, *pool_scale, *w_pool_o, *w_out, *g_norm_ffn, *w_up, *conv_w, *conv_b, *w_down, *g_norm_final;
    float* out; unsigned char* ws;
    float inv_freq[32];
    int ph_lo, ph_hi;
};
constexpr size_t O_YP = 0, O_YS = O_YP + (size_t)MREAL * D, O_PSK = O_YS + 128 * D, O_PSV = O_PSK + 131072, O_KM = O_PSV + 131072, O_VM = O_KM + 16384,
    O_PPOOL = O_VM + 16384, O_PCONV = O_PPOOL + 61440, O_SSK = O_PCONV + 90112, O_SSV = O_SSK + 16384, O_SPOOL = O_SSV + 16384, O_SCONV = O_SPOOL + 61440, O_END = O_SCONV + 90112;

__device__ __forceinline__ unsigned pk2(float lo, float hi) { f32x2v v = {lo, hi}; bf16x2v b = __builtin_convertvector(v, bf16x2v); return __builtin_bit_cast(unsigned, b); }
__device__ __forceinline__ float bf_lo(unsigned u) { return __uint_as_float(u << 16); }
__device__ __forceinline__ float bf_hi(unsigned u) { return __uint_as_float(u & 0xffff0000u); }
__device__ __forceinline__ float bf1(bf16_t h) { return __uint_as_float((unsigned)h << 16); }
__device__ __forceinline__ int row_pos(int r) {
    if (r < MREAL) return 16 + (r & 4095);
    if (r < ROW_SAMP) return r - ROW_META;
    if (r < ROW_PAD) return 16 + 1024 + ((r - ROW_SAMP) & 15);
    return 0;
}
__device__ __forceinline__ const float* row_x(const float* xp, const float* mt, const float* xs, int r) {
    if (r < MREAL) return xp + (size_t)r * D;
    if (r < ROW_SAMP) return mt + (size_t)(r - ROW_META) * D;
    if (r < ROW_PAD) return xs + (size_t)(r - ROW_SAMP) * D;
    return nullptr;
}
__device__ __forceinline__ float wave_sum(float v) {
#pragma unroll
    for (int o = 1; o < 64; o <<= 1) v += __shfl_xor(v, o);
    return v;
}
__device__ __forceinline__ float sigmoidf_(float x) { return __builtin_amdgcn_rcpf(1.0f + __builtin_amdgcn_exp2f(x * -1.4426950408889634f)); }

struct EpiZ {
    static constexpr bool PERM = true, AFTER_DRAIN = false, APERM = false;
    bf16_t *Q, *Kb, *Vb, *Pb, *GA, *GP; const float* b_gate; const float* rope;
    __device__ __forceinline__ void operator()(const f32x4 (&acc)[2][2][4][2], const Unit& u, int wr, int wc, int fr_in, int fq_in) const {
        int fr = fr_in, fq = fq_in; asm volatile("" : "+v"(fr), "+v"(fq));
        const int pn = u.pn, cw = wc * 32 + 8 * fq;
        if (pn < 4) {
#pragma unroll
            for (int ai = 0; ai < 2; ++ai) {
                f32x4 t[4][2][2];
#pragma unroll
                for (int m = 0; m < 4; ++m) {
                    const int row = u.pm * 256 + ai * 128 + wr * 64 + m * 16 + fr; const int pos = row_pos(row);
#pragma unroll
                    for (int bj = 0; bj < 2; ++bj) { const f32x4* tp = (const f32x4*)(rope + ((size_t)pos * 32 + (((bj * 128 + cw) & 63) >> 1)) * 2); t[m][bj][0] = tp[0]; t[m][bj][1] = tp[1]; }
                }
#pragma unroll
                for (int m = 0; m < 4; ++m) {
                    const int row = u.pm * 256 + ai * 128 + wr * 64 + m * 16 + fr;
#pragma unroll
                    for (int bj = 0; bj < 2; ++bj) {
                        const f32x4 v0 = acc[ai][bj][m][0], v1 = acc[ai][bj][m][1], t0 = t[m][bj][0], t1 = t[m][bj][1];
                        u32x4 w;
                        w.x = pk2(v0[0] * t0[0] - v0[1] * t0[1], v0[1] * t0[0] + v0[0] * t0[1]); w.y = pk2(v0[2] * t0[2] - v0[3] * t0[3], v0[3] * t0[2] + v0[2] * t0[3]);
                        w.z = pk2(v1[0] * t1[0] - v1[1] * t1[1], v1[1] * t1[0] + v1[0] * t1[1]); w.w = pk2(v1[2] * t1[2] - v1[3] * t1[3], v1[3] * t1[2] + v1[2] * t1[3]);
                        *(u32x4*)(Q + (size_t)row * 1024 + pn * 256 + bj * 128 + cw) = w;
                    }
                }
            }
        } else if (pn == 4) {
            f32x4 t[2][4][2];
#pragma unroll
            for (int ai = 0; ai < 2; ++ai)
#pragma unroll
                for (int m = 0; m < 4; ++m) {
                    const int row = u.pm * 256 + ai * 128 + wr * 64 + m * 16 + fr; const int pos = row_pos(row);
                    const f32x4* tp = (const f32x4*)(rope + ((size_t)pos * 32 + ((cw & 63) >> 1)) * 2); t[ai][m][0] = tp[0]; t[ai][m][1] = tp[1];
                }
#pragma unroll
            for (int ai = 0; ai < 2; ++ai)
#pragma unroll
                for (int m = 0; m < 4; ++m) {
                    const int row = u.pm * 256 + ai * 128 + wr * 64 + m * 16 + fr;
                    { const f32x4 v0 = acc[ai][0][m][0], v1 = acc[ai][0][m][1], t0 = t[ai][m][0], t1 = t[ai][m][1];
                      u32x4 w;
                      w.x = pk2(v0[0] * t0[0] - v0[1] * t0[1], v0[1] * t0[0] + v0[0] * t0[1]); w.y = pk2(v0[2] * t0[2] - v0[3] * t0[3], v0[3] * t0[2] + v0[2] * t0[3]);
                      w.z = pk2(v1[0] * t1[0] - v1[1] * t1[1], v1[1] * t1[0] + v1[0] * t1[1]); w.w = pk2(v1[2] * t1[2] - v1[3] * t1[3], v1[3] * t1[2] + v1[2] * t1[3]);
                      *(u32x4*)(Kb + (size_t)row * 128 + cw) = w; }
                    { const f32x4 v0 = acc[ai][1][m][0], v1 = acc[ai][1][m][1];
                      u32x4 w; w.x = pk2(v0[0], v0[1]); w.y = pk2(v0[2], v0[3]); w.z = pk2(v1[0], v1[1]); w.w = pk2(v1[2], v1[3]);
                      *(u32x4*)(Vb + (size_t)row * 128 + cw) = w; }
                }
        } else if (pn < 7) {
#pragma unroll
            for (int ai = 0; ai < 2; ++ai)
#pragma unroll
                for (int m = 0; m < 4; ++m) {
                    const int row = u.pm * 256 + ai * 128 + wr * 64 + m * 16 + fr;
#pragma unroll
                    for (int bj = 0; bj < 2; ++bj) {
                        const f32x4 v0 = acc[ai][bj][m][0], v1 = acc[ai][bj][m][1];
                        u32x4 w; w.x = pk2(v0[0], v0[1]); w.y = pk2(v0[2], v0[3]); w.z = pk2(v1[0], v1[1]); w.w = pk2(v1[2], v1[3]);
                        *(u32x4*)(Pb + (size_t)row * 512 + (pn - 5) * 256 + bj * 128 + cw) = w;
                    }
                }
        } else {
            const int gc = pn * 256 - 1792 + cw;
            f32x4 b[2][2];
#pragma unroll
            for (int bj = 0; bj < 2; ++bj) { b[bj][0] = *(const f32x4*)(b_gate + gc + bj * 128); b[bj][1] = *(const f32x4*)(b_gate + gc + bj * 128 + 4); }
            bf16_t* dstb = (pn < 11) ? GA + gc : GP + (gc - 1024);
#pragma unroll
            for (int ai = 0; ai < 2; ++ai)
#pragma unroll
                for (int m = 0; m < 4; ++m) {
                    const int row = u.pm * 256 + ai * 128 + wr * 64 + m * 16 + fr;
#pragma unroll
                    for (int bj = 0; bj < 2; ++bj) {
                        f32x4 v0 = acc[ai][bj][m][0] + b[bj][0], v1 = acc[ai][bj][m][1] + b[bj][1];
#pragma unroll
                        for (int i = 0; i < 4; ++i) { v0[i] = sigmoidf_(v0[i]); v1[i] = sigmoidf_(v1[i]); }
                        u32x4 w; w.x = pk2(v0[0], v0[1]); w.y = pk2(v0[2], v0[3]); w.z = pk2(v1[0], v1[1]); w.w = pk2(v1[2], v1[3]);
                        *(u32x4*)(dstb + (size_t)row * 1024 + bj * 128) = w;
                    }
                }
        }
    }
};
struct EpiT1 {
    static constexpr bool PERM = true, AFTER_DRAIN = false, APERM = false;
    const bf16_t* G; bf16_t* O;
    __device__ __forceinline__ void operator()(const f32x4 (&acc)[2][2][4][2], const Unit& u, int wr, int wc, int fr_in, int fq_in) const {
        int fr = fr_in, fq = fq_in; asm volatile("" : "+v"(fr), "+v"(fq));
        const size_t base = (size_t)(u.pm * 256 + wr * 64 + fr) * 1024 + u.pn * 256 + wc * 32 + 8 * fq;
        u32x4 g[2][4][2];
#pragma unroll
        for (int ai = 0; ai < 2; ++ai)
#pragma unroll
            for (int m = 0; m < 4; ++m)
#pragma unroll
                for (int bj = 0; bj < 2; ++bj) g[ai][m][bj] = __builtin_nontemporal_load((const u32x4*)(G + base + (size_t)(ai * 128 + m * 16) * 1024 + bj * 128));
#pragma unroll
        for (int ai = 0; ai < 2; ++ai)
#pragma unroll
            for (int m = 0; m < 4; ++m)
#pragma unroll
                for (int bj = 0; bj < 2; ++bj) {
                    const u32x4 gg = g[ai][m][bj]; const f32x4 v0 = acc[ai][bj][m][0], v1 = acc[ai][bj][m][1];
                    u32x4 w; w.x = pk2(v0[0] * bf_lo(gg.x), v0[1] * bf_hi(gg.x)); w.y = pk2(v0[2] * bf_lo(gg.y), v0[3] * bf_hi(gg.y));
                    w.z = pk2(v1[0] * bf_lo(gg.z), v1[1] * bf_hi(gg.z)); w.w = pk2(v1[2] * bf_lo(gg.w), v1[3] * bf_hi(gg.w));
                    *(u32x4*)(O + base + (size_t)(ai * 128 + m * 16) * 1024 + bj * 128) = w;
                }
    }
};
struct EpiMix {
    static constexpr bool PERM = true, AFTER_DRAIN = false, APERM = false;
    const bf16_t* G; bf16_t* O;
    __device__ __forceinline__ void operator()(const f32x4 (&acc)[2][2][4][2], const Unit& u, int wr, int wc, int fr_in, int fq_in) const {
        int fr = fr_in, fq = fq_in; asm volatile("" : "+v"(fr), "+v"(fq));
        const size_t base = (size_t)(u.pm * 256 + wr * 64 + fr) * 1024 + u.pn * 256 + wc * 32 + 8 * fq;
#pragma unroll
        for (int ai = 0; ai < 2; ++ai) {
            u32x4 g[4][2], t[4][2];
#pragma unroll
            for (int m = 0; m < 4; ++m)
#pragma unroll
                for (int bj = 0; bj < 2; ++bj) { g[m][bj] = __builtin_nontemporal_load((const u32x4*)(G + base + (size_t)(ai * 128 + m * 16) * 1024 + bj * 128)); t[m][bj] = *(const u32x4*)(O + base + (size_t)(ai * 128 + m * 16) * 1024 + bj * 128); }
#pragma unroll
            for (int m = 0; m < 4; ++m)
#pragma unroll
                for (int bj = 0; bj < 2; ++bj) {
                    const u32x4 gg = g[m][bj], tt = t[m][bj]; const f32x4 v0 = acc[ai][bj][m][0], v1 = acc[ai][bj][m][1];
                    u32x4 w; w.x = pk2(bf_lo(tt.x) + v0[0] * bf_lo(gg.x), bf_hi(tt.x) + v0[1] * bf_hi(gg.x)); w.y = pk2(bf_lo(tt.y) + v0[2] * bf_lo(gg.y), bf_hi(tt.y) + v0[3] * bf_hi(gg.y));
                    w.z = pk2(bf_lo(tt.z) + v1[0] * bf_lo(gg.z), bf_hi(tt.z) + v1[1] * bf_hi(gg.z)); w.w = pk2(bf_lo(tt.w) + v1[2] * bf_lo(gg.w), bf_hi(tt.w) + v1[3] * bf_hi(gg.w));
                    *(u32x4*)(O + base + (size_t)(ai * 128 + m * 16) * 1024 + bj * 128) = w;
                }
        }
    }
};
struct EpiX1 {
    static constexpr bool PERM = true, AFTER_DRAIN = false, APERM = false;
    const bf16_t* XN; const float *r0i, *gmix, *gffn; bf16_t* XG; float* ssq;
    __device__ __forceinline__ void operator()(const f32x4 (&acc)[2][2][4][2], const Unit& u, int wr, int wc, int fr_in, int fq_in) const {
        int fr = fr_in, fq = fq_in; asm volatile("" : "+v"(fr), "+v"(fq));
        const int col0 = u.pn * 256 + wc * 32 + 8 * fq;
        f32x4 g[2][2], ig[2][2];
#pragma unroll
        for (int bj = 0; bj < 2; ++bj)
#pragma unroll
            for (int hh = 0; hh < 2; ++hh) { g[bj][hh] = *(const f32x4*)(gffn + col0 + bj * 128 + 4 * hh); const f32x4 gm = *(const f32x4*)(gmix + col0 + bj * 128 + 4 * hh);
#pragma unroll
                for (int i = 0; i < 4; ++i) ig[bj][hh][i] = __builtin_amdgcn_rcpf(gm[i]); }
#pragma unroll
        for (int ai = 0; ai < 2; ++ai) {
            u32x4 xn[4][2]; float ri[4];
#pragma unroll
            for (int m = 0; m < 4; ++m) {
                const int row = u.pm * 256 + ai * 128 + wr * 64 + m * 16 + fr;
                ri[m] = r0i[row];
#pragma unroll
                for (int bj = 0; bj < 2; ++bj) xn[m][bj] = *(const u32x4*)(XN + (size_t)row * 1024 + col0 + bj * 128);
            }
#pragma unroll
            for (int m = 0; m < 4; ++m) {
                const int row = u.pm * 256 + ai * 128 + wr * 64 + m * 16 + fr;
                const float rr = ri[m];
                float ss = 0.f;
#pragma unroll
                for (int bj = 0; bj < 2; ++bj) {
                    const u32x4 q = xn[m][bj];
                    f32x4 x0, x1;
                    x0[0] = bf_lo(q.x) * rr * ig[bj][0][0]; x0[1] = bf_hi(q.x) * rr * ig[bj][0][1]; x0[2] = bf_lo(q.y) * rr * ig[bj][0][2]; x0[3] = bf_hi(q.y) * rr * ig[bj][0][3];
                    x1[0] = bf_lo(q.z) * rr * ig[bj][1][0]; x1[1] = bf_hi(q.z) * rr * ig[bj][1][1]; x1[2] = bf_lo(q.w) * rr * ig[bj][1][2]; x1[3] = bf_hi(q.w) * rr * ig[bj][1][3];
                    const f32x4 v0 = acc[ai][bj][m][0] + x0, v1 = acc[ai][bj][m][1] + x1, g0 = g[bj][0], g1 = g[bj][1];
                    u32x4 w; w.x = pk2(v0[0] * g0[0], v0[1] * g0[1]); w.y = pk2(v0[2] * g0[2], v0[3] * g0[3]); w.z = pk2(v1[0] * g1[0], v1[1] * g1[1]); w.w = pk2(v1[2] * g1[2], v1[3] * g1[3]);
                    *(u32x4*)(XG + (size_t)row * 1024 + col0 + bj * 128) = w;
                    ss += (v0[0] * v0[0] + v0[1] * v0[1]) + (v0[2] * v0[2] + v0[3] * v0[3]) + (v1[0] * v1[0] + v1[1] * v1[1]) + (v1[2] * v1[2] + v1[3] * v1[3]);
                }
                ss += __shfl_xor(ss, 16); ss += __shfl_xor(ss, 32);
                if (fq == 0) ssq[(size_t)row * 16 + u.pn * 4 + wc] = ss;
            }
        }
    }
};
__device__ __forceinline__ float ror1(float x) { return __builtin_bit_cast(float, __builtin_amdgcn_mov_dpp(__builtin_bit_cast(int, x), 0x121, 0xf, 0xf, false)); }
__device__ __forceinline__ float ror2(float x) { return __builtin_bit_cast(float, __builtin_amdgcn_mov_dpp(__builtin_bit_cast(int, x), 0x122, 0xf, 0xf, false)); }
__device__ __forceinline__ float shr1(float old, float x) { return __builtin_bit_cast(float, __builtin_amdgcn_update_dpp(__builtin_bit_cast(int, old), __builtin_bit_cast(int, x), 0x111, 0xf, 0xf, false)); }
__device__ __forceinline__ float shr2(float old, float x) { return __builtin_bit_cast(float, __builtin_amdgcn_update_dpp(__builtin_bit_cast(int, old), __builtin_bit_cast(int, x), 0x112, 0xf, 0xf, false)); }
struct EpiUp {
    static constexpr bool PERM = true, AFTER_DRAIN = false, APERM = true;
    const float *ssq, *cw, *cb; bf16_t* ACT; float* HALO; float* UPT;
    __device__ __forceinline__ void operator()(const f32x4 (&acc)[2][2][4][2], const Unit& u, int wr, int wc, int fr_in, int fq_in) const {
        int fr = fr_in, fq = fq_in; asm volatile("" : "+v"(fr), "+v"(fq));
        const int jb = u.pn * 128 + wc * 32 + 8 * fq;
        const int row0 = u.pm * 256 + wr * 128 + fr;
        float r1[2][4];
#pragma unroll
        for (int ai = 0; ai < 2; ++ai)
#pragma unroll
            for (int m = 0; m < 4; ++m) {
                const f32x4* sp = (const f32x4*)(ssq + (size_t)(row0 + ai * 64 + m * 16) * 16);
                const f32x4 a = sp[0], b = sp[1], c = sp[2], d = sp[3];
                const float s = ((a[0] + a[1]) + (a[2] + a[3])) + ((b[0] + b[1]) + (b[2] + b[3])) + ((c[0] + c[1]) + (c[2] + c[3])) + ((d[0] + d[1]) + (d[2] + d[3]));
                r1[ai][m] = rsqrtf(s * (1.0f / 1024.0f) + RMS_EPS);
            }
#pragma unroll
        for (int ai = 0; ai < 2; ++ai)
#pragma unroll
            for (int m = 0; m < 4; ++m) asm volatile("" : "+v"(r1[ai][m]));
        __builtin_amdgcn_sched_barrier(0);
        const int slab = u.pm * 2 + wr;
#pragma unroll
        for (int n = 0; n < 2; ++n) {
            int jg = jb + 4 * n; asm volatile("" : "+v"(jg) :: "memory");
            const f32x4 w0g = *(const f32x4*)(cw + jg), w1g = *(const f32x4*)(cw + FF2 + jg), w2g = *(const f32x4*)(cw + 2 * FF2 + jg), bg = *(const f32x4*)(cb + jg);
            const f32x4 w0v = *(const f32x4*)(cw + FF + jg), w1v = *(const f32x4*)(cw + FF2 + FF + jg), w2v = *(const f32x4*)(cw + 2 * FF2 + FF + jg), bv = *(const f32x4*)(cb + FF + jg);
            f32x4 pg = {0.f, 0.f, 0.f, 0.f}, pv = {0.f, 0.f, 0.f, 0.f};
#pragma unroll
            for (int ai = 0; ai < 2; ++ai) {
#pragma unroll
                for (int m = 0; m < 4; ++m) {
                    const int row = row0 + ai * 64 + m * 16;
                    const f32x4 ug = acc[ai][0][m][n] * r1[ai][m], uv = acc[ai][1][m][n] * r1[ai][m];
                    const bool first = (ai == 0 && m == 0), last = (ai == 1 && m == 3);
                    if (first && fr < 2) { *(f32x4*)(HALO + (size_t)(slab * 4 + fr) * FF2 + jg) = ug; *(f32x4*)(HALO + (size_t)(slab * 4 + fr) * FF2 + FF + jg) = uv; }
                    if (last && fr >= 14) { *(f32x4*)(HALO + (size_t)(slab * 4 + fr - 12) * FF2 + jg) = ug; *(f32x4*)(HALO + (size_t)(slab * 4 + fr - 12) * FF2 + FF + jg) = uv; }
                    f32x4 g1, g2, v1, v2;
#pragma unroll
                    for (int i = 0; i < 4; ++i) {
                        g1[i] = shr1(ror1(pg[i]), ug[i]); g2[i] = shr2(ror2(pg[i]), ug[i]);
                        v1[i] = shr1(ror1(pv[i]), uv[i]); v2[i] = shr2(ror2(pv[i]), uv[i]);
                    }
                    const f32x4 cg = bg + w0g * g2 + w1g * g1 + w2g * ug;
                    const f32x4 cv = bv + w0v * v2 + w1v * v1 + w2v * uv;
                    float a[4];
#pragma unroll
                    for (int i = 0; i < 4; ++i) a[i] = cg[i] * sigmoidf_(cg[i]) * cv[i];
                    if (!(first && fr < 2)) { u32x2 w; w.x = pk2(a[0], a[1]); w.y = pk2(a[2], a[3]); *(u32x2*)(ACT + (size_t)row * FF + jg) = w; }
                    pg = ug; pv = uv;
                }
            }
        }
    }
};
constexpr size_t WS_PCNT = 8 * MiB + 768 * 1024;
#define AG_LD(p) __hip_atomic_load((p), __ATOMIC_RELAXED, __HIP_MEMORY_SCOPE_AGENT)
#define AG_ST(p, v) __hip_atomic_store((p), (v), __ATOMIC_RELAXED, __HIP_MEMORY_SCOPE_AGENT)
struct EpiDown {
    static constexpr bool PERM = true, AFTER_DRAIN = false, APERM = false;
    const bf16_t* XG; const float* gffn; const float* gfin; float* out; float* ssq;
    __device__ __forceinline__ void operator()(const f32x4 (&acc_c)[2][2][4][2], const Unit& u, int wr, int wc, int fr_in, int fq_in) const {
        int fr = fr_in, fq = fq_in; asm volatile("" : "+v"(fr), "+v"(fq));
        f32x4 (&acc)[2][2][4][2] = const_cast<f32x4 (&)[2][2][4][2]>(acc_c);
        const int col0 = u.pn * 256 + wc * 32 + 8 * fq;
        f32x4 ig[2][2];
#pragma unroll
        for (int bj = 0; bj < 2; ++bj)
#pragma unroll
            for (int hh = 0; hh < 2; ++hh) { const f32x4 gg = *(const f32x4*)(gffn + col0 + bj * 128 + 4 * hh);
#pragma unroll
                for (int i = 0; i < 4; ++i) ig[bj][hh][i] = __builtin_amdgcn_rcpf(gg[i]); }
#pragma unroll
        for (int ai = 0; ai < 2; ++ai) {
            u32x4 xgv[4][2];
#pragma unroll
            for (int m = 0; m < 4; ++m)
#pragma unroll
                for (int bj = 0; bj < 2; ++bj) xgv[m][bj] = __builtin_nontemporal_load((const u32x4*)(XG + (size_t)(u.pm * 256 + ai * 128 + wr * 64 + m * 16 + fr) * 1024 + col0 + bj * 128));
#pragma unroll
            for (int m = 0; m < 4; ++m) {
                const int row = u.pm * 256 + ai * 128 + wr * 64 + m * 16 + fr;
                float ss = 0.f;
#pragma unroll
                for (int bj = 0; bj < 2; ++bj) {
                    const u32x4 xg = xgv[m][bj];
                    f32x4 x0, x1;
                    x0[0] = bf_lo(xg.x) * ig[bj][0][0]; x0[1] = bf_hi(xg.x) * ig[bj][0][1]; x0[2] = bf_lo(xg.y) * ig[bj][0][2]; x0[3] = bf_hi(xg.y) * ig[bj][0][3];
                    x1[0] = bf_lo(xg.z) * ig[bj][1][0]; x1[1] = bf_hi(xg.z) * ig[bj][1][1]; x1[2] = bf_lo(xg.w) * ig[bj][1][2]; x1[3] = bf_hi(xg.w) * ig[bj][1][3];
                    const f32x4 v0 = acc[ai][bj][m][0] + x0, v1 = acc[ai][bj][m][1] + x1;
                    acc[ai][bj][m][0] = v0; acc[ai][bj][m][1] = v1;
                    ss += (v0[0] * v0[0] + v0[1] * v0[1]) + (v0[2] * v0[2] + v0[3] * v0[3]) + (v1[0] * v1[0] + v1[1] * v1[1]) + (v1[2] * v1[2] + v1[3] * v1[3]);
                }
                ss += __shfl_xor(ss, 16); ss += __shfl_xor(ss, 32);
                if (fq == 0) AG_ST(ssq + (size_t)row * 16 + u.pn * 4 + wc, ss);
            }
        }
        asm volatile("s_waitcnt vmcnt(0)" ::: "memory");
        unsigned* pc = (unsigned*)((char*)ssq + (WS_PCNT - WS_SSQ2)) + 64 * u.pm;
        if (fr == 0 && fq == 0) __hip_atomic_fetch_add(pc, 1u, __ATOMIC_RELAXED, __HIP_MEMORY_SCOPE_AGENT);
        for (int tries = 0; tries < (1 << 18); ++tries) {
            const unsigned c = (unsigned)__builtin_amdgcn_readfirstlane((int)AG_LD(pc));
            if (c >= 32u) break;
            __builtin_amdgcn_s_sleep(2);
        }
        float rs[2][4];
        {
            float* spb = ssq + (size_t)(u.pm * 256 + wr * 64 + fr) * 16 + 4 * fq;
#pragma unroll
            for (int ai = 0; ai < 2; ++ai)
#pragma unroll
                for (int m = 0; m < 4; ++m) {
                    float* sp = spb + (ai * 128 + m * 16) * 16;
                    const float a = AG_LD(sp), b = AG_LD(sp + 1), c = AG_LD(sp + 2), d = AG_LD(sp + 3);
                    rs[ai][m] = (a + b) + (c + d);
                }
        }
#pragma unroll
        for (int ai = 0; ai < 2; ++ai)
#pragma unroll
            for (int m = 0; m < 4; ++m) {
                const int row = u.pm * 256 + ai * 128 + wr * 64 + m * 16 + fr;
                float s = rs[ai][m]; s += __shfl_xor(s, 16); s += __shfl_xor(s, 32);
                const float r = rsqrtf(s * (1.0f / 1024.0f) + RMS_EPS);
                float* orow = out + O_YP + (size_t)row * D;
#pragma unroll
                for (int bj = 0; bj < 2; ++bj) {
                    const int col = u.pn * 256 + bj * 128 + wc * 32 + 8 * fq;
                    const f32x4 g0 = *(const f32x4*)(gfin + col), g1 = *(const f32x4*)(gfin + col + 4);
                    *(f32x4*)(orow + col) = acc[ai][bj][m][0] * r * g0; *(f32x4*)(orow + col + 4) = acc[ai][bj][m][1] * r * g1;
                }
            }
    }
};

struct MapId { __device__ __forceinline__ int operator()(int n) const { return n; } };
struct MapIn { __device__ __forceinline__ int operator()(int n) const { return n < 1152 ? ((n & ~63) + 2 * (n & 31) + ((n >> 5) & 1)) : n; } };
struct MapUp { __device__ __forceinline__ int operator()(int n) const { if (n < FF) return 256 * (n >> 7) + (n & 127); const int m = n - FF; return 256 * (m >> 7) + 128 + (m & 127); } };
template <class Map>
__device__ __forceinline__ void p0_transpose_item(const float* W, int K, int N, bf16_t* WT, LAS float* scr, int item, int lane, Map map) {
    const int nblk = N / 32, kb = item / nblk, nb = item % nblk, k0 = 64 * kb, n0 = 32 * nb;
#pragma unroll 8
    for (int i = 0; i < 32; ++i) { const int kk = 2 * i + (lane >> 5); scr[kk * 33 + (lane & 31)] = __builtin_nontemporal_load(W + (size_t)(k0 + kk) * N + n0 + (lane & 31)); }
    asm volatile("s_waitcnt lgkmcnt(0)" ::: "memory");
    const int c = lane & 7;
#pragma unroll
    for (int j = 0; j < 4; ++j) { const int n = (lane >> 3) + 8 * j; const LAS float* s = scr + (8 * c) * 33 + n;
        u32x4 o; o.x = pk2(s[0 * 33], s[1 * 33]); o.y = pk2(s[2 * 33], s[3 * 33]); o.z = pk2(s[4 * 33], s[5 * 33]); o.w = pk2(s[6 * 33], s[7 * 33]);
        *(u32x4*)(WT + (size_t)map(n0 + n) * K + k0 + 8 * c) = o; }
    asm volatile("s_waitcnt lgkmcnt(0)" ::: "memory");
}
__device__ __forceinline__ void p0_prologue(const Params& p, LAS unsigned char* lds, int wave, int lane) {
    unsigned char* ws = p.ws;
    if (wave < 4) {
        bf16_t* XN = (bf16_t*)(ws + WS_XN);
        const int gw = blockIdx.x * 4 + wave, NGW = gridDim.x * 4;
        f32x4 gv[4];
#pragma unroll
        for (int j = 0; j < 4; ++j) gv[j] = ((const f32x4*)p.g_norm_mix)[lane + 64 * j];
        for (int m0 = gw * 4; m0 < M; m0 += NGW * 4) {
            f32x4 v[4][4]; const float* xr[4];
#pragma unroll
            for (int q = 0; q < 4; ++q) {
                xr[q] = row_x(p.x_prompt, p.meta_tokens, p.x_sample, m0 + q);
#pragma unroll
                for (int j = 0; j < 4; ++j) v[q][j] = xr[q] ? __builtin_nontemporal_load((const f32x4*)xr[q] + lane + 64 * j) : (f32x4){0.f, 0.f, 0.f, 0.f};
            }
#pragma unroll
            for (int q = 0; q < 4; ++q) {
                float s = 0.f;
#pragma unroll
                for (int j = 0; j < 4; ++j) s += (v[q][j][0] * v[q][j][0] + v[q][j][1] * v[q][j][1]) + (v[q][j][2] * v[q][j][2] + v[q][j][3] * v[q][j][3]);
                const float ms = wave_sum(s) * (1.0f / D) + RMS_EPS;
                const float r = rsqrtf(ms);
                if (lane == 0) ((float*)(ws + WS_R0I))[m0 + q] = sqrtf(ms);
                unsigned long long* o8 = (unsigned long long*)(XN + (size_t)(m0 + q) * D) + lane;
#pragma unroll
                for (int j = 0; j < 4; ++j) { const f32x4 w = v[q][j] * r * gv[j]; o8[64 * j] = (unsigned long long)pk2(w[0], w[1]) | ((unsigned long long)pk2(w[2], w[3]) << 32); }
            }
        }
        return;
    }
    LAS float* scr = (LAS float*)(lds + wave * 16384);
    const int gw = blockIdx.x * 4 + (wave - 4), NGW = gridDim.x * 4;
    const int gt = blockIdx.x * 256 + (int)threadIdx.x - 256, NT = gridDim.x * 256;
    constexpr int I_IN = 16 * (INW / 32), I_AO = 16 * 32, I_OUT = 16 * 32, I_UP = 16 * (FF2 / 32), I_DN = (FF / 64) * 32;
    constexpr int NITEMS = I_IN + I_AO + I_OUT + I_UP + I_DN;
    for (int it = gw; it < NITEMS; it += NGW) {
        int r = it;
        if (r < I_IN) { p0_transpose_item(p.w_in, D, INW, (bf16_t*)(ws + WS_WIN), scr, r, lane, MapIn()); continue; } r -= I_IN;
        if (r < I_AO) { p0_transpose_item(p.w_attn_o, D, D, (bf16_t*)(ws + WS_WAO), scr, r, lane, MapId()); continue; } r -= I_AO;
        if (r < I_OUT) { p0_transpose_item(p.w_out, D, D, (bf16_t*)(ws + WS_WOUT), scr, r, lane, MapId()); continue; } r -= I_OUT;
        if (r < I_UP) { p0_transpose_item(p.w_up, D, FF2, (bf16_t*)(ws + WS_WUP), scr, r, lane, MapUp()); continue; } r -= I_UP;
        p0_transpose_item(p.w_down, FF, D, (bf16_t*)(ws + WS_WDOWN), scr, r, lane, MapId());
    }
    {
        bf16_t* WP = (bf16_t*)(ws + WS_WPO);
        for (int idx = gt; idx < 1024 * 128; idx += NT) {
            const int n = idx & 1023, k0 = (idx >> 10) * 4, g = k0 >> 7;
            const float* wg = p.w_pool_grp + (size_t)k0 * 128;
            const float* sc = p.pool_scale + g * 128;
            const float* wo = p.w_pool_o + (size_t)(g * 128) * 1024 + n;
            float a[4] = {0.f, 0.f, 0.f, 0.f};
#pragma unroll 2
            for (int d = 0; d < 128; d += 4) {
                const f32x4 s4 = *(const f32x4*)(sc + d);
                float wv[4];
#pragma unroll
                for (int e = 0; e < 4; ++e) wv[e] = wo[(size_t)(d + e) * 1024] * s4[e];
#pragma unroll
                for (int j = 0; j < 4; ++j) { const f32x4 w4 = *(const f32x4*)(wg + j * 128 + d); a[j] += (w4[0] * wv[0] + w4[1] * wv[1]) + (w4[2] * wv[2] + w4[3] * wv[3]); }
            }
            u32x2 o; o.x = pk2(a[0], a[1]); o.y = pk2(a[2], a[3]);
            *(u32x2*)(WP + (size_t)n * 512 + k0) = o;
        }
    }
    float* rope = (float*)(ws + WS_ROPE);
    for (int i = gt; i < NPOS * 32; i += NT) {
        const int pos = i >> 5, d = i & 31;
        const float ang = (float)pos * p.inv_freq[d];
        const double rev = (double)ang * 0.15915494309189535;
        const float fr = (float)(rev - floor(rev));
        rope[2 * i] = __builtin_amdgcn_cosf(fr); rope[2 * i + 1] = __builtin_amdgcn_sinf(fr);
    }
}

constexpr int KS_PITCH = 144, VT_PITCH = 464, ATT_VT_OFF = 208 * KS_PITCH;
constexpr float LOG2E = 1.4426950408889634f, C2 = 0.125f * 1.4426950408889634f;

template <int NQ>
__device__ __forceinline__ void attn_load_q(bf16x8 (&qf)[NQ][2], const bf16_t* Qb, int qrow0, int h, int lane) {
    const int fr = lane & 15, fq = lane >> 4;
#pragma unroll
    for (int qb = 0; qb < NQ; ++qb)
#pragma unroll
        for (int ks = 0; ks < 2; ++ks) qf[qb][ks] = __builtin_nontemporal_load((const bf16x8*)(Qb + (size_t)(qrow0 + 16 * qb + fr) * 1024 + h * 64 + 32 * ks + 8 * fq));
}
template <int NQ>
__device__ __forceinline__ void attn_compute(LAS unsigned char* lds, const bf16x8 (&qf)[NQ][2], bf16_t* ATT, int qrow0, int h, unsigned vmask, float sink2, int lane) {
    const int fr = lane & 15, fq = lane >> 4;
    f32x4 s[NQ][13];
    const LAS unsigned char* kp = lds + fr * KS_PITCH + fq * 16;
    bf16x8 kc0 = *(const LAS bf16x8*)kp, kc1 = *(const LAS bf16x8*)(kp + 64);
#pragma unroll
    for (int kb = 0; kb < 13; ++kb) {
        bf16x8 kn0 = kc0, kn1 = kc1;
        if (kb < 12) { kn0 = *(const LAS bf16x8*)(kp + (kb + 1) * 16 * KS_PITCH); kn1 = *(const LAS bf16x8*)(kp + (kb + 1) * 16 * KS_PITCH + 64); }
#pragma unroll
        for (int qb = 0; qb < NQ; ++qb) {
            f32x4 a = {0.f, 0.f, 0.f, 0.f};
            a = __builtin_amdgcn_mfma_f32_16x16x32_bf16(kc0, qf[qb][0], a, 0, 0, 0);
            a = __builtin_amdgcn_mfma_f32_16x16x32_bf16(kc1, qf[qb][1], a, 0, 0, 0);
            s[qb][kb] = a;
        }
        kc0 = kn0; kc1 = kn1;
        __builtin_amdgcn_sched_barrier(0);
    }
    float rl[NQ];
#pragma unroll
    for (int qb = 0; qb < NQ; ++qb) {
        float mr = -1e30f;
#pragma unroll
        for (int kb = 0; kb < 13; ++kb) {
            if (vmask != 0x1fffu) {
                const bool valid = (vmask >> kb) & 1u;
#pragma unroll
                for (int i = 0; i < 4; ++i) s[qb][kb][i] = valid ? s[qb][kb][i] : -1e30f;
            }
            mr = fmaxf(mr, fmaxf(fmaxf(s[qb][kb][0], s[qb][kb][1]), fmaxf(s[qb][kb][2], s[qb][kb][3])));
        }
        mr = fmaxf(mr, __shfl_xor(mr, 16)); mr = fmaxf(mr, __shfl_xor(mr, 32));
        const float mx = fmaxf(mr * C2, sink2), nmx = -mx;
        float l = 0.f;
#pragma unroll
        for (int kb = 0; kb < 13; ++kb)
#pragma unroll
            for (int i = 0; i < 4; ++i) { const float pv = __builtin_amdgcn_exp2f(fmaf(s[qb][kb][i], C2, nmx)); s[qb][kb][i] = pv; l += pv; }
        l += __shfl_xor(l, 16); l += __shfl_xor(l, 32);
        l += __builtin_amdgcn_exp2f(sink2 - mx);
        rl[qb] = __builtin_amdgcn_rcpf(l);
    }
    f32x4 o[NQ][4];
#pragma unroll
    for (int qb = 0; qb < NQ; ++qb)
#pragma unroll
        for (int db = 0; db < 4; ++db) o[qb][db] = (f32x4){0.f, 0.f, 0.f, 0.f};
    const LAS unsigned char* vp = lds + ATT_VT_OFF + fr * VT_PITCH + fq * 8;
    u32x2 vlo[4], vhi[4];
#pragma unroll
    for (int db = 0; db < 4; ++db) { vlo[db] = *(const LAS u32x2*)(vp + db * 16 * VT_PITCH); vhi[db] = *(const LAS u32x2*)(vp + db * 16 * VT_PITCH + 32); }
#pragma unroll
    for (int kk = 0; kk < 7; ++kk) {
        u32x2 nlo[4], nhi[4];
#pragma unroll
        for (int db = 0; db < 4; ++db) { nlo[db] = vlo[db]; nhi[db] = vhi[db]; }
        if (kk < 6) {
#pragma unroll
            for (int db = 0; db < 4; ++db) { nlo[db] = *(const LAS u32x2*)(vp + db * 16 * VT_PITCH + (kk + 1) * 64); nhi[db] = *(const LAS u32x2*)(vp + db * 16 * VT_PITCH + (kk + 1) * 64 + 32); }
        }
        bf16x8 pf[NQ];
#pragma unroll
        for (int qb = 0; qb < NQ; ++qb) {
            u32x4 w;
            w.x = pk2(s[qb][2 * kk][0], s[qb][2 * kk][1]); w.y = pk2(s[qb][2 * kk][2], s[qb][2 * kk][3]);
            if (2 * kk + 1 < 13) { w.z = pk2(s[qb][(2 * kk + 1) % 13][0], s[qb][(2 * kk + 1) % 13][1]); w.w = pk2(s[qb][(2 * kk + 1) % 13][2], s[qb][(2 * kk + 1) % 13][3]); }
            else { w.z = 0u; w.w = 0u; }
            pf[qb] = __builtin_bit_cast(bf16x8, w);
        }
#pragma unroll
        for (int db = 0; db < 4; ++db) {
            u32x4 vv; vv.x = vlo[db].x; vv.y = vlo[db].y; vv.z = vhi[db].x; vv.w = vhi[db].y;
            const bf16x8 vf = __builtin_bit_cast(bf16x8, vv);
#pragma unroll
            for (int qb = 0; qb < NQ; ++qb) o[qb][db] = __builtin_amdgcn_mfma_f32_16x16x32_bf16(vf, pf[qb], o[qb][db], 0, 0, 0);
        }
#pragma unroll
        for (int db = 0; db < 4; ++db) { vlo[db] = nlo[db]; vhi[db] = nhi[db]; }
        __builtin_amdgcn_sched_barrier(0);
    }
#pragma unroll
    for (int qb = 0; qb < NQ; ++qb)
#pragma unroll
        for (int db = 0; db < 4; ++db) {
            const f32x4 v = o[qb][db] * rl[qb];
            u32x2 w; w.x = pk2(v[0], v[1]); w.y = pk2(v[2], v[3]);
            *(u32x2*)(ATT + (size_t)(qrow0 + 16 * qb + fr) * 1024 + h * 64 + 16 * db + 4 * fq) = w;
        }
}
__device__ __forceinline__ void attn_zero_pad(LAS unsigned char* lds, int tid) {
    if (tid < 128) { const int row = tid >> 1, half = tid & 1; *(LAS u32x4*)(lds + ATT_VT_OFF + row * VT_PITCH + 416 + half * 16) = (u32x4){0u, 0u, 0u, 0u}; }
}
__device__ __forceinline__ void attn_fill_bf16(LAS unsigned char* lds, const bf16_t* Kb, const bf16_t* Vb, int srow, int n, int kk, int ch) {
    u32x4 kv = {0u, 0u, 0u, 0u}, vv = {0u, 0u, 0u, 0u};
    if (srow >= 0) { kv = *(const u32x4*)(Kb + (size_t)srow * 128 + n * 64 + ch * 8); vv = *(const u32x4*)(Vb + (size_t)srow * 128 + n * 64 + ch * 8); }
    *(LAS u32x4*)(lds + kk * KS_PITCH + ch * 16) = kv;
    LAS unsigned short* vt = (LAS unsigned short*)(lds + ATT_VT_OFF + (ch * 8) * VT_PITCH + kk * 2);
    vt[0 * (VT_PITCH / 2)] = (unsigned short)(vv.x & 0xffffu); vt[1 * (VT_PITCH / 2)] = (unsigned short)(vv.x >> 16);
    vt[2 * (VT_PITCH / 2)] = (unsigned short)(vv.y & 0xffffu); vt[3 * (VT_PITCH / 2)] = (unsigned short)(vv.y >> 16);
    vt[4 * (VT_PITCH / 2)] = (unsigned short)(vv.z & 0xffffu); vt[5 * (VT_PITCH / 2)] = (unsigned short)(vv.z >> 16);
    vt[6 * (VT_PITCH / 2)] = (unsigned short)(vv.w & 0xffffu); vt[7 * (VT_PITCH / 2)] = (unsigned short)(vv.w >> 16);
}
__device__ __forceinline__ void attn_fill_f32(LAS unsigned char* lds, const float* ksrc, const float* vsrc, int kk, int ch) {
    const f32x4 k0 = *(const f32x4*)(ksrc + ch * 8), k1 = *(const f32x4*)(ksrc + ch * 8 + 4);
    const f32x4 v0 = *(const f32x4*)(vsrc + ch * 8), v1 = *(const f32x4*)(vsrc + ch * 8 + 4);
    LAS unsigned short* kr = (LAS unsigned short*)(lds + kk * KS_PITCH);
    LAS unsigned short* vt = (LAS unsigned short*)(lds + ATT_VT_OFF + (ch * 8) * VT_PITCH + kk * 2);
#pragma unroll
    for (int e = 0; e < 8; ++e) {
        const int d = ch * 8 + e;
        const float kvv = e < 4 ? k0[e & 3] : k1[e & 3], vvv = e < 4 ? v0[e & 3] : v1[e & 3];
        kr[2 * (d & 31) + (d >> 5)] = (unsigned short)(pk2(kvv, 0.f) & 0xffffu);
        vt[e * (VT_PITCH / 2)] = (unsigned short)(pk2(vvv, 0.f) & 0xffffu);
    }
}
__device__ __forceinline__ void attn_chunk_unit(const Params& p, LAS unsigned char* lds, int unit, int tid, int wave, int lane) {
    unsigned char* ws = p.ws;
    const bf16_t *Qb = (const bf16_t*)(ws + WS_Q), *Kb = (const bf16_t*)(ws + WS_K), *Vb = (const bf16_t*)(ws + WS_V); bf16_t* ATT = (bf16_t*)(ws + WS_ATT);
    const int n = unit & 1, c = (unit >> 1) & 63, b = unit >> 7;
    asm volatile("" : "+v"(tid), "+v"(lane));
    const int h = n * 8 + wave, r0 = b * SEQ + c * 64;
    bf16x8 qa[2][2], qb2[2][2];
    attn_load_q<2>(qa, Qb, r0, h, lane);
#pragma unroll
    for (int jb = 0; jb < 2; ++jb) {
        u32x4 kv[2], vv[2];
#pragma unroll
        for (int j = 0; j < 2; ++j) {
            const int i = tid + 512 * (2 * jb + j), kk = i >> 3, ch = i & 7;
            int srow;
            if (kk < 16) srow = ROW_META + kk;
            else { const int t = (c - 2) * 64 + kk - 16; srow = t < 0 ? -1 : b * SEQ + t; }
            kv[j] = (u32x4){0u, 0u, 0u, 0u}; vv[j] = (u32x4){0u, 0u, 0u, 0u};
            if (i < 208 * 8 && srow >= 0) { kv[j] = *(const u32x4*)(Kb + (size_t)srow * 128 + n * 64 + ch * 8); vv[j] = *(const u32x4*)(Vb + (size_t)srow * 128 + n * 64 + ch * 8); }
        }
#pragma unroll
        for (int j = 0; j < 2; ++j) {
            const int i = tid + 512 * (2 * jb + j), kk = i >> 3, ch = i & 7;
            if (i < 208 * 8) {
                *(LAS u32x4*)(lds + kk * KS_PITCH + ch * 16) = kv[j];
                LAS unsigned short* vt = (LAS unsigned short*)(lds + ATT_VT_OFF + (ch * 8) * VT_PITCH + kk * 2);
                vt[0 * (VT_PITCH / 2)] = (unsigned short)(vv[j].x & 0xffffu); vt[1 * (VT_PITCH / 2)] = (unsigned short)(vv[j].x >> 16);
                vt[2 * (VT_PITCH / 2)] = (unsigned short)(vv[j].y & 0xffffu); vt[3 * (VT_PITCH / 2)] = (unsigned short)(vv[j].y >> 16);
                vt[4 * (VT_PITCH / 2)] = (unsigned short)(vv[j].z & 0xffffu); vt[5 * (VT_PITCH / 2)] = (unsigned short)(vv[j].z >> 16);
                vt[6 * (VT_PITCH / 2)] = (unsigned short)(vv[j].w & 0xffffu); vt[7 * (VT_PITCH / 2)] = (unsigned short)(vv[j].w >> 16);
            }
        }
    }
    attn_zero_pad(lds, tid);
    __syncthreads();
    unsigned vmask = 0x1fffu;
    if (c == 0) vmask = 0x1e01u; else if (c == 1) vmask = 0x1fe1u;
    const float sink2 = p.sinks[h] * LOG2E;
    attn_compute<2>(lds, qa, ATT, r0, h, vmask, sink2, lane);
    attn_load_q<2>(qb2, Qb, r0 + 32, h, lane);
    attn_compute<2>(lds, qb2, ATT, r0 + 32, h, vmask, sink2, lane);
    __syncthreads();
}
__device__ __forceinline__ void attn_small_unit(const Params& p, LAS unsigned char* lds, int unit, int tid, int wave, int lane) {
    unsigned char* ws = p.ws;
    const bf16_t *Qb = (const bf16_t*)(ws + WS_Q), *Kb = (const bf16_t*)(ws + WS_K), *Vb = (const bf16_t*)(ws + WS_V); bf16_t* ATT = (bf16_t*)(ws + WS_ATT);
    int n, qrow0; unsigned vmask;
    if (unit < 2) {
        n = unit; qrow0 = ROW_META; vmask = 1u;
        for (int i = tid; i < 208 * 8; i += 512) { const int kk = i >> 3, ch = i & 7; attn_fill_bf16(lds, Kb, Vb, kk < 16 ? ROW_META + kk : -1, n, kk, ch); }
    } else {
        const int b = (unit - 2) >> 1; n = (unit - 2) & 1; qrow0 = ROW_SAMP + b * 16; vmask = 0x3ffu;
        for (int i = tid; i < 208 * 8; i += 512) {
            const int kk = i >> 3, ch = i & 7;
            if (kk < 16) attn_fill_f32(lds, p.cache_meta_k + ((size_t)(b * 16 + kk) * 2 + n) * 64, p.cache_meta_v + ((size_t)(b * 16 + kk) * 2 + n) * 64, kk, ch);
            else if (kk < 144) attn_fill_f32(lds, p.cache_swa_k + ((size_t)(b * 128 + kk - 16) * 2 + n) * 64, p.cache_swa_v + ((size_t)(b * 128 + kk - 16) * 2 + n) * 64, kk, ch);
            else attn_fill_bf16(lds, Kb, Vb, kk < 160 ? ROW_SAMP + b * 16 + kk - 144 : -1, n, kk, ch);
        }
    }
    attn_zero_pad(lds, tid);
    __syncthreads();
    const int h = n * 8 + wave;
    bf16x8 q1[1][2]; attn_load_q<1>(q1, Qb, qrow0, h, lane);
    attn_compute<1>(lds, q1, ATT, qrow0, h, vmask, p.sinks[h] * LOG2E, lane);
    __syncthreads();
}
constexpr int PM_PITCH = 1040;
__device__ __forceinline__ void add8(float (&s)[8], const u32x4 v) {
    s[0] += bf_lo(v.x); s[1] += bf_hi(v.x); s[2] += bf_lo(v.y); s[3] += bf_hi(v.y); s[4] += bf_lo(v.z); s[5] += bf_hi(v.z); s[6] += bf_lo(v.w); s[7] += bf_hi(v.w);
}
__device__ __forceinline__ void unpack8(float (&s)[8], const u32x4 v) {
    s[0] = bf_lo(v.x); s[1] = bf_hi(v.x); s[2] = bf_lo(v.y); s[3] = bf_hi(v.y); s[4] = bf_lo(v.z); s[5] = bf_hi(v.z); s[6] = bf_lo(v.w); s[7] = bf_hi(v.w);
}
template <int W>
__device__ __forceinline__ void pool_pm_main(const bf16_t* Pb, bf16_t* POOL, int R0, int wave, int lane) {
    const int g = wave >> 1, col = (g * 16 + (lane & 15)) * 8, seg = (wave & 1) * 4 + (lane >> 4);
    const int sb = R0 & 4095, s0 = sb + seg * 8, base = R0 - sb;
    constexpr int NL = 8 + W - 1;
    u32x4 v[NL];
#pragma unroll
    for (int t = 0; t < NL; ++t) {
        const int sk = s0 + t - (W - 1);
        const int row = sk >= 0 ? base + sk : ROW_META + 16 + sk;
        v[t] = *(const u32x4*)(Pb + (size_t)row * PW + col);
    }
    float s[8] = {0.f, 0.f, 0.f, 0.f, 0.f, 0.f, 0.f, 0.f};
#pragma unroll
    for (int t = 0; t < W - 1; ++t) add8(s, v[t]);
#pragma unroll
    for (int j = 0; j < 8; ++j) {
        float cur[8], old[8];
        unpack8(cur, v[j + W - 1]); unpack8(old, v[j]);
#pragma unroll
        for (int e = 0; e < 8; ++e) s[e] += cur[e];
        constexpr float inv = 1.0f / (float)W;
        u32x4 o; o.x = pk2(s[0] * inv - cur[0], s[1] * inv - cur[1]); o.y = pk2(s[2] * inv - cur[2], s[3] * inv - cur[3]);
        o.z = pk2(s[4] * inv - cur[4], s[5] * inv - cur[5]); o.w = pk2(s[6] * inv - cur[6], s[7] * inv - cur[7]);
        *(u32x4*)(POOL + (size_t)(R0 + seg * 8 + j) * PW + col) = o;
#pragma unroll
        for (int e = 0; e < 8; ++e) s[e] -= old[e];
    }
}
__device__ __forceinline__ void pool_unit(const Params& p, LAS unsigned char* lds, int pt, int tid, int wave, int lane) {
    unsigned char* ws = p.ws;
    const bf16_t* Pb = (const bf16_t*)(ws + WS_P); bf16_t* POOL = (bf16_t*)(ws + WS_POOL);
    const bool tail = pt >= 512;
    const int R0 = tail ? MREAL + 16 * (pt - 512) : pt * 64;
    if (!tail) {
        switch (wave >> 1) {
            case 0: pool_pm_main<2>(Pb, POOL, R0, wave, lane); break;
            case 1: pool_pm_main<4>(Pb, POOL, R0, wave, lane); break;
            case 2: pool_pm_main<8>(Pb, POOL, R0, wave, lane); break;
            default: pool_pm_main<16>(Pb, POOL, R0, wave, lane); break;
        }
    } else
    for (int i = tid; i < 1024; i += 512) {
        const int rr = i >> 6, ch = i & 63, R = R0 + rr, g = ch >> 4, w = 2 << g, col = ch * 8;
        float s[8] = {0.f, 0.f, 0.f, 0.f, 0.f, 0.f, 0.f, 0.f}, cur[8] = {0.f, 0.f, 0.f, 0.f, 0.f, 0.f, 0.f, 0.f};
        float inv = 1.0f / (float)w;
        if (R < ROW_SAMP) {
            const int pos = R - ROW_META; const int cnt = w < pos + 1 ? w : pos + 1; inv = 1.0f / (float)cnt;
#pragma unroll
            for (int k = 0; k < 16; ++k) {
                const bool on = k < cnt;
                float t[8]; unpack8(t, *(const u32x4*)(Pb + (size_t)(on ? R - k : R) * PW + col));
#pragma unroll
                for (int e = 0; e < 8; ++e) { s[e] += on ? t[e] : 0.f; if (k == 0) cur[e] = t[e]; }
            }
        } else if (R < ROW_PAD) {
            const int q = R - ROW_SAMP, b = q >> 4, ii = q & 15;
#pragma unroll
            for (int k = 0; k < 16; ++k) {
                const bool on = k < w, frombuf = ii - k >= 0;
                float t[8]; unpack8(t, *(const u32x4*)(Pb + (size_t)(frombuf ? R - k : R) * PW + col));
                const float* sp = p.state_pool + ((size_t)b * 15 + (frombuf ? 0 : 15 + ii - k)) * PW + col; const f32x4 a = *(const f32x4*)sp, c2 = *(const f32x4*)(sp + 4);
                const float u[8] = {a[0], a[1], a[2], a[3], c2[0], c2[1], c2[2], c2[3]};
#pragma unroll
                for (int e = 0; e < 8; ++e) { const float x = frombuf ? t[e] : u[e]; s[e] += on ? x : 0.f; if (k == 0) cur[e] = t[e]; }
            }
        }
        u32x4 o; o.x = pk2(s[0] * inv - cur[0], s[1] * inv - cur[1]); o.y = pk2(s[2] * inv - cur[2], s[3] * inv - cur[3]);
        o.z = pk2(s[4] * inv - cur[4], s[5] * inv - cur[5]); o.w = pk2(s[6] * inv - cur[6], s[7] * inv - cur[7]);
        *(u32x4*)(POOL + (size_t)R * PW + col) = o;
    }
}
__device__ __forceinline__ int deinter(int d) { return 2 * (d & 31) + (d >> 5); }
__device__ __forceinline__ void small_outputs(const Params& p) {
    unsigned char* ws = p.ws;
    const bf16_t *Kb = (const bf16_t*)(ws + WS_K), *Vb = (const bf16_t*)(ws + WS_V), *Pb = (const bf16_t*)(ws + WS_P);
    float* out = p.out;
    const int gt = blockIdx.x * 512 + threadIdx.x, NT = gridDim.x * 512;
    for (int i = gt; i < 131072; i += NT) {
        const int d = i & 63, n = (i >> 6) & 1, w = (i >> 7) & 127, b = i >> 14; const size_t row = (size_t)b * SEQ + 3968 + w;
        out[O_PSK + i] = bf1(Kb[row * 128 + n * 64 + deinter(d)]); out[O_PSV + i] = bf1(Vb[row * 128 + n * 64 + d]);
    }
    for (int i = gt; i < 16384; i += NT) {
        const int d = i & 63, n = (i >> 6) & 1, t = (i >> 7) & 15, b = i >> 11;
        const size_t rm = (size_t)ROW_META + t, rs = (size_t)ROW_SAMP + b * 16 + t;
        out[O_KM + i] = bf1(Kb[rm * 128 + n * 64 + deinter(d)]); out[O_VM + i] = bf1(Vb[rm * 128 + n * 64 + d]);
        out[O_SSK + i] = bf1(Kb[rs * 128 + n * 64 + deinter(d)]); out[O_SSV + i] = bf1(Vb[rs * 128 + n * 64 + d]);
    }
    for (int i = gt; i < 61440; i += NT) {
        const int c = i & 511, r = (i >> 9) % 15, b = (i >> 9) / 15;
        out[O_PPOOL + i] = bf1(Pb[((size_t)b * SEQ + 4081 + r) * PW + c]);
        out[O_SPOOL + i] = bf1(Pb[((size_t)ROW_SAMP + b * 16 + 1 + r) * PW + c]);
    }
}


constexpr size_t WS_SSQT1 = 5 * MiB + 512 * 1024, WS_SSQT2 = 8 * MiB + 512 * 1024;
struct SkinnyOp { const bf16_t* A; const bf16_t* Bt; int K; };
__device__ __forceinline__ void skinny_accum(const SkinnyOp op, int n0, int wave, int lane, f32x4 (&acc)[9]) {
    const int fr = lane & 15, fq = lane >> 4;
    const bf16_t* bp = op.Bt + (size_t)(n0 + fr) * op.K + 8 * fq;
    const bf16_t* ap = op.A + (size_t)(ROW_META + fr) * op.K + 8 * fq;
    const int nks = op.K >> 5;
    for (int ks = wave; ks < nks; ks += 16) {
        const bool two = ks + 8 < nks;
        const int k0 = ks * 32, k1 = two ? (ks + 8) * 32 : k0;
        const bf16x8 b0 = *(const bf16x8*)(bp + k0), b1 = *(const bf16x8*)(bp + k1);
        bf16x8 a0[9], a1[9];
#pragma unroll
        for (int rb = 0; rb < 9; ++rb) { a0[rb] = *(const bf16x8*)(ap + (size_t)rb * 16 * op.K + k0); a1[rb] = *(const bf16x8*)(ap + (size_t)rb * 16 * op.K + k1); }
#pragma unroll
        for (int rb = 0; rb < 9; ++rb) acc[rb] = __builtin_amdgcn_mfma_f32_16x16x32_bf16(b0, a0[rb], acc[rb], 0, 0, 0);
        if (two) {
#pragma unroll
            for (int rb = 0; rb < 9; ++rb) acc[rb] = __builtin_amdgcn_mfma_f32_16x16x32_bf16(b1, a1[rb], acc[rb], 0, 0, 0);
        }
    }
}
__device__ __forceinline__ void skinny_reduce(LAS unsigned char* lds, const f32x4 (&acc)[9], int wave, int lane, f32x4& r0, f32x4& r8) {
    LAS f32x4* part = (LAS f32x4*)lds;
#pragma unroll
    for (int rb = 0; rb < 9; ++rb) part[(wave * 9 + rb) * 64 + lane] = acc[rb];
    __syncthreads();
    r0 = (f32x4){0.f, 0.f, 0.f, 0.f}; r8 = (f32x4){0.f, 0.f, 0.f, 0.f};
#pragma unroll
    for (int w = 0; w < 8; ++w) r0 += part[(w * 9 + wave) * 64 + lane];
    if (wave == 0) {
#pragma unroll
        for (int w = 0; w < 8; ++w) r8 += part[(w * 9 + 8) * 64 + lane];
    }
    __syncthreads();
}
#define ZERO9(a) _Pragma("unroll") for (int z_ = 0; z_ < 9; ++z_) a[z_] = (f32x4){0.f, 0.f, 0.f, 0.f}
__device__ __forceinline__ void tail_mix_unit(const Params& p, LAS unsigned char* lds, int unit, int wave, int lane) {
    unsigned char* ws = p.ws; const int n0 = unit * 16, fr = lane & 15, fq = lane >> 4;
    f32x4 acc[9], a0, a8, b0, b8;
    ZERO9(acc); skinny_accum(SkinnyOp{(const bf16_t*)(ws + WS_ATT), (const bf16_t*)(ws + WS_WAO), 1024}, n0, wave, lane, acc); skinny_reduce(lds, acc, wave, lane, a0, a8);
    ZERO9(acc); skinny_accum(SkinnyOp{(const bf16_t*)(ws + WS_POOL), (const bf16_t*)(ws + WS_WPO), 512}, n0, wave, lane, acc); skinny_reduce(lds, acc, wave, lane, b0, b8);
    const bf16_t *GA = (const bf16_t*)(ws + WS_GA), *GP = (const bf16_t*)(ws + WS_GP); bf16_t* MIX = (bf16_t*)(ws + WS_MIX);
#pragma unroll
    for (int t = 0; t < 2; ++t) {
        if (t == 1 && wave != 0) break;
        const int rb = t ? 8 : wave; const f32x4 va = t ? a8 : a0, vb = t ? b8 : b0;
        const size_t off = (size_t)(ROW_META + 16 * rb + fr) * 1024 + n0 + 4 * fq;
        const u32x2 ga = *(const u32x2*)(GA + off), gp = *(const u32x2*)(GP + off);
        u32x2 w; w.x = pk2(bf_lo(ga.x) * va[0] + bf_lo(gp.x) * vb[0], bf_hi(ga.x) * va[1] + bf_hi(gp.x) * vb[1]);
        w.y = pk2(bf_lo(ga.y) * va[2] + bf_lo(gp.y) * vb[2], bf_hi(ga.y) * va[3] + bf_hi(gp.y) * vb[3]);
        *(u32x2*)(MIX + off) = w;
    }
}
__device__ __forceinline__ void tail_x1_unit(const Params& p, LAS unsigned char* lds, int unit, int wave, int lane) {
    unsigned char* ws = p.ws; const int n0 = unit * 16, fr = lane & 15, fq = lane >> 4;
    f32x4 acc[9], a0, a8;
    ZERO9(acc); skinny_accum(SkinnyOp{(const bf16_t*)(ws + WS_MIX), (const bf16_t*)(ws + WS_WOUT), 1024}, n0, wave, lane, acc); skinny_reduce(lds, acc, wave, lane, a0, a8);
    bf16_t* XG = (bf16_t*)(ws + WS_XG); float* ssqt = (float*)(ws + WS_SSQT1);
#pragma unroll
    for (int t = 0; t < 2; ++t) {
        if (t == 1 && wave != 0) break;
        const int rb = t ? 8 : wave; const f32x4 va = t ? a8 : a0;
        const int lr = 16 * rb + fr, row = ROW_META + lr, col = n0 + 4 * fq;
        const f32x4 x = *(const f32x4*)(row_x(p.x_prompt, p.meta_tokens, p.x_sample, row) + col);
        const f32x4 v = va + x, g = *(const f32x4*)(p.g_norm_ffn + col);
        u32x2 w; w.x = pk2(v[0] * g[0], v[1] * g[1]); w.y = pk2(v[2] * g[2], v[3] * g[3]);
        *(u32x2*)(XG + (size_t)row * 1024 + col) = w;
        float ss = (v[0] * v[0] + v[1] * v[1]) + (v[2] * v[2] + v[3] * v[3]);
        ss += __shfl_xor(ss, 16); ss += __shfl_xor(ss, 32);
        if (fq == 0) ssqt[lr * 64 + unit] = ss;
    }
}
__device__ __forceinline__ float tail_row_sum64(const float* ssqt, int lr) {
    const f32x4* sp = (const f32x4*)(ssqt + lr * 64); float s = 0.f;
#pragma unroll
    for (int j = 0; j < 16; ++j) { const f32x4 a = sp[j]; s += (a[0] + a[1]) + (a[2] + a[3]); }
    return s;
}
__device__ __forceinline__ void tail_up_unit(const Params& p, LAS unsigned char* lds, int unit, int wave, int lane) {
    unsigned char* ws = p.ws; const int n0 = unit * 16, fr = lane & 15, fq = lane >> 4;
    f32x4 acc[9], a0, a8;
    ZERO9(acc); skinny_accum(SkinnyOp{(const bf16_t*)(ws + WS_XG), (const bf16_t*)(ws + WS_WUP), 1024}, n0, wave, lane, acc); skinny_reduce(lds, acc, wave, lane, a0, a8);
    float* UPT = (float*)(ws + WS_UPT); const float* ssqt = (const float*)(ws + WS_SSQT1);
    const int oc = ((n0 >> 7) & 1) * FF + 128 * (n0 >> 8) + (n0 & 127) + 4 * fq;
#pragma unroll
    for (int t = 0; t < 2; ++t) {
        if (t == 1 && wave != 0) break;
        const int rb = t ? 8 : wave; const f32x4 va = t ? a8 : a0;
        const int lr = 16 * rb + fr;
        const float r1 = rsqrtf(tail_row_sum64(ssqt, lr) * (1.0f / 1024.0f) + RMS_EPS);
        *(f32x4*)(UPT + (size_t)lr * FF2 + oc) = va * r1;
    }
}
__device__ __forceinline__ void tail_down_unit(const Params& p, LAS unsigned char* lds, int unit, int wave, int lane) {
    unsigned char* ws = p.ws; const int n0 = unit * 16, fr = lane & 15, fq = lane >> 4;
    f32x4 acc[9], a0, a8;
    ZERO9(acc); skinny_accum(SkinnyOp{(const bf16_t*)(ws + WS_ACT), (const bf16_t*)(ws + WS_WDOWN), FF}, n0, wave, lane, acc); skinny_reduce(lds, acc, wave, lane, a0, a8);
    const bf16_t* XG = (const bf16_t*)(ws + WS_XG); float* ssqt = (float*)(ws + WS_SSQT2);
    f32x4 vv[2];
#pragma unroll
    for (int t = 0; t < 2; ++t) {
        if (t == 1 && wave != 0) break;
        const int rb = t ? 8 : wave; const f32x4 va = t ? a8 : a0;
        const int lr = 16 * rb + fr, row = ROW_META + lr, col = n0 + 4 * fq;
        const u32x2 xg = *(const u32x2*)(XG + (size_t)row * 1024 + col); const f32x4 g = *(const f32x4*)(p.g_norm_ffn + col);
        f32x4 v;
        v[0] = va[0] + bf_lo(xg.x) * __builtin_amdgcn_rcpf(g[0]); v[1] = va[1] + bf_hi(xg.x) * __builtin_amdgcn_rcpf(g[1]);
        v[2] = va[2] + bf_lo(xg.y) * __builtin_amdgcn_rcpf(g[2]); v[3] = va[3] + bf_hi(xg.y) * __builtin_amdgcn_rcpf(g[3]);
        vv[t] = v;
        float ss = (v[0] * v[0] + v[1] * v[1]) + (v[2] * v[2] + v[3] * v[3]);
        ss += __shfl_xor(ss, 16); ss += __shfl_xor(ss, 32);
        if (fq == 0) AG_ST(ssqt + lr * 64 + unit, ss);
    }
#pragma unroll
    for (int t = 0; t < 2; ++t) {
        if (t == 1 && wave != 0) break;
        const int rb = t ? 8 : wave;
        const int lr = 16 * rb + fr, col = n0 + 4 * fq;
        float s = 0.f;
        for (int tries = 0; tries < (1 << 16); ++tries) {
            bool ready = true; s = 0.f;
#pragma unroll
            for (int j = 0; j < 16; ++j) { const float a = AG_LD(ssqt + lr * 64 + 16 * fq + j); ready = ready && (a >= 0.f); s += a; }
            if (__all(ready)) break;
            __builtin_amdgcn_s_sleep(8);
        }
        s += __shfl_xor(s, 16); s += __shfl_xor(s, 32);
        const float r = rsqrtf(s * (1.0f / 1024.0f) + RMS_EPS);
        if (lr >= 16) *(f32x4*)(p.out + O_YS + (size_t)(lr - 16) * D + col) = vv[t] * r * *(const f32x4*)(p.g_norm_final + col);
    }
}

__device__ __forceinline__ void skinny_accum3(const SkinnyOp op, int n0, int rb0, int wave, int lane, f32x4 (&acc)[3]) {
    const int fr = lane & 15, fq = lane >> 4;
    const bf16_t* bp = op.Bt + (size_t)(n0 + fr) * op.K + 8 * fq;
    const bf16_t* ap = op.A + (size_t)(ROW_META + 16 * rb0 + fr) * op.K + 8 * fq;
    const int nks = op.K >> 5;
    for (int ks0 = wave; ks0 < nks; ks0 += 32) {
        bf16x8 b[4], a[4][3];
#pragma unroll
        for (int j = 0; j < 4; ++j) {
            const int ks = ks0 + 8 * j; const int k = (ks < nks ? ks : ks0) * 32;
            b[j] = *(const bf16x8*)(bp + k);
#pragma unroll
            for (int rb = 0; rb < 3; ++rb) a[j][rb] = *(const bf16x8*)(ap + (size_t)rb * 16 * op.K + k);
        }
#pragma unroll
        for (int j = 0; j < 4; ++j) {
            if (ks0 + 8 * j < nks) {
#pragma unroll
                for (int rb = 0; rb < 3; ++rb) acc[rb] = __builtin_amdgcn_mfma_f32_16x16x32_bf16(b[j], a[j][rb], acc[rb], 0, 0, 0);
            }
        }
    }
}
__device__ __forceinline__ f32x4 skinny_reduce3(LAS unsigned char* lds, const f32x4 (&acc)[3], int wave, int lane) {
    LAS f32x4* part = (LAS f32x4*)lds;
#pragma unroll
    for (int rb = 0; rb < 3; ++rb) part[(wave * 3 + rb) * 64 + lane] = acc[rb];
    __syncthreads();
    f32x4 r = {0.f, 0.f, 0.f, 0.f};
    if (wave < 3) {
#pragma unroll
        for (int w = 0; w < 8; ++w) r += part[(w * 3 + wave) * 64 + lane];
    }
    __syncthreads();
    return r;
}
#define ZERO3(a) _Pragma("unroll") for (int z_ = 0; z_ < 3; ++z_) a[z_] = (f32x4){0.f, 0.f, 0.f, 0.f}
__device__ __forceinline__ void tail_mix_unit3(const Params& p, LAS unsigned char* lds, int unit, int wave, int lane) {
    unsigned char* ws = p.ws; const int n0 = (unit & 63) * 16, rb0 = 3 * (unit >> 6), fr = lane & 15, fq = lane >> 4;
    f32x4 acc[3];
    ZERO3(acc); skinny_accum3(SkinnyOp{(const bf16_t*)(ws + WS_ATT), (const bf16_t*)(ws + WS_WAO), 1024}, n0, rb0, wave, lane, acc); const f32x4 va = skinny_reduce3(lds, acc, wave, lane);
    ZERO3(acc); skinny_accum3(SkinnyOp{(const bf16_t*)(ws + WS_POOL), (const bf16_t*)(ws + WS_WPO), 512}, n0, rb0, wave, lane, acc); const f32x4 vb = skinny_reduce3(lds, acc, wave, lane);
    if (wave < 3) {
        const bf16_t *GA = (const bf16_t*)(ws + WS_GA), *GP = (const bf16_t*)(ws + WS_GP); bf16_t* MIX = (bf16_t*)(ws + WS_MIX);
        const size_t off = (size_t)(ROW_META + 16 * (rb0 + wave) + fr) * 1024 + n0 + 4 * fq;
        const u32x2 ga = *(const u32x2*)(GA + off), gp = *(const u32x2*)(GP + off);
        u32x2 w; w.x = pk2(bf_lo(ga.x) * va[0] + bf_lo(gp.x) * vb[0], bf_hi(ga.x) * va[1] + bf_hi(gp.x) * vb[1]);
        w.y = pk2(bf_lo(ga.y) * va[2] + bf_lo(gp.y) * vb[2], bf_hi(ga.y) * va[3] + bf_hi(gp.y) * vb[3]);
        *(u32x2*)(MIX + off) = w;
    }
}
__device__ __forceinline__ void tail_x1_unit3(const Params& p, LAS unsigned char* lds, int unit, int wave, int lane) {
    unsigned char* ws = p.ws; const int cu = unit & 63, n0 = cu * 16, rb0 = 3 * (unit >> 6), fr = lane & 15, fq = lane >> 4;
    f32x4 acc[3];
    ZERO3(acc); skinny_accum3(SkinnyOp{(const bf16_t*)(ws + WS_MIX), (const bf16_t*)(ws + WS_WOUT), 1024}, n0, rb0, wave, lane, acc); const f32x4 va = skinny_reduce3(lds, acc, wave, lane);
    if (wave < 3) {
        bf16_t* XG = (bf16_t*)(ws + WS_XG); float* ssqt = (float*)(ws + WS_SSQT1);
        const int lr = 16 * (rb0 + wave) + fr, row = ROW_META + lr, col = n0 + 4 * fq;
        const f32x4 x = *(const f32x4*)(row_x(p.x_prompt, p.meta_tokens, p.x_sample, row) + col);
        const f32x4 v = va + x, g = *(const f32x4*)(p.g_norm_ffn + col);
        u32x2 w; w.x = pk2(v[0] * g[0], v[1] * g[1]); w.y = pk2(v[2] * g[2], v[3] * g[3]);
        *(u32x2*)(XG + (size_t)row * 1024 + col) = w;
        float ss = (v[0] * v[0] + v[1] * v[1]) + (v[2] * v[2] + v[3] * v[3]);
        ss += __shfl_xor(ss, 16); ss += __shfl_xor(ss, 32);
        if (fq == 0) ssqt[lr * 64 + cu] = ss;
    }
}
__device__ __forceinline__ void tail_down_unit3(const Params& p, LAS unsigned char* lds, int unit, int wave, int lane) {
    unsigned char* ws = p.ws; const int cu = unit & 63, n0 = cu * 16, rb0 = 3 * (unit >> 6), fr = lane & 15, fq = lane >> 4;
    f32x4 acc[3];
    ZERO3(acc); skinny_accum3(SkinnyOp{(const bf16_t*)(ws + WS_ACT), (const bf16_t*)(ws + WS_WDOWN), FF}, n0, rb0, wave, lane, acc); const f32x4 va = skinny_reduce3(lds, acc, wave, lane);
    if (wave < 3) {
        const bf16_t* XG = (const bf16_t*)(ws + WS_XG); float* ssqt = (float*)(ws + WS_SSQT2);
        const int lr = 16 * (rb0 + wave) + fr, row = ROW_META + lr, col = n0 + 4 * fq;
        const u32x2 xg = *(const u32x2*)(XG + (size_t)row * 1024 + col); const f32x4 g = *(const f32x4*)(p.g_norm_ffn + col);
        f32x4 v;
        v[0] = va[0] + bf_lo(xg.x) * __builtin_amdgcn_rcpf(g[0]); v[1] = va[1] + bf_hi(xg.x) * __builtin_amdgcn_rcpf(g[1]);
        v[2] = va[2] + bf_lo(xg.y) * __builtin_amdgcn_rcpf(g[2]); v[3] = va[3] + bf_hi(xg.y) * __builtin_amdgcn_rcpf(g[3]);
        float ss = (v[0] * v[0] + v[1] * v[1]) + (v[2] * v[2] + v[3] * v[3]);
        ss += __shfl_xor(ss, 16); ss += __shfl_xor(ss, 32);
        if (fq == 0) AG_ST(ssqt + lr * 64 + cu, ss);
        float s = 0.f;
        for (int tries = 0; tries < (1 << 16); ++tries) {
            bool ready = true; s = 0.f;
#pragma unroll
            for (int j = 0; j < 16; ++j) { const float a = AG_LD(ssqt + lr * 64 + 16 * fq + j); ready = ready && (a >= 0.f); s += a; }
            if (__all(ready)) break;
            __builtin_amdgcn_s_sleep(2);
        }
        s += __shfl_xor(s, 16); s += __shfl_xor(s, 32);
        const float r = rsqrtf(s * (1.0f / 1024.0f) + RMS_EPS);
        if (lr >= 16) *(f32x4*)(p.out + O_YS + (size_t)(lr - 16) * D + col) = v * r * *(const f32x4*)(p.g_norm_final + col);
    }
}

__device__ __forceinline__ void conv_fix(const Params& p) {
    unsigned char* ws = p.ws;
    const float* HALO = (const float*)(ws + WS_HALO); const float* UPT = (const float*)(ws + WS_UPT); bf16_t* ACT = (bf16_t*)(ws + WS_ACT);
    const float *cw = p.conv_w, *cb = p.conv_b;
    const int gt = blockIdx.x * 512 + threadIdx.x, NT = gridDim.x * 512;
    constexpr int NCH = FF / 4;
    constexpr int N_SLAB = 256 * 2 * NCH, N_SAMP = 128 * NCH;
    for (int it = gt; it < N_SLAB + N_SAMP; it += NT) {
        const float *u0, *u1, *u2; int row, j;
        if (it < N_SLAB) {
            const int ch = it % NCH, sr = it / NCH, rr = sr & 1, s = sr >> 1; j = ch * 4;
            row = s * 128 + rr;
            const float* l1 = (s & 31) ? HALO + (size_t)((s - 1) * 4 + 3) * FF2 : UPT + (size_t)15 * FF2;
            const float* l0 = (s & 31) ? HALO + (size_t)((s - 1) * 4 + 2) * FF2 : UPT + (size_t)14 * FF2;
            u0 = HALO + (size_t)(s * 4 + rr) * FF2;
            if (rr == 0) { u1 = l1; u2 = l0; } else { u1 = HALO + (size_t)(s * 4) * FF2; u2 = l1; }
        } else {
            const int t = it - N_SLAB, ch = t % NCH, q = t / NCH, b = q >> 4, i = q & 15; j = ch * 4;
            row = ROW_SAMP + q;
            u0 = UPT + (size_t)(16 + q) * FF2;
            u1 = (i >= 1) ? UPT + (size_t)(16 + q - 1) * FF2 : p.state_conv + ((size_t)b * 2 + 1) * FF2;
            u2 = (i >= 2) ? UPT + (size_t)(16 + q - 2) * FF2 : p.state_conv + ((size_t)b * 2 + i) * FF2;
        }
        const f32x4 g0 = *(const f32x4*)(u0 + j), g1 = *(const f32x4*)(u1 + j), g2 = *(const f32x4*)(u2 + j);
        const f32x4 v0 = *(const f32x4*)(u0 + FF + j), v1 = *(const f32x4*)(u1 + FF + j), v2 = *(const f32x4*)(u2 + FF + j);
        const f32x4 cg = *(const f32x4*)(cb + j) + *(const f32x4*)(cw + j) * g2 + *(const f32x4*)(cw + FF2 + j) * g1 + *(const f32x4*)(cw + 2 * FF2 + j) * g0;
        const f32x4 cv = *(const f32x4*)(cb + FF + j) + *(const f32x4*)(cw + FF + j) * v2 + *(const f32x4*)(cw + FF2 + FF + j) * v1 + *(const f32x4*)(cw + 2 * FF2 + FF + j) * v0;
        float a[4];
#pragma unroll
        for (int i = 0; i < 4; ++i) a[i] = cg[i] * sigmoidf_(cg[i]) * cv[i];
        u32x2 w; w.x = pk2(a[0], a[1]); w.y = pk2(a[2], a[3]);
        *(u32x2*)(ACT + (size_t)row * FF + j) = w;
    }
    { f32x4* q4 = (f32x4*)(ws + WS_SSQ2); for (int i = gt; i < MREAL * 4; i += NT) q4[i] = (f32x4){-1.f, -1.f, -1.f, -1.f};
      f32x4* t4 = (f32x4*)(ws + WS_SSQT2); for (int i = gt; i < 144 * 16; i += NT) t4[i] = (f32x4){-1.f, -1.f, -1.f, -1.f};
      unsigned* pc = (unsigned*)(ws + WS_PCNT); for (int i = gt; i < 128; i += NT) pc[64 * i] = 0u; }
    for (int i = gt; i < 8 * 2 * FF2; i += NT) {
        const int c = i % FF2, k = (i / FF2) & 1, b = i / (2 * FF2);
        p.out[O_PCONV + i] = HALO[(size_t)((b * 32 + 31) * 4 + 2 + k) * FF2 + c];
        p.out[O_SCONV + i] = UPT[(size_t)(16 + b * 16 + 14 + k) * FF2 + c];
    }
}
__device__ __forceinline__ void final_norm(const Params& p, int wave, int lane) {
    const float* ssq = (const float*)(p.ws + WS_SSQ2);
    const int gw = blockIdx.x * 8 + wave, NGW = gridDim.x * 8;
    f32x4 gv[4];
#pragma unroll
    for (int j = 0; j < 4; ++j) gv[j] = ((const f32x4*)p.g_norm_final)[lane + 64 * j];
    for (int m0 = gw * 4; m0 < MREAL + 128; m0 += NGW * 4) {
        float sv[4]; f32x4 x[4][4]; float* orow[4];
#pragma unroll
        for (int q = 0; q < 4; ++q) {
            const int m = m0 + q;
            orow[q] = m < MREAL ? p.out + O_YP + (size_t)m * D : p.out + O_YS + (size_t)(m - MREAL) * D;
            if (m < MREAL) sv[q] = ssq[(size_t)m * 16 + (lane & 15)];
            else { const float* st = (const float*)(p.ws + WS_SSQT2) + (16 + m - MREAL) * 64; sv[q] = (st[lane & 15] + st[16 + (lane & 15)]) + (st[32 + (lane & 15)] + st[48 + (lane & 15)]); }
#pragma unroll
            for (int j = 0; j < 4; ++j) x[q][j] = ((const f32x4*)orow[q])[lane + 64 * j];
        }
#pragma unroll
        for (int q = 0; q < 4; ++q) {
            float s = sv[q];
            s += __shfl_xor(s, 1); s += __shfl_xor(s, 2); s += __shfl_xor(s, 4); s += __shfl_xor(s, 8);
            const float r = rsqrtf(s * (1.0f / D) + RMS_EPS);
#pragma unroll
            for (int j = 0; j < 4; ++j) ((f32x4*)orow[q])[lane + 64 * j] = x[q][j] * r * gv[j];
        }
    }
}


struct EpiNull {
    static constexpr bool PERM = true, AFTER_DRAIN = false, APERM = false;
    float* sink;
    __device__ __forceinline__ void operator()(const f32x4 (&acc)[2][2][4][2], const Unit& u, int wr, int wc, int fr, int fq) const {
        f32x4 t = {0.f, 0.f, 0.f, 0.f};
#pragma unroll
        for (int a = 0; a < 2; ++a)
#pragma unroll
            for (int b = 0; b < 2; ++b)
#pragma unroll
                for (int m = 0; m < 4; ++m)
#pragma unroll
                    for (int n = 0; n < 2; ++n) t += acc[a][b][m][n];
        if (t[0] + t[1] + t[2] + t[3] == 123456.789f) sink[threadIdx.x] = t[0];
    }
};
struct SamePanelOrder {
    int G, c, nr;
    __device__ bool next(int i, Unit& u) const { if (i >= nr) return false; u.pm = 0; u.pn = (c >> 6) & 3; return true; }
    __device__ __forceinline__ void a_ready(const Unit&) const {}
    __device__ __forceinline__ void done(const Unit&) const {}
};

typedef unsigned v4u_unused_t;
#define XB_TMO      128
#define XB_XCNT(j)  (256  + 64 * (j))
#define XB_XSUB(j)  (1280 + 64 * (j))
#define XB_XGEN(j)  (2304 + 64 * (j))
#define XB_TOP      3328
#define XB_TOPGEN   3392
#define XCD_BAR_WORDS 3456
#define XB_SPIN_CAP (1u << 18)

__device__ __forceinline__ unsigned xb_ld(unsigned* p)              { return __hip_atomic_load(p, __ATOMIC_RELAXED, __HIP_MEMORY_SCOPE_AGENT); }
__device__ __forceinline__ unsigned xb_add(unsigned* p, unsigned v) { return __hip_atomic_fetch_add(p, v, __ATOMIC_RELAXED, __HIP_MEMORY_SCOPE_AGENT); }
__device__ __forceinline__ unsigned xb_xcc_id() { return (unsigned)__builtin_amdgcn_s_getreg((3 << 11) | 20) & 0xFu; }
#define XB_SPIN(cond, bar) do { unsigned _sp = 0; while (cond) { __builtin_amdgcn_s_sleep(1); \
    if ((++_sp & 255u) == 0u) { if (xb_ld(&(bar)[XB_TMO])) break; if (_sp > XB_SPIN_CAP) { atomicAdd(&(bar)[XB_TMO], 1u); break; } } } } while (0)

struct XcdBarrier {
    unsigned* bar; unsigned x;
    volatile LAS unsigned* st;
};

__device__ __forceinline__ XcdBarrier xcd_barrier_post(unsigned* bar, volatile LAS unsigned* st) {
    XcdBarrier b; b.bar = bar; b.x = xb_xcc_id(); b.st = st;
    if (threadIdx.x == 0) (void)xb_add(&bar[XB_XCNT(b.x)], 1u);
    return b;
}
__device__ __forceinline__ void xcd_barrier_complete(unsigned* bar, unsigned x, unsigned& nloc, unsigned& nx) {
    const unsigned G = gridDim.x * gridDim.y * gridDim.z;
    unsigned sum, cnt, mine, sp = 0u;
    for (;;) {
        sum = 0u; cnt = 0u; mine = 0u;
#pragma unroll
        for (unsigned j = 0; j < 16; ++j) { const unsigned c = xb_ld(&bar[XB_XCNT(j)]); sum += c; cnt += (c > 0u) ? 1u : 0u; mine = (j == x) ? c : mine; }
        if (sum == G) break;
        __builtin_amdgcn_s_sleep(1);
        if ((++sp & 255u) == 0u) { if (xb_ld(&bar[XB_TMO])) break; if (sp > XB_SPIN_CAP) { atomicAdd(&bar[XB_TMO], 1u); break; } }
    }
    nloc = mine > 0u ? mine : 1u; nx = cnt > 0u ? cnt : 1u;
}

__device__ __forceinline__ void xcd_barrier(const XcdBarrier& b) {
    asm volatile("s_waitcnt vmcnt(0)" ::: "memory");
    __syncthreads();
    if (threadIdx.x == 0) {
        unsigned* bar = b.bar;
        __builtin_amdgcn_s_waitcnt(0);
        unsigned nloc = b.st[0], nx = b.st[1];
        if (nloc == 0u) { xcd_barrier_complete(bar, b.x, nloc, nx); b.st[0] = nloc; b.st[1] = nx; }
        const unsigned old = xb_add(&bar[XB_XSUB(b.x)], 1u);
        const unsigned gen = old / nloc;
        if (old + 1u == (gen + 1u) * nloc) {
            __builtin_amdgcn_fence(__ATOMIC_RELEASE, "agent");
            asm volatile("s_waitcnt vmcnt(0)" ::: "memory");
            const unsigned og = xb_add(&bar[XB_TOP], 1u);
            const unsigned tg = og / nx;
            if (og + 1u == (tg + 1u) * nx) xb_add(&bar[XB_TOPGEN], 1u);
            else XB_SPIN(xb_ld(&bar[XB_TOPGEN]) == tg, bar);
            __builtin_amdgcn_fence(__ATOMIC_ACQUIRE, "agent");
            xb_add(&bar[XB_XGEN(b.x)], 1u);
            asm volatile("s_waitcnt vmcnt(0)" ::: "memory");
        } else {
            XB_SPIN(xb_ld(&bar[XB_XGEN(b.x)]) == gen, bar);
            __builtin_amdgcn_fence(__ATOMIC_ACQUIRE, "agent");
            asm volatile("s_waitcnt vmcnt(0)" ::: "memory");
        }
    }
    __syncthreads();
}

__device__ __forceinline__ void grid_bar(unsigned* ctr, unsigned target) {
    asm volatile("s_waitcnt vmcnt(0) lgkmcnt(0)" ::: "memory");
    __syncthreads();
    if (threadIdx.x == 0) {
        __hip_atomic_fetch_add(ctr, 1u, __ATOMIC_RELEASE, __HIP_MEMORY_SCOPE_AGENT);
        unsigned spins = 0;
        while (__hip_atomic_load(ctr, __ATOMIC_RELAXED, __HIP_MEMORY_SCOPE_AGENT) < target) { __builtin_amdgcn_s_sleep(2); if (++spins > (1u << 24)) break; }
        __builtin_amdgcn_fence(__ATOMIC_ACQUIRE, "agent");
        asm volatile("s_waitcnt vmcnt(0)" ::: "memory");
    }
    __syncthreads();
}
__global__ void __launch_bounds__(512, 2) fwd_megakernel(Params p) {
    extern __shared__ __attribute__((aligned(16))) unsigned char lds_raw[];
    LAS unsigned char* lds = (LAS unsigned char*)lds_raw;
    cg::grid_group grid = cg::this_grid();
    const int wave = __builtin_amdgcn_readfirstlane(threadIdx.x >> 6);
#define TIDLANE() int tid = threadIdx.x; asm volatile("" : "+v"(tid)); const int lane = tid & 63
    unsigned char* ws = p.ws;
    const int lo = p.ph_lo, hi = p.ph_hi, G = gridDim.x;
#define IN(k) (lo <= (k) && (k) < hi)
#define SEAM(k) do { if (IN(k) && IN((k) + 1)) xcd_barrier(xbar); } while (0)
    if (lo < 0) grid.sync();
    volatile LAS unsigned* xst = (volatile LAS unsigned*)(lds + LDS_BYTES - 32);
    if (threadIdx.x < 2) xst[threadIdx.x] = 0u;
    __syncthreads();
    XcdBarrier xbar = xcd_barrier_post((unsigned*)(ws + 4096), xst);
    if (IN(0)) { TIDLANE(); (void)tid; p0_prologue(p, lds, wave, lane); __syncthreads(); }
    SEAM(0);
    if (IN(1)) {
        pg8::Gemm g{(const bf16_t*)(ws + WS_XN), (const bf16_t*)(ws + WS_WIN), M, INW, D}; pg8::StaticOrder S; S.init(M, INW, G, (int)blockIdx.x);
        EpiZ E{(bf16_t*)(ws + WS_Q), (bf16_t*)(ws + WS_K), (bf16_t*)(ws + WS_V), (bf16_t*)(ws + WS_P), (bf16_t*)(ws + WS_GA), (bf16_t*)(ws + WS_GP), p.b_gate, (const float*)(ws + WS_ROPE)};
        pg8::gemm_phase<EpiZ, pg8::StaticOrder, true, true>(lds, g, S, E);
    }
    SEAM(1);
    if (IN(2)) {
        TIDLANE();
        for (int unit = blockIdx.x; unit < 1024; unit += G) attn_chunk_unit(p, lds, unit, tid, wave, lane);
        constexpr int N_EXTRA = 27;
        if (G > 2 * N_EXTRA) {
            if ((int)blockIdx.x < N_EXTRA) { const int e = blockIdx.x; if (e < 18) attn_small_unit(p, lds, e, tid, wave, lane); else pool_unit(p, lds, 512 + e - 18, tid, wave, lane); }
            else for (int unit = blockIdx.x - N_EXTRA; unit < 512; unit += G - N_EXTRA) pool_unit(p, lds, unit, tid, wave, lane);
        } else {
            for (int unit = blockIdx.x; unit < 18 + 521; unit += G) { if (unit < 18) attn_small_unit(p, lds, unit, tid, wave, lane); else pool_unit(p, lds, unit - 18, tid, wave, lane); }
        }
        small_outputs(p);
    }
    SEAM(2);
    if (IN(3)) {
        { TIDLANE(); (void)tid; for (int unit = blockIdx.x; unit < 192; unit += G) tail_mix_unit3(p, lds, unit, wave, lane); }
        { pg8::Gemm g{(const bf16_t*)(ws + WS_ATT), (const bf16_t*)(ws + WS_WAO), MREAL, D, D}; pg8::StaticOrder S; S.init(MREAL, D, G, (int)blockIdx.x);
          EpiT1 E{(const bf16_t*)(ws + WS_GA), (bf16_t*)(ws + WS_MIX)};
          pg8::gemm_phase<EpiT1, pg8::StaticOrder, true, true>(lds, g, S, E); }
        __syncthreads();
        { pg8::Gemm g{(const bf16_t*)(ws + WS_POOL), (const bf16_t*)(ws + WS_WPO), MREAL, D, PW}; pg8::StaticOrder S; S.init(MREAL, D, G, (int)blockIdx.x);
          EpiMix E{(const bf16_t*)(ws + WS_GP), (bf16_t*)(ws + WS_MIX)};
          pg8::gemm_phase<EpiMix, pg8::StaticOrder, true, true>(lds, g, S, E); }
    }
    SEAM(3);
    if (IN(4)) {
        { TIDLANE(); (void)tid; for (int unit = blockIdx.x; unit < 192; unit += G) tail_x1_unit3(p, lds, unit, wave, lane); }
        pg8::Gemm g{(const bf16_t*)(ws + WS_MIX), (const bf16_t*)(ws + WS_WOUT), MREAL, D, D}; pg8::StaticOrder S; S.init(MREAL, D, G, (int)blockIdx.x);
        EpiX1 E{(const bf16_t*)(ws + WS_XN), (const float*)(ws + WS_R0I), p.g_norm_mix, p.g_norm_ffn, (bf16_t*)(ws + WS_XG), (float*)(ws + WS_SSQ1)};
        pg8::gemm_phase<EpiX1, pg8::StaticOrder, true, true>(lds, g, S, E);
    }
    SEAM(4);
    if (IN(5)) {
        { TIDLANE(); (void)tid; for (int unit = blockIdx.x; unit < FF2 / 16; unit += G) tail_up_unit(p, lds, unit, wave, lane); }
        pg8::Gemm g{(const bf16_t*)(ws + WS_XG), (const bf16_t*)(ws + WS_WUP), MREAL, FF2, D}; pg8::StaticOrder S; S.init(MREAL, FF2, G, (int)blockIdx.x);
        EpiUp E{(const float*)(ws + WS_SSQ1), p.conv_w, p.conv_b, (bf16_t*)(ws + WS_ACT), (float*)(ws + WS_HALO), (float*)(ws + WS_UPT)};
        pg8::gemm_phase<EpiUp, pg8::StaticOrder, true, true>(lds, g, S, E);
    }
    SEAM(5);
    if (IN(6)) conv_fix(p);
    SEAM(6);
    if (IN(7)) {
        { TIDLANE(); (void)tid; for (int unit = blockIdx.x; unit < 192; unit += G) tail_down_unit3(p, lds, unit, wave, lane); }
        pg8::Gemm g{(const bf16_t*)(ws + WS_ACT), (const bf16_t*)(ws + WS_WDOWN), MREAL, D, FF}; pg8::StaticOrder S; S.init(MREAL, D, G, (int)blockIdx.x, 1);
        EpiDown E{(const bf16_t*)(ws + WS_XG), p.g_norm_ffn, p.g_norm_final, p.out, (float*)(ws + WS_SSQ2)};
        pg8::gemm_phase<EpiDown, pg8::StaticOrder, true, true>(lds, g, S, E);
    }
    if (IN(8)) { TIDLANE(); for (int unit = blockIdx.x; unit < 1024; unit += G) attn_chunk_unit(p, lds, unit, tid, wave, lane); }
    if (IN(9)) { TIDLANE(); for (int unit = blockIdx.x; unit < 512; unit += G) pool_unit(p, lds, unit, tid, wave, lane); }
    if (IN(12)) { TIDLANE(); for (int unit = 512 + blockIdx.x; unit < 521; unit += G) pool_unit(p, lds, unit, tid, wave, lane); }
    if (IN(10)) { TIDLANE(); for (int unit = blockIdx.x; unit < 18; unit += G) attn_small_unit(p, lds, unit, tid, wave, lane); }
    if (IN(11)) { small_outputs(p); }
    if (IN(17)) { pg8::Gemm g{(const bf16_t*)(ws + WS_ACT), (const bf16_t*)(ws + WS_WDOWN), MREAL, D, FF}; pg8::StaticOrder S; S.init(MREAL, D, G, (int)blockIdx.x, 1);
        EpiDown E{(const bf16_t*)(ws + WS_XG), p.g_norm_ffn, p.g_norm_final, p.out, (float*)(ws + WS_SSQ2)};
        pg8::gemm_phase<EpiDown, pg8::StaticOrder, true, true>(lds, g, S, E); }
    if (IN(18)) { TIDLANE(); (void)tid; for (int unit = blockIdx.x; unit < 192; unit += G) tail_down_unit3(p, lds, unit, wave, lane); }
    if (IN(14)) { pg8::Gemm g{(const bf16_t*)(ws + WS_ACT), (const bf16_t*)(ws + WS_WDOWN), MREAL, D, FF}; pg8::StaticOrder S; S.init(MREAL, D, G, (int)blockIdx.x, 1); EpiNull E{(float*)(ws + WS_SSQ1)};
        pg8::gemm_phase<EpiNull, pg8::StaticOrder, true, true>(lds, g, S, E); }
    if (IN(15)) { pg8::Gemm g{(const bf16_t*)(ws + WS_ACT), (const bf16_t*)(ws + WS_WDOWN), MREAL, D, FF}; SamePanelOrder S{G, (int)blockIdx.x, 2}; EpiNull E{(float*)(ws + WS_SSQ1)};
        pg8::gemm_phase<EpiNull, SamePanelOrder, true, true>(lds, g, S, E); }
    if (IN(16)) { pg8::Gemm g{(const bf16_t*)(ws + WS_MIX), (const bf16_t*)(ws + WS_WOUT), MREAL, D, D}; pg8::StaticOrder S; S.init(MREAL, D, G, (int)blockIdx.x); EpiNull E{(float*)(ws + WS_SSQ1)};
        pg8::gemm_phase<EpiNull, pg8::StaticOrder, true, true>(lds, g, S, E); }
#undef IN
#undef SEAM
}

#ifndef MK_N_LAUNCHES
#define MK_N_LAUNCHES 1
#endif
#ifndef PROBE_PHASE
#define PROBE_PHASE -1
#endif
extern "C" void kernel_launch(void* const* d_in, const int* in_sizes, int n_in, void* d_out, int out_size, void* d_ws, size_t ws_size, hipStream_t stream) {
    static int grid = 0;
    if (grid == 0) {
        if (n_in != 24 || (size_t)out_size != O_END || ws_size < WS_END) { fprintf(stderr, "kernel_launch: unexpected shapes: n_in %d out %d ws %zu (need %zu)\n", n_in, out_size, ws_size, (size_t)WS_END); grid = -1; return; }
        int dev = 0, cus = 0, per_cu = 0;
        hipGetDevice(&dev); hipDeviceGetAttribute(&cus, hipDeviceAttributeMultiprocessorCount, dev);
        if (hipFuncSetAttribute((const void*)fwd_megakernel, hipFuncAttributeMaxDynamicSharedMemorySize, LDS_BYTES) != hipSuccess) { fprintf(stderr, "kernel_launch: hipFuncSetAttribute failed\n"); grid = -1; return; }
        if (hipOccupancyMaxActiveBlocksPerMultiprocessor(&per_cu, (const void*)fwd_megakernel, 512, LDS_BYTES) != hipSuccess || per_cu < 1) { fprintf(stderr, "kernel_launch: occupancy query gave %d\n", per_cu); per_cu = 1; }
        (void)hipGetLastError();
        grid = cus;
        fprintf(stderr, "kernel_launch: grid %d (per_cu %d)\n", grid, per_cu);
    }
    if (grid < 0) return;
    Params p{};
    const float** pp = (const float**)&p;
    for (int i = 0; i < 24; ++i) pp[i] = (const float*)d_in[i];
    p.out = (float*)d_out; p.ws = (unsigned char*)d_ws;
    for (int i = 0; i < 32; ++i) p.inv_freq[i] = powf(10000.0f, -(float)i / 32.0f);
    const int NPH = 8;
    int seq[8][2]; int nseq = 0;
    if (PROBE_PHASE >= NPH) { seq[0][0] = 0; seq[0][1] = NPH; seq[1][0] = PROBE_PHASE; seq[1][1] = PROBE_PHASE + 1; nseq = 2; }
    else if (PROBE_PHASE >= 0) { seq[0][0] = 0; seq[0][1] = PROBE_PHASE + 1; seq[1][0] = PROBE_PHASE; seq[1][1] = PROBE_PHASE + 1; nseq = 2; if (PROBE_PHASE + 1 < NPH) { seq[2][0] = PROBE_PHASE + 1; seq[2][1] = NPH; nseq = 3; } }
    else { seq[0][0] = 0; seq[0][1] = NPH; nseq = 1; }
    for (int k = 0; k < nseq; ++k) {
        if (hipMemsetAsync(d_ws, 0, 32768, stream) != hipSuccess) fprintf(stderr, "kernel_launch: memset failed\n");
        p.ph_lo = seq[k][0]; p.ph_hi = seq[k][1];
        void* args[] = {&p}; hipError_t e = hipLaunchCooperativeKernel((const void*)fwd_megakernel, dim3(grid), dim3(512), args, LDS_BYTES, stream);
        if (e != hipSuccess) fprintf(stderr, "kernel_launch: cooperative launch %d failed: %s\n", k, hipGetErrorString(e));
    }
}
```

```cpp
#include <hip/hip_runtime.h>
#include <hip/hip_cooperative_groups.h>
#include <cstdio>
#include <cstdint>
#include <cmath>
namespace cg = cooperative_groups;
namespace pg8 {
#define PG8_LAS __attribute__((address_space(3)))
typedef unsigned short bf16_t;
typedef short bf16x8 __attribute__((ext_vector_type(8)));
typedef float f32x4 __attribute__((ext_vector_type(4)));
typedef unsigned u32x4 __attribute__((ext_vector_type(4)));
constexpr int BM = 256, BK = 64, HALF = 128, HTB = HALF * BK * 2  , STAGE_BYTES = 8 * HTB, NXCD = 8, WGM = 8;

__host__ __device__ __forceinline__ int lds_byte(int r, int c) { const int st = (r >> 4) * 2 + (c >> 5), rr = r & 15, cc = c & 31, ob = rr * 64 + cc * 2; return st * 1024 + (ob ^ (((ob >> 9) & 1) << 5)); }
__host__ __device__ __forceinline__ void stage_rc(int b, int& R, int& C) { const int st = b / 1024, sb = b % 1024, swz = sb ^ (((sb >> 9) & 1) << 5); R = (st >> 1) * 16 + swz / 64; C = (st & 1) * 32 + (swz % 64) / 2; }
__host__ __device__ __forceinline__ int perm32(int rho) { const int n = rho >> 4, i = rho & 15; return 8 * (i >> 2) + 4 * n + (i & 3); }

struct Unit { int pm, pn; };
struct Gemm { const bf16_t* A; const bf16_t* Bt; int M, N, K; };

struct StaticOrder {
    int nM, nN, nwg, G, c, rev;
    __host__ __device__ void init(int M, int N, int G_, int c_, int rev_ = 0) { nM = M / BM; nN = N / BM; nwg = nM * nN; G = G_; c = c_; rev = rev_; }
    __host__ __device__ bool next(int i, Unit& u) const {
        const int nr = (nwg + G - 1) / G;
        if (i >= nr) return false;
        const long L = (long)((rev && nwg % G == 0) ? nr - 1 - i : i) * G + c; if (L >= nwg) return false;
        int wgid = (int)L; { const int q = nwg / NXCD, r = nwg % NXCD, xcd = wgid % NXCD, off = wgid / NXCD; wgid = (xcd < r ? xcd * (q + 1) : r * (q + 1) + (xcd - r) * q) + off; }
        const int nig = WGM * nN, gid = wgid / nig, fm = gid * WGM, gsz = (nM - fm) < WGM ? (nM - fm) : WGM;
        u.pm = fm + ((wgid % nig) % gsz); u.pn = (wgid % nig) / gsz; return true;
    }
    __device__ __forceinline__ void a_ready(const Unit&) const {}
    __device__ __forceinline__ void done(const Unit&) const {}
};

__device__ __forceinline__ unsigned cvt_pk_bf16(float lo, float hi) { unsigned r; asm volatile("v_cvt_pk_bf16_f32 %0, %1, %2" : "=v"(r) : "v"(lo), "v"(hi)); return r; }
template <class Epi, class Sched, bool ALIGN_EPI = false, bool SP2 = false>
__device__ __forceinline__ void gemm_phase(PG8_LAS unsigned char* lds, const Gemm g, const Sched& S, const Epi& E) {
    const int tid = threadIdx.x, wid = __builtin_amdgcn_readfirstlane(tid >> 6), lane = tid & 63, wr = wid >> 2, wc = wid & 3, fr = lane & 15, fq = lane >> 4;
    const int K = g.K, nt = K / BK;
    unsigned voffA[2], voffB[2];
#pragma unroll
    for (int i = 0; i < 2; ++i) { int R, C; stage_rc(tid * 16 + i * 8192, R, C); const int Rb = Epi::PERM ? ((R & ~31) + perm32(R & 31)) : R;
        const int Ra = Epi::APERM ? ((R >> 6) * 128 + (R & 63)) : R;
        voffA[i] = (unsigned)(Ra * K + C) * 2u; voffB[i] = (unsigned)(Rb * K + C) * 2u; }
    const size_t kstep = (size_t)(BK * 2);
    const size_t hstep = (size_t)HALF * K * 2;
    const size_t tstep = 2 * hstep;
    const size_t hstepA = Epi::APERM ? (size_t)64 * K * 2 : hstep;
    const unsigned ldsw = (unsigned)wid * 1024u;
    const int aoff = lds_byte(wr * 64 + fr, fq * 8), boff = lds_byte(wc * 32 + fr, fq * 8);
#define PG8_SA(b, h) (((b) * 2 + (h)) * HTB)
#define PG8_SB(b, h) ((4 + (b) * 2 + (h)) * HTB)
#define PG8_STAGE(bufoff, gbase, voff) do { _Pragma("unroll") for (int _i = 0; _i < 2; ++_i) \
        __builtin_amdgcn_global_load_lds((const unsigned*)((const char*)(gbase) + (voff)[_i]), (PG8_LAS unsigned*)(lds + (bufoff) + ldsw + _i * 8192), 16, 0, 0); } while (0)
#define PG8_LDA(dst, b, h) do { _Pragma("unroll") for (int m = 0; m < 4; ++m) _Pragma("unroll") for (int k = 0; k < 2; ++k) dst[m][k] = *(const PG8_LAS bf16x8*)(lds + PG8_SA(b, h) + aoff + m * 2048 + k * 1024); } while (0)
#define PG8_LDB(dst, b, h) do { _Pragma("unroll") for (int n = 0; n < 2; ++n) _Pragma("unroll") for (int k = 0; k < 2; ++k) dst[n][k] = *(const PG8_LAS bf16x8*)(lds + PG8_SB(b, h) + boff + n * 2048 + k * 1024); } while (0)
#define PG8_MMA(ai, bj, At, Bt) do { __builtin_amdgcn_s_setprio(1); _Pragma("unroll") for (int m = 0; m < 4; ++m) _Pragma("unroll") for (int n = 0; n < 2; ++n) _Pragma("unroll") for (int k = 0; k < 2; ++k) \
        acc[ai][bj][m][n] = __builtin_amdgcn_mfma_f32_16x16x32_bf16(Bt[n][k], At[m][k], acc[ai][bj][m][n], 0, 0, 0); __builtin_amdgcn_s_setprio(0); } while (0)
#define PG8_WAIT_V(n) asm volatile("s_waitcnt vmcnt(" #n ")" ::: "memory")
#define PG8_WAIT_L(n) asm volatile("s_waitcnt lgkmcnt(" #n ")" ::: "memory")
#define PG8_BAR __builtin_amdgcn_s_barrier()
#define PG8_SCHED __builtin_amdgcn_sched_barrier(0)
    Unit cur, nxt; int ui = 0;
    if (!S.next(0, cur)) return;
    f32x4 acc[2][2][4][2];
#pragma unroll
    for (int a = 0; a < 2; ++a)
#pragma unroll
        for (int b = 0; b < 2; ++b)
#pragma unroll
            for (int m = 0; m < 4; ++m)
#pragma unroll
                for (int n = 0; n < 2; ++n) acc[a][b][m][n] = (f32x4){0.f, 0.f, 0.f, 0.f};
    bf16x8 At[4][2], B0[2][2], B1[2][2];
    const char* cA = (const char*)g.A + (size_t)cur.pm * tstep; const char* cB = (const char*)g.Bt + (size_t)cur.pn * tstep;
    S.a_ready(cur);
    if constexpr (SP2) {
        PG8_STAGE(PG8_SB(0, 0), cB, voffB); PG8_STAGE(PG8_SB(0, 1), cB + hstep, voffB); PG8_STAGE(PG8_SA(0, 0), cA, voffA); PG8_STAGE(PG8_SA(0, 1), cA + hstepA, voffA);
        if (wr == 1) PG8_BAR;
        PG8_WAIT_V(2); PG8_BAR;
        PG8_STAGE(PG8_SB(1, 0), cB + kstep, voffB); PG8_STAGE(PG8_SA(1, 0), cA + kstep, voffA); PG8_STAGE(PG8_SB(1, 1), cB + hstep + kstep, voffB);
        PG8_WAIT_V(6); PG8_BAR;
    } else {
        PG8_STAGE(PG8_SB(0, 0), cB, voffB); PG8_STAGE(PG8_SA(0, 0), cA, voffA); PG8_STAGE(PG8_SB(0, 1), cB + hstep, voffB); PG8_STAGE(PG8_SA(0, 1), cA + hstepA, voffA);
        if (wr == 1) PG8_BAR;
        PG8_WAIT_V(4); PG8_BAR;
        PG8_STAGE(PG8_SB(1, 0), cB + kstep, voffB); PG8_STAGE(PG8_SA(1, 0), cA + kstep, voffA); PG8_STAGE(PG8_SB(1, 1), cB + hstep + kstep, voffB);
        PG8_WAIT_V(6); PG8_BAR;
    }
    for (;;) {
        const bool has_next = S.next(ui + 1, nxt);
        const char* nA = has_next ? (const char*)g.A + (size_t)nxt.pm * tstep : cA; const char* nB = has_next ? (const char*)g.Bt + (size_t)nxt.pn * tstep : cB;
        for (int t = 0; t < nt; t += 2) {
            const bool last = (t == nt - 2);
            const char* a1 = cA + (size_t)(t + 1) * kstep;
            const char* a2 = last ? nA : cA + (size_t)(t + 2) * kstep; const char* b2 = last ? nB : cB + (size_t)(t + 2) * kstep;
            const char* a3 = a2 + kstep; const char* b3 = b2 + kstep;
            if (last && has_next) S.a_ready(nxt);
            if constexpr (SP2) {
            PG8_LDB(B0, 0, 0); PG8_LDB(B1, 0, 1); PG8_SCHED; PG8_LDA(At, 0, 0); PG8_STAGE(PG8_SA(1, 1), a1 + hstepA, voffA);
            PG8_WAIT_V(8); PG8_WAIT_L(0); PG8_BAR; PG8_MMA(0, 0, At, B0); PG8_MMA(0, 1, At, B1); PG8_BAR; PG8_SCHED;
            PG8_LDA(At, 0, 1); PG8_STAGE(PG8_SB(0, 0), b2, voffB); PG8_STAGE(PG8_SB(0, 1), b2 + hstep, voffB); PG8_STAGE(PG8_SA(0, 0), a2, voffA);
            PG8_WAIT_V(8); PG8_WAIT_L(0); PG8_BAR; PG8_MMA(1, 0, At, B0); PG8_MMA(1, 1, At, B1); PG8_BAR; PG8_SCHED;
            PG8_LDB(B0, 1, 0); PG8_LDB(B1, 1, 1); PG8_SCHED; PG8_LDA(At, 1, 0); PG8_STAGE(PG8_SA(0, 1), a2 + hstepA, voffA);
            PG8_WAIT_V(8); PG8_WAIT_L(0); PG8_BAR; PG8_MMA(0, 0, At, B0); PG8_MMA(0, 1, At, B1); PG8_BAR; PG8_SCHED;
            PG8_LDA(At, 1, 1); PG8_STAGE(PG8_SB(1, 0), b3, voffB); PG8_STAGE(PG8_SB(1, 1), b3 + hstep, voffB); PG8_STAGE(PG8_SA(1, 0), a3, voffA);
            PG8_WAIT_V(8); PG8_WAIT_L(0); PG8_BAR; PG8_MMA(1, 0, At, B0); PG8_MMA(1, 1, At, B1); PG8_BAR; PG8_SCHED;
            } else {
            PG8_LDB(B0, 0, 0); PG8_SCHED; PG8_LDA(At, 0, 0); PG8_STAGE(PG8_SA(1, 1), a1 + hstepA, voffA);
            PG8_WAIT_L(8); PG8_BAR; PG8_WAIT_L(0); PG8_MMA(0, 0, At, B0); PG8_BAR; PG8_SCHED;
            PG8_LDB(B1, 0, 1); PG8_STAGE(PG8_SB(0, 0), b2, voffB);
            PG8_BAR; PG8_WAIT_L(0); PG8_MMA(0, 1, At, B1); PG8_BAR;
            PG8_LDA(At, 0, 1); PG8_STAGE(PG8_SA(0, 0), a2, voffA);
            PG8_BAR; PG8_WAIT_L(0); PG8_MMA(1, 0, At, B0); PG8_BAR; PG8_SCHED;
            PG8_STAGE(PG8_SB(0, 1), b2 + hstep, voffB);
            PG8_WAIT_V(6); PG8_BAR; PG8_MMA(1, 1, At, B1); PG8_BAR;
            PG8_LDB(B0, 1, 0); PG8_SCHED; PG8_LDA(At, 1, 0); PG8_STAGE(PG8_SA(0, 1), a2 + hstepA, voffA);
            PG8_WAIT_L(8); PG8_BAR; PG8_WAIT_L(0); PG8_MMA(0, 0, At, B0); PG8_BAR; PG8_SCHED;
            PG8_LDB(B1, 1, 1); PG8_STAGE(PG8_SB(1, 0), b3, voffB);
            PG8_BAR; PG8_WAIT_L(0); PG8_MMA(0, 1, At, B1); PG8_BAR;
            PG8_LDA(At, 1, 1); PG8_STAGE(PG8_SA(1, 0), a3, voffA);
            PG8_BAR; PG8_WAIT_L(0); PG8_MMA(1, 0, At, B0); PG8_BAR; PG8_SCHED;
            PG8_STAGE(PG8_SB(1, 1), b3 + hstep, voffB);
            PG8_WAIT_V(6); PG8_BAR; PG8_MMA(1, 1, At, B1); PG8_BAR;
            }
        }
        if constexpr (ALIGN_EPI) { if (wr == 0) PG8_BAR; }
        if constexpr (!Epi::AFTER_DRAIN) { E(acc, cur, wr, wc, fr, fq); S.done(cur); }
        if (!has_next) break;
#pragma unroll
        for (int a = 0; a < 2; ++a)
#pragma unroll
            for (int b = 0; b < 2; ++b)
#pragma unroll
                for (int m = 0; m < 4; ++m)
#pragma unroll
                    for (int n = 0; n < 2; ++n) acc[a][b][m][n] = (f32x4){0.f, 0.f, 0.f, 0.f};
        cur = nxt; cA = nA; cB = nB; ++ui;
        if constexpr (ALIGN_EPI) { if (wr == 1) PG8_BAR; }
    }
    PG8_WAIT_V(0);
    if constexpr (!ALIGN_EPI) { if (wr == 0) PG8_BAR; }
    PG8_BAR;
    if constexpr (Epi::AFTER_DRAIN) { E.fused(acc, cur, wr, wc, fr, fq, lds, wid, lane); S.done(cur); }
#undef PG8_SA
#undef PG8_SB
#undef PG8_STAGE
#undef PG8_LDA
#undef PG8_LDB
#undef PG8_MMA
#undef PG8_WAIT_V
#undef PG8_WAIT_L
#undef PG8_BAR
#undef PG8_SCHED
}
}

using pg8::bf16_t; using pg8::bf16x8; using pg8::f32x4; using pg8::u32x4; using pg8::Unit;
#define LAS __attribute__((address_space(3)))
typedef float f32x2v __attribute__((ext_vector_type(2)));
typedef __bf16 bf16x2v __attribute__((ext_vector_type(2)));
typedef unsigned u32x2 __attribute__((ext_vector_type(2)));

constexpr int D = 1024, NBATCH = 8, SEQ = 4096;
constexpr int MREAL = NBATCH * SEQ;
constexpr int ROW_META = MREAL;
constexpr int ROW_SAMP = MREAL + 16;
constexpr int ROW_PAD = ROW_SAMP + 128;
constexpr int M = MREAL + 256;
constexpr int INW = 3840, FF = 2816, FF2 = 5632, PW = 512;
constexpr float RMS_EPS = 1e-6f;
constexpr int NPOS = 4112;

constexpr size_t MiB = 1u << 20;
constexpr size_t WS_ROPE = 1 * MiB, WS_SSQ1 = 3 * MiB, WS_SSQ2 = 6 * MiB;
constexpr size_t WS_WIN = 9 * MiB, WS_WAO = 17 * MiB, WS_WPO = 19 * MiB, WS_WOUT = 20 * MiB, WS_WUP = 22 * MiB, WS_WDOWN = 33 * MiB, WS_WGRP = 39 * MiB;
constexpr size_t WS_XN = 40 * MiB, WS_MIX = 105 * MiB  , WS_HALO = 40 * MiB, WS_UPT = 84 * MiB;
constexpr size_t WS_R0I = 64 * 1024;
constexpr size_t WS_Q = 105 * MiB, WS_K = 170 * MiB, WS_V = 179 * MiB, WS_P = 188 * MiB, WS_GA = 221 * MiB, WS_GP = 286 * MiB, WS_ATT = 351 * MiB, WS_POOL = 416 * MiB;
constexpr size_t WS_X1 = 105 * MiB, WS_XG = 234 * MiB, WS_ACT = 299 * MiB, WS_END = 477 * MiB;

constexpr int LDS_BYTES = 147456;

struct Params {
    const float *x_prompt, *x_sample, *cache_swa_k, *cache_swa_v, *cache_meta_k, *cache_meta_v, *state_pool, *state_conv, *meta_tokens, *g_norm_mix, *w_in, *b_gate, *sinks,
        *w_attn_o, *w_pool_grp, *pool_scale, *w_pool_o, *w_out, *g_norm_ffn, *w_up, *conv_w, *conv_b, *w_down, *g_norm_final;
    float* out; unsigned char* ws;
    float inv_freq[32];
    int ph_lo, ph_hi;
};
constexpr size_t O_YP = 0, O_YS = O_YP + (size_t)MREAL * D, O_PSK = O_YS + 128 * D, O_PSV = O_PSK + 131072, O_KM = O_PSV + 131072, O_VM = O_KM + 16384,
    O_PPOOL = O_VM + 16384, O_PCONV = O_PPOOL + 61440, O_SSK = O_PCONV + 90112, O_SSV = O_SSK + 16384, O_SPOOL = O_SSV + 16384, O_SCONV = O_SPOOL + 61440, O_END = O_SCONV + 90112;

__device__ __forceinline__ unsigned pk2(float lo, float hi) { f32x2v v = {lo, hi}; bf16x2v b = __builtin_convertvector(v, bf16x2v); return __builtin_bit_cast(unsigned, b); }
__device__ __forceinline__ float bf_lo(unsigned u) { return __uint_as_float(u << 16); }
__device__ __forceinline__ float bf_hi(unsigned u) { return __uint_as_float(u & 0xffff0000u); }
__device__ __forceinline__ float bf1(bf16_t h) { return __uint_as_float((unsigned)h << 16); }
__device__ __forceinline__ int row_pos(int r) {
    if (r < MREAL) return 16 + (r & 4095);
    if (r < ROW_SAMP) return r - ROW_META;
    if (r < ROW_PAD) return 16 + 1024 + ((r - ROW_SAMP) & 15);
    return 0;
}
__device__ __forceinline__ const float* row_x(const float* xp, const float* mt, const float* xs, int r) {
    if (r < MREAL) return xp + (size_t)r * D;
    if (r < ROW_SAMP) return mt + (size_t)(r - ROW_META) * D;
    if (r < ROW_PAD) return xs + (size_t)(r - ROW_SAMP) * D;
    return nullptr;
}
__device__ __forceinline__ float wave_sum(float v) {
#pragma unroll
    for (int o = 1; o < 64; o <<= 1) v += __shfl_xor(v, o);
    return v;
}
__device__ __forceinline__ float sigmoidf_(float x) { return __builtin_amdgcn_rcpf(1.0f + __builtin_amdgcn_exp2f(x * -1.4426950408889634f)); }

struct EpiZ {
    static constexpr bool PERM = true, AFTER_DRAIN = false, APERM = false;
    bf16_t *Q, *Kb, *Vb, *Pb, *GA, *GP; const float* b_gate; const float* rope;
    __device__ __forceinline__ void operator()(const f32x4 (&acc)[2][2][4][2], const Unit& u, int wr, int wc, int fr_in, int fq_in) const {
        int fr = fr_in, fq = fq_in; asm volatile("" : "+v"(fr), "+v"(fq));
        const int pn = u.pn, cw = wc * 32 + 8 * fq;
        if (pn < 4) {
#pragma unroll
            for (int ai = 0; ai < 2; ++ai) {
                f32x4 t[4][2][2];
#pragma unroll
                for (int m = 0; m < 4; ++m) {
                    const int row = u.pm * 256 + ai * 128 + wr * 64 + m * 16 + fr; const int pos = row_pos(row);
#pragma unroll
                    for (int bj = 0; bj < 2; ++bj) { const f32x4* tp = (const f32x4*)(rope + ((size_t)pos * 32 + (((bj * 128 + cw) & 63) >> 1)) * 2); t[m][bj][0] = tp[0]; t[m][bj][1] = tp[1]; }
                }
#pragma unroll
                for (int m = 0; m < 4; ++m) {
                    const int row = u.pm * 256 + ai * 128 + wr * 64 + m * 16 + fr;
#pragma unroll
                    for (int bj = 0; bj < 2; ++bj) {
                        const f32x4 v0 = acc[ai][bj][m][0], v1 = acc[ai][bj][m][1], t0 = t[m][bj][0], t1 = t[m][bj][1];
                        u32x4 w;
                        w.x = pk2(v0[0] * t0[0] - v0[1] * t0[1], v0[1] * t0[0] + v0[0] * t0[1]); w.y = pk2(v0[2] * t0[2] - v0[3] * t0[3], v0[3] * t0[2] + v0[2] * t0[3]);
                        w.z = pk2(v1[0] * t1[0] - v1[1] * t1[1], v1[1] * t1[0] + v1[0] * t1[1]); w.w = pk2(v1[2] * t1[2] - v1[3] * t1[3], v1[3] * t1[2] + v1[2] * t1[3]);
                        *(u32x4*)(Q + (size_t)row * 1024 + pn * 256 + bj * 128 + cw) = w;
                    }
                }
            }
        } else if (pn == 4) {
            f32x4 t[2][4][2];
#pragma unroll
            for (int ai = 0; ai < 2; ++ai)
#pragma unroll
                for (int m = 0; m < 4; ++m) {
                    const int row = u.pm * 256 + ai * 128 + wr * 64 + m * 16 + fr; const int pos = row_pos(row);
                    const f32x4* tp = (const f32x4*)(rope + ((size_t)pos * 32 + ((cw & 63) >> 1)) * 2); t[ai][m][0] = tp[0]; t[ai][m][1] = tp[1];
                }
#pragma unroll
            for (int ai = 0; ai < 2; ++ai)
#pragma unroll
                for (int m = 0; m < 4; ++m) {
                    const int row = u.pm * 256 + ai * 128 + wr * 64 + m * 16 + fr;
                    { const f32x4 v0 = acc[ai][0][m][0], v1 = acc[ai][0][m][1], t0 = t[ai][m][0], t1 = t[ai][m][1];
                      u32x4 w;
                      w.x = pk2(v0[0] * t0[0] - v0[1] * t0[1], v0[1] * t0[0] + v0[0] * t0[1]); w.y = pk2(v0[2] * t0[2] - v0[3] * t0[3], v0[3] * t0[2] + v0[2] * t0[3]);
                      w.z = pk2(v1[0] * t1[0] - v1[1] * t1[1], v1[1] * t1[0] + v1[0] * t1[1]); w.w = pk2(v1[2] * t1[2] - v1[3] * t1[3], v1[3] * t1[2] + v1[2] * t1[3]);
                      *(u32x4*)(Kb + (size_t)row * 128 + cw) = w; }
                    { const f32x4 v0 = acc[ai][1][m][0], v1 = acc[ai][1][m][1];
                      u32x4 w; w.x = pk2(v0[0], v0[1]); w.y = pk2(v0[2], v0[3]); w.z = pk2(v1[0], v1[1]); w.w = pk2(v1[2], v1[3]);
                      *(u32x4*)(Vb + (size_t)row * 128 + cw) = w; }
                }
        } else if (pn < 7) {
#pragma unroll
            for (int ai = 0; ai < 2; ++ai)
#pragma unroll
                for (int m = 0; m < 4; ++m) {
                    const int row = u.pm * 256 + ai * 128 + wr * 64 + m * 16 + fr;
#pragma unroll
                    for (int bj = 0; bj < 2; ++bj) {
                        const f32x4 v0 = acc[ai][bj][m][0], v1 = acc[ai][bj][m][1];
                        u32x4 w; w.x = pk2(v0[0], v0[1]); w.y = pk2(v0[2], v0[3]); w.z = pk2(v1[0], v1[1]); w.w = pk2(v1[2], v1[3]);
                        *(u32x4*)(Pb + (size_t)row * 512 + (pn - 5) * 256 + bj * 128 + cw) = w;
                    }
                }
        } else {
            const int gc = pn * 256 - 1792 + cw;
            f32x4 b[2][2];
#pragma unroll
            for (int bj = 0; bj < 2; ++bj) { b[bj][0] = *(const f32x4*)(b_gate + gc + bj * 128); b[bj][1] = *(const f32x4*)(b_gate + gc + bj * 128 + 4); }
            bf16_t* dstb = (pn < 11) ? GA + gc : GP + (gc - 1024);
#pragma unroll
            for (int ai = 0; ai < 2; ++ai)
#pragma unroll
                for (int m = 0; m < 4; ++m) {
                    const int row = u.pm * 256 + ai * 128 + wr * 64 + m * 16 + fr;
#pragma unroll
                    for (int bj = 0; bj < 2; ++bj) {
                        f32x4 v0 = acc[ai][bj][m][0] + b[bj][0], v1 = acc[ai][bj][m][1] + b[bj][1];
#pragma unroll
                        for (int i = 0; i < 4; ++i) { v0[i] = sigmoidf_(v0[i]); v1[i] = sigmoidf_(v1[i]); }
                        u32x4 w; w.x = pk2(v0[0], v0[1]); w.y = pk2(v0[2], v0[3]); w.z = pk2(v1[0], v1[1]); w.w = pk2(v1[2], v1[3]);
                        __builtin_nontemporal_store(w, (u32x4*)(dstb + (size_t)row * 1024 + bj * 128));
                    }
                }
        }
    }
};
struct EpiT1 {
    static constexpr bool PERM = true, AFTER_DRAIN = false, APERM = false;
    const bf16_t* G; bf16_t* O;
    __device__ __forceinline__ void operator()(const f32x4 (&acc)[2][2][4][2], const Unit& u, int wr, int wc, int fr_in, int fq_in) const {
        int fr = fr_in, fq = fq_in; asm volatile("" : "+v"(fr), "+v"(fq));
        const size_t base = (size_t)(u.pm * 256 + wr * 64 + fr) * 1024 + u.pn * 256 + wc * 32 + 8 * fq;
        u32x4 g[2][4][2];
#pragma unroll
        for (int ai = 0; ai < 2; ++ai)
#pragma unroll
            for (int m = 0; m < 4; ++m)
#pragma unroll
                for (int bj = 0; bj < 2; ++bj) g[ai][m][bj] = __builtin_nontemporal_load((const u32x4*)(G + base + (size_t)(ai * 128 + m * 16) * 1024 + bj * 128));
#pragma unroll
        for (int ai = 0; ai < 2; ++ai)
#pragma unroll
            for (int m = 0; m < 4; ++m)
#pragma unroll
                for (int bj = 0; bj < 2; ++bj) {
                    const u32x4 gg = g[ai][m][bj]; const f32x4 v0 = acc[ai][bj][m][0], v1 = acc[ai][bj][m][1];
                    u32x4 w; w.x = pk2(v0[0] * bf_lo(gg.x), v0[1] * bf_hi(gg.x)); w.y = pk2(v0[2] * bf_lo(gg.y), v0[3] * bf_hi(gg.y));
                    w.z = pk2(v1[0] * bf_lo(gg.z), v1[1] * bf_hi(gg.z)); w.w = pk2(v1[2] * bf_lo(gg.w), v1[3] * bf_hi(gg.w));
                    *(u32x4*)(O + base + (size_t)(ai * 128 + m * 16) * 1024 + bj * 128) = w;
                }
    }
};
struct EpiMix {
    static constexpr bool PERM = true, AFTER_DRAIN = false, APERM = false;
    const bf16_t* G; bf16_t* O;
    __device__ __forceinline__ void operator()(const f32x4 (&acc)[2][2][4][2], const Unit& u, int wr, int wc, int fr_in, int fq_in) const {
        int fr = fr_in, fq = fq_in; asm volatile("" : "+v"(fr), "+v"(fq));
        const size_t base = (size_t)(u.pm * 256 + wr * 64 + fr) * 1024 + u.pn * 256 + wc * 32 + 8 * fq;
#pragma unroll
        for (int ai = 0; ai < 2; ++ai) {
            u32x4 g[4][2], t[4][2];
#pragma unroll
            for (int m = 0; m < 4; ++m)
#pragma unroll
                for (int bj = 0; bj < 2; ++bj) { g[m][bj] = __builtin_nontemporal_load((const u32x4*)(G + base + (size_t)(ai * 128 + m * 16) * 1024 + bj * 128)); t[m][bj] = *(const u32x4*)(O + base + (size_t)(ai * 128 + m * 16) * 1024 + bj * 128); }
#pragma unroll
            for (int m = 0; m < 4; ++m)
#pragma unroll
                for (int bj = 0; bj < 2; ++bj) {
                    const u32x4 gg = g[m][bj], tt = t[m][bj]; const f32x4 v0 = acc[ai][bj][m][0], v1 = acc[ai][bj][m][1];
                    u32x4 w; w.x = pk2(bf_lo(tt.x) + v0[0] * bf_lo(gg.x), bf_hi(tt.x) + v0[1] * bf_hi(gg.x)); w.y = pk2(bf_lo(tt.y) + v0[2] * bf_lo(gg.y), bf_hi(tt.y) + v0[3] * bf_hi(gg.y));
                    w.z = pk2(bf_lo(tt.z) + v1[0] * bf_lo(gg.z), bf_hi(tt.z) + v1[1] * bf_hi(gg.z)); w.w = pk2(bf_lo(tt.w) + v1[2] * bf_lo(gg.w), bf_hi(tt.w) + v1[3] * bf_hi(gg.w));
                    *(u32x4*)(O + base + (size_t)(ai * 128 + m * 16) * 1024 + bj * 128) = w;
                }
        }
    }
};
struct EpiX1 {
    static constexpr bool PERM = true, AFTER_DRAIN = false, APERM = false;
    const bf16_t* XN; const float *r0i, *gmix, *gffn; bf16_t* XG; float* ssq;
    __device__ __forceinline__ void operator()(const f32x4 (&acc)[2][2][4][2], const Unit& u, int wr, int wc, int fr_in, int fq_in) const {
        int fr = fr_in, fq = fq_in; asm volatile("" : "+v"(fr), "+v"(fq));
        const int col0 = u.pn * 256 + wc * 32 + 8 * fq;
        f32x4 g[2][2], ig[2][2];
#pragma unroll
        for (int bj = 0; bj < 2; ++bj)
#pragma unroll
            for (int hh = 0; hh < 2; ++hh) { g[bj][hh] = *(const f32x4*)(gffn + col0 + bj * 128 + 4 * hh); const f32x4 gm = *(const f32x4*)(gmix + col0 + bj * 128 + 4 * hh);
#pragma unroll
                for (int i = 0; i < 4; ++i) ig[bj][hh][i] = __builtin_amdgcn_rcpf(gm[i]); }
#pragma unroll
        for (int ai = 0; ai < 2; ++ai) {
            u32x4 xn[4][2]; float ri[4];
#pragma unroll
            for (int m = 0; m < 4; ++m) {
                const int row = u.pm * 256 + ai * 128 + wr * 64 + m * 16 + fr;
                ri[m] = r0i[row];
#pragma unroll
                for (int bj = 0; bj < 2; ++bj) xn[m][bj] = *(const u32x4*)(XN + (size_t)row * 1024 + col0 + bj * 128);
            }
#pragma unroll
            for (int m = 0; m < 4; ++m) {
                const int row = u.pm * 256 + ai * 128 + wr * 64 + m * 16 + fr;
                const float rr = ri[m];
                float ss = 0.f;
#pragma unroll
                for (int bj = 0; bj < 2; ++bj) {
                    const u32x4 q = xn[m][bj];
                    f32x4 x0, x1;
                    x0[0] = bf_lo(q.x) * rr * ig[bj][0][0]; x0[1] = bf_hi(q.x) * rr * ig[bj][0][1]; x0[2] = bf_lo(q.y) * rr * ig[bj][0][2]; x0[3] = bf_hi(q.y) * rr * ig[bj][0][3];
                    x1[0] = bf_lo(q.z) * rr * ig[bj][1][0]; x1[1] = bf_hi(q.z) * rr * ig[bj][1][1]; x1[2] = bf_lo(q.w) * rr * ig[bj][1][2]; x1[3] = bf_hi(q.w) * rr * ig[bj][1][3];
                    const f32x4 v0 = acc[ai][bj][m][0] + x0, v1 = acc[ai][bj][m][1] + x1, g0 = g[bj][0], g1 = g[bj][1];
                    u32x4 w; w.x = pk2(v0[0] * g0[0], v0[1] * g0[1]); w.y = pk2(v0[2] * g0[2], v0[3] * g0[3]); w.z = pk2(v1[0] * g1[0], v1[1] * g1[1]); w.w = pk2(v1[2] * g1[2], v1[3] * g1[3]);
                    *(u32x4*)(XG + (size_t)row * 1024 + col0 + bj * 128) = w;
                    ss += (v0[0] * v0[0] + v0[1] * v0[1]) + (v0[2] * v0[2] + v0[3] * v0[3]) + (v1[0] * v1[0] + v1[1] * v1[1]) + (v1[2] * v1[2] + v1[3] * v1[3]);
                }
                ss += __shfl_xor(ss, 16); ss += __shfl_xor(ss, 32);
                if (fq == 0) ssq[(size_t)row * 16 + u.pn * 4 + wc] = ss;
            }
        }
    }
};
__device__ __forceinline__ float ror1(float x) { return __builtin_bit_cast(float, __builtin_amdgcn_mov_dpp(__builtin_bit_cast(int, x), 0x121, 0xf, 0xf, false)); }
__device__ __forceinline__ float ror2(float x) { return __builtin_bit_cast(float, __builtin_amdgcn_mov_dpp(__builtin_bit_cast(int, x), 0x122, 0xf, 0xf, false)); }
__device__ __forceinline__ float shr1(float old, float x) { return __builtin_bit_cast(float, __builtin_amdgcn_update_dpp(__builtin_bit_cast(int, old), __builtin_bit_cast(int, x), 0x111, 0xf, 0xf, false)); }
__device__ __forceinline__ float shr2(float old, float x) { return __builtin_bit_cast(float, __builtin_amdgcn_update_dpp(__builtin_bit_cast(int, old), __builtin_bit_cast(int, x), 0x112, 0xf, 0xf, false)); }
struct EpiUp {
    static constexpr bool PERM = true, AFTER_DRAIN = false, APERM = true;
    const float *ssq, *cw, *cb; bf16_t* ACT; float* HALO; float* UPT;
    __device__ __forceinline__ void operator()(const f32x4 (&acc)[2][2][4][2], const Unit& u, int wr, int wc, int fr_in, int fq_in) const {
        int fr = fr_in, fq = fq_in; asm volatile("" : "+v"(fr), "+v"(fq));
        const int jb = u.pn * 128 + wc * 32 + 8 * fq;
        const int row0 = u.pm * 256 + wr * 128 + fr;
        float r1[2][4];
#pragma unroll
        for (int ai = 0; ai < 2; ++ai)
#pragma unroll
            for (int m = 0; m < 4; ++m) {
                const f32x4* sp = (const f32x4*)(ssq + (size_t)(row0 + ai * 64 + m * 16) * 16);
                const f32x4 a = sp[0], b = sp[1], c = sp[2], d = sp[3];
                const float s = ((a[0] + a[1]) + (a[2] + a[3])) + ((b[0] + b[1]) + (b[2] + b[3])) + ((c[0] + c[1]) + (c[2] + c[3])) + ((d[0] + d[1]) + (d[2] + d[3]));
                r1[ai][m] = rsqrtf(s * (1.0f / 1024.0f) + RMS_EPS);
            }
#pragma unroll
        for (int ai = 0; ai < 2; ++ai)
#pragma unroll
            for (int m = 0; m < 4; ++m) asm volatile("" : "+v"(r1[ai][m]));
        __builtin_amdgcn_sched_barrier(0);
        const int slab = u.pm * 2 + wr;
#pragma unroll
        for (int n = 0; n < 2; ++n) {
            int jg = jb + 4 * n; asm volatile("" : "+v"(jg) :: "memory");
            const f32x4 w0g = *(const f32x4*)(cw + jg), w1g = *(const f32x4*)(cw + FF2 + jg), w2g = *(const f32x4*)(cw + 2 * FF2 + jg), bg = *(const f32x4*)(cb + jg);
            const f32x4 w0v = *(const f32x4*)(cw + FF + jg), w1v = *(const f32x4*)(cw + FF2 + FF + jg), w2v = *(const f32x4*)(cw + 2 * FF2 + FF + jg), bv = *(const f32x4*)(cb + FF + jg);
            f32x4 pg = {0.f, 0.f, 0.f, 0.f}, pv = {0.f, 0.f, 0.f, 0.f};
#pragma unroll
            for (int ai = 0; ai < 2; ++ai) {
#pragma unroll
                for (int m = 0; m < 4; ++m) {
                    const int row = row0 + ai * 64 + m * 16;
                    const f32x4 ug = acc[ai][0][m][n] * r1[ai][m], uv = acc[ai][1][m][n] * r1[ai][m];
                    const bool first = (ai == 0 && m == 0), last = (ai == 1 && m == 3);
                    if (first && fr < 2) { *(f32x4*)(HALO + (size_t)(slab * 4 + fr) * FF2 + jg) = ug; *(f32x4*)(HALO + (size_t)(slab * 4 + fr) * FF2 + FF + jg) = uv; }
                    if (last && fr >= 14) { *(f32x4*)(HALO + (size_t)(slab * 4 + fr - 12) * FF2 + jg) = ug; *(f32x4*)(HALO + (size_t)(slab * 4 + fr - 12) * FF2 + FF + jg) = uv; }
                    f32x4 g1, g2, v1, v2;
#pragma unroll
                    for (int i = 0; i < 4; ++i) {
                        g1[i] = shr1(ror1(pg[i]), ug[i]); g2[i] = shr2(ror2(pg[i]), ug[i]);
                        v1[i] = shr1(ror1(pv[i]), uv[i]); v2[i] = shr2(ror2(pv[i]), uv[i]);
                    }
                    const f32x4 cg = bg + w0g * g2 + w1g * g1 + w2g * ug;
                    const f32x4 cv = bv + w0v * v2 + w1v * v1 + w2v * uv;
                    float a[4];
#pragma unroll
                    for (int i = 0; i < 4; ++i) a[i] = cg[i] * sigmoidf_(cg[i]) * cv[i];
                    if (!(first && fr < 2)) { u32x2 w; w.x = pk2(a[0], a[1]); w.y = pk2(a[2], a[3]); *(u32x2*)(ACT + (size_t)row * FF + jg) = w; }
                    pg = ug; pv = uv;
                }
            }
        }
    }
};
constexpr size_t WS_PCNT = 8 * MiB + 768 * 1024;
#define AG_LD(p) __hip_atomic_load((p), __ATOMIC_RELAXED, __HIP_MEMORY_SCOPE_AGENT)
#define AG_ST(p, v) __hip_atomic_store((p), (v), __ATOMIC_RELAXED, __HIP_MEMORY_SCOPE_AGENT)
struct EpiDown {
    static constexpr bool PERM = true, AFTER_DRAIN = false, APERM = false;
    const bf16_t* XG; const float* gffn; const float* gfin; float* out; float* ssq;
    __device__ __forceinline__ void operator()(const f32x4 (&acc_c)[2][2][4][2], const Unit& u, int wr, int wc, int fr_in, int fq_in) const {
        int fr = fr_in, fq = fq_in; asm volatile("" : "+v"(fr), "+v"(fq));
        f32x4 (&acc)[2][2][4][2] = const_cast<f32x4 (&)[2][2][4][2]>(acc_c);
        const int col0 = u.pn * 256 + wc * 32 + 8 * fq;
        f32x4 ig[2][2];
#pragma unroll
        for (int bj = 0; bj < 2; ++bj)
#pragma unroll
            for (int hh = 0; hh < 2; ++hh) { const f32x4 gg = *(const f32x4*)(gffn + col0 + bj * 128 + 4 * hh);
#pragma unroll
                for (int i = 0; i < 4; ++i) ig[bj][hh][i] = __builtin_amdgcn_rcpf(gg[i]); }
#pragma unroll
        for (int ai = 0; ai < 2; ++ai) {
            u32x4 xgv[4][2];
#pragma unroll
            for (int m = 0; m < 4; ++m)
#pragma unroll
                for (int bj = 0; bj < 2; ++bj) xgv[m][bj] = __builtin_nontemporal_load((const u32x4*)(XG + (size_t)(u.pm * 256 + ai * 128 + wr * 64 + m * 16 + fr) * 1024 + col0 + bj * 128));
#pragma unroll
            for (int m = 0; m < 4; ++m) {
                const int row = u.pm * 256 + ai * 128 + wr * 64 + m * 16 + fr;
                float ss = 0.f;
#pragma unroll
                for (int bj = 0; bj < 2; ++bj) {
                    const u32x4 xg = xgv[m][bj];
                    f32x4 x0, x1;
                    x0[0] = bf_lo(xg.x) * ig[bj][0][0]; x0[1] = bf_hi(xg.x) * ig[bj][0][1]; x0[2] = bf_lo(xg.y) * ig[bj][0][2]; x0[3] = bf_hi(xg.y) * ig[bj][0][3];
                    x1[0] = bf_lo(xg.z) * ig[bj][1][0]; x1[1] = bf_hi(xg.z) * ig[bj][1][1]; x1[2] = bf_lo(xg.w) * ig[bj][1][2]; x1[3] = bf_hi(xg.w) * ig[bj][1][3];
                    const f32x4 v0 = acc[ai][bj][m][0] + x0, v1 = acc[ai][bj][m][1] + x1;
                    acc[ai][bj][m][0] = v0; acc[ai][bj][m][1] = v1;
                    ss += (v0[0] * v0[0] + v0[1] * v0[1]) + (v0[2] * v0[2] + v0[3] * v0[3]) + (v1[0] * v1[0] + v1[1] * v1[1]) + (v1[2] * v1[2] + v1[3] * v1[3]);
                }
                ss += __shfl_xor(ss, 16); ss += __shfl_xor(ss, 32);
                if (fq == 0) AG_ST(ssq + (size_t)row * 16 + u.pn * 4 + wc, ss);
            }
        }
        asm volatile("s_waitcnt vmcnt(0)" ::: "memory");
        unsigned* pc = (unsigned*)((char*)ssq + (WS_PCNT - WS_SSQ2)) + 64 * u.pm;
        if (fr == 0 && fq == 0) __hip_atomic_fetch_add(pc, 1u, __ATOMIC_RELAXED, __HIP_MEMORY_SCOPE_AGENT);
        for (int tries = 0; tries < (1 << 18); ++tries) {
            const unsigned c = (unsigned)__builtin_amdgcn_readfirstlane((int)AG_LD(pc));
            if (c >= 32u) break;
            __builtin_amdgcn_s_sleep(2);
        }
        float rs[2][4];
        {
            float* spb = ssq + (size_t)(u.pm * 256 + wr * 64 + fr) * 16 + 4 * fq;
#pragma unroll
            for (int ai = 0; ai < 2; ++ai)
#pragma unroll
                for (int m = 0; m < 4; ++m) {
                    float* sp = spb + (ai * 128 + m * 16) * 16;
                    const float a = AG_LD(sp), b = AG_LD(sp + 1), c = AG_LD(sp + 2), d = AG_LD(sp + 3);
                    rs[ai][m] = (a + b) + (c + d);
                }
        }
#pragma unroll
        for (int ai = 0; ai < 2; ++ai)
#pragma unroll
            for (int m = 0; m < 4; ++m) {
                const int row = u.pm * 256 + ai * 128 + wr * 64 + m * 16 + fr;
                float s = rs[ai][m]; s += __shfl_xor(s, 16); s += __shfl_xor(s, 32);
                const float r = rsqrtf(s * (1.0f / 1024.0f) + RMS_EPS);
                float* orow = out + O_YP + (size_t)row * D;
#pragma unroll
                for (int bj = 0; bj < 2; ++bj) {
                    const int col = u.pn * 256 + bj * 128 + wc * 32 + 8 * fq;
                    const f32x4 g0 = *(const f32x4*)(gfin + col), g1 = *(const f32x4*)(gfin + col + 4);
                    *(f32x4*)(orow + col) = acc[ai][bj][m][0] * r * g0; *(f32x4*)(orow + col + 4) = acc[ai][bj][m][1] * r * g1;
                }
            }
    }
};

struct MapId { __device__ __forceinline__ int operator()(int n) const { return n; } };
struct MapIn { __device__ __forceinline__ int operator()(int n) const { return n < 1152 ? ((n & ~63) + 2 * (n & 31) + ((n >> 5) & 1)) : n; } };
struct MapUp { __device__ __forceinline__ int operator()(int n) const { if (n < FF) return 256 * (n >> 7) + (n & 127); const int m = n - FF; return 256 * (m >> 7) + 128 + (m & 127); } };
template <class Map>
__device__ __forceinline__ void p0_transpose_item(const float* W, int K, int N, bf16_t* WT, LAS float* scr, int item, int lane, Map map) {
    const int nblk = N / 32, kb = item / nblk, nb = item % nblk, k0 = 64 * kb, n0 = 32 * nb;
#pragma unroll 8
    for (int i = 0; i < 32; ++i) { const int kk = 2 * i + (lane >> 5); scr[kk * 33 + (lane & 31)] = __builtin_nontemporal_load(W + (size_t)(k0 + kk) * N + n0 + (lane & 31)); }
    asm volatile("s_waitcnt lgkmcnt(0)" ::: "memory");
    const int c = lane & 7;
#pragma unroll
    for (int j = 0; j < 4; ++j) { const int n = (lane >> 3) + 8 * j; const LAS float* s = scr + (8 * c) * 33 + n;
        u32x4 o; o.x = pk2(s[0 * 33], s[1 * 33]); o.y = pk2(s[2 * 33], s[3 * 33]); o.z = pk2(s[4 * 33], s[5 * 33]); o.w = pk2(s[6 * 33], s[7 * 33]);
        *(u32x4*)(WT + (size_t)map(n0 + n) * K + k0 + 8 * c) = o; }
    asm volatile("s_waitcnt lgkmcnt(0)" ::: "memory");
}
__device__ __forceinline__ void p0_prologue(const Params& p, LAS unsigned char* lds, int wave, int lane) {
    unsigned char* ws = p.ws;
    if (wave < 4) {
        bf16_t* XN = (bf16_t*)(ws + WS_XN);
        const int gw = blockIdx.x * 4 + wave, NGW = gridDim.x * 4;
        f32x4 gv[4];
#pragma unroll
        for (int j = 0; j < 4; ++j) gv[j] = ((const f32x4*)p.g_norm_mix)[lane + 64 * j];
        for (int m0 = gw * 4; m0 < M; m0 += NGW * 4) {
            f32x4 v[4][4]; const float* xr[4];
#pragma unroll
            for (int q = 0; q < 4; ++q) {
                xr[q] = row_x(p.x_prompt, p.meta_tokens, p.x_sample, m0 + q);
#pragma unroll
                for (int j = 0; j < 4; ++j) v[q][j] = xr[q] ? __builtin_nontemporal_load((const f32x4*)xr[q] + lane + 64 * j) : (f32x4){0.f, 0.f, 0.f, 0.f};
            }
#pragma unroll
            for (int q = 0; q < 4; ++q) {
                float s = 0.f;
#pragma unroll
                for (int j = 0; j < 4; ++j) s += (v[q][j][0] * v[q][j][0] + v[q][j][1] * v[q][j][1]) + (v[q][j][2] * v[q][j][2] + v[q][j][3] * v[q][j][3]);
                const float ms = wave_sum(s) * (1.0f / D) + RMS_EPS;
                const float r = rsqrtf(ms);
                if (lane == 0) ((float*)(ws + WS_R0I))[m0 + q] = sqrtf(ms);
                unsigned long long* o8 = (unsigned long long*)(XN + (size_t)(m0 + q) * D) + lane;
#pragma unroll
                for (int j = 0; j < 4; ++j) { const f32x4 w = v[q][j] * r * gv[j]; o8[64 * j] = (unsigned long long)pk2(w[0], w[1]) | ((unsigned long long)pk2(w[2], w[3]) << 32); }
            }
        }
        return;
    }
    LAS float* scr = (LAS float*)(lds + wave * 16384);
    const int gw = blockIdx.x * 4 + (wave - 4), NGW = gridDim.x * 4;
    const int gt = blockIdx.x * 256 + (int)threadIdx.x - 256, NT = gridDim.x * 256;
    constexpr int I_IN = 16 * (INW / 32), I_AO = 16 * 32, I_OUT = 16 * 32, I_UP = 16 * (FF2 / 32), I_DN = (FF / 64) * 32;
    constexpr int NITEMS = I_IN + I_AO + I_OUT + I_UP + I_DN;
    for (int it = gw; it < NITEMS; it += NGW) {
        int r = it;
        if (r < I_IN) { p0_transpose_item(p.w_in, D, INW, (bf16_t*)(ws + WS_WIN), scr, r, lane, MapIn()); continue; } r -= I_IN;
        if (r < I_AO) { p0_transpose_item(p.w_attn_o, D, D, (bf16_t*)(ws + WS_WAO), scr, r, lane, MapId()); continue; } r -= I_AO;
        if (r < I_OUT) { p0_transpose_item(p.w_out, D, D, (bf16_t*)(ws + WS_WOUT), scr, r, lane, MapId()); continue; } r -= I_OUT;
        if (r < I_UP) { p0_transpose_item(p.w_up, D, FF2, (bf16_t*)(ws + WS_WUP), scr, r, lane, MapUp()); continue; } r -= I_UP;
        p0_transpose_item(p.w_down, FF, D, (bf16_t*)(ws + WS_WDOWN), scr, r, lane, MapId());
    }
    {
        bf16_t* WP = (bf16_t*)(ws + WS_WPO);
        for (int idx = gt; idx < 1024 * 128; idx += NT) {
            const int n = idx & 1023, k0 = (idx >> 10) * 4, g = k0 >> 7;
            const float* wg = p.w_pool_grp + (size_t)k0 * 128;
            const float* sc = p.pool_scale + g * 128;
            const float* wo = p.w_pool_o + (size_t)(g * 128) * 1024 + n;
            float a[4] = {0.f, 0.f, 0.f, 0.f};
#pragma unroll 2
            for (int d = 0; d < 128; d += 4) {
                const f32x4 s4 = *(const f32x4*)(sc + d);
                float wv[4];
#pragma unroll
                for (int e = 0; e < 4; ++e) wv[e] = wo[(size_t)(d + e) * 1024] * s4[e];
#pragma unroll
                for (int j = 0; j < 4; ++j) { const f32x4 w4 = *(const f32x4*)(wg + j * 128 + d); a[j] += (w4[0] * wv[0] + w4[1] * wv[1]) + (w4[2] * wv[2] + w4[3] * wv[3]); }
            }
            u32x2 o; o.x = pk2(a[0], a[1]); o.y = pk2(a[2], a[3]);
            *(u32x2*)(WP + (size_t)n * 512 + k0) = o;
        }
    }
    float* rope = (float*)(ws + WS_ROPE);
    for (int i = gt; i < NPOS * 32; i += NT) {
        const int pos = i >> 5, d = i & 31;
        const float ang = (float)pos * p.inv_freq[d];
        const double rev = (double)ang * 0.15915494309189535;
        const float fr = (float)(rev - floor(rev));
        rope[2 * i] = __builtin_amdgcn_cosf(fr); rope[2 * i + 1] = __builtin_amdgcn_sinf(fr);
    }
}

constexpr int KS_PITCH = 144, VT_PITCH = 464, ATT_VT_OFF = 208 * KS_PITCH;
constexpr float LOG2E = 1.4426950408889634f, C2 = 0.125f * 1.4426950408889634f;

template <int NQ>
__device__ __forceinline__ void attn_load_q(bf16x8 (&qf)[NQ][2], const bf16_t* Qb, int qrow0, int h, int lane) {
    const int fr = lane & 15, fq = lane >> 4;
#pragma unroll
    for (int qb = 0; qb < NQ; ++qb)
#pragma unroll
        for (int ks = 0; ks < 2; ++ks) qf[qb][ks] = __builtin_nontemporal_load((const bf16x8*)(Qb + (size_t)(qrow0 + 16 * qb + fr) * 1024 + h * 64 + 32 * ks + 8 * fq));
}
template <int NQ>
__device__ __forceinline__ void attn_compute(LAS unsigned char* lds, const bf16x8 (&qf)[NQ][2], bf16_t* ATT, int qrow0, int h, unsigned vmask, float sink2, int lane) {
    const int fr = lane & 15, fq = lane >> 4;
    f32x4 s[NQ][13];
    const LAS unsigned char* kp = lds + fr * KS_PITCH + fq * 16;
    bf16x8 kc0 = *(const LAS bf16x8*)kp, kc1 = *(const LAS bf16x8*)(kp + 64);
#pragma unroll
    for (int kb = 0; kb < 13; ++kb) {
        bf16x8 kn0 = kc0, kn1 = kc1;
        if (kb < 12) { kn0 = *(const LAS bf16x8*)(kp + (kb + 1) * 16 * KS_PITCH); kn1 = *(const LAS bf16x8*)(kp + (kb + 1) * 16 * KS_PITCH + 64); }
#pragma unroll
        for (int qb = 0; qb < NQ; ++qb) {
            f32x4 a = {0.f, 0.f, 0.f, 0.f};
            a = __builtin_amdgcn_mfma_f32_16x16x32_bf16(kc0, qf[qb][0], a, 0, 0, 0);
            a = __builtin_amdgcn_mfma_f32_16x16x32_bf16(kc1, qf[qb][1], a, 0, 0, 0);
            s[qb][kb] = a;
        }
        kc0 = kn0; kc1 = kn1;
        __builtin_amdgcn_sched_barrier(0);
    }
    float rl[NQ];
#pragma unroll
    for (int qb = 0; qb < NQ; ++qb) {
        float mr = -1e30f;
#pragma unroll
        for (int kb = 0; kb < 13; ++kb) {
            if (vmask != 0x1fffu) {
                const bool valid = (vmask >> kb) & 1u;
#pragma unroll
                for (int i = 0; i < 4; ++i) s[qb][kb][i] = valid ? s[qb][kb][i] : -1e30f;
            }
            mr = fmaxf(mr, fmaxf(fmaxf(s[qb][kb][0], s[qb][kb][1]), fmaxf(s[qb][kb][2], s[qb][kb][3])));
        }
        mr = fmaxf(mr, __shfl_xor(mr, 16)); mr = fmaxf(mr, __shfl_xor(mr, 32));
        const float mx = fmaxf(mr * C2, sink2), nmx = -mx;
        float l = 0.f;
#pragma unroll
        for (int kb = 0; kb < 13; ++kb)
#pragma unroll
            for (int i = 0; i < 4; ++i) { const float pv = __builtin_amdgcn_exp2f(fmaf(s[qb][kb][i], C2, nmx)); s[qb][kb][i] = pv; l += pv; }
        l += __shfl_xor(l, 16); l += __shfl_xor(l, 32);
        l += __builtin_amdgcn_exp2f(sink2 - mx);
        rl[qb] = __builtin_amdgcn_rcpf(l);
    }
    f32x4 o[NQ][4];
#pragma unroll
    for (int qb = 0; qb < NQ; ++qb)
#pragma unroll
        for (int db = 0; db < 4; ++db) o[qb][db] = (f32x4){0.f, 0.f, 0.f, 0.f};
    const LAS unsigned char* vp = lds + ATT_VT_OFF + fr * VT_PITCH + fq * 8;
    u32x2 vlo[4], vhi[4];
#pragma unroll
    for (int db = 0; db < 4; ++db) { vlo[db] = *(const LAS u32x2*)(vp + db * 16 * VT_PITCH); vhi[db] = *(const LAS u32x2*)(vp + db * 16 * VT_PITCH + 32); }
#pragma unroll
    for (int kk = 0; kk < 7; ++kk) {
        u32x2 nlo[4], nhi[4];
#pragma unroll
        for (int db = 0; db < 4; ++db) { nlo[db] = vlo[db]; nhi[db] = vhi[db]; }
        if (kk < 6) {
#pragma unroll
            for (int db = 0; db < 4; ++db) { nlo[db] = *(const LAS u32x2*)(vp + db * 16 * VT_PITCH + (kk + 1) * 64); nhi[db] = *(const LAS u32x2*)(vp + db * 16 * VT_PITCH + (kk + 1) * 64 + 32); }
        }
        bf16x8 pf[NQ];
#pragma unroll
        for (int qb = 0; qb < NQ; ++qb) {
            u32x4 w;
            w.x = pk2(s[qb][2 * kk][0], s[qb][2 * kk][1]); w.y = pk2(s[qb][2 * kk][2], s[qb][2 * kk][3]);
            if (2 * kk + 1 < 13) { w.z = pk2(s[qb][(2 * kk + 1) % 13][0], s[qb][(2 * kk + 1) % 13][1]); w.w = pk2(s[qb][(2 * kk + 1) % 13][2], s[qb][(2 * kk + 1) % 13][3]); }
            else { w.z = 0u; w.w = 0u; }
            pf[qb] = __builtin_bit_cast(bf16x8, w);
        }
#pragma unroll
        for (int db = 0; db < 4; ++db) {
            u32x4 vv; vv.x = vlo[db].x; vv.y = vlo[db].y; vv.z = vhi[db].x; vv.w = vhi[db].y;
            const bf16x8 vf = __builtin_bit_cast(bf16x8, vv);
#pragma unroll
            for (int qb = 0; qb < NQ; ++qb) o[qb][db] = __builtin_amdgcn_mfma_f32_16x16x32_bf16(vf, pf[qb], o[qb][db], 0, 0, 0);
        }
#pragma unroll
        for (int db = 0; db < 4; ++db) { vlo[db] = nlo[db]; vhi[db] = nhi[db]; }
        __builtin_amdgcn_sched_barrier(0);
    }
#pragma unroll
    for (int qb = 0; qb < NQ; ++qb)
#pragma unroll
        for (int db = 0; db < 4; ++db) {
            const f32x4 v = o[qb][db] * rl[qb];
            u32x2 w; w.x = pk2(v[0], v[1]); w.y = pk2(v[2], v[3]);
            *(u32x2*)(ATT + (size_t)(qrow0 + 16 * qb + fr) * 1024 + h * 64 + 16 * db + 4 * fq) = w;
        }
}
__device__ __forceinline__ void attn_zero_pad(LAS unsigned char* lds, int tid) {
    if (tid < 128) { const int row = tid >> 1, half = tid & 1; *(LAS u32x4*)(lds + ATT_VT_OFF + row * VT_PITCH + 416 + half * 16) = (u32x4){0u, 0u, 0u, 0u}; }
}
__device__ __forceinline__ void attn_fill_bf16(LAS unsigned char* lds, const bf16_t* Kb, const bf16_t* Vb, int srow, int n, int kk, int ch) {
    u32x4 kv = {0u, 0u, 0u, 0u}, vv = {0u, 0u, 0u, 0u};
    if (srow >= 0) { kv = *(const u32x4*)(Kb + (size_t)srow * 128 + n * 64 + ch * 8); vv = *(const u32x4*)(Vb + (size_t)srow * 128 + n * 64 + ch * 8); }
    *(LAS u32x4*)(lds + kk * KS_PITCH + ch * 16) = kv;
    LAS unsigned short* vt = (LAS unsigned short*)(lds + ATT_VT_OFF + (ch * 8) * VT_PITCH + kk * 2);
    vt[0 * (VT_PITCH / 2)] = (unsigned short)(vv.x & 0xffffu); vt[1 * (VT_PITCH / 2)] = (unsigned short)(vv.x >> 16);
    vt[2 * (VT_PITCH / 2)] = (unsigned short)(vv.y & 0xffffu); vt[3 * (VT_PITCH / 2)] = (unsigned short)(vv.y >> 16);
    vt[4 * (VT_PITCH / 2)] = (unsigned short)(vv.z & 0xffffu); vt[5 * (VT_PITCH / 2)] = (unsigned short)(vv.z >> 16);
    vt[6 * (VT_PITCH / 2)] = (unsigned short)(vv.w & 0xffffu); vt[7 * (VT_PITCH / 2)] = (unsigned short)(vv.w >> 16);
}
__device__ __forceinline__ void attn_fill_f32(LAS unsigned char* lds, const float* ksrc, const float* vsrc, int kk, int ch) {
    const f32x4 k0 = *(const f32x4*)(ksrc + ch * 8), k1 = *(const f32x4*)(ksrc + ch * 8 + 4);
    const f32x4 v0 = *(const f32x4*)(vsrc + ch * 8), v1 = *(const f32x4*)(vsrc + ch * 8 + 4);
    LAS unsigned short* kr = (LAS unsigned short*)(lds + kk * KS_PITCH);
    LAS unsigned short* vt = (LAS unsigned short*)(lds + ATT_VT_OFF + (ch * 8) * VT_PITCH + kk * 2);
#pragma unroll
    for (int e = 0; e < 8; ++e) {
        const int d = ch * 8 + e;
        const float kvv = e < 4 ? k0[e & 3] : k1[e & 3], vvv = e < 4 ? v0[e & 3] : v1[e & 3];
        kr[2 * (d & 31) + (d >> 5)] = (unsigned short)(pk2(kvv, 0.f) & 0xffffu);
        vt[e * (VT_PITCH / 2)] = (unsigned short)(pk2(vvv, 0.f) & 0xffffu);
    }
}
__device__ __forceinline__ void attn_chunk_unit(const Params& p, LAS unsigned char* lds, int unit, int tid, int wave, int lane) {
    unsigned char* ws = p.ws;
    const bf16_t *Qb = (const bf16_t*)(ws + WS_Q), *Kb = (const bf16_t*)(ws + WS_K), *Vb = (const bf16_t*)(ws + WS_V); bf16_t* ATT = (bf16_t*)(ws + WS_ATT);
    const int n = unit & 1, c = (unit >> 1) & 63, b = unit >> 7;
    asm volatile("" : "+v"(tid), "+v"(lane));
    const int h = n * 8 + wave, r0 = b * SEQ + c * 64;
    bf16x8 qa[2][2], qb2[2][2];
    attn_load_q<2>(qa, Qb, r0, h, lane);
#pragma unroll
    for (int jb = 0; jb < 2; ++jb) {
        u32x4 kv[2], vv[2];
#pragma unroll
        for (int j = 0; j < 2; ++j) {
            const int i = tid + 512 * (2 * jb + j), kk = i >> 3, ch = i & 7;
            int srow;
            if (kk < 16) srow = ROW_META + kk;
            else { const int t = (c - 2) * 64 + kk - 16; srow = t < 0 ? -1 : b * SEQ + t; }
            kv[j] = (u32x4){0u, 0u, 0u, 0u}; vv[j] = (u32x4){0u, 0u, 0u, 0u};
            if (i < 208 * 8 && srow >= 0) { kv[j] = *(const u32x4*)(Kb + (size_t)srow * 128 + n * 64 + ch * 8); vv[j] = *(const u32x4*)(Vb + (size_t)srow * 128 + n * 64 + ch * 8); }
        }
#pragma unroll
        for (int j = 0; j < 2; ++j) {
            const int i = tid + 512 * (2 * jb + j), kk = i >> 3, ch = i & 7;
            if (i < 208 * 8) {
                *(LAS u32x4*)(lds + kk * KS_PITCH + ch * 16) = kv[j];
                LAS unsigned short* vt = (LAS unsigned short*)(lds + ATT_VT_OFF + (ch * 8) * VT_PITCH + kk * 2);
                vt[0 * (VT_PITCH / 2)] = (unsigned short)(vv[j].x & 0xffffu); vt[1 * (VT_PITCH / 2)] = (unsigned short)(vv[j].x >> 16);
                vt[2 * (VT_PITCH / 2)] = (unsigned short)(vv[j].y & 0xffffu); vt[3 * (VT_PITCH / 2)] = (unsigned short)(vv[j].y >> 16);
                vt[4 * (VT_PITCH / 2)] = (unsigned short)(vv[j].z & 0xffffu); vt[5 * (VT_PITCH / 2)] = (unsigned short)(vv[j].z >> 16);
                vt[6 * (VT_PITCH / 2)] = (unsigned short)(vv[j].w & 0xffffu); vt[7 * (VT_PITCH / 2)] = (unsigned short)(vv[j].w >> 16);
            }
        }
    }
    attn_zero_pad(lds, tid);
    __syncthreads();
    unsigned vmask = 0x1fffu;
    if (c == 0) vmask = 0x1e01u; else if (c == 1) vmask = 0x1fe1u;
    const float sink2 = p.sinks[h] * LOG2E;
    attn_compute<2>(lds, qa, ATT, r0, h, vmask, sink2, lane);
    attn_load_q<2>(qb2, Qb, r0 + 32, h, lane);
    attn_compute<2>(lds, qb2, ATT, r0 + 32, h, vmask, sink2, lane);
    __syncthreads();
}
__device__ __forceinline__ void attn_small_unit(const Params& p, LAS unsigned char* lds, int unit, int tid, int wave, int lane) {
    unsigned char* ws = p.ws;
    const bf16_t *Qb = (const bf16_t*)(ws + WS_Q), *Kb = (const bf16_t*)(ws + WS_K), *Vb = (const bf16_t*)(ws + WS_V); bf16_t* ATT = (bf16_t*)(ws + WS_ATT);
    int n, qrow0; unsigned vmask;
    if (unit < 2) {
        n = unit; qrow0 = ROW_META; vmask = 1u;
        for (int i = tid; i < 208 * 8; i += 512) { const int kk = i >> 3, ch = i & 7; attn_fill_bf16(lds, Kb, Vb, kk < 16 ? ROW_META + kk : -1, n, kk, ch); }
    } else {
        const int b = (unit - 2) >> 1; n = (unit - 2) & 1; qrow0 = ROW_SAMP + b * 16; vmask = 0x3ffu;
        for (int i = tid; i < 208 * 8; i += 512) {
            const int kk = i >> 3, ch = i & 7;
            if (kk < 16) attn_fill_f32(lds, p.cache_meta_k + ((size_t)(b * 16 + kk) * 2 + n) * 64, p.cache_meta_v + ((size_t)(b * 16 + kk) * 2 + n) * 64, kk, ch);
            else if (kk < 144) attn_fill_f32(lds, p.cache_swa_k + ((size_t)(b * 128 + kk - 16) * 2 + n) * 64, p.cache_swa_v + ((size_t)(b * 128 + kk - 16) * 2 + n) * 64, kk, ch);
            else attn_fill_bf16(lds, Kb, Vb, kk < 160 ? ROW_SAMP + b * 16 + kk - 144 : -1, n, kk, ch);
        }
    }
    attn_zero_pad(lds, tid);
    __syncthreads();
    const int h = n * 8 + wave;
    bf16x8 q1[1][2]; attn_load_q<1>(q1, Qb, qrow0, h, lane);
    attn_compute<1>(lds, q1, ATT, qrow0, h, vmask, p.sinks[h] * LOG2E, lane);
    __syncthreads();
}
constexpr int PM_PITCH = 1040;
__device__ __forceinline__ void add8(float (&s)[8], const u32x4 v) {
    s[0] += bf_lo(v.x); s[1] += bf_hi(v.x); s[2] += bf_lo(v.y); s[3] += bf_hi(v.y); s[4] += bf_lo(v.z); s[5] += bf_hi(v.z); s[6] += bf_lo(v.w); s[7] += bf_hi(v.w);
}
__device__ __forceinline__ void unpack8(float (&s)[8], const u32x4 v) {
    s[0] = bf_lo(v.x); s[1] = bf_hi(v.x); s[2] = bf_lo(v.y); s[3] = bf_hi(v.y); s[4] = bf_lo(v.z); s[5] = bf_hi(v.z); s[6] = bf_lo(v.w); s[7] = bf_hi(v.w);
}
template <int W>
__device__ __forceinline__ void pool_pm_main(const bf16_t* Pb, bf16_t* POOL, int R0, int wave, int lane) {
    const int g = wave >> 1, col = (g * 16 + (lane & 15)) * 8, seg = (wave & 1) * 4 + (lane >> 4);
    const int sb = R0 & 4095, s0 = sb + seg * 8, base = R0 - sb;
    constexpr int NL = 8 + W - 1;
    u32x4 v[NL];
#pragma unroll
    for (int t = 0; t < NL; ++t) {
        const int sk = s0 + t - (W - 1);
        const int row = sk >= 0 ? base + sk : ROW_META + 16 + sk;
        v[t] = *(const u32x4*)(Pb + (size_t)row * PW + col);
    }
    float s[8] = {0.f, 0.f, 0.f, 0.f, 0.f, 0.f, 0.f, 0.f};
#pragma unroll
    for (int t = 0; t < W - 1; ++t) add8(s, v[t]);
#pragma unroll
    for (int j = 0; j < 8; ++j) {
        float cur[8], old[8];
        unpack8(cur, v[j + W - 1]); unpack8(old, v[j]);
#pragma unroll
        for (int e = 0; e < 8; ++e) s[e] += cur[e];
        constexpr float inv = 1.0f / (float)W;
        u32x4 o; o.x = pk2(s[0] * inv - cur[0], s[1] * inv - cur[1]); o.y = pk2(s[2] * inv - cur[2], s[3] * inv - cur[3]);
        o.z = pk2(s[4] * inv - cur[4], s[5] * inv - cur[5]); o.w = pk2(s[6] * inv - cur[6], s[7] * inv - cur[7]);
        *(u32x4*)(POOL + (size_t)(R0 + seg * 8 + j) * PW + col) = o;
#pragma unroll
        for (int e = 0; e < 8; ++e) s[e] -= old[e];
    }
}
__device__ __forceinline__ void pool_unit(const Params& p, LAS unsigned char* lds, int pt, int tid, int wave, int lane) {
    unsigned char* ws = p.ws;
    const bf16_t* Pb = (const bf16_t*)(ws + WS_P); bf16_t* POOL = (bf16_t*)(ws + WS_POOL);
    const bool tail = pt >= 512;
    const int R0 = tail ? MREAL + 16 * (pt - 512) : pt * 64;
    if (!tail) {
        switch (wave >> 1) {
            case 0: pool_pm_main<2>(Pb, POOL, R0, wave, lane); break;
            case 1: pool_pm_main<4>(Pb, POOL, R0, wave, lane); break;
            case 2: pool_pm_main<8>(Pb, POOL, R0, wave, lane); break;
            default: pool_pm_main<16>(Pb, POOL, R0, wave, lane); break;
        }
    } else
    for (int i = tid; i < 1024; i += 512) {
        const int rr = i >> 6, ch = i & 63, R = R0 + rr, g = ch >> 4, w = 2 << g, col = ch * 8;
        float s[8] = {0.f, 0.f, 0.f, 0.f, 0.f, 0.f, 0.f, 0.f}, cur[8] = {0.f, 0.f, 0.f, 0.f, 0.f, 0.f, 0.f, 0.f};
        float inv = 1.0f / (float)w;
        if (R < ROW_SAMP) {
            const int pos = R - ROW_META; const int cnt = w < pos + 1 ? w : pos + 1; inv = 1.0f / (float)cnt;
#pragma unroll
            for (int k = 0; k < 16; ++k) {
                const bool on = k < cnt;
                float t[8]; unpack8(t, *(const u32x4*)(Pb + (size_t)(on ? R - k : R) * PW + col));
#pragma unroll
                for (int e = 0; e < 8; ++e) { s[e] += on ? t[e] : 0.f; if (k == 0) cur[e] = t[e]; }
            }
        } else if (R < ROW_PAD) {
            const int q = R - ROW_SAMP, b = q >> 4, ii = q & 15;
#pragma unroll
            for (int k = 0; k < 16; ++k) {
                const bool on = k < w, frombuf = ii - k >= 0;
                float t[8]; unpack8(t, *(const u32x4*)(Pb + (size_t)(frombuf ? R - k : R) * PW + col));
                const float* sp = p.state_pool + ((size_t)b * 15 + (frombuf ? 0 : 15 + ii - k)) * PW + col; const f32x4 a = *(const f32x4*)sp, c2 = *(const f32x4*)(sp + 4);
                const float u[8] = {a[0], a[1], a[2], a[3], c2[0], c2[1], c2[2], c2[3]};
#pragma unroll
                for (int e = 0; e < 8; ++e) { const float x = frombuf ? t[e] : u[e]; s[e] += on ? x : 0.f; if (k == 0) cur[e] = t[e]; }
            }
        }
        u32x4 o; o.x = pk2(s[0] * inv - cur[0], s[1] * inv - cur[1]); o.y = pk2(s[2] * inv - cur[2], s[3] * inv - cur[3]);
        o.z = pk2(s[4] * inv - cur[4], s[5] * inv - cur[5]); o.w = pk2(s[6] * inv - cur[6], s[7] * inv - cur[7]);
        *(u32x4*)(POOL + (size_t)R * PW + col) = o;
    }
}
__device__ __forceinline__ int deinter(int d) { return 2 * (d & 31) + (d >> 5); }
__device__ __forceinline__ void small_outputs(const Params& p) {
    unsigned char* ws = p.ws;
    const bf16_t *Kb = (const bf16_t*)(ws + WS_K), *Vb = (const bf16_t*)(ws + WS_V), *Pb = (const bf16_t*)(ws + WS_P);
    float* out = p.out;
    const int gt = blockIdx.x * 512 + threadIdx.x, NT = gridDim.x * 512;
    for (int i = gt; i < 131072; i += NT) {
        const int d = i & 63, n = (i >> 6) & 1, w = (i >> 7) & 127, b = i >> 14; const size_t row = (size_t)b * SEQ + 3968 + w;
        out[O_PSK + i] = bf1(Kb[row * 128 + n * 64 + deinter(d)]); out[O_PSV + i] = bf1(Vb[row * 128 + n * 64 + d]);
    }
    for (int i = gt; i < 16384; i += NT) {
        const int d = i & 63, n = (i >> 6) & 1, t = (i >> 7) & 15, b = i >> 11;
        const size_t rm = (size_t)ROW_META + t, rs = (size_t)ROW_SAMP + b * 16 + t;
        out[O_KM + i] = bf1(Kb[rm * 128 + n * 64 + deinter(d)]); out[O_VM + i] = bf1(Vb[rm * 128 + n * 64 + d]);
        out[O_SSK + i] = bf1(Kb[rs * 128 + n * 64 + deinter(d)]); out[O_SSV + i] = bf1(Vb[rs * 128 + n * 64 + d]);
    }
    for (int i = gt; i < 61440; i += NT) {
        const int c = i & 511, r = (i >> 9) % 15, b = (i >> 9) / 15;
        out[O_PPOOL + i] = bf1(Pb[((size_t)b * SEQ + 4081 + r) * PW + c]);
        out[O_SPOOL + i] = bf1(Pb[((size_t)ROW_SAMP + b * 16 + 1 + r) * PW + c]);
    }
}


constexpr size_t WS_SSQT1 = 5 * MiB + 512 * 1024, WS_SSQT2 = 8 * MiB + 512 * 1024;
struct SkinnyOp { const bf16_t* A; const bf16_t* Bt; int K; };
__device__ __forceinline__ void skinny_accum(const SkinnyOp op, int n0, int wave, int lane, f32x4 (&acc)[9]) {
    const int fr = lane & 15, fq = lane >> 4;
    const bf16_t* bp = op.Bt + (size_t)(n0 + fr) * op.K + 8 * fq;
    const bf16_t* ap = op.A + (size_t)(ROW_META + fr) * op.K + 8 * fq;
    const int nks = op.K >> 5;
    for (int ks = wave; ks < nks; ks += 16) {
        const bool two = ks + 8 < nks;
        const int k0 = ks * 32, k1 = two ? (ks + 8) * 32 : k0;
        const bf16x8 b0 = *(const bf16x8*)(bp + k0), b1 = *(const bf16x8*)(bp + k1);
        bf16x8 a0[9], a1[9];
#pragma unroll
        for (int rb = 0; rb < 9; ++rb) { a0[rb] = *(const bf16x8*)(ap + (size_t)rb * 16 * op.K + k0); a1[rb] = *(const bf16x8*)(ap + (size_t)rb * 16 * op.K + k1); }
#pragma unroll
        for (int rb = 0; rb < 9; ++rb) acc[rb] = __builtin_amdgcn_mfma_f32_16x16x32_bf16(b0, a0[rb], acc[rb], 0, 0, 0);
        if (two) {
#pragma unroll
            for (int rb = 0; rb < 9; ++rb) acc[rb] = __builtin_amdgcn_mfma_f32_16x16x32_bf16(b1, a1[rb], acc[rb], 0, 0, 0);
        }
    }
}
__device__ __forceinline__ void skinny_reduce(LAS unsigned char* lds, const f32x4 (&acc)[9], int wave, int lane, f32x4& r0, f32x4& r8) {
    LAS f32x4* part = (LAS f32x4*)lds;
#pragma unroll
    for (int rb = 0; rb < 9; ++rb) part[(wave * 9 + rb) * 64 + lane] = acc[rb];
    __syncthreads();
    r0 = (f32x4){0.f, 0.f, 0.f, 0.f}; r8 = (f32x4){0.f, 0.f, 0.f, 0.f};
#pragma unroll
    for (int w = 0; w < 8; ++w) r0 += part[(w * 9 + wave) * 64 + lane];
    if (wave == 0) {
#pragma unroll
        for (int w = 0; w < 8; ++w) r8 += part[(w * 9 + 8) * 64 + lane];
    }
    __syncthreads();
}
#define ZERO9(a) _Pragma("unroll") for (int z_ = 0; z_ < 9; ++z_) a[z_] = (f32x4){0.f, 0.f, 0.f, 0.f}
__device__ __forceinline__ void tail_mix_unit(const Params& p, LAS unsigned char* lds, int unit, int wave, int lane) {
    unsigned char* ws = p.ws; const int n0 = unit * 16, fr = lane & 15, fq = lane >> 4;
    f32x4 acc[9], a0, a8, b0, b8;
    ZERO9(acc); skinny_accum(SkinnyOp{(const bf16_t*)(ws + WS_ATT), (const bf16_t*)(ws + WS_WAO), 1024}, n0, wave, lane, acc); skinny_reduce(lds, acc, wave, lane, a0, a8);
    ZERO9(acc); skinny_accum(SkinnyOp{(const bf16_t*)(ws + WS_POOL), (const bf16_t*)(ws + WS_WPO), 512}, n0, wave, lane, acc); skinny_reduce(lds, acc, wave, lane, b0, b8);
    const bf16_t *GA = (const bf16_t*)(ws + WS_GA), *GP = (const bf16_t*)(ws + WS_GP); bf16_t* MIX = (bf16_t*)(ws + WS_MIX);
#pragma unroll
    for (int t = 0; t < 2; ++t) {
        if (t == 1 && wave != 0) break;
        const int rb = t ? 8 : wave; const f32x4 va = t ? a8 : a0, vb = t ? b8 : b0;
        const size_t off = (size_t)(ROW_META + 16 * rb + fr) * 1024 + n0 + 4 * fq;
        const u32x2 ga = *(const u32x2*)(GA + off), gp = *(const u32x2*)(GP + off);
        u32x2 w; w.x = pk2(bf_lo(ga.x) * va[0] + bf_lo(gp.x) * vb[0], bf_hi(ga.x) * va[1] + bf_hi(gp.x) * vb[1]);
        w.y = pk2(bf_lo(ga.y) * va[2] + bf_lo(gp.y) * vb[2], bf_hi(ga.y) * va[3] + bf_hi(gp.y) * vb[3]);
        *(u32x2*)(MIX + off) = w;
    }
}
__device__ __forceinline__ void tail_x1_unit(const Params& p, LAS unsigned char* lds, int unit, int wave, int lane) {
    unsigned char* ws = p.ws; const int n0 = unit * 16, fr = lane & 15, fq = lane >> 4;
    f32x4 acc[9], a0, a8;
    ZERO9(acc); skinny_accum(SkinnyOp{(const bf16_t*)(ws + WS_MIX), (const bf16_t*)(ws + WS_WOUT), 1024}, n0, wave, lane, acc); skinny_reduce(lds, acc, wave, lane, a0, a8);
    bf16_t* XG = (bf16_t*)(ws + WS_XG); float* ssqt = (float*)(ws + WS_SSQT1);
#pragma unroll
    for (int t = 0; t < 2; ++t) {
        if (t == 1 && wave != 0) break;
        const int rb = t ? 8 : wave; const f32x4 va = t ? a8 : a0;
        const int lr = 16 * rb + fr, row = ROW_META + lr, col = n0 + 4 * fq;
        const f32x4 x = *(const f32x4*)(row_x(p.x_prompt, p.meta_tokens, p.x_sample, row) + col);
        const f32x4 v = va + x, g = *(const f32x4*)(p.g_norm_ffn + col);
        u32x2 w; w.x = pk2(v[0] * g[0], v[1] * g[1]); w.y = pk2(v[2] * g[2], v[3] * g[3]);
        *(u32x2*)(XG + (size_t)row * 1024 + col) = w;
        float ss = (v[0] * v[0] + v[1] * v[1]) + (v[2] * v[2] + v[3] * v[3]);
        ss += __shfl_xor(ss, 16); ss += __shfl_xor(ss, 32);
        if (fq == 0) ssqt[lr * 64 + unit] = ss;
    }
}
__device__ __forceinline__ float tail_row_sum64(const float* ssqt, int lr) {
    const f32x4* sp = (const f32x4*)(ssqt + lr * 64); float s = 0.f;
#pragma unroll
    for (int j = 0; j < 16; ++j) { const f32x4 a = sp[j]; s += (a[0] + a[1]) + (a[2] + a[3]); }
    return s;
}
__device__ __forceinline__ void tail_up_unit(const Params& p, LAS unsigned char* lds, int unit, int wave, int lane) {
    unsigned char* ws = p.ws; const int n0 = unit * 16, fr = lane & 15, fq = lane >> 4;
    f32x4 acc[9], a0, a8;
    ZERO9(acc); skinny_accum(SkinnyOp{(const bf16_t*)(ws + WS_XG), (const bf16_t*)(ws + WS_WUP), 1024}, n0, wave, lane, acc); skinny_reduce(lds, acc, wave, lane, a0, a8);
    float* UPT = (float*)(ws + WS_UPT); const float* ssqt = (const float*)(ws + WS_SSQT1);
    const int oc = ((n0 >> 7) & 1) * FF + 128 * (n0 >> 8) + (n0 & 127) + 4 * fq;
#pragma unroll
    for (int t = 0; t < 2; ++t) {
        if (t == 1 && wave != 0) break;
        const int rb = t ? 8 : wave; const f32x4 va = t ? a8 : a0;
        const int lr = 16 * rb + fr;
        const float r1 = rsqrtf(tail_row_sum64(ssqt, lr) * (1.0f / 1024.0f) + RMS_EPS);
        *(f32x4*)(UPT + (size_t)lr * FF2 + oc) = va * r1;
    }
}
__device__ __forceinline__ void tail_down_unit(const Params& p, LAS unsigned char* lds, int unit, int wave, int lane) {
    unsigned char* ws = p.ws; const int n0 = unit * 16, fr = lane & 15, fq = lane >> 4;
    f32x4 acc[9], a0, a8;
    ZERO9(acc); skinny_accum(SkinnyOp{(const bf16_t*)(ws + WS_ACT), (const bf16_t*)(ws + WS_WDOWN), FF}, n0, wave, lane, acc); skinny_reduce(lds, acc, wave, lane, a0, a8);
    const bf16_t* XG = (const bf16_t*)(ws + WS_XG); float* ssqt = (float*)(ws + WS_SSQT2);
    f32x4 vv[2];
#pragma unroll
    for (int t = 0; t < 2; ++t) {
        if (t == 1 && wave != 0) break;
        const int rb = t ? 8 : wave; const f32x4 va = t ? a8 : a0;
        const int lr = 16 * rb + fr, row = ROW_META + lr, col = n0 + 4 * fq;
        const u32x2 xg = *(const u32x2*)(XG + (size_t)row * 1024 + col); const f32x4 g = *(const f32x4*)(p.g_norm_ffn + col);
        f32x4 v;
        v[0] = va[0] + bf_lo(xg.x) * __builtin_amdgcn_rcpf(g[0]); v[1] = va[1] + bf_hi(xg.x) * __builtin_amdgcn_rcpf(g[1]);
        v[2] = va[2] + bf_lo(xg.y) * __builtin_amdgcn_rcpf(g[2]); v[3] = va[3] + bf_hi(xg.y) * __builtin_amdgcn_rcpf(g[3]);
        vv[t] = v;
        float ss = (v[0] * v[0] + v[1] * v[1]) + (v[2] * v[2] + v[3] * v[3]);
        ss += __shfl_xor(ss, 16); ss += __shfl_xor(ss, 32);
        if (fq == 0) AG_ST(ssqt + lr * 64 + unit, ss);
    }
#pragma unroll
    for (int t = 0; t < 2; ++t) {
        if (t == 1 && wave != 0) break;
        const int rb = t ? 8 : wave;
        const int lr = 16 * rb + fr, col = n0 + 4 * fq;
        float s = 0.f;
        for (int tries = 0; tries < (1 << 16); ++tries) {
            bool ready = true; s = 0.f;
#pragma unroll
            for (int j = 0; j < 16; ++j) { const float a = AG_LD(ssqt + lr * 64 + 16 * fq + j); ready = ready && (a >= 0.f); s += a; }
            if (__all(ready)) break;
            __builtin_amdgcn_s_sleep(8);
        }
        s += __shfl_xor(s, 16); s += __shfl_xor(s, 32);
        const float r = rsqrtf(s * (1.0f / 1024.0f) + RMS_EPS);
        if (lr >= 16) *(f32x4*)(p.out + O_YS + (size_t)(lr - 16) * D + col) = vv[t] * r * *(const f32x4*)(p.g_norm_final + col);
    }
}

__device__ __forceinline__ void skinny_accum3(const SkinnyOp op, int n0, int rb0, int wave, int lane, f32x4 (&acc)[3]) {
    const int fr = lane & 15, fq = lane >> 4;
    const bf16_t* bp = op.Bt + (size_t)(n0 + fr) * op.K + 8 * fq;
    const bf16_t* ap = op.A + (size_t)(ROW_META + 16 * rb0 + fr) * op.K + 8 * fq;
    const int nks = op.K >> 5;
    for (int ks0 = wave; ks0 < nks; ks0 += 32) {
        bf16x8 b[4], a[4][3];
#pragma unroll
        for (int j = 0; j < 4; ++j) {
            const int ks = ks0 + 8 * j; const int k = (ks < nks ? ks : ks0) * 32;
            b[j] = *(const bf16x8*)(bp + k);
#pragma unroll
            for (int rb = 0; rb < 3; ++rb) a[j][rb] = *(const bf16x8*)(ap + (size_t)rb * 16 * op.K + k);
        }
#pragma unroll
        for (int j = 0; j < 4; ++j) {
            if (ks0 + 8 * j < nks) {
#pragma unroll
                for (int rb = 0; rb < 3; ++rb) acc[rb] = __builtin_amdgcn_mfma_f32_16x16x32_bf16(b[j], a[j][rb], acc[rb], 0, 0, 0);
            }
        }
    }
}
__device__ __forceinline__ f32x4 skinny_reduce3(LAS unsigned char* lds, const f32x4 (&acc)[3], int wave, int lane) {
    LAS f32x4* part = (LAS f32x4*)lds;
#pragma unroll
    for (int rb = 0; rb < 3; ++rb) part[(wave * 3 + rb) * 64 + lane] = acc[rb];
    __syncthreads();
    f32x4 r = {0.f, 0.f, 0.f, 0.f};
    if (wave < 3) {
#pragma unroll
        for (int w = 0; w < 8; ++w) r += part[(w * 3 + wave) * 64 + lane];
    }
    __syncthreads();
    return r;
}
#define ZERO3(a) _Pragma("unroll") for (int z_ = 0; z_ < 3; ++z_) a[z_] = (f32x4){0.f, 0.f, 0.f, 0.f}
__device__ __forceinline__ void tail_mix_unit3(const Params& p, LAS unsigned char* lds, int unit, int wave, int lane) {
    unsigned char* ws = p.ws; const int n0 = (unit & 63) * 16, rb0 = 3 * (unit >> 6), fr = lane & 15, fq = lane >> 4;
    f32x4 acc[3];
    ZERO3(acc); skinny_accum3(SkinnyOp{(const bf16_t*)(ws + WS_ATT), (const bf16_t*)(ws + WS_WAO), 1024}, n0, rb0, wave, lane, acc); const f32x4 va = skinny_reduce3(lds, acc, wave, lane);
    ZERO3(acc); skinny_accum3(SkinnyOp{(const bf16_t*)(ws + WS_POOL), (const bf16_t*)(ws + WS_WPO), 512}, n0, rb0, wave, lane, acc); const f32x4 vb = skinny_reduce3(lds, acc, wave, lane);
    if (wave < 3) {
        const bf16_t *GA = (const bf16_t*)(ws + WS_GA), *GP = (const bf16_t*)(ws + WS_GP); bf16_t* MIX = (bf16_t*)(ws + WS_MIX);
        const size_t off = (size_t)(ROW_META + 16 * (rb0 + wave) + fr) * 1024 + n0 + 4 * fq;
        const u32x2 ga = *(const u32x2*)(GA + off), gp = *(const u32x2*)(GP + off);
        u32x2 w; w.x = pk2(bf_lo(ga.x) * va[0] + bf_lo(gp.x) * vb[0], bf_hi(ga.x) * va[1] + bf_hi(gp.x) * vb[1]);
        w.y = pk2(bf_lo(ga.y) * va[2] + bf_lo(gp.y) * vb[2], bf_hi(ga.y) * va[3] + bf_hi(gp.y) * vb[3]);
        *(u32x2*)(MIX + off) = w;
    }
}
__device__ __forceinline__ void tail_x1_unit3(const Params& p, LAS unsigned char* lds, int unit, int wave, int lane) {
    unsigned char* ws = p.ws; const int cu = unit & 63, n0 = cu * 16, rb0 = 3 * (unit >> 6), fr = lane & 15, fq = lane >> 4;
    f32x4 acc[3];
    ZERO3(acc); skinny_accum3(SkinnyOp{(const bf16_t*)(ws + WS_MIX), (const bf16_t*)(ws + WS_WOUT), 1024}, n0, rb0, wave, lane, acc); const f32x4 va = skinny_reduce3(lds, acc, wave, lane);
    if (wave < 3) {
        bf16_t* XG = (bf16_t*)(ws + WS_XG); float* ssqt = (float*)(ws + WS_SSQT1);
        const int lr = 16 * (rb0 + wave) + fr, row = ROW_META + lr, col = n0 + 4 * fq;
        const f32x4 x = *(const f32x4*)(row_x(p.x_prompt, p.meta_tokens, p.x_sample, row) + col);
        const f32x4 v = va + x, g = *(const f32x4*)(p.g_norm_ffn + col);
        u32x2 w; w.x = pk2(v[0] * g[0], v[1] * g[1]); w.y = pk2(v[2] * g[2], v[3] * g[3]);
        *(u32x2*)(XG + (size_t)row * 1024 + col) = w;
        float ss = (v[0] * v[0] + v[1] * v[1]) + (v[2] * v[2] + v[3] * v[3]);
        ss += __shfl_xor(ss, 16); ss += __shfl_xor(ss, 32);
        if (fq == 0) ssqt[lr * 64 + cu] = ss;
    }
}
__device__ __forceinline__ void tail_down_unit3(const Params& p, LAS unsigned char* lds, int unit, int wave, int lane) {
    unsigned char* ws = p.ws; const int cu = unit & 63, n0 = cu * 16, rb0 = 3 * (unit >> 6), fr = lane & 15, fq = lane >> 4;
    f32x4 acc[3];
    ZERO3(acc); skinny_accum3(SkinnyOp{(const bf16_t*)(ws + WS_ACT), (const bf16_t*)(ws + WS_WDOWN), FF}, n0, rb0, wave, lane, acc); const f32x4 va = skinny_reduce3(lds, acc, wave, lane);
    if (wave < 3) {
        const bf16_t* XG = (const bf16_t*)(ws + WS_XG); float* ssqt = (float*)(ws + WS_SSQT2);
        const int lr = 16 * (rb0 + wave) + fr, row = ROW_META + lr, col = n0 + 4 * fq;
        const u32x2 xg = *(const u32x2*)(XG + (size_t)row * 1024 + col); const f32x4 g = *(const f32x4*)(p.g_norm_ffn + col);
        f32x4 v;
        v[0] = va[0] + bf_lo(xg.x) * __builtin_amdgcn_rcpf(g[0]); v[1] = va[1] + bf_hi(xg.x) * __builtin_amdgcn_rcpf(g[1]);
        v[2] = va[2] + bf_lo(xg.y) * __builtin_amdgcn_rcpf(g[2]); v[3] = va[3] + bf_hi(xg.y) * __builtin_amdgcn_rcpf(g[3]);
        float ss = (v[0] * v[0] + v[1] * v[1]) + (v[2] * v[2] + v[3] * v[3]);
        ss += __shfl_xor(ss, 16); ss += __shfl_xor(ss, 32);
        if (fq == 0) AG_ST(ssqt + lr * 64 + cu, ss);
        float s = 0.f;
        for (int tries = 0; tries < (1 << 16); ++tries) {
            bool ready = true; s = 0.f;
#pragma unroll
            for (int j = 0; j < 16; ++j) { const float a = AG_LD(ssqt + lr * 64 + 16 * fq + j); ready = ready && (a >= 0.f); s += a; }
            if (__all(ready)) break;
            __builtin_amdgcn_s_sleep(2);
        }
        s += __shfl_xor(s, 16); s += __shfl_xor(s, 32);
        const float r = rsqrtf(s * (1.0f / 1024.0f) + RMS_EPS);
        if (lr >= 16) *(f32x4*)(p.out + O_YS + (size_t)(lr - 16) * D + col) = v * r * *(const f32x4*)(p.g_norm_final + col);
    }
}

__device__ __forceinline__ void conv_fix(const Params& p) {
    unsigned char* ws = p.ws;
    const float* HALO = (const float*)(ws + WS_HALO); const float* UPT = (const float*)(ws + WS_UPT); bf16_t* ACT = (bf16_t*)(ws + WS_ACT);
    const float *cw = p.conv_w, *cb = p.conv_b;
    const int gt = blockIdx.x * 512 + threadIdx.x, NT = gridDim.x * 512;
    constexpr int NCH = FF / 4;
    constexpr int N_SLAB = 256 * 2 * NCH, N_SAMP = 128 * NCH;
    for (int it = gt; it < N_SLAB + N_SAMP; it += NT) {
        const float *u0, *u1, *u2; int row, j;
        if (it < N_SLAB) {
            const int ch = it % NCH, sr = it / NCH, rr = sr & 1, s = sr >> 1; j = ch * 4;
            row = s * 128 + rr;
            const float* l1 = (s & 31) ? HALO + (size_t)((s - 1) * 4 + 3) * FF2 : UPT + (size_t)15 * FF2;
            const float* l0 = (s & 31) ? HALO + (size_t)((s - 1) * 4 + 2) * FF2 : UPT + (size_t)14 * FF2;
            u0 = HALO + (size_t)(s * 4 + rr) * FF2;
            if (rr == 0) { u1 = l1; u2 = l0; } else { u1 = HALO + (size_t)(s * 4) * FF2; u2 = l1; }
        } else {
            const int t = it - N_SLAB, ch = t % NCH, q = t / NCH, b = q >> 4, i = q & 15; j = ch * 4;
            row = ROW_SAMP + q;
            u0 = UPT + (size_t)(16 + q) * FF2;
            u1 = (i >= 1) ? UPT + (size_t)(16 + q - 1) * FF2 : p.state_conv + ((size_t)b * 2 + 1) * FF2;
            u2 = (i >= 2) ? UPT + (size_t)(16 + q - 2) * FF2 : p.state_conv + ((size_t)b * 2 + i) * FF2;
        }
        const f32x4 g0 = *(const f32x4*)(u0 + j), g1 = *(const f32x4*)(u1 + j), g2 = *(const f32x4*)(u2 + j);
        const f32x4 v0 = *(const f32x4*)(u0 + FF + j), v1 = *(const f32x4*)(u1 + FF + j), v2 = *(const f32x4*)(u2 + FF + j);
        const f32x4 cg = *(const f32x4*)(cb + j) + *(const f32x4*)(cw + j) * g2 + *(const f32x4*)(cw + FF2 + j) * g1 + *(const f32x4*)(cw + 2 * FF2 + j) * g0;
        const f32x4 cv = *(const f32x4*)(cb + FF + j) + *(const f32x4*)(cw + FF + j) * v2 + *(const f32x4*)(cw + FF2 + FF + j) * v1 + *(const f32x4*)(cw + 2 * FF2 + FF + j) * v0;
        float a[4];
#pragma unroll
        for (int i = 0; i < 4; ++i) a[i] = cg[i] * sigmoidf_(cg[i]) * cv[i];
        u32x2 w; w.x = pk2(a[0], a[1]); w.y = pk2(a[2], a[3]);
        *(u32x2*)(ACT + (size_t)row * FF + j) = w;
    }
    { f32x4* q4 = (f32x4*)(ws + WS_SSQ2); for (int i = gt; i < MREAL * 4; i += NT) q4[i] = (f32x4){-1.f, -1.f, -1.f, -1.f};
      f32x4* t4 = (f32x4*)(ws + WS_SSQT2); for (int i = gt; i < 144 * 16; i += NT) t4[i] = (f32x4){-1.f, -1.f, -1.f, -1.f};
      unsigned* pc = (unsigned*)(ws + WS_PCNT); for (int i = gt; i < 128; i += NT) pc[64 * i] = 0u; }
    for (int i = gt; i < 8 * 2 * FF2; i += NT) {
        const int c = i % FF2, k = (i / FF2) & 1, b = i / (2 * FF2);
        p.out[O_PCONV + i] = HALO[(size_t)((b * 32 + 31) * 4 + 2 + k) * FF2 + c];
        p.out[O_SCONV + i] = UPT[(size_t)(16 + b * 16 + 14 + k) * FF2 + c];
    }
}
__device__ __forceinline__ void final_norm(const Params& p, int wave, int lane) {
    const float* ssq = (const float*)(p.ws + WS_SSQ2);
    const int gw = blockIdx.x * 8 + wave, NGW = gridDim.x * 8;
    f32x4 gv[4];
#pragma unroll
    for (int j = 0; j < 4; ++j) gv[j] = ((const f32x4*)p.g_norm_final)[lane + 64 * j];
    for (int m0 = gw * 4; m0 < MREAL + 128; m0 += NGW * 4) {
        float sv[4]; f32x4 x[4][4]; float* orow[4];
#pragma unroll
        for (int q = 0; q < 4; ++q) {
            const int m = m0 + q;
            orow[q] = m < MREAL ? p.out + O_YP + (size_t)m * D : p.out + O_YS + (size_t)(m - MREAL) * D;
            if (m < MREAL) sv[q] = ssq[(size_t)m * 16 + (lane & 15)];
            else { const float* st = (const float*)(p.ws + WS_SSQT2) + (16 + m - MREAL) * 64; sv[q] = (st[lane & 15] + st[16 + (lane & 15)]) + (st[32 + (lane & 15)] + st[48 + (lane & 15)]); }
#pragma unroll
            for (int j = 0; j < 4; ++j) x[q][j] = ((const f32x4*)orow[q])[lane + 64 * j];
        }
#pragma unroll
        for (int q = 0; q < 4; ++q) {
            float s = sv[q];
            s += __shfl_xor(s, 1); s += __shfl_xor(s, 2); s += __shfl_xor(s, 4); s += __shfl_xor(s, 8);
            const float r = rsqrtf(s * (1.0f / D) + RMS_EPS);
#pragma unroll
            for (int j = 0; j < 4; ++j) ((f32x4*)orow[q])[lane + 64 * j] = x[q][j] * r * gv[j];
        }
    }
}


struct EpiNull {
    static constexpr bool PERM = true, AFTER_DRAIN = false, APERM = false;
    float* sink;
    __device__ __forceinline__ void operator()(const f32x4 (&acc)[2][2][4][2], const Unit& u, int wr, int wc, int fr, int fq) const {
        f32x4 t = {0.f, 0.f, 0.f, 0.f};
#pragma unroll
        for (int a = 0; a < 2; ++a)
#pragma unroll
            for (int b = 0; b < 2; ++b)
#pragma unroll
                for (int m = 0; m < 4; ++m)
#pragma unroll
                    for (int n = 0; n < 2; ++n) t += acc[a][b][m][n];
        if (t[0] + t[1] + t[2] + t[3] == 123456.789f) sink[threadIdx.x] = t[0];
    }
};
struct SamePanelOrder {
    int G, c, nr;
    __device__ bool next(int i, Unit& u) const { if (i >= nr) return false; u.pm = 0; u.pn = (c >> 6) & 3; return true; }
    __device__ __forceinline__ void a_ready(const Unit&) const {}
    __device__ __forceinline__ void done(const Unit&) const {}
};

typedef unsigned v4u_unused_t;
#define XB_TMO      128
#define XB_XCNT(j)  (256  + 64 * (j))
#define XB_XSUB(j)  (1280 + 64 * (j))
#define XB_XGEN(j)  (2304 + 64 * (j))
#define XB_TOP      3328
#define XB_TOPGEN   3392
#define XCD_BAR_WORDS 3456
#define XB_SPIN_CAP (1u << 18)

__device__ __forceinline__ unsigned xb_ld(unsigned* p)              { return __hip_atomic_load(p, __ATOMIC_RELAXED, __HIP_MEMORY_SCOPE_AGENT); }
__device__ __forceinline__ unsigned xb_add(unsigned* p, unsigned v) { return __hip_atomic_fetch_add(p, v, __ATOMIC_RELAXED, __HIP_MEMORY_SCOPE_AGENT); }
__device__ __forceinline__ unsigned xb_xcc_id() { return (unsigned)__builtin_amdgcn_s_getreg((3 << 11) | 20) & 0xFu; }
#define XB_SPIN(cond, bar) do { unsigned _sp = 0; while (cond) { __builtin_amdgcn_s_sleep(1); \
    if ((++_sp & 255u) == 0u) { if (xb_ld(&(bar)[XB_TMO])) break; if (_sp > XB_SPIN_CAP) { atomicAdd(&(bar)[XB_TMO], 1u); break; } } } } while (0)

struct XcdBarrier {
    unsigned* bar; unsigned x;
    volatile LAS unsigned* st;
};

__device__ __forceinline__ XcdBarrier xcd_barrier_post(unsigned* bar, volatile LAS unsigned* st) {
    XcdBarrier b; b.bar = bar; b.x = xb_xcc_id(); b.st = st;
    if (threadIdx.x == 0) (void)xb_add(&bar[XB_XCNT(b.x)], 1u);
    return b;
}
__device__ __forceinline__ void xcd_barrier_complete(unsigned* bar, unsigned x, unsigned& nloc, unsigned& nx) {
    const unsigned G = gridDim.x * gridDim.y * gridDim.z;
    unsigned sum, cnt, mine, sp = 0u;
    for (;;) {
        sum = 0u; cnt = 0u; mine = 0u;
#pragma unroll
        for (unsigned j = 0; j < 16; ++j) { const unsigned c = xb_ld(&bar[XB_XCNT(j)]); sum += c; cnt += (c > 0u) ? 1u : 0u; mine = (j == x) ? c : mine; }
        if (sum == G) break;
        __builtin_amdgcn_s_sleep(1);
        if ((++sp & 255u) == 0u) { if (xb_ld(&bar[XB_TMO])) break; if (sp > XB_SPIN_CAP) { atomicAdd(&bar[XB_TMO], 1u); break; } }
    }
    nloc = mine > 0u ? mine : 1u; nx = cnt > 0u ? cnt : 1u;
}

__device__ __forceinline__ void xcd_barrier(const XcdBarrier& b) {
    asm volatile("s_waitcnt vmcnt(0)" ::: "memory");
    __syncthreads();
    if (threadIdx.x == 0) {
        unsigned* bar = b.bar;
        __builtin_amdgcn_s_waitcnt(0);
        unsigned nloc = b.st[0], nx = b.st[1];
        if (nloc == 0u) { xcd_barrier_complete(bar, b.x, nloc, nx); b.st[0] = nloc; b.st[1] = nx; }
        const unsigned old = xb_add(&bar[XB_XSUB(b.x)], 1u);
        const unsigned gen = old / nloc;
        if (old + 1u == (gen + 1u) * nloc) {
            __builtin_amdgcn_fence(__ATOMIC_RELEASE, "agent");
            asm volatile("s_waitcnt vmcnt(0)" ::: "memory");
            const unsigned og = xb_add(&bar[XB_TOP], 1u);
            const unsigned tg = og / nx;
            if (og + 1u == (tg + 1u) * nx) xb_add(&bar[XB_TOPGEN], 1u);
            else XB_SPIN(xb_ld(&bar[XB_TOPGEN]) == tg, bar);
            __builtin_amdgcn_fence(__ATOMIC_ACQUIRE, "agent");
            xb_add(&bar[XB_XGEN(b.x)], 1u);
            asm volatile("s_waitcnt vmcnt(0)" ::: "memory");
        } else {
            XB_SPIN(xb_ld(&bar[XB_XGEN(b.x)]) == gen, bar);
            __builtin_amdgcn_fence(__ATOMIC_ACQUIRE, "agent");
            asm volatile("s_waitcnt vmcnt(0)" ::: "memory");
        }
    }
    __syncthreads();
}

__device__ __forceinline__ void grid_bar(unsigned* ctr, unsigned target) {
    asm volatile("s_waitcnt vmcnt(0) lgkmcnt(0)" ::: "memory");
    __syncthreads();
    if (threadIdx.x == 0) {
        __hip_atomic_fetch_add(ctr, 1u, __ATOMIC_RELEASE, __HIP_MEMORY_SCOPE_AGENT);
        unsigned spins = 0;
        while (__hip_atomic_load(ctr, __ATOMIC_RELAXED, __HIP_MEMORY_SCOPE_AGENT) < target) { __builtin_amdgcn_s_sleep(2); if (++spins > (1u << 24)) break; }
        __builtin_amdgcn_fence(__ATOMIC_ACQUIRE, "agent");
        asm volatile("s_waitcnt vmcnt(0)" ::: "memory");
    }
    __syncthreads();
}
__global__ void __launch_bounds__(512, 2) fwd_megakernel(Params p) {
    extern __shared__ __attribute__((aligned(16))) unsigned char lds_raw[];
    LAS unsigned char* lds = (LAS unsigned char*)lds_raw;
    cg::grid_group grid = cg::this_grid();
    const int wave = __builtin_amdgcn_readfirstlane(threadIdx.x >> 6);
#define TIDLANE() int tid = threadIdx.x; asm volatile("" : "+v"(tid)); const int lane = tid & 63
    unsigned char* ws = p.ws;
    const int lo = p.ph_lo, hi = p.ph_hi, G = gridDim.x;
#define IN(k) (lo <= (k) && (k) < hi)
#define SEAM(k) do { if (IN(k) && IN((k) + 1)) xcd_barrier(xbar); } while (0)
    if (lo < 0) grid.sync();
    volatile LAS unsigned* xst = (volatile LAS unsigned*)(lds + LDS_BYTES - 32);
    if (threadIdx.x < 2) xst[threadIdx.x] = 0u;
    __syncthreads();
    XcdBarrier xbar = xcd_barrier_post((unsigned*)(ws + 4096), xst);
    if (IN(0)) { TIDLANE(); (void)tid; p0_prologue(p, lds, wave, lane); __syncthreads(); }
    SEAM(0);
    if (IN(1)) {
        pg8::Gemm g{(const bf16_t*)(ws + WS_XN), (const bf16_t*)(ws + WS_WIN), M, INW, D}; pg8::StaticOrder S; S.init(M, INW, G, (int)blockIdx.x);
        EpiZ E{(bf16_t*)(ws + WS_Q), (bf16_t*)(ws + WS_K), (bf16_t*)(ws + WS_V), (bf16_t*)(ws + WS_P), (bf16_t*)(ws + WS_GA), (bf16_t*)(ws + WS_GP), p.b_gate, (const float*)(ws + WS_ROPE)};
        pg8::gemm_phase<EpiZ, pg8::StaticOrder, true, true>(lds, g, S, E);
    }
    SEAM(1);
    if (IN(2)) {
        TIDLANE();
        for (int unit = blockIdx.x; unit < 1024; unit += G) attn_chunk_unit(p, lds, unit, tid, wave, lane);
        constexpr int N_EXTRA = 27;
        if (G > 2 * N_EXTRA) {
            if ((int)blockIdx.x < N_EXTRA) { const int e = blockIdx.x; if (e < 18) attn_small_unit(p, lds, e, tid, wave, lane); else pool_unit(p, lds, 512 + e - 18, tid, wave, lane); }
            else for (int unit = blockIdx.x - N_EXTRA; unit < 512; unit += G - N_EXTRA) pool_unit(p, lds, unit, tid, wave, lane);
        } else {
            for (int unit = blockIdx.x; unit < 18 + 521; unit += G) { if (unit < 18) attn_small_unit(p, lds, unit, tid, wave, lane); else pool_unit(p, lds, unit - 18, tid, wave, lane); }
        }
        small_outputs(p);
    }
    SEAM(2);
    if (IN(3)) {
        { TIDLANE(); (void)tid; for (int unit = blockIdx.x; unit < 192; unit += G) tail_mix_unit3(p, lds, unit, wave, lane); }
        { pg8::Gemm g{(const bf16_t*)(ws + WS_ATT), (const bf16_t*)(ws + WS_WAO), MREAL, D, D}; pg8::StaticOrder S; S.init(MREAL, D, G, (int)blockIdx.x);
          EpiT1 E{(const bf16_t*)(ws + WS_GA), (bf16_t*)(ws + WS_MIX)};
          pg8::gemm_phase<EpiT1, pg8::StaticOrder, true, true>(lds, g, S, E); }
        __syncthreads();
        { pg8::Gemm g{(const bf16_t*)(ws + WS_POOL), (const bf16_t*)(ws + WS_WPO), MREAL, D, PW}; pg8::StaticOrder S; S.init(MREAL, D, G, (int)blockIdx.x);
          EpiMix E{(const bf16_t*)(ws + WS_GP), (bf16_t*)(ws + WS_MIX)};
          pg8::gemm_phase<EpiMix, pg8::StaticOrder, true, true>(lds, g, S, E); }
    }
    SEAM(3);
    if (IN(4)) {
        { TIDLANE(); (void)tid; for (int unit = blockIdx.x; unit < 192; unit += G) tail_x1_unit3(p, lds, unit, wave, lane); }
        pg8::Gemm g{(const bf16_t*)(ws + WS_MIX), (const bf16_t*)(ws + WS_WOUT), MREAL, D, D}; pg8::StaticOrder S; S.init(MREAL, D, G, (int)blockIdx.x);
        EpiX1 E{(const bf16_t*)(ws + WS_XN), (const float*)(ws + WS_R0I), p.g_norm_mix, p.g_norm_ffn, (bf16_t*)(ws + WS_XG), (float*)(ws + WS_SSQ1)};
        pg8::gemm_phase<EpiX1, pg8::StaticOrder, true, true>(lds, g, S, E);
    }
    SEAM(4);
    if (IN(5)) {
        { TIDLANE(); (void)tid; for (int unit = blockIdx.x; unit < FF2 / 16; unit += G) tail_up_unit(p, lds, unit, wave, lane); }
        pg8::Gemm g{(const bf16_t*)(ws + WS_XG), (const bf16_t*)(ws + WS_WUP), MREAL, FF2, D}; pg8::StaticOrder S; S.init(MREAL, FF2, G, (int)blockIdx.x);
        EpiUp E{(const float*)(ws + WS_SSQ1), p.conv_w, p.conv_b, (bf16_t*)(ws + WS_ACT), (float*)(ws + WS_HALO), (float*)(ws + WS_UPT)};
        pg8::gemm_phase<EpiUp, pg8::StaticOrder, true, true>(lds, g, S, E);
    }
    SEAM(5);
    if (IN(6)) conv_fix(p);
    SEAM(6);
    if (IN(7)) {
        { TIDLANE(); (void)tid; for (int unit = blockIdx.x; unit < 192; unit += G) tail_down_unit3(p, lds, unit, wave, lane); }
        pg8::Gemm g{(const bf16_t*)(ws + WS_ACT), (const bf16_t*)(ws + WS_WDOWN), MREAL, D, FF}; pg8::StaticOrder S; S.init(MREAL, D, G, (int)blockIdx.x, 1);
        EpiDown E{(const bf16_t*)(ws + WS_XG), p.g_norm_ffn, p.g_norm_final, p.out, (float*)(ws + WS_SSQ2)};
        pg8::gemm_phase<EpiDown, pg8::StaticOrder, true, true>(lds, g, S, E);
    }
    if (IN(8)) { TIDLANE(); for (int unit = blockIdx.x; unit < 1024; unit += G) attn_chunk_unit(p, lds, unit, tid, wave, lane); }
    if (IN(9)) { TIDLANE(); for (int unit = blockIdx.x; unit < 512; unit += G) pool_unit(p, lds, unit, tid, wave, lane); }
    if (IN(12)) { TIDLANE(); for (int unit = 512 + blockIdx.x; unit < 521; unit += G) pool_unit(p, lds, unit, tid, wave, lane); }
    if (IN(10)) { TIDLANE(); for (int unit = blockIdx.x; unit < 18; unit += G) attn_small_unit(p, lds, unit, tid, wave, lane); }
    if (IN(11)) { small_outputs(p); }
    if (IN(17)) { pg8::Gemm g{(const bf16_t*)(ws + WS_ACT), (const bf16_t*)(ws + WS_WDOWN), MREAL, D, FF}; pg8::StaticOrder S; S.init(MREAL, D, G, (int)blockIdx.x, 1);
        EpiDown E{(const bf16_t*)(ws + WS_XG), p.g_norm_ffn, p.g_norm_final, p.out, (float*)(ws + WS_SSQ2)};
        pg8::gemm_phase<EpiDown, pg8::StaticOrder, true, true>(lds, g, S, E); }
    if (IN(18)) { TIDLANE(); (void)tid; for (int unit = blockIdx.x; unit < 192; unit += G) tail_down_unit3(p, lds, unit, wave, lane); }
    if (IN(14)) { pg8::Gemm g{(const bf16_t*)(ws + WS_ACT), (const bf16_t*)(ws + WS_WDOWN), MREAL, D, FF}; pg8::StaticOrder S; S.init(MREAL, D, G, (int)blockIdx.x, 1); EpiNull E{(float*)(ws + WS_SSQ1)};
        pg8::gemm_phase<EpiNull, pg8::StaticOrder, true, true>(lds, g, S, E); }
    if (IN(15)) { pg8::Gemm g{(const bf16_t*)(ws + WS_ACT), (const bf16_t*)(ws + WS_WDOWN), MREAL, D, FF}; SamePanelOrder S{G, (int)blockIdx.x, 2}; EpiNull E{(float*)(ws + WS_SSQ1)};
        pg8::gemm_phase<EpiNull, SamePanelOrder, true, true>(lds, g, S, E); }
    if (IN(16)) { pg8::Gemm g{(const bf16_t*)(ws + WS_MIX), (const bf16_t*)(ws + WS_WOUT), MREAL, D, D}; pg8::StaticOrder S; S.init(MREAL, D, G, (int)blockIdx.x); EpiNull E{(float*)(ws + WS_SSQ1)};
        pg8::gemm_phase<EpiNull, pg8::StaticOrder, true, true>(lds, g, S, E); }
#undef IN
#undef SEAM
}

#ifndef MK_N_LAUNCHES
#define MK_N_LAUNCHES 1
#endif
#ifndef PROBE_PHASE
#define PROBE_PHASE -1
#endif
extern "C" void kernel_launch(void* const* d_in, const int* in_sizes, int n_in, void* d_out, int out_size, void* d_ws, size_t ws_size, hipStream_t stream) {
    static int grid = 0;
    if (grid == 0) {
        if (n_in != 24 || (size_t)out_size != O_END || ws_size < WS_END) { fprintf(stderr, "kernel_launch: unexpected shapes: n_in %d out %d ws %zu (need %zu)\n", n_in, out_size, ws_size, (size_t)WS_END); grid = -1; return; }
        int dev = 0, cus = 0, per_cu = 0;
        hipGetDevice(&dev); hipDeviceGetAttribute(&cus, hipDeviceAttributeMultiprocessorCount, dev);
        if (hipFuncSetAttribute((const void*)fwd_megakernel, hipFuncAttributeMaxDynamicSharedMemorySize, LDS_BYTES) != hipSuccess) { fprintf(stderr, "kernel_launch: hipFuncSetAttribute failed\n"); grid = -1; return; }
        if (hipOccupancyMaxActiveBlocksPerMultiprocessor(&per_cu, (const void*)fwd_megakernel, 512, LDS_BYTES) != hipSuccess || per_cu < 1) { fprintf(stderr, "kernel_launch: occupancy query gave %d\n", per_cu); per_cu = 1; }
        (void)hipGetLastError();
        grid = cus;
        fprintf(stderr, "kernel_launch: grid %d (per_cu %d)\n", grid, per_cu);
    }
    if (grid < 0) return;
    Params p{};
    const float** pp = (const float**)&p;
    for (int i = 0; i < 24; ++i) pp[i] = (const float*)d_in[i];
    p.out = (float*)d_out; p.ws = (unsigned char*)d_ws;
    for (int i = 0; i < 32; ++i) p.inv_freq[i] = powf(10000.0f, -(float)i / 32.0f);
    const int NPH = 8;
    int seq[8][2]; int nseq = 0;
    if (PROBE_PHASE >= NPH) { seq[0][0] = 0; seq[0][1] = NPH; seq[1][0] = PROBE_PHASE; seq[1][1] = PROBE_PHASE + 1; nseq = 2; }
    else if (PROBE_PHASE >= 0) { seq[0][0] = 0; seq[0][1] = PROBE_PHASE + 1; seq[1][0] = PROBE_PHASE; seq[1][1] = PROBE_PHASE + 1; nseq = 2; if (PROBE_PHASE + 1 < NPH) { seq[2][0] = PROBE_PHASE + 1; seq[2][1] = NPH; nseq = 3; } }
    else { seq[0][0] = 0; seq[0][1] = NPH; nseq = 1; }
    for (int k = 0; k < nseq; ++k) {
        if (hipMemsetAsync(d_ws, 0, 32768, stream) != hipSuccess) fprintf(stderr, "kernel_launch: memset failed\n");
        p.ph_lo = seq[k][0]; p.ph_hi = seq[k][1];
        void* args[] = {&p}; hipError_t e = hipLaunchCooperativeKernel((const void*)fwd_megakernel, dim3(grid), dim3(512), args, LDS_BYTES, stream);
        if (e != hipSuccess) fprintf(stderr, "kernel_launch: cooperative launch %d failed: %s\n", k, hipGetErrorString(e));
    }
}
```

```cpp
#include <hip/hip_runtime.h>
#include <hip/hip_cooperative_groups.h>
#include <cstdio>
#include <cstdint>
#include <cmath>
namespace cg = cooperative_groups;
namespace pg8 {
#define PG8_LAS __attribute__((address_space(3)))
typedef unsigned short bf16_t;
typedef short bf16x8 __attribute__((ext_vector_type(8)));
typedef float f32x4 __attribute__((ext_vector_type(4)));
typedef unsigned u32x4 __attribute__((ext_vector_type(4)));
constexpr int BM = 256, BK = 64, HALF = 128, HTB = HALF * BK * 2  , STAGE_BYTES = 8 * HTB, NXCD = 8, WGM = 8;

__host__ __device__ __forceinline__ int lds_byte(int r, int c) { const int st = (r >> 4) * 2 + (c >> 5), rr = r & 15, cc = c & 31, ob = rr * 64 + cc * 2; return st * 1024 + (ob ^ (((ob >> 9) & 1) << 5)); }
__host__ __device__ __forceinline__ void stage_rc(int b, int& R, int& C) { const int st = b / 1024, sb = b % 1024, swz = sb ^ (((sb >> 9) & 1) << 5); R = (st >> 1) * 16 + swz / 64; C = (st & 1) * 32 + (swz % 64) / 2; }
__host__ __device__ __forceinline__ int perm32(int rho) { const int n = rho >> 4, i = rho & 15; return 8 * (i >> 2) + 4 * n + (i & 3); }

struct Unit { int pm, pn; };
struct Gemm { const bf16_t* A; const bf16_t* Bt; int M, N, K; };

struct StaticOrder {
    int nM, nN, nwg, G, c, rev;
    __host__ __device__ void init(int M, int N, int G_, int c_, int rev_ = 0) { nM = M / BM; nN = N / BM; nwg = nM * nN; G = G_; c = c_; rev = rev_; }
    __host__ __device__ bool next(int i, Unit& u) const {
        const int nr = (nwg + G - 1) / G;
        if (i >= nr) return false;
        const long L = (long)((rev && nwg % G == 0) ? nr - 1 - i : i) * G + c; if (L >= nwg) return false;
        int wgid = (int)L; { const int q = nwg / NXCD, r = nwg % NXCD, xcd = wgid % NXCD, off = wgid / NXCD; wgid = (xcd < r ? xcd * (q + 1) : r * (q + 1) + (xcd - r) * q) + off; }
        const int nig = WGM * nN, gid = wgid / nig, fm = gid * WGM, gsz = (nM - fm) < WGM ? (nM - fm) : WGM;
        u.pm = fm + ((wgid % nig) % gsz); u.pn = (wgid % nig) / gsz; return true;
    }
    __device__ __forceinline__ void a_ready(const Unit&) const {}
    __device__ __forceinline__ void done(const Unit&) const {}
};

__device__ __forceinline__ unsigned cvt_pk_bf16(float lo, float hi) { unsigned r; asm volatile("v_cvt_pk_bf16_f32 %0, %1, %2" : "=v"(r) : "v"(lo), "v"(hi)); return r; }
template <class Epi, class Sched, bool ALIGN_EPI = false, bool SP2 = false>
__device__ __forceinline__ void gemm_phase(PG8_LAS unsigned char* lds, const Gemm g, const Sched& S, const Epi& E) {
    const int tid = threadIdx.x, wid = __builtin_amdgcn_readfirstlane(tid >> 6), lane = tid & 63, wr = wid >> 2, wc = wid & 3, fr = lane & 15, fq = lane >> 4;
    const int K = g.K, nt = K / BK;
    unsigned voffA[2], voffB[2];
#pragma unroll
    for (int i = 0; i < 2; ++i) { int R, C; stage_rc(tid * 16 + i * 8192, R, C); const int Rb = Epi::PERM ? ((R & ~31) + perm32(R & 31)) : R;
        const int Ra = Epi::APERM ? ((R >> 6) * 128 + (R & 63)) : R;
        voffA[i] = (unsigned)(Ra * K + C) * 2u; voffB[i] = (unsigned)(Rb * K + C) * 2u; }
    const size_t kstep = (size_t)(BK * 2);
    const size_t hstep = (size_t)HALF * K * 2;
    const size_t tstep = 2 * hstep;
    const size_t hstepA = Epi::APERM ? (size_t)64 * K * 2 : hstep;
    const unsigned ldsw = (unsigned)wid * 1024u;
    const int aoff = lds_byte(wr * 64 + fr, fq * 8), boff = lds_byte(wc * 32 + fr, fq * 8);
#define PG8_SA(b, h) (((b) * 2 + (h)) * HTB)
#define PG8_SB(b, h) ((4 + (b) * 2 + (h)) * HTB)
#define PG8_STAGE(bufoff, gbase, voff) do { _Pragma("unroll") for (int _i = 0; _i < 2; ++_i) \
        __builtin_amdgcn_global_load_lds((const unsigned*)((const char*)(gbase) + (voff)[_i]), (PG8_LAS unsigned*)(lds + (bufoff) + ldsw + _i * 8192), 16, 0, 0); } while (0)
#define PG8_LDA(dst, b, h) do { _Pragma("unroll") for (int m = 0; m < 4; ++m) _Pragma("unroll") for (int k = 0; k < 2; ++k) dst[m][k] = *(const PG8_LAS bf16x8*)(lds + PG8_SA(b, h) + aoff + m * 2048 + k * 1024); } while (0)
#define PG8_LDB(dst, b, h) do { _Pragma("unroll") for (int n = 0; n < 2; ++n) _Pragma("unroll") for (int k = 0; k < 2; ++k) dst[n][k] = *(const PG8_LAS bf16x8*)(lds + PG8_SB(b, h) + boff + n * 2048 + k * 1024); } while (0)
#define PG8_MMA(ai, bj, At, Bt) do { __builtin_amdgcn_s_setprio(1); _Pragma("unroll") for (int m = 0; m < 4; ++m) _Pragma("unroll") for (int n = 0; n < 2; ++n) _Pragma("unroll") for (int k = 0; k < 2; ++k) \
        acc[ai][bj][m][n] = __builtin_amdgcn_mfma_f32_16x16x32_bf16(Bt[n][k], At[m][k], acc[ai][bj][m][n], 0, 0, 0); __builtin_amdgcn_s_setprio(0); } while (0)
#define PG8_WAIT_V(n) asm volatile("s_waitcnt vmcnt(" #n ")" ::: "memory")
#define PG8_WAIT_L(n) asm volatile("s_waitcnt lgkmcnt(" #n ")" ::: "memory")
#define PG8_BAR __builtin_amdgcn_s_barrier()
#define PG8_SCHED __builtin_amdgcn_sched_barrier(0)
    Unit cur, nxt; int ui = 0;
    if (!S.next(0, cur)) return;
    f32x4 acc[2][2][4][2];
#pragma unroll
    for (int a = 0; a < 2; ++a)
#pragma unroll
        for (int b = 0; b < 2; ++b)
#pragma unroll
            for (int m = 0; m < 4; ++m)
#pragma unroll
                for (int n = 0; n < 2; ++n) acc[a][b][m][n] = (f32x4){0.f, 0.f, 0.f, 0.f};
    bf16x8 At[4][2], B0[2][2], B1[2][2];
    const char* cA = (const char*)g.A + (size_t)cur.pm * tstep; const char* cB = (const char*)g.Bt + (size_t)cur.pn * tstep;
    S.a_ready(cur);
    if constexpr (SP2) {
        PG8_STAGE(PG8_SB(0, 0), cB, voffB); PG8_STAGE(PG8_SB(0, 1), cB + hstep, voffB); PG8_STAGE(PG8_SA(0, 0), cA, voffA); PG8_STAGE(PG8_SA(0, 1), cA + hstepA, voffA);
        if (wr == 1) PG8_BAR;
        PG8_WAIT_V(2); PG8_BAR;
        PG8_STAGE(PG8_SB(1, 0), cB + kstep, voffB); PG8_STAGE(PG8_SA(1, 0), cA + kstep, voffA); PG8_STAGE(PG8_SB(1, 1), cB + hstep + kstep, voffB);
        PG8_WAIT_V(6); PG8_BAR;
    } else {
        PG8_STAGE(PG8_SB(0, 0), cB, voffB); PG8_STAGE(PG8_SA(0, 0), cA, voffA); PG8_STAGE(PG8_SB(0, 1), cB + hstep, voffB); PG8_STAGE(PG8_SA(0, 1), cA + hstepA, voffA);
        if (wr == 1) PG8_BAR;
        PG8_WAIT_V(4); PG8_BAR;
        PG8_STAGE(PG8_SB(1, 0), cB + kstep, voffB); PG8_STAGE(PG8_SA(1, 0), cA + kstep, voffA); PG8_STAGE(PG8_SB(1, 1), cB + hstep + kstep, voffB);
        PG8_WAIT_V(6); PG8_BAR;
    }
    for (;;) {
        const bool has_next = S.next(ui + 1, nxt);
        const char* nA = has_next ? (const char*)g.A + (size_t)nxt.pm * tstep : cA; const char* nB = has_next ? (const char*)g.Bt + (size_t)nxt.pn * tstep : cB;
        for (int t = 0; t < nt; t += 2) {
            const bool last = (t == nt - 2);
            const char* a1 = cA + (size_t)(t + 1) * kstep;
            const char* a2 = last ? nA : cA + (size_t)(t + 2) * kstep; const char* b2 = last ? nB : cB + (size_t)(t + 2) * kstep;
            const char* a3 = a2 + kstep; const char* b3 = b2 + kstep;
            if (last && has_next) S.a_ready(nxt);
            if constexpr (SP2) {
            PG8_LDB(B0, 0, 0); PG8_LDB(B1, 0, 1); PG8_SCHED; PG8_LDA(At, 0, 0); PG8_STAGE(PG8_SA(1, 1), a1 + hstepA, voffA);
            PG8_WAIT_V(8); PG8_WAIT_L(0); PG8_BAR; PG8_MMA(0, 0, At, B0); PG8_MMA(0, 1, At, B1); PG8_BAR; PG8_SCHED;
            PG8_LDA(At, 0, 1); PG8_STAGE(PG8_SB(0, 0), b2, voffB); PG8_STAGE(PG8_SB(0, 1), b2 + hstep, voffB); PG8_STAGE(PG8_SA(0, 0), a2, voffA);
            PG8_WAIT_V(8); PG8_WAIT_L(0); PG8_BAR; PG8_MMA(1, 0, At, B0); PG8_MMA(1, 1, At, B1); PG8_BAR; PG8_SCHED;
            PG8_LDB(B0, 1, 0); PG8_LDB(B1, 1, 1); PG8_SCHED; PG8_LDA(At, 1, 0); PG8_STAGE(PG8_SA(0, 1), a2 + hstepA, voffA);
            PG8_WAIT_V(8); PG8_WAIT_L(0); PG8_BAR; PG8_MMA(0, 0, At, B0); PG8_MMA(0, 1, At, B1); PG8_BAR; PG8_SCHED;
            PG8_LDA(At, 1, 1); PG8_STAGE(PG8_SB(1, 0), b3, voffB); PG8_STAGE(PG8_SB(1, 1), b3 + hstep, voffB); PG8_STAGE(PG8_SA(1, 0), a3, voffA);
            PG8_WAIT_V(8); PG8_WAIT_L(0); PG8_BAR; PG8_MMA(1, 0, At, B0); PG8_MMA(1, 1, At, B1); PG8_BAR; PG8_SCHED;
            } else {
            PG8_LDB(B0, 0, 0); PG8_SCHED; PG8_LDA(At, 0, 0); PG8_STAGE(PG8_SA(1, 1), a1 + hstepA, voffA);
            PG8_WAIT_L(8); PG8_BAR; PG8_WAIT_L(0); PG8_MMA(0, 0, At, B0); PG8_BAR; PG8_SCHED;
            PG8_LDB(B1, 0, 1); PG8_STAGE(PG8_SB(0, 0), b2, voffB);
            PG8_BAR; PG8_WAIT_L(0); PG8_MMA(0, 1, At, B1); PG8_BAR;
            PG8_LDA(At, 0, 1); PG8_STAGE(PG8_SA(0, 0), a2, voffA);
            PG8_BAR; PG8_WAIT_L(0); PG8_MMA(1, 0, At, B0); PG8_BAR; PG8_SCHED;
            PG8_STAGE(PG8_SB(0, 1), b2 + hstep, voffB);
            PG8_WAIT_V(6); PG8_BAR; PG8_MMA(1, 1, At, B1); PG8_BAR;
            PG8_LDB(B0, 1, 0); PG8_SCHED; PG8_LDA(At, 1, 0); PG8_STAGE(PG8_SA(0, 1), a2 + hstepA, voffA);
            PG8_WAIT_L(8); PG8_BAR; PG8_WAIT_L(0); PG8_MMA(0, 0, At, B0); PG8_BAR; PG8_SCHED;
            PG8_LDB(B1, 1, 1); PG8_STAGE(PG8_SB(1, 0), b3, voffB);
            PG8_BAR; PG8_WAIT_L(0); PG8_MMA(0, 1, At, B1); PG8_BAR;
            PG8_LDA(At, 1, 1); PG8_STAGE(PG8_SA(1, 0), a3, voffA);
            PG8_BAR; PG8_WAIT_L(0); PG8_MMA(1, 0, At, B0); PG8_BAR; PG8_SCHED;
            PG8_STAGE(PG8_SB(1, 1), b3 + hstep, voffB);
            PG8_WAIT_V(6); PG8_BAR; PG8_MMA(1, 1, At, B1); PG8_BAR;
            }
        }
        if constexpr (ALIGN_EPI) { if (wr == 0) PG8_BAR; }
        if constexpr (!Epi::AFTER_DRAIN) { E(acc, cur, wr, wc, fr, fq); S.done(cur); }
        if (!has_next) break;
#pragma unroll
        for (int a = 0; a < 2; ++a)
#pragma unroll
            for (int b = 0; b < 2; ++b)
#pragma unroll
                for (int m = 0; m < 4; ++m)
#pragma unroll
                    for (int n = 0; n < 2; ++n) acc[a][b][m][n] = (f32x4){0.f, 0.f, 0.f, 0.f};
        cur = nxt; cA = nA; cB = nB; ++ui;
        if constexpr (ALIGN_EPI) { if (wr == 1) PG8_BAR; }
    }
    PG8_WAIT_V(0);
    if constexpr (!ALIGN_EPI) { if (wr == 0) PG8_BAR; }
    PG8_BAR;
    if constexpr (Epi::AFTER_DRAIN) { E.fused(acc, cur, wr, wc, fr, fq, lds, wid, lane); S.done(cur); }
#undef PG8_SA
#undef PG8_SB
#undef PG8_STAGE
#undef PG8_LDA
#undef PG8_LDB
#undef PG8_MMA
#undef PG8_WAIT_V
#undef PG8_WAIT_L
#undef PG8_BAR
#undef PG8_SCHED
}
}

using pg8::bf16_t; using pg8::bf16x8; using pg8::f32x4; using pg8::u32x4; using pg8::Unit;
#define LAS __attribute__((address_space(3)))
typedef float f32x2v __attribute__((ext_vector_type(2)));
typedef __bf16 bf16x2v __attribute__((ext_vector_type(2)));
typedef unsigned u32x2 __attribute__((ext_vector_type(2)));

constexpr int D = 1024, NBATCH = 8, SEQ = 4096;
constexpr int MREAL = NBATCH * SEQ;
constexpr int ROW_META = MREAL;
constexpr int ROW_SAMP = MREAL + 16;
constexpr int ROW_PAD = ROW_SAMP + 128;
constexpr int M = MREAL + 256;
constexpr int INW = 3840, FF = 2816, FF2 = 5632, PW = 512;
constexpr float RMS_EPS = 1e-6f;
constexpr int NPOS = 4112;

constexpr size_t MiB = 1u << 20;
constexpr size_t WS_ROPE = 1 * MiB, WS_SSQ1 = 3 * MiB, WS_SSQ2 = 6 * MiB;
constexpr size_t WS_WIN = 9 * MiB, WS_WAO = 17 * MiB, WS_WPO = 19 * MiB, WS_WOUT = 20 * MiB, WS_WUP = 22 * MiB, WS_WDOWN = 33 * MiB, WS_WGRP = 39 * MiB;
constexpr size_t WS_XN = 40 * MiB, WS_MIX = 105 * MiB  , WS_HALO = 40 * MiB, WS_UPT = 84 * MiB;
constexpr size_t WS_R0I = 64 * 1024;
constexpr size_t WS_Q = 105 * MiB, WS_K = 170 * MiB, WS_V = 179 * MiB, WS_P = 188 * MiB, WS_GA = 221 * MiB, WS_GP = 286 * MiB, WS_ATT = 351 * MiB, WS_POOL = 416 * MiB;
constexpr size_t WS_X1 = 105 * MiB, WS_XG = 234 * MiB, WS_ACT = 299 * MiB, WS_END = 477 * MiB;

constexpr int LDS_BYTES = 147456;

struct Params {
    const float *x_prompt, *x_sample, *cache_swa_k, *cache_swa_v, *cache_meta_k, *cache_meta_v, *state_pool, *state_conv, *meta_tokens, *g_norm_mix, *w_in, *b_gate, *sinks,
        *w_attn_o, *w_pool_grp, *pool_scale, *w_pool_o, *w_out, *g_norm_ffn, *w_up, *conv_w, *conv_b, *w_down, *g_norm_final;
    float* out; unsigned char* ws;
    float inv_freq[32];
    int ph_lo, ph_hi;
};
constexpr size_t O_YP = 0, O_YS = O_YP + (size_t)MREAL * D, O_PSK = O_YS + 128 * D, O_PSV = O_PSK + 131072, O_KM = O_PSV + 131072, O_VM = O_KM + 16384,
    O_PPOOL = O_VM + 16384, O_PCONV = O_PPOOL + 61440, O_SSK = O_PCONV + 90112, O_SSV = O_SSK + 16384, O_SPOOL = O_SSV + 16384, O_SCONV = O_SPOOL + 61440, O_END = O_SCONV + 90112;

__device__ __forceinline__ unsigned pk2(float lo, float hi) { f32x2v v = {lo, hi}; bf16x2v b = __builtin_convertvector(v, bf16x2v); return __builtin_bit_cast(unsigned, b); }
__device__ __forceinline__ float bf_lo(unsigned u) { return __uint_as_float(u << 16); }
__device__ __forceinline__ float bf_hi(unsigned u) { return __uint_as_float(u & 0xffff0000u); }
__device__ __forceinline__ float bf1(bf16_t h) { return __uint_as_float((unsigned)h << 16); }
__device__ __forceinline__ int row_pos(int r) {
    if (r < MREAL) return 16 + (r & 4095);
    if (r < ROW_SAMP) return r - ROW_META;
    if (r < ROW_PAD) return 16 + 1024 + ((r - ROW_SAMP) & 15);
    return 0;
}
__device__ __forceinline__ const float* row_x(const float* xp, const float* mt, const float* xs, int r) {
    if (r < MREAL) return xp + (size_t)r * D;
    if (r < ROW_SAMP) return mt + (size_t)(r - ROW_META) * D;
    if (r < ROW_PAD) return xs + (size_t)(r - ROW_SAMP) * D;
    return nullptr;
}
__device__ __forceinline__ float wave_sum(float v) {
#pragma unroll
    for (int o = 1; o < 64; o <<= 1) v += __shfl_xor(v, o);
    return v;
}
__device__ __forceinline__ float sigmoidf_(float x) { return __builtin_amdgcn_rcpf(1.0f + __builtin_amdgcn_exp2f(x * -1.4426950408889634f)); }

struct EpiZ {
    static constexpr bool PERM = true, AFTER_DRAIN = false, APERM = false;
    bf16_t *Q, *Kb, *Vb, *Pb, *GA, *GP; const float* b_gate; const float* rope;
    __device__ __forceinline__ void operator()(const f32x4 (&acc)[2][2][4][2], const Unit& u, int wr, int wc, int fr_in, int fq_in) const {
        int fr = fr_in, fq = fq_in; asm volatile("" : "+v"(fr), "+v"(fq));
        const int pn = u.pn, cw = wc * 32 + 8 * fq;
        if (pn < 4) {
#pragma unroll
            for (int ai = 0; ai < 2; ++ai) {
                f32x4 t[4][2][2];
#pragma unroll
                for (int m = 0; m < 4; ++m) {
                    const int row = u.pm * 256 + ai * 128 + wr * 64 + m * 16 + fr; const int pos = row_pos(row);
#pragma unroll
                    for (int bj = 0; bj < 2; ++bj) { const f32x4* tp = (const f32x4*)(rope + ((size_t)pos * 32 + (((bj * 128 + cw) & 63) >> 1)) * 2); t[m][bj][0] = tp[0]; t[m][bj][1] = tp[1]; }
                }
#pragma unroll
                for (int m = 0; m < 4; ++m) {
                    const int row = u.pm * 256 + ai * 128 + wr * 64 + m * 16 + fr;
#pragma unroll
                    for (int bj = 0; bj < 2; ++bj) {
                        const f32x4 v0 = acc[ai][bj][m][0], v1 = acc[ai][bj][m][1], t0 = t[m][bj][0], t1 = t[m][bj][1];
                        u32x4 w;
                        w.x = pk2(v0[0] * t0[0] - v0[1] * t0[1], v0[1] * t0[0] + v0[0] * t0[1]); w.y = pk2(v0[2] * t0[2] - v0[3] * t0[3], v0[3] * t0[2] + v0[2] * t0[3]);
                        w.z = pk2(v1[0] * t1[0] - v1[1] * t1[1], v1[1] * t1[0] + v1[0] * t1[1]); w.w = pk2(v1[2] * t1[2] - v1[3] * t1[3], v1[3] * t1[2] + v1[2] * t1[3]);
                        *(u32x4*)(Q + (size_t)row * 1024 + pn * 256 + bj * 128 + cw) = w;
                    }
                }
            }
        } else if (pn == 4) {
            f32x4 t[2][4][2];
#pragma unroll
            for (int ai = 0; ai < 2; ++ai)
#pragma unroll
                for (int m = 0; m < 4; ++m) {
                    const int row = u.pm * 256 + ai * 128 + wr * 64 + m * 16 + fr; const int pos = row_pos(row);
                    const f32x4* tp = (const f32x4*)(rope + ((size_t)pos * 32 + ((cw & 63) >> 1)) * 2); t[ai][m][0] = tp[0]; t[ai][m][1] = tp[1];
                }
#pragma unroll
            for (int ai = 0; ai < 2; ++ai)
#pragma unroll
                for (int m = 0; m < 4; ++m) {
                    const int row = u.pm * 256 + ai * 128 + wr * 64 + m * 16 + fr;
                    { const f32x4 v0 = acc[ai][0][m][0], v1 = acc[ai][0][m][1], t0 = t[ai][m][0], t1 = t[ai][m][1];
                      u32x4 w;
                      w.x = pk2(v0[0] * t0[0] - v0[1] * t0[1], v0[1] * t0[0] + v0[0] * t0[1]); w.y = pk2(v0[2] * t0[2] - v0[3] * t0[3], v0[3] * t0[2] + v0[2] * t0[3]);
                      w.z = pk2(v1[0] * t1[0] - v1[1] * t1[1], v1[1] * t1[0] + v1[0] * t1[1]); w.w = pk2(v1[2] * t1[2] - v1[3] * t1[3], v1[3] * t1[2] + v1[2] * t1[3]);
                      *(u32x4*)(Kb + (size_t)row * 128 + cw) = w; }
                    { const f32x4 v0 = acc[ai][1][m][0], v1 = acc[ai][1][m][1];
                      u32x4 w; w.x = pk2(v0[0], v0[1]); w.y = pk2(v0[2], v0[3]); w.z = pk2(v1[0], v1[1]); w.w = pk2(v1[2], v1[3]);
                      *(u32x4*)(Vb + (size_t)row * 128 + cw) = w; }
                }
        } else if (pn < 7) {
#pragma unroll
            for (int ai = 0; ai < 2; ++ai)
#pragma unroll
                for (int m = 0; m < 4; ++m) {
                    const int row = u.pm * 256 + ai * 128 + wr * 64 + m * 16 + fr;
#pragma unroll
                    for (int bj = 0; bj < 2; ++bj) {
                        const f32x4 v0 = acc[ai][bj][m][0], v1 = acc[ai][bj][m][1];
                        u32x4 w; w.x = pk2(v0[0], v0[1]); w.y = pk2(v0[2], v0[3]); w.z = pk2(v1[0], v1[1]); w.w = pk2(v1[2], v1[3]);
                        *(u32x4*)(Pb + (size_t)row * 512 + (pn - 5) * 256 + bj * 128 + cw) = w;
                    }
                }
        } else {
            const int gc = pn * 256 - 1792 + cw;
            f32x4 b[2][2];
#pragma unroll
            for (int bj = 0; bj < 2; ++bj) { b[bj][0] = *(const f32x4*)(b_gate + gc + bj * 128); b[bj][1] = *(const f32x4*)(b_gate + gc + bj * 128 + 4); }
            bf16_t* dstb = (pn < 11) ? GA + gc : GP + (gc - 1024);
#pragma unroll
            for (int ai = 0; ai < 2; ++ai)
#pragma unroll
                for (int m = 0; m < 4; ++m) {
                    const int row = u.pm * 256 + ai * 128 + wr * 64 + m * 16 + fr;
#pragma unroll
                    for (int bj = 0; bj < 2; ++bj) {
                        f32x4 v0 = acc[ai][bj][m][0] + b[bj][0], v1 = acc[ai][bj][m][1] + b[bj][1];
#pragma unroll
                        for (int i = 0; i < 4; ++i) { v0[i] = sigmoidf_(v0[i]); v1[i] = sigmoidf_(v1[i]); }
                        u32x4 w; w.x = pk2(v0[0], v0[1]); w.y = pk2(v0[2], v0[3]); w.z = pk2(v1[0], v1[1]); w.w = pk2(v1[2], v1[3]);
                        __builtin_nontemporal_store(w, (u32x4*)(dstb + (size_t)row * 1024 + bj * 128));
                    }
                }
        }
    }
};
struct EpiT1 {
    static constexpr bool PERM = true, AFTER_DRAIN = false, APERM = false;
    const bf16_t* G; bf16_t* O;
    __device__ __forceinline__ void operator()(const f32x4 (&acc)[2][2][4][2], const Unit& u, int wr, int wc, int fr_in, int fq_in) const {
        int fr = fr_in, fq = fq_in; asm volatile("" : "+v"(fr), "+v"(fq));
        const size_t base = (size_t)(u.pm * 256 + wr * 64 + fr) * 1024 + u.pn * 256 + wc * 32 + 8 * fq;
        u32x4 g[2][4][2];
#pragma unroll
        for (int ai = 0; ai < 2; ++ai)
#pragma unroll
            for (int m = 0; m < 4; ++m)
#pragma unroll
                for (int bj = 0; bj < 2; ++bj) g[ai][m][bj] = __builtin_nontemporal_load((const u32x4*)(G + base + (size_t)(ai * 128 + m * 16) * 1024 + bj * 128));
#pragma unroll
        for (int ai = 0; ai < 2; ++ai)
#pragma unroll
            for (int m = 0; m < 4; ++m)
#pragma unroll
                for (int bj = 0; bj < 2; ++bj) {
                    const u32x4 gg = g[ai][m][bj]; const f32x4 v0 = acc[ai][bj][m][0], v1 = acc[ai][bj][m][1];
                    u32x4 w; w.x = pk2(v0[0] * bf_lo(gg.x), v0[1] * bf_hi(gg.x)); w.y = pk2(v0[2] * bf_lo(gg.y), v0[3] * bf_hi(gg.y));
                    w.z = pk2(v1[0] * bf_lo(gg.z), v1[1] * bf_hi(gg.z)); w.w = pk2(v1[2] * bf_lo(gg.w), v1[3] * bf_hi(gg.w));
                    *(u32x4*)(O + base + (size_t)(ai * 128 + m * 16) * 1024 + bj * 128) = w;
                }
    }
};
struct EpiMix {
    static constexpr bool PERM = true, AFTER_DRAIN = false, APERM = false;
    const bf16_t* G; bf16_t* O;
    __device__ __forceinline__ void operator()(const f32x4 (&acc)[2][2][4][2], const Unit& u, int wr, int wc, int fr_in, int fq_in) const {
        int fr = fr_in, fq = fq_in; asm volatile("" : "+v"(fr), "+v"(fq));
        const size_t base = (size_t)(u.pm * 256 + wr * 64 + fr) * 1024 + u.pn * 256 + wc * 32 + 8 * fq;
#pragma unroll
        for (int ai = 0; ai < 2; ++ai) {
            u32x4 g[4][2], t[4][2];
#pragma unroll
            for (int m = 0; m < 4; ++m)
#pragma unroll
                for (int bj = 0; bj < 2; ++bj) { g[m][bj] = __builtin_nontemporal_load((const u32x4*)(G + base + (size_t)(ai * 128 + m * 16) * 1024 + bj * 128)); t[m][bj] = *(const u32x4*)(O + base + (size_t)(ai * 128 + m * 16) * 1024 + bj * 128); }
#pragma unroll
            for (int m = 0; m < 4; ++m)
#pragma unroll
                for (int bj = 0; bj < 2; ++bj) {
                    const u32x4 gg = g[m][bj], tt = t[m][bj]; const f32x4 v0 = acc[ai][bj][m][0], v1 = acc[ai][bj][m][1];
                    u32x4 w; w.x = pk2(bf_lo(tt.x) + v0[0] * bf_lo(gg.x), bf_hi(tt.x) + v0[1] * bf_hi(gg.x)); w.y = pk2(bf_lo(tt.y) + v0[2] * bf_lo(gg.y), bf_hi(tt.y) + v0[3] * bf_hi(gg.y));
                    w.z = pk2(bf_lo(tt.z) + v1[0] * bf_lo(gg.z), bf_hi(tt.z) + v1[1] * bf_hi(gg.z)); w.w = pk2(bf_lo(tt.w) + v1[2] * bf_lo(gg.w), bf_hi(tt.w) + v1[3] * bf_hi(gg.w));
                    *(u32x4*)(O + base + (size_t)(ai * 128 + m * 16) * 1024 + bj * 128) = w;
                }
        }
    }
};
struct EpiX1 {
    static constexpr bool PERM = true, AFTER_DRAIN = false, APERM = false;
    const bf16_t* XN; const float *r0i, *gmix, *gffn; bf16_t* XG; float* ssq;
    __device__ __forceinline__ void operator()(const f32x4 (&acc)[2][2][4][2], const Unit& u, int wr, int wc, int fr_in, int fq_in) const {
        int fr = fr_in, fq = fq_in; asm volatile("" : "+v"(fr), "+v"(fq));
        const int col0 = u.pn * 256 + wc * 32 + 8 * fq;
        f32x4 g[2][2], ig[2][2];
#pragma unroll
        for (int bj = 0; bj < 2; ++bj)
#pragma unroll
            for (int hh = 0; hh < 2; ++hh) { g[bj][hh] = *(const f32x4*)(gffn + col0 + bj * 128 + 4 * hh); const f32x4 gm = *(const f32x4*)(gmix + col0 + bj * 128 + 4 * hh);
#pragma unroll
                for (int i = 0; i < 4; ++i) ig[bj][hh][i] = __builtin_amdgcn_rcpf(gm[i]); }
#pragma unroll
        for (int ai = 0; ai < 2; ++ai) {
            u32x4 xn[4][2]; float ri[4];
#pragma unroll
            for (int m = 0; m < 4; ++m) {
                const int row = u.pm * 256 + ai * 128 + wr * 64 + m * 16 + fr;
                ri[m] = r0i[row];
#pragma unroll
                for (int bj = 0; bj < 2; ++bj) xn[m][bj] = *(const u32x4*)(XN + (size_t)row * 1024 + col0 + bj * 128);
            }
#pragma unroll
            for (int m = 0; m < 4; ++m) {
                const int row = u.pm * 256 + ai * 128 + wr * 64 + m * 16 + fr;
                const float rr = ri[m];
                float ss = 0.f;
#pragma unroll
                for (int bj = 0; bj < 2; ++bj) {
                    const u32x4 q = xn[m][bj];
                    f32x4 x0, x1;
                    x0[0] = bf_lo(q.x) * rr * ig[bj][0][0]; x0[1] = bf_hi(q.x) * rr * ig[bj][0][1]; x0[2] = bf_lo(q.y) * rr * ig[bj][0][2]; x0[3] = bf_hi(q.y) * rr * ig[bj][0][3];
                    x1[0] = bf_lo(q.z) * rr * ig[bj][1][0]; x1[1] = bf_hi(q.z) * rr * ig[bj][1][1]; x1[2] = bf_lo(q.w) * rr * ig[bj][1][2]; x1[3] = bf_hi(q.w) * rr * ig[bj][1][3];
                    const f32x4 v0 = acc[ai][bj][m][0] + x0, v1 = acc[ai][bj][m][1] + x1, g0 = g[bj][0], g1 = g[bj][1];
                    u32x4 w; w.x = pk2(v0[0] * g0[0], v0[1] * g0[1]); w.y = pk2(v0[2] * g0[2], v0[3] * g0[3]); w.z = pk2(v1[0] * g1[0], v1[1] * g1[1]); w.w = pk2(v1[2] * g1[2], v1[3] * g1[3]);
                    *(u32x4*)(XG + (size_t)row * 1024 + col0 + bj * 128) = w;
                    ss += (v0[0] * v0[0] + v0[1] * v0[1]) + (v0[2] * v0[2] + v0[3] * v0[3]) + (v1[0] * v1[0] + v1[1] * v1[1]) + (v1[2] * v1[2] + v1[3] * v1[3]);
                }
                ss += __shfl_xor(ss, 16); ss += __shfl_xor(ss, 32);
                if (fq == 0) ssq[(size_t)row * 16 + u.pn * 4 + wc] = ss;
            }
        }
    }
};
__device__ __forceinline__ float ror1(float x) { return __builtin_bit_cast(float, __builtin_amdgcn_mov_dpp(__builtin_bit_cast(int, x), 0x121, 0xf, 0xf, false)); }
__device__ __forceinline__ float ror2(float x) { return __builtin_bit_cast(float, __builtin_amdgcn_mov_dpp(__builtin_bit_cast(int, x), 0x122, 0xf, 0xf, false)); }
__device__ __forceinline__ float shr1(float old, float x) { return __builtin_bit_cast(float, __builtin_amdgcn_update_dpp(__builtin_bit_cast(int, old), __builtin_bit_cast(int, x), 0x111, 0xf, 0xf, false)); }
__device__ __forceinline__ float shr2(float old, float x) { return __builtin_bit_cast(float, __builtin_amdgcn_update_dpp(__builtin_bit_cast(int, old), __builtin_bit_cast(int, x), 0x112, 0xf, 0xf, false)); }
struct EpiUp {
    static constexpr bool PERM = true, AFTER_DRAIN = false, APERM = true;
    const float *ssq, *cw, *cb; bf16_t* ACT; float* HALO; float* UPT;
    __device__ __forceinline__ void operator()(const f32x4 (&acc)[2][2][4][2], const Unit& u, int wr, int wc, int fr_in, int fq_in) const {
        int fr = fr_in, fq = fq_in; asm volatile("" : "+v"(fr), "+v"(fq));
        const int jb = u.pn * 128 + wc * 32 + 8 * fq;
        const int row0 = u.pm * 256 + wr * 128 + fr;
        float r1[2][4];
#pragma unroll
        for (int ai = 0; ai < 2; ++ai)
#pragma unroll
            for (int m = 0; m < 4; ++m) {
                const f32x4* sp = (const f32x4*)(ssq + (size_t)(row0 + ai * 64 + m * 16) * 16);
                const f32x4 a = sp[0], b = sp[1], c = sp[2], d = sp[3];
                const float s = ((a[0] + a[1]) + (a[2] + a[3])) + ((b[0] + b[1]) + (b[2] + b[3])) + ((c[0] + c[1]) + (c[2] + c[3])) + ((d[0] + d[1]) + (d[2] + d[3]));
                r1[ai][m] = rsqrtf(s * (1.0f / 1024.0f) + RMS_EPS);
            }
#pragma unroll
        for (int ai = 0; ai < 2; ++ai)
#pragma unroll
            for (int m = 0; m < 4; ++m) asm volatile("" : "+v"(r1[ai][m]));
        __builtin_amdgcn_sched_barrier(0);
        const int slab = u.pm * 2 + wr;
#pragma unroll
        for (int n = 0; n < 2; ++n) {
            int jg = jb + 4 * n; asm volatile("" : "+v"(jg) :: "memory");
            const f32x4 w0g = *(const f32x4*)(cw + jg), w1g = *(const f32x4*)(cw + FF2 + jg), w2g = *(const f32x4*)(cw + 2 * FF2 + jg), bg = *(const f32x4*)(cb + jg);
            const f32x4 w0v = *(const f32x4*)(cw + FF + jg), w1v = *(const f32x4*)(cw + FF2 + FF + jg), w2v = *(const f32x4*)(cw + 2 * FF2 + FF + jg), bv = *(const f32x4*)(cb + FF + jg);
            f32x4 pg = {0.f, 0.f, 0.f, 0.f}, pv = {0.f, 0.f, 0.f, 0.f};
#pragma unroll
            for (int ai = 0; ai < 2; ++ai) {
#pragma unroll
                for (int m = 0; m < 4; ++m) {
                    const int row = row0 + ai * 64 + m * 16;
                    const f32x4 ug = acc[ai][0][m][n] * r1[ai][m], uv = acc[ai][1][m][n] * r1[ai][m];
                    const bool first = (ai == 0 && m == 0), last = (ai == 1 && m == 3);
                    if (first && fr < 2) { *(f32x4*)(HALO + (size_t)(slab * 4 + fr) * FF2 + jg) = ug; *(f32x4*)(HALO + (size_t)(slab * 4 + fr) * FF2 + FF + jg) = uv; }
                    if (last && fr >= 14) { *(f32x4*)(HALO + (size_t)(slab * 4 + fr - 12) * FF2 + jg) = ug; *(f32x4*)(HALO + (size_t)(slab * 4 + fr - 12) * FF2 + FF + jg) = uv; }
                    f32x4 g1, g2, v1, v2;
#pragma unroll
                    for (int i = 0; i < 4; ++i) {
                        g1[i] = shr1(ror1(pg[i]), ug[i]); g2[i] = shr2(ror2(pg[i]), ug[i]);
                        v1[i] = shr1(ror1(pv[i]), uv[i]); v2[i] = shr2(ror2(pv[i]), uv[i]);
                    }
                    const f32x4 cg = bg + w0g * g2 + w1g * g1 + w2g * ug;
                    const f32x4 cv = bv + w0v * v2 + w1v * v1 + w2v * uv;
                    float a[4];
#pragma unroll
                    for (int i = 0; i < 4; ++i) a[i] = cg[i] * sigmoidf_(cg[i]) * cv[i];
                    if (!(first && fr < 2)) { u32x2 w; w.x = pk2(a[0], a[1]); w.y = pk2(a[2], a[3]); *(u32x2*)(ACT + (size_t)row * FF + jg) = w; }
                    pg = ug; pv = uv;
                }
            }
        }
    }
};
constexpr size_t WS_PCNT = 8 * MiB + 768 * 1024;
#define AG_LD(p) __hip_atomic_load((p), __ATOMIC_RELAXED, __HIP_MEMORY_SCOPE_AGENT)
#define AG_ST(p, v) __hip_atomic_store((p), (v), __ATOMIC_RELAXED, __HIP_MEMORY_SCOPE_AGENT)
struct EpiDown {
    static constexpr bool PERM = true, AFTER_DRAIN = false, APERM = false;
    const bf16_t* XG; const float* gffn; const float* gfin; float* out; float* ssq;
    __device__ __forceinline__ void operator()(const f32x4 (&acc_c)[2][2][4][2], const Unit& u, int wr, int wc, int fr_in, int fq_in) const {
        int fr = fr_in, fq = fq_in; asm volatile("" : "+v"(fr), "+v"(fq));
        f32x4 (&acc)[2][2][4][2] = const_cast<f32x4 (&)[2][2][4][2]>(acc_c);
        const int col0 = u.pn * 256 + wc * 32 + 8 * fq;
        f32x4 ig[2][2];
#pragma unroll
        for (int bj = 0; bj < 2; ++bj)
#pragma unroll
            for (int hh = 0; hh < 2; ++hh) { const f32x4 gg = *(const f32x4*)(gffn + col0 + bj * 128 + 4 * hh);
#pragma unroll
                for (int i = 0; i < 4; ++i) ig[bj][hh][i] = __builtin_amdgcn_rcpf(gg[i]); }
#pragma unroll
        for (int ai = 0; ai < 2; ++ai) {
            u32x4 xgv[4][2];
#pragma unroll
            for (int m = 0; m < 4; ++m)
#pragma unroll
                for (int bj = 0; bj < 2; ++bj) xgv[m][bj] = __builtin_nontemporal_load((const u32x4*)(XG + (size_t)(u.pm * 256 + ai * 128 + wr * 64 + m * 16 + fr) * 1024 + col0 + bj * 128));
#pragma unroll
            for (int m = 0; m < 4; ++m) {
                const int row = u.pm * 256 + ai * 128 + wr * 64 + m * 16 + fr;
                float ss = 0.f;
#pragma unroll
                for (int bj = 0; bj < 2; ++bj) {
                    const u32x4 xg = xgv[m][bj];
                    f32x4 x0, x1;
                    x0[0] = bf_lo(xg.x) * ig[bj][0][0]; x0[1] = bf_hi(xg.x) * ig[bj][0][1]; x0[2] = bf_lo(xg.y) * ig[bj][0][2]; x0[3] = bf_hi(xg.y) * ig[bj][0][3];
                    x1[0] = bf_lo(xg.z) * ig[bj][1][0]; x1[1] = bf_hi(xg.z) * ig[bj][1][1]; x1[2] = bf_lo(xg.w) * ig[bj][1][2]; x1[3] = bf_hi(xg.w) * ig[bj][1][3];
                    const f32x4 v0 = acc[ai][bj][m][0] + x0, v1 = acc[ai][bj][m][1] + x1;
                    acc[ai][bj][m][0] = v0; acc[ai][bj][m][1] = v1;
                    ss += (v0[0] * v0[0] + v0[1] * v0[1]) + (v0[2] * v0[2] + v0[3] * v0[3]) + (v1[0] * v1[0] + v1[1] * v1[1]) + (v1[2] * v1[2] + v1[3] * v1[3]);
                }
                ss += __shfl_xor(ss, 16); ss += __shfl_xor(ss, 32);
                if (fq == 0) AG_ST(ssq + (size_t)row * 16 + u.pn * 4 + wc, ss);
            }
        }
        asm volatile("s_waitcnt vmcnt(0)" ::: "memory");
        unsigned* pc = (unsigned*)((char*)ssq + (WS_PCNT - WS_SSQ2)) + 64 * u.pm;
        if (fr == 0 && fq == 0) __hip_atomic_fetch_add(pc, 1u, __ATOMIC_RELAXED, __HIP_MEMORY_SCOPE_AGENT);
        for (int tries = 0; tries < (1 << 18); ++tries) {
            const unsigned c = (unsigned)__builtin_amdgcn_readfirstlane((int)AG_LD(pc));
            if (c >= 32u) break;
            __builtin_amdgcn_s_sleep(2);
        }
        float rs[2][4];
        {
            float* spb = ssq + (size_t)(u.pm * 256 + wr * 64 + fr) * 16 + 4 * fq;
#pragma unroll
            for (int ai = 0; ai < 2; ++ai)
#pragma unroll
                for (int m = 0; m < 4; ++m) {
                    float* sp = spb + (ai * 128 + m * 16) * 16;
                    const float a = AG_LD(sp), b = AG_LD(sp + 1), c = AG_LD(sp + 2), d = AG_LD(sp + 3);
                    rs[ai][m] = (a + b) + (c + d);
                }
        }
#pragma unroll
        for (int ai = 0; ai < 2; ++ai)
#pragma unroll
            for (int m = 0; m < 4; ++m) {
                const int row = u.pm * 256 + ai * 128 + wr * 64 + m * 16 + fr;
                float s = rs[ai][m]; s += __shfl_xor(s, 16); s += __shfl_xor(s, 32);
                const float r = rsqrtf(s * (1.0f / 1024.0f) + RMS_EPS);
                float* orow = out + O_YP + (size_t)row * D;
#pragma unroll
                for (int bj = 0; bj < 2; ++bj) {
                    const int col = u.pn * 256 + bj * 128 + wc * 32 + 8 * fq;
                    const f32x4 g0 = *(const f32x4*)(gfin + col), g1 = *(const f32x4*)(gfin + col + 4);
                    *(f32x4*)(orow + col) = acc[ai][bj][m][0] * r * g0; *(f32x4*)(orow + col + 4) = acc[ai][bj][m][1] * r * g1;
                }
            }
    }
};

struct MapId { __device__ __forceinline__ int operator()(int n) const { return n; } };
struct MapIn { __device__ __forceinline__ int operator()(int n) const { return n < 1152 ? ((n & ~63) + 2 * (n & 31) + ((n >> 5) & 1)) : n; } };
struct MapUp { __device__ __forceinline__ int operator()(int n) const { if (n < FF) return 256 * (n >> 7) + (n & 127); const int m = n - FF; return 256 * (m >> 7) + 128 + (m & 127); } };
template <class Map>
__device__ __forceinline__ void p0_transpose_item(const float* W, int K, int N, bf16_t* WT, LAS float* scr, int item, int lane, Map map) {
    const int nblk = N / 32, kb = item / nblk, nb = item % nblk, k0 = 64 * kb, n0 = 32 * nb;
#pragma unroll
    for (int i = 0; i < 32; ++i) { const int kk = 2 * i + (lane >> 5); scr[kk * 33 + (lane & 31)] = __builtin_nontemporal_load(W + (size_t)(k0 + kk) * N + n0 + (lane & 31)); }
    asm volatile("s_waitcnt lgkmcnt(0)" ::: "memory");
    const int c = lane & 7;
#pragma unroll
    for (int j = 0; j < 4; ++j) { const int n = (lane >> 3) + 8 * j; const LAS float* s = scr + (8 * c) * 33 + n;
        u32x4 o; o.x = pk2(s[0 * 33], s[1 * 33]); o.y = pk2(s[2 * 33], s[3 * 33]); o.z = pk2(s[4 * 33], s[5 * 33]); o.w = pk2(s[6 * 33], s[7 * 33]);
        *(u32x4*)(WT + (size_t)map(n0 + n) * K + k0 + 8 * c) = o; }
    asm volatile("s_waitcnt lgkmcnt(0)" ::: "memory");
}
__device__ __forceinline__ void p0_prologue(const Params& p, LAS unsigned char* lds, int wave, int lane) {
    unsigned char* ws = p.ws;
    if (wave < 4) {
        bf16_t* XN = (bf16_t*)(ws + WS_XN);
        const int gw = blockIdx.x * 4 + wave, NGW = gridDim.x * 4;
        f32x4 gv[4];
#pragma unroll
        for (int j = 0; j < 4; ++j) gv[j] = ((const f32x4*)p.g_norm_mix)[lane + 64 * j];
        for (int m0 = gw * 4; m0 < M; m0 += NGW * 4) {
            f32x4 v[4][4]; const float* xr[4];
#pragma unroll
            for (int q = 0; q < 4; ++q) {
                xr[q] = row_x(p.x_prompt, p.meta_tokens, p.x_sample, m0 + q);
#pragma unroll
                for (int j = 0; j < 4; ++j) v[q][j] = xr[q] ? __builtin_nontemporal_load((const f32x4*)xr[q] + lane + 64 * j) : (f32x4){0.f, 0.f, 0.f, 0.f};
            }
#pragma unroll
            for (int q = 0; q < 4; ++q) {
                float s = 0.f;
#pragma unroll
                for (int j = 0; j < 4; ++j) s += (v[q][j][0] * v[q][j][0] + v[q][j][1] * v[q][j][1]) + (v[q][j][2] * v[q][j][2] + v[q][j][3] * v[q][j][3]);
                const float ms = wave_sum(s) * (1.0f / D) + RMS_EPS;
                const float r = rsqrtf(ms);
                if (lane == 0) ((float*)(ws + WS_R0I))[m0 + q] = sqrtf(ms);
                unsigned long long* o8 = (unsigned long long*)(XN + (size_t)(m0 + q) * D) + lane;
#pragma unroll
                for (int j = 0; j < 4; ++j) { const f32x4 w = v[q][j] * r * gv[j]; o8[64 * j] = (unsigned long long)pk2(w[0], w[1]) | ((unsigned long long)pk2(w[2], w[3]) << 32); }
            }
        }
        return;
    }
    LAS float* scr = (LAS float*)(lds + wave * 16384);
    const int gw = blockIdx.x * 4 + (wave - 4), NGW = gridDim.x * 4;
    const int gt = blockIdx.x * 256 + (int)threadIdx.x - 256, NT = gridDim.x * 256;
    constexpr int I_IN = 16 * (INW / 32), I_AO = 16 * 32, I_OUT = 16 * 32, I_UP = 16 * (FF2 / 32), I_DN = (FF / 64) * 32;
    constexpr int NITEMS = I_IN + I_AO + I_OUT + I_UP + I_DN;
    for (int it = gw; it < NITEMS; it += NGW) {
        int r = it;
        if (r < I_IN) { p0_transpose_item(p.w_in, D, INW, (bf16_t*)(ws + WS_WIN), scr, r, lane, MapIn()); continue; } r -= I_IN;
        if (r < I_AO) { p0_transpose_item(p.w_attn_o, D, D, (bf16_t*)(ws + WS_WAO), scr, r, lane, MapId()); continue; } r -= I_AO;
        if (r < I_OUT) { p0_transpose_item(p.w_out, D, D, (bf16_t*)(ws + WS_WOUT), scr, r, lane, MapId()); continue; } r -= I_OUT;
        if (r < I_UP) { p0_transpose_item(p.w_up, D, FF2, (bf16_t*)(ws + WS_WUP), scr, r, lane, MapUp()); continue; } r -= I_UP;
        p0_transpose_item(p.w_down, FF, D, (bf16_t*)(ws + WS_WDOWN), scr, r, lane, MapId());
    }
    {
        bf16_t* WP = (bf16_t*)(ws + WS_WPO);
        for (int idx = gt; idx < 1024 * 128; idx += NT) {
            const int n = idx & 1023, k0 = (idx >> 10) * 4, g = k0 >> 7;
            const float* wg = p.w_pool_grp + (size_t)k0 * 128;
            const float* sc = p.pool_scale + g * 128;
            const float* wo = p.w_pool_o + (size_t)(g * 128) * 1024 + n;
            float a[4] = {0.f, 0.f, 0.f, 0.f};
#pragma unroll 2
            for (int d = 0; d < 128; d += 4) {
                const f32x4 s4 = *(const f32x4*)(sc + d);
                float wv[4];
#pragma unroll
                for (int e = 0; e < 4; ++e) wv[e] = wo[(size_t)(d + e) * 1024] * s4[e];
#pragma unroll
                for (int j = 0; j < 4; ++j) { const f32x4 w4 = *(const f32x4*)(wg + j * 128 + d); a[j] += (w4[0] * wv[0] + w4[1] * wv[1]) + (w4[2] * wv[2] + w4[3] * wv[3]); }
            }
            u32x2 o; o.x = pk2(a[0], a[1]); o.y = pk2(a[2], a[3]);
            *(u32x2*)(WP + (size_t)n * 512 + k0) = o;
        }
    }
    float* rope = (float*)(ws + WS_ROPE);
    for (int i = gt; i < NPOS * 32; i += NT) {
        const int pos = i >> 5, d = i & 31;
        const float ang = (float)pos * p.inv_freq[d];
        const double rev = (double)ang * 0.15915494309189535;
        const float fr = (float)(rev - floor(rev));
        rope[2 * i] = __builtin_amdgcn_cosf(fr); rope[2 * i + 1] = __builtin_amdgcn_sinf(fr);
    }
}

constexpr int KS_PITCH = 144, VT_PITCH = 464, ATT_VT_OFF = 208 * KS_PITCH;
constexpr float LOG2E = 1.4426950408889634f, C2 = 0.125f * 1.4426950408889634f;

template <int NQ>
__device__ __forceinline__ void attn_load_q(bf16x8 (&qf)[NQ][2], const bf16_t* Qb, int qrow0, int h, int lane) {
    const int fr = lane & 15, fq = lane >> 4;
#pragma unroll
    for (int qb = 0; qb < NQ; ++qb)
#pragma unroll
        for (int ks = 0; ks < 2; ++ks) qf[qb][ks] = __builtin_nontemporal_load((const bf16x8*)(Qb + (size_t)(qrow0 + 16 * qb + fr) * 1024 + h * 64 + 32 * ks + 8 * fq));
}
template <int NQ>
__device__ __forceinline__ void attn_compute(LAS unsigned char* lds, const bf16x8 (&qf)[NQ][2], bf16_t* ATT, int qrow0, int h, unsigned vmask, float sink2, int lane) {
    const int fr = lane & 15, fq = lane >> 4;
    f32x4 s[NQ][13];
    const LAS unsigned char* kp = lds + fr * KS_PITCH + fq * 16;
    bf16x8 kc0 = *(const LAS bf16x8*)kp, kc1 = *(const LAS bf16x8*)(kp + 64);
#pragma unroll
    for (int kb = 0; kb < 13; ++kb) {
        bf16x8 kn0 = kc0, kn1 = kc1;
        if (kb < 12) { kn0 = *(const LAS bf16x8*)(kp + (kb + 1) * 16 * KS_PITCH); kn1 = *(const LAS bf16x8*)(kp + (kb + 1) * 16 * KS_PITCH + 64); }
#pragma unroll
        for (int qb = 0; qb < NQ; ++qb) {
            f32x4 a = {0.f, 0.f, 0.f, 0.f};
            a = __builtin_amdgcn_mfma_f32_16x16x32_bf16(kc0, qf[qb][0], a, 0, 0, 0);
            a = __builtin_amdgcn_mfma_f32_16x16x32_bf16(kc1, qf[qb][1], a, 0, 0, 0);
            s[qb][kb] = a;
        }
        kc0 = kn0; kc1 = kn1;
        __builtin_amdgcn_sched_barrier(0);
    }
    float rl[NQ];
#pragma unroll
    for (int qb = 0; qb < NQ; ++qb) {
        float mr = -1e30f;
#pragma unroll
        for (int kb = 0; kb < 13; ++kb) {
            if (vmask != 0x1fffu) {
                const bool valid = (vmask >> kb) & 1u;
#pragma unroll
                for (int i = 0; i < 4; ++i) s[qb][kb][i] = valid ? s[qb][kb][i] : -1e30f;
            }
            mr = fmaxf(mr, fmaxf(fmaxf(s[qb][kb][0], s[qb][kb][1]), fmaxf(s[qb][kb][2], s[qb][kb][3])));
        }
        mr = fmaxf(mr, __shfl_xor(mr, 16)); mr = fmaxf(mr, __shfl_xor(mr, 32));
        const float mx = fmaxf(mr * C2, sink2), nmx = -mx;
        float l = 0.f;
#pragma unroll
        for (int kb = 0; kb < 13; ++kb)
#pragma unroll
            for (int i = 0; i < 4; ++i) { const float pv = __builtin_amdgcn_exp2f(fmaf(s[qb][kb][i], C2, nmx)); s[qb][kb][i] = pv; l += pv; }
        l += __shfl_xor(l, 16); l += __shfl_xor(l, 32);
        l += __builtin_amdgcn_exp2f(sink2 - mx);
        rl[qb] = __builtin_amdgcn_rcpf(l);
    }
    f32x4 o[NQ][4];
#pragma unroll
    for (int qb = 0; qb < NQ; ++qb)
#pragma unroll
        for (int db = 0; db < 4; ++db) o[qb][db] = (f32x4){0.f, 0.f, 0.f, 0.f};
    const LAS unsigned char* vp = lds + ATT_VT_OFF + fr * VT_PITCH + fq * 8;
    u32x2 vlo[4], vhi[4];
#pragma unroll
    for (int db = 0; db < 4; ++db) { vlo[db] = *(const LAS u32x2*)(vp + db * 16 * VT_PITCH); vhi[db] = *(const LAS u32x2*)(vp + db * 16 * VT_PITCH + 32); }
#pragma unroll
    for (int kk = 0; kk < 7; ++kk) {
        u32x2 nlo[4], nhi[4];
#pragma unroll
        for (int db = 0; db < 4; ++db) { nlo[db] = vlo[db]; nhi[db] = vhi[db]; }
        if (kk < 6) {
#pragma unroll
            for (int db = 0; db < 4; ++db) { nlo[db] = *(const LAS u32x2*)(vp + db * 16 * VT_PITCH + (kk + 1) * 64); nhi[db] = *(const LAS u32x2*)(vp + db * 16 * VT_PITCH + (kk + 1) * 64 + 32); }
        }
        bf16x8 pf[NQ];
#pragma unroll
        for (int qb = 0; qb < NQ; ++qb) {
            u32x4 w;
            w.x = pk2(s[qb][2 * kk][0], s[qb][2 * kk][1]); w.y = pk2(s[qb][2 * kk][2], s[qb][2 * kk][3]);
            if (2 * kk + 1 < 13) { w.z = pk2(s[qb][(2 * kk + 1) % 13][0], s[qb][(2 * kk + 1) % 13][1]); w.w = pk2(s[qb][(2 * kk + 1) % 13][2], s[qb][(2 * kk + 1) % 13][3]); }
            else { w.z = 0u; w.w = 0u; }
            pf[qb] = __builtin_bit_cast(bf16x8, w);
        }
#pragma unroll
        for (int db = 0; db < 4; ++db) {
            u32x4 vv; vv.x = vlo[db].x; vv.y = vlo[db].y; vv.z = vhi[db].x; vv.w = vhi[db].y;
            const bf16x8 vf = __builtin_bit_cast(bf16x8, vv);
#pragma unroll
            for (int qb = 0; qb < NQ; ++qb) o[qb][db] = __builtin_amdgcn_mfma_f32_16x16x32_bf16(vf, pf[qb], o[qb][db], 0, 0, 0);
        }
#pragma unroll
        for (int db = 0; db < 4; ++db) { vlo[db] = nlo[db]; vhi[db] = nhi[db]; }
        __builtin_amdgcn_sched_barrier(0);
    }
#pragma unroll
    for (int qb = 0; qb < NQ; ++qb)
#pragma unroll
        for (int db = 0; db < 4; ++db) {
            const f32x4 v = o[qb][db] * rl[qb];
            u32x2 w; w.x = pk2(v[0], v[1]); w.y = pk2(v[2], v[3]);
            *(u32x2*)(ATT + (size_t)(qrow0 + 16 * qb + fr) * 1024 + h * 64 + 16 * db + 4 * fq) = w;
        }
}
__device__ __forceinline__ void attn_zero_pad(LAS unsigned char* lds, int tid) {
    if (tid < 128) { const int row = tid >> 1, half = tid & 1; *(LAS u32x4*)(lds + ATT_VT_OFF + row * VT_PITCH + 416 + half * 16) = (u32x4){0u, 0u, 0u, 0u}; }
}
__device__ __forceinline__ void attn_fill_bf16(LAS unsigned char* lds, const bf16_t* Kb, const bf16_t* Vb, int srow, int n, int kk, int ch) {
    u32x4 kv = {0u, 0u, 0u, 0u}, vv = {0u, 0u, 0u, 0u};
    if (srow >= 0) { kv = *(const u32x4*)(Kb + (size_t)srow * 128 + n * 64 + ch * 8); vv = *(const u32x4*)(Vb + (size_t)srow * 128 + n * 64 + ch * 8); }
    *(LAS u32x4*)(lds + kk * KS_PITCH + ch * 16) = kv;
    LAS unsigned short* vt = (LAS unsigned short*)(lds + ATT_VT_OFF + (ch * 8) * VT_PITCH + kk * 2);
    vt[0 * (VT_PITCH / 2)] = (unsigned short)(vv.x & 0xffffu); vt[1 * (VT_PITCH / 2)] = (unsigned short)(vv.x >> 16);
    vt[2 * (VT_PITCH / 2)] = (unsigned short)(vv.y & 0xffffu); vt[3 * (VT_PITCH / 2)] = (unsigned short)(vv.y >> 16);
    vt[4 * (VT_PITCH / 2)] = (unsigned short)(vv.z & 0xffffu); vt[5 * (VT_PITCH / 2)] = (unsigned short)(vv.z >> 16);
    vt[6 * (VT_PITCH / 2)] = (unsigned short)(vv.w & 0xffffu); vt[7 * (VT_PITCH / 2)] = (unsigned short)(vv.w >> 16);
}
__device__ __forceinline__ void attn_fill_f32(LAS unsigned char* lds, const float* ksrc, const float* vsrc, int kk, int ch) {
    const f32x4 k0 = *(const f32x4*)(ksrc + ch * 8), k1 = *(const f32x4*)(ksrc + ch * 8 + 4);
    const f32x4 v0 = *(const f32x4*)(vsrc + ch * 8), v1 = *(const f32x4*)(vsrc + ch * 8 + 4);
    LAS unsigned short* kr = (LAS unsigned short*)(lds + kk * KS_PITCH);
    LAS unsigned short* vt = (LAS unsigned short*)(lds + ATT_VT_OFF + (ch * 8) * VT_PITCH + kk * 2);
#pragma unroll
    for (int e = 0; e < 8; ++e) {
        const int d = ch * 8 + e;
        const float kvv = e < 4 ? k0[e & 3] : k1[e & 3], vvv = e < 4 ? v0[e & 3] : v1[e & 3];
        kr[2 * (d & 31) + (d >> 5)] = (unsigned short)(pk2(kvv, 0.f) & 0xffffu);
        vt[e * (VT_PITCH / 2)] = (unsigned short)(pk2(vvv, 0.f) & 0xffffu);
    }
}
__device__ __forceinline__ void attn_chunk_unit(const Params& p, LAS unsigned char* lds, int unit, int tid, int wave, int lane) {
    unsigned char* ws = p.ws;
    const bf16_t *Qb = (const bf16_t*)(ws + WS_Q), *Kb = (const bf16_t*)(ws + WS_K), *Vb = (const bf16_t*)(ws + WS_V); bf16_t* ATT = (bf16_t*)(ws + WS_ATT);
    const int n = unit & 1, c = (unit >> 1) & 63, b = unit >> 7;
    asm volatile("" : "+v"(tid), "+v"(lane));
    const int h = n * 8 + wave, r0 = b * SEQ + c * 64;
    bf16x8 qa[2][2], qb2[2][2];
    attn_load_q<2>(qa, Qb, r0, h, lane);
#pragma unroll
    for (int jb = 0; jb < 2; ++jb) {
        u32x4 kv[2], vv[2];
#pragma unroll
        for (int j = 0; j < 2; ++j) {
            const int i = tid + 512 * (2 * jb + j), kk = i >> 3, ch = i & 7;
            int srow;
            if (kk < 16) srow = ROW_META + kk;
            else { const int t = (c - 2) * 64 + kk - 16; srow = t < 0 ? -1 : b * SEQ + t; }
            kv[j] = (u32x4){0u, 0u, 0u, 0u}; vv[j] = (u32x4){0u, 0u, 0u, 0u};
            if (i < 208 * 8 && srow >= 0) { kv[j] = *(const u32x4*)(Kb + (size_t)srow * 128 + n * 64 + ch * 8); vv[j] = *(const u32x4*)(Vb + (size_t)srow * 128 + n * 64 + ch * 8); }
        }
#pragma unroll
        for (int j = 0; j < 2; ++j) {
            const int i = tid + 512 * (2 * jb + j), kk = i >> 3, ch = i & 7;
            if (i < 208 * 8) {
                *(LAS u32x4*)(lds + kk * KS_PITCH + ch * 16) = kv[j];
                LAS unsigned short* vt = (LAS unsigned short*)(lds + ATT_VT_OFF + (ch * 8) * VT_PITCH + kk * 2);
                vt[0 * (VT_PITCH / 2)] = (unsigned short)(vv[j].x & 0xffffu); vt[1 * (VT_PITCH / 2)] = (unsigned short)(vv[j].x >> 16);
                vt[2 * (VT_PITCH / 2)] = (unsigned short)(vv[j].y & 0xffffu); vt[3 * (VT_PITCH / 2)] = (unsigned short)(vv[j].y >> 16);
                vt[4 * (VT_PITCH / 2)] = (unsigned short)(vv[j].z & 0xffffu); vt[5 * (VT_PITCH / 2)] = (unsigned short)(vv[j].z >> 16);
                vt[6 * (VT_PITCH / 2)] = (unsigned short)(vv[j].w & 0xffffu); vt[7 * (VT_PITCH / 2)] = (unsigned short)(vv[j].w >> 16);
            }
        }
    }
    attn_zero_pad(lds, tid);
    __syncthreads();
    unsigned vmask = 0x1fffu;
    if (c == 0) vmask = 0x1e01u; else if (c == 1) vmask = 0x1fe1u;
    const float sink2 = p.sinks[h] * LOG2E;
    attn_compute<2>(lds, qa, ATT, r0, h, vmask, sink2, lane);
    attn_load_q<2>(qb2, Qb, r0 + 32, h, lane);
    attn_compute<2>(lds, qb2, ATT, r0 + 32, h, vmask, sink2, lane);
    __syncthreads();
}
__device__ __forceinline__ void attn_small_unit(const Params& p, LAS unsigned char* lds, int unit, int tid, int wave, int lane) {
    unsigned char* ws = p.ws;
    const bf16_t *Qb = (const bf16_t*)(ws + WS_Q), *Kb = (const bf16_t*)(ws + WS_K), *Vb = (const bf16_t*)(ws + WS_V); bf16_t* ATT = (bf16_t*)(ws + WS_ATT);
    int n, qrow0; unsigned vmask;
    if (unit < 2) {
        n = unit; qrow0 = ROW_META; vmask = 1u;
        for (int i = tid; i < 208 * 8; i += 512) { const int kk = i >> 3, ch = i & 7; attn_fill_bf16(lds, Kb, Vb, kk < 16 ? ROW_META + kk : -1, n, kk, ch); }
    } else {
        const int b = (unit - 2) >> 1; n = (unit - 2) & 1; qrow0 = ROW_SAMP + b * 16; vmask = 0x3ffu;
        for (int i = tid; i < 208 * 8; i += 512) {
            const int kk = i >> 3, ch = i & 7;
            if (kk < 16) attn_fill_f32(lds, p.cache_meta_k + ((size_t)(b * 16 + kk) * 2 + n) * 64, p.cache_meta_v + ((size_t)(b * 16 + kk) * 2 + n) * 64, kk, ch);
            else if (kk < 144) attn_fill_f32(lds, p.cache_swa_k + ((size_t)(b * 128 + kk - 16) * 2 + n) * 64, p.cache_swa_v + ((size_t)(b * 128 + kk - 16) * 2 + n) * 64, kk, ch);
            else attn_fill_bf16(lds, Kb, Vb, kk < 160 ? ROW_SAMP + b * 16 + kk - 144 : -1, n, kk, ch);
        }
    }
    attn_zero_pad(lds, tid);
    __syncthreads();
    const int h = n * 8 + wave;
    bf16x8 q1[1][2]; attn_load_q<1>(q1, Qb, qrow0, h, lane);
    attn_compute<1>(lds, q1, ATT, qrow0, h, vmask, p.sinks[h] * LOG2E, lane);
    __syncthreads();
}
constexpr int PM_PITCH = 1040;
__device__ __forceinline__ void add8(float (&s)[8], const u32x4 v) {
    s[0] += bf_lo(v.x); s[1] += bf_hi(v.x); s[2] += bf_lo(v.y); s[3] += bf_hi(v.y); s[4] += bf_lo(v.z); s[5] += bf_hi(v.z); s[6] += bf_lo(v.w); s[7] += bf_hi(v.w);
}
__device__ __forceinline__ void unpack8(float (&s)[8], const u32x4 v) {
    s[0] = bf_lo(v.x); s[1] = bf_hi(v.x); s[2] = bf_lo(v.y); s[3] = bf_hi(v.y); s[4] = bf_lo(v.z); s[5] = bf_hi(v.z); s[6] = bf_lo(v.w); s[7] = bf_hi(v.w);
}
template <int W>
__device__ __forceinline__ void pool_pm_main(const bf16_t* Pb, bf16_t* POOL, int R0, int wave, int lane) {
    const int g = wave >> 1, col = (g * 16 + (lane & 15)) * 8, seg = (wave & 1) * 4 + (lane >> 4);
    const int sb = R0 & 4095, s0 = sb + seg * 8, base = R0 - sb;
    constexpr int NL = 8 + W - 1;
    u32x4 v[NL];
#pragma unroll
    for (int t = 0; t < NL; ++t) {
        const int sk = s0 + t - (W - 1);
        const int row = sk >= 0 ? base + sk : ROW_META + 16 + sk;
        v[t] = *(const u32x4*)(Pb + (size_t)row * PW + col);
    }
    float s[8] = {0.f, 0.f, 0.f, 0.f, 0.f, 0.f, 0.f, 0.f};
#pragma unroll
    for (int t = 0; t < W - 1; ++t) add8(s, v[t]);
#pragma unroll
    for (int j = 0; j < 8; ++j) {
        float cur[8], old[8];
        unpack8(cur, v[j + W - 1]); unpack8(old, v[j]);
#pragma unroll
        for (int e = 0; e < 8; ++e) s[e] += cur[e];
        constexpr float inv = 1.0f / (float)W;
        u32x4 o; o.x = pk2(s[0] * inv - cur[0], s[1] * inv - cur[1]); o.y = pk2(s[2] * inv - cur[2], s[3] * inv - cur[3]);
        o.z = pk2(s[4] * inv - cur[4], s[5] * inv - cur[5]); o.w = pk2(s[6] * inv - cur[6], s[7] * inv - cur[7]);
        *(u32x4*)(POOL + (size_t)(R0 + seg * 8 + j) * PW + col) = o;
#pragma unroll
        for (int e = 0; e < 8; ++e) s[e] -= old[e];
    }
}
__device__ __forceinline__ void pool_unit(const Params& p, LAS unsigned char* lds, int pt, int tid, int wave, int lane) {
    unsigned char* ws = p.ws;
    const bf16_t* Pb = (const bf16_t*)(ws + WS_P); bf16_t* POOL = (bf16_t*)(ws + WS_POOL);
    const bool tail = pt >= 512;
    const int R0 = tail ? MREAL + 16 * (pt - 512) : pt * 64;
    if (!tail) {
        switch (wave >> 1) {
            case 0: pool_pm_main<2>(Pb, POOL, R0, wave, lane); break;
            case 1: pool_pm_main<4>(Pb, POOL, R0, wave, lane); break;
            case 2: pool_pm_main<8>(Pb, POOL, R0, wave, lane); break;
            default: pool_pm_main<16>(Pb, POOL, R0, wave, lane); break;
        }
    } else
    for (int i = tid; i < 1024; i += 512) {
        const int rr = i >> 6, ch = i & 63, R = R0 + rr, g = ch >> 4, w = 2 << g, col = ch * 8;
        float s[8] = {0.f, 0.f, 0.f, 0.f, 0.f, 0.f, 0.f, 0.f}, cur[8] = {0.f, 0.f, 0.f, 0.f, 0.f, 0.f, 0.f, 0.f};
        float inv = 1.0f / (float)w;
        if (R < ROW_SAMP) {
            const int pos = R - ROW_META; const int cnt = w < pos + 1 ? w : pos + 1; inv = 1.0f / (float)cnt;
#pragma unroll
            for (int k = 0; k < 16; ++k) {
                const bool on = k < cnt;
                float t[8]; unpack8(t, *(const u32x4*)(Pb + (size_t)(on ? R - k : R) * PW + col));
#pragma unroll
                for (int e = 0; e < 8; ++e) { s[e] += on ? t[e] : 0.f; if (k == 0) cur[e] = t[e]; }
            }
        } else if (R < ROW_PAD) {
            const int q = R - ROW_SAMP, b = q >> 4, ii = q & 15;
#pragma unroll
            for (int k = 0; k < 16; ++k) {
                const bool on = k < w, frombuf = ii - k >= 0;
                float t[8]; unpack8(t, *(const u32x4*)(Pb + (size_t)(frombuf ? R - k : R) * PW + col));
                const float* sp = p.state_pool + ((size_t)b * 15 + (frombuf ? 0 : 15 + ii - k)) * PW + col; const f32x4 a = *(const f32x4*)sp, c2 = *(const f32x4*)(sp + 4);
                const float u[8] = {a[0], a[1], a[2], a[3], c2[0], c2[1], c2[2], c2[3]};
#pragma unroll
                for (int e = 0; e < 8; ++e) { const float x = frombuf ? t[e] : u[e]; s[e] += on ? x : 0.f; if (k == 0) cur[e] = t[e]; }
            }
        }
        u32x4 o; o.x = pk2(s[0] * inv - cur[0], s[1] * inv - cur[1]); o.y = pk2(s[2] * inv - cur[2], s[3] * inv - cur[3]);
        o.z = pk2(s[4] * inv - cur[4], s[5] * inv - cur[5]); o.w = pk2(s[6] * inv - cur[6], s[7] * inv - cur[7]);
        *(u32x4*)(POOL + (size_t)R * PW + col) = o;
    }
}
__device__ __forceinline__ int deinter(int d) { return 2 * (d & 31) + (d >> 5); }
__device__ __forceinline__ void small_outputs(const Params& p) {
    unsigned char* ws = p.ws;
    const bf16_t *Kb = (const bf16_t*)(ws + WS_K), *Vb = (const bf16_t*)(ws + WS_V), *Pb = (const bf16_t*)(ws + WS_P);
    float* out = p.out;
    const int gt = blockIdx.x * 512 + threadIdx.x, NT = gridDim.x * 512;
    for (int i = gt; i < 131072; i += NT) {
        const int d = i & 63, n = (i >> 6) & 1, w = (i >> 7) & 127, b = i >> 14; const size_t row = (size_t)b * SEQ + 3968 + w;
        out[O_PSK + i] = bf1(Kb[row * 128 + n * 64 + deinter(d)]); out[O_PSV + i] = bf1(Vb[row * 128 + n * 64 + d]);
    }
    for (int i = gt; i < 16384; i += NT) {
        const int d = i & 63, n = (i >> 6) & 1, t = (i >> 7) & 15, b = i >> 11;
        const size_t rm = (size_t)ROW_META + t, rs = (size_t)ROW_SAMP + b * 16 + t;
        out[O_KM + i] = bf1(Kb[rm * 128 + n * 64 + deinter(d)]); out[O_VM + i] = bf1(Vb[rm * 128 + n * 64 + d]);
        out[O_SSK + i] = bf1(Kb[rs * 128 + n * 64 + deinter(d)]); out[O_SSV + i] = bf1(Vb[rs * 128 + n * 64 + d]);
    }
    for (int i = gt; i < 61440; i += NT) {
        const int c = i & 511, r = (i >> 9) % 15, b = (i >> 9) / 15;
        out[O_PPOOL + i] = bf1(Pb[((size_t)b * SEQ + 4081 + r) * PW + c]);
        out[O_SPOOL + i] = bf1(Pb[((size_t)ROW_SAMP + b * 16 + 1 + r) * PW + c]);
    }
}


constexpr size_t WS_SSQT1 = 5 * MiB + 512 * 1024, WS_SSQT2 = 8 * MiB + 512 * 1024;
struct SkinnyOp { const bf16_t* A; const bf16_t* Bt; int K; };
__device__ __forceinline__ void skinny_accum(const SkinnyOp op, int n0, int wave, int lane, f32x4 (&acc)[9]) {
    const int fr = lane & 15, fq = lane >> 4;
    const bf16_t* bp = op.Bt + (size_t)(n0 + fr) * op.K + 8 * fq;
    const bf16_t* ap = op.A + (size_t)(ROW_META + fr) * op.K + 8 * fq;
    const int nks = op.K >> 5;
    for (int ks = wave; ks < nks; ks += 16) {
        const bool two = ks + 8 < nks;
        const int k0 = ks * 32, k1 = two ? (ks + 8) * 32 : k0;
        const bf16x8 b0 = *(const bf16x8*)(bp + k0), b1 = *(const bf16x8*)(bp + k1);
        bf16x8 a0[9], a1[9];
#pragma unroll
        for (int rb = 0; rb < 9; ++rb) { a0[rb] = *(const bf16x8*)(ap + (size_t)rb * 16 * op.K + k0); a1[rb] = *(const bf16x8*)(ap + (size_t)rb * 16 * op.K + k1); }
#pragma unroll
        for (int rb = 0; rb < 9; ++rb) acc[rb] = __builtin_amdgcn_mfma_f32_16x16x32_bf16(b0, a0[rb], acc[rb], 0, 0, 0);
        if (two) {
#pragma unroll
            for (int rb = 0; rb < 9; ++rb) acc[rb] = __builtin_amdgcn_mfma_f32_16x16x32_bf16(b1, a1[rb], acc[rb], 0, 0, 0);
        }
    }
}
__device__ __forceinline__ void skinny_reduce(LAS unsigned char* lds, const f32x4 (&acc)[9], int wave, int lane, f32x4& r0, f32x4& r8) {
    LAS f32x4* part = (LAS f32x4*)lds;
#pragma unroll
    for (int rb = 0; rb < 9; ++rb) part[(wave * 9 + rb) * 64 + lane] = acc[rb];
    __syncthreads();
    r0 = (f32x4){0.f, 0.f, 0.f, 0.f}; r8 = (f32x4){0.f, 0.f, 0.f, 0.f};
#pragma unroll
    for (int w = 0; w < 8; ++w) r0 += part[(w * 9 + wave) * 64 + lane];
    if (wave == 0) {
#pragma unroll
        for (int w = 0; w < 8; ++w) r8 += part[(w * 9 + 8) * 64 + lane];
    }
    __syncthreads();
}
#define ZERO9(a) _Pragma("unroll") for (int z_ = 0; z_ < 9; ++z_) a[z_] = (f32x4){0.f, 0.f, 0.f, 0.f}
__device__ __forceinline__ void tail_mix_unit(const Params& p, LAS unsigned char* lds, int unit, int wave, int lane) {
    unsigned char* ws = p.ws; const int n0 = unit * 16, fr = lane & 15, fq = lane >> 4;
    f32x4 acc[9], a0, a8, b0, b8;
    ZERO9(acc); skinny_accum(SkinnyOp{(const bf16_t*)(ws + WS_ATT), (const bf16_t*)(ws + WS_WAO), 1024}, n0, wave, lane, acc); skinny_reduce(lds, acc, wave, lane, a0, a8);
    ZERO9(acc); skinny_accum(SkinnyOp{(const bf16_t*)(ws + WS_POOL), (const bf16_t*)(ws + WS_WPO), 512}, n0, wave, lane, acc); skinny_reduce(lds, acc, wave, lane, b0, b8);
    const bf16_t *GA = (const bf16_t*)(ws + WS_GA), *GP = (const bf16_t*)(ws + WS_GP); bf16_t* MIX = (bf16_t*)(ws + WS_MIX);
#pragma unroll
    for (int t = 0; t < 2; ++t) {
        if (t == 1 && wave != 0) break;
        const int rb = t ? 8 : wave; const f32x4 va = t ? a8 : a0, vb = t ? b8 : b0;
        const size_t off = (size_t)(ROW_META + 16 * rb + fr) * 1024 + n0 + 4 * fq;
        const u32x2 ga = *(const u32x2*)(GA + off), gp = *(const u32x2*)(GP + off);
        u32x2 w; w.x = pk2(bf_lo(ga.x) * va[0] + bf_lo(gp.x) * vb[0], bf_hi(ga.x) * va[1] + bf_hi(gp.x) * vb[1]);
        w.y = pk2(bf_lo(ga.y) * va[2] + bf_lo(gp.y) * vb[2], bf_hi(ga.y) * va[3] + bf_hi(gp.y) * vb[3]);
        *(u32x2*)(MIX + off) = w;
    }
}
__device__ __forceinline__ void tail_x1_unit(const Params& p, LAS unsigned char* lds, int unit, int wave, int lane) {
    unsigned char* ws = p.ws; const int n0 = unit * 16, fr = lane & 15, fq = lane >> 4;
    f32x4 acc[9], a0, a8;
    ZERO9(acc); skinny_accum(SkinnyOp{(const bf16_t*)(ws + WS_MIX), (const bf16_t*)(ws + WS_WOUT), 1024}, n0, wave, lane, acc); skinny_reduce(lds, acc, wave, lane, a0, a8);
    bf16_t* XG = (bf16_t*)(ws + WS_XG); float* ssqt = (float*)(ws + WS_SSQT1);
#pragma unroll
    for (int t = 0; t < 2; ++t) {
        if (t == 1 && wave != 0) break;
        const int rb = t ? 8 : wave; const f32x4 va = t ? a8 : a0;
        const int lr = 16 * rb + fr, row = ROW_META + lr, col = n0 + 4 * fq;
        const f32x4 x = *(const f32x4*)(row_x(p.x_prompt, p.meta_tokens, p.x_sample, row) + col);
        const f32x4 v = va + x, g = *(const f32x4*)(p.g_norm_ffn + col);
        u32x2 w; w.x = pk2(v[0] * g[0], v[1] * g[1]); w.y = pk2(v[2] * g[2], v[3] * g[3]);
        *(u32x2*)(XG + (size_t)row * 1024 + col) = w;
        float ss = (v[0] * v[0] + v[1] * v[1]) + (v[2] * v[2] + v[3] * v[3]);
        ss += __shfl_xor(ss, 16); ss += __shfl_xor(ss, 32);
        if (fq == 0) ssqt[lr * 64 + unit] = ss;
    }
}
__device__ __forceinline__ float tail_row_sum64(const float* ssqt, int lr) {
    const f32x4* sp = (const f32x4*)(ssqt + lr * 64); float s = 0.f;
#pragma unroll
    for (int j = 0; j < 16; ++j) { const f32x4 a = sp[j]; s += (a[0] + a[1]) + (a[2] + a[3]); }
    return s;
}
__device__ __forceinline__ void tail_up_unit(const Params& p, LAS unsigned char* lds, int unit, int wave, int lane) {
    unsigned char* ws = p.ws; const int n0 = unit * 16, fr = lane & 15, fq = lane >> 4;
    f32x4 acc[9], a0, a8;
    ZERO9(acc); skinny_accum(SkinnyOp{(const bf16_t*)(ws + WS_XG), (const bf16_t*)(ws + WS_WUP), 1024}, n0, wave, lane, acc); skinny_reduce(lds, acc, wave, lane, a0, a8);
    float* UPT = (float*)(ws + WS_UPT); const float* ssqt = (const float*)(ws + WS_SSQT1);
    const int oc = ((n0 >> 7) & 1) * FF + 128 * (n0 >> 8) + (n0 & 127) + 4 * fq;
#pragma unroll
    for (int t = 0; t < 2; ++t) {
        if (t == 1 && wave != 0) break;
        const int rb = t ? 8 : wave; const f32x4 va = t ? a8 : a0;
        const int lr = 16 * rb + fr;
        const float r1 = rsqrtf(tail_row_sum64(ssqt, lr) * (1.0f / 1024.0f) + RMS_EPS);
        *(f32x4*)(UPT + (size_t)lr * FF2 + oc) = va * r1;
    }
}
__device__ __forceinline__ void tail_down_unit(const Params& p, LAS unsigned char* lds, int unit, int wave, int lane) {
    unsigned char* ws = p.ws; const int n0 = unit * 16, fr = lane & 15, fq = lane >> 4;
    f32x4 acc[9], a0, a8;
    ZERO9(acc); skinny_accum(SkinnyOp{(const bf16_t*)(ws + WS_ACT), (const bf16_t*)(ws + WS_WDOWN), FF}, n0, wave, lane, acc); skinny_reduce(lds, acc, wave, lane, a0, a8);
    const bf16_t* XG = (const bf16_t*)(ws + WS_XG); float* ssqt = (float*)(ws + WS_SSQT2);
    f32x4 vv[2];
#pragma unroll
    for (int t = 0; t < 2; ++t) {
        if (t == 1 && wave != 0) break;
        const int rb = t ? 8 : wave; const f32x4 va = t ? a8 : a0;
        const int lr = 16 * rb + fr, row = ROW_META + lr, col = n0 + 4 * fq;
        const u32x2 xg = *(const u32x2*)(XG + (size_t)row * 1024 + col); const f32x4 g = *(const f32x4*)(p.g_norm_ffn + col);
        f32x4 v;
        v[0] = va[0] + bf_lo(xg.x) * __builtin_amdgcn_rcpf(g[0]); v[1] = va[1] + bf_hi(xg.x) * __builtin_amdgcn_rcpf(g[1]);
        v[2] = va[2] + bf_lo(xg.y) * __builtin_amdgcn_rcpf(g[2]); v[3] = va[3] + bf_hi(xg.y) * __builtin_amdgcn_rcpf(g[3]);
        vv[t] = v;
        float ss = (v[0] * v[0] + v[1] * v[1]) + (v[2] * v[2] + v[3] * v[3]);
        ss += __shfl_xor(ss, 16); ss += __shfl_xor(ss, 32);
        if (fq == 0) AG_ST(ssqt + lr * 64 + unit, ss);
    }
#pragma unroll
    for (int t = 0; t < 2; ++t) {
        if (t == 1 && wave != 0) break;
        const int rb = t ? 8 : wave;
        const int lr = 16 * rb + fr, col = n0 + 4 * fq;
        float s = 0.f;
        for (int tries = 0; tries < (1 << 16); ++tries) {
            bool ready = true; s = 0.f;
#pragma unroll
            for (int j = 0; j < 16; ++j) { const float a = AG_LD(ssqt + lr * 64 + 16 * fq + j); ready = ready && (a >= 0.f); s += a; }
            if (__all(ready)) break;
            __builtin_amdgcn_s_sleep(8);
        }
        s += __shfl_xor(s, 16); s += __shfl_xor(s, 32);
        const float r = rsqrtf(s * (1.0f / 1024.0f) + RMS_EPS);
        if (lr >= 16) *(f32x4*)(p.out + O_YS + (size_t)(lr - 16) * D + col) = vv[t] * r * *(const f32x4*)(p.g_norm_final + col);
    }
}

__device__ __forceinline__ void skinny_accum3(const SkinnyOp op, int n0, int rb0, int wave, int lane, f32x4 (&acc)[3]) {
    const int fr = lane & 15, fq = lane >> 4;
    const bf16_t* bp = op.Bt + (size_t)(n0 + fr) * op.K + 8 * fq;
    const bf16_t* ap = op.A + (size_t)(ROW_META + 16 * rb0 + fr) * op.K + 8 * fq;
    const int nks = op.K >> 5;
    for (int ks0 = wave; ks0 < nks; ks0 += 32) {
        bf16x8 b[4], a[4][3];
#pragma unroll
        for (int j = 0; j < 4; ++j) {
            const int ks = ks0 + 8 * j; const int k = (ks < nks ? ks : ks0) * 32;
            b[j] = *(const bf16x8*)(bp + k);
#pragma unroll
            for (int rb = 0; rb < 3; ++rb) a[j][rb] = *(const bf16x8*)(ap + (size_t)rb * 16 * op.K + k);
        }
#pragma unroll
        for (int j = 0; j < 4; ++j) {
            if (ks0 + 8 * j < nks) {
#pragma unroll
                for (int rb = 0; rb < 3; ++rb) acc[rb] = __builtin_amdgcn_mfma_f32_16x16x32_bf16(b[j], a[j][rb], acc[rb], 0, 0, 0);
            }
        }
    }
}
__device__ __forceinline__ f32x4 skinny_reduce3(LAS unsigned char* lds, const f32x4 (&acc)[3], int wave, int lane) {
    LAS f32x4* part = (LAS f32x4*)lds;
#pragma unroll
    for (int rb = 0; rb < 3; ++rb) part[(wave * 3 + rb) * 64 + lane] = acc[rb];
    __syncthreads();
    f32x4 r = {0.f, 0.f, 0.f, 0.f};
    if (wave < 3) {
#pragma unroll
        for (int w = 0; w < 8; ++w) r += part[(w * 3 + wave) * 64 + lane];
    }
    __syncthreads();
    return r;
}
#define ZERO3(a) _Pragma("unroll") for (int z_ = 0; z_ < 3; ++z_) a[z_] = (f32x4){0.f, 0.f, 0.f, 0.f}
__device__ __forceinline__ void tail_mix_unit3(const Params& p, LAS unsigned char* lds, int unit, int wave, int lane) {
    unsigned char* ws = p.ws; const int n0 = (unit & 63) * 16, rb0 = 3 * (unit >> 6), fr = lane & 15, fq = lane >> 4;
    f32x4 acc[3];
    ZERO3(acc); skinny_accum3(SkinnyOp{(const bf16_t*)(ws + WS_ATT), (const bf16_t*)(ws + WS_WAO), 1024}, n0, rb0, wave, lane, acc); const f32x4 va = skinny_reduce3(lds, acc, wave, lane);
    ZERO3(acc); skinny_accum3(SkinnyOp{(const bf16_t*)(ws + WS_POOL), (const bf16_t*)(ws + WS_WPO), 512}, n0, rb0, wave, lane, acc); const f32x4 vb = skinny_reduce3(lds, acc, wave, lane);
    if (wave < 3) {
        const bf16_t *GA = (const bf16_t*)(ws + WS_GA), *GP = (const bf16_t*)(ws + WS_GP); bf16_t* MIX = (bf16_t*)(ws + WS_MIX);
        const size_t off = (size_t)(ROW_META + 16 * (rb0 + wave) + fr) * 1024 + n0 + 4 * fq;
        const u32x2 ga = *(const u32x2*)(GA + off), gp = *(const u32x2*)(GP + off);
        u32x2 w; w.x = pk2(bf_lo(ga.x) * va[0] + bf_lo(gp.x) * vb[0], bf_hi(ga.x) * va[1] + bf_hi(gp.x) * vb[1]);
        w.y = pk2(bf_lo(ga.y) * va[2] + bf_lo(gp.y) * vb[2], bf_hi(ga.y) * va[3] + bf_hi(gp.y) * vb[3]);
        *(u32x2*)(MIX + off) = w;
    }
}
__device__ __forceinline__ void tail_x1_unit3(const Params& p, LAS unsigned char* lds, int unit, int wave, int lane) {
    unsigned char* ws = p.ws; const int cu = unit & 63, n0 = cu * 16, rb0 = 3 * (unit >> 6), fr = lane & 15, fq = lane >> 4;
    f32x4 acc[3];
    ZERO3(acc); skinny_accum3(SkinnyOp{(const bf16_t*)(ws + WS_MIX), (const bf16_t*)(ws + WS_WOUT), 1024}, n0, rb0, wave, lane, acc); const f32x4 va = skinny_reduce3(lds, acc, wave, lane);
    if (wave < 3) {
        bf16_t* XG = (bf16_t*)(ws + WS_XG); float* ssqt = (float*)(ws + WS_SSQT1);
        const int lr = 16 * (rb0 + wave) + fr, row = ROW_META + lr, col = n0 + 4 * fq;
        const f32x4 x = *(const f32x4*)(row_x(p.x_prompt, p.meta_tokens, p.x_sample, row) + col);
        const f32x4 v = va + x, g = *(const f32x4*)(p.g_norm_ffn + col);
        u32x2 w; w.x = pk2(v[0] * g[0], v[1] * g[1]); w.y = pk2(v[2] * g[2], v[3] * g[3]);
        *(u32x2*)(XG + (size_t)row * 1024 + col) = w;
        float ss = (v[0] * v[0] + v[1] * v[1]) + (v[2] * v[2] + v[3] * v[3]);
        ss += __shfl_xor(ss, 16); ss += __shfl_xor(ss, 32);
        if (fq == 0) ssqt[lr * 64 + cu] = ss;
    }
}
__device__ __forceinline__ void tail_down_unit3(const Params& p, LAS unsigned char* lds, int unit, int wave, int lane) {
    unsigned char* ws = p.ws; const int cu = unit & 63, n0 = cu * 16, rb0 = 3 * (unit >> 6), fr = lane & 15, fq = lane >> 4;
    f32x4 acc[3];
    ZERO3(acc); skinny_accum3(SkinnyOp{(const bf16_t*)(ws + WS_ACT), (const bf16_t*)(ws + WS_WDOWN), FF}, n0, rb0, wave, lane, acc); const f32x4 va = skinny_reduce3(lds, acc, wave, lane);
    if (wave < 3) {
        const bf16_t* XG = (const bf16_t*)(ws + WS_XG); float* ssqt = (float*)(ws + WS_SSQT2);
        const int lr = 16 * (rb0 + wave) + fr, row = ROW_META + lr, col = n0 + 4 * fq;
        const u32x2 xg = *(const u32x2*)(XG + (size_t)row * 1024 + col); const f32x4 g = *(const f32x4*)(p.g_norm_ffn + col);
        f32x4 v;
        v[0] = va[0] + bf_lo(xg.x) * __builtin_amdgcn_rcpf(g[0]); v[1] = va[1] + bf_hi(xg.x) * __builtin_amdgcn_rcpf(g[1]);
        v[2] = va[2] + bf_lo(xg.y) * __builtin_amdgcn_rcpf(g[2]); v[3] = va[3] + bf_hi(xg.y) * __builtin_amdgcn_rcpf(g[3]);
        float ss = (v[0] * v[0] + v[1] * v[1]) + (v[2] * v[2] + v[3] * v[3]);
        ss += __shfl_xor(ss, 16); ss += __shfl_xor(ss, 32);
        if (fq == 0) AG_ST(ssqt + lr * 64 + cu, ss);
        float s = 0.f;
        for (int tries = 0; tries < (1 << 16); ++tries) {
            bool ready = true; s = 0.f;
#pragma unroll
            for (int j = 0; j < 16; ++j) { const float a = AG_LD(ssqt + lr * 64 + 16 * fq + j); ready = ready && (a >= 0.f); s += a; }
            if (__all(ready)) break;
            __builtin_amdgcn_s_sleep(2);
        }
        s += __shfl_xor(s, 16); s += __shfl_xor(s, 32);
        const float r = rsqrtf(s * (1.0f / 1024.0f) + RMS_EPS);
        if (lr >= 16) *(f32x4*)(p.out + O_YS + (size_t)(lr - 16) * D + col) = v * r * *(const f32x4*)(p.g_norm_final + col);
    }
}

__device__ __forceinline__ void conv_fix(const Params& p) {
    unsigned char* ws = p.ws;
    const float* HALO = (const float*)(ws + WS_HALO); const float* UPT = (const float*)(ws + WS_UPT); bf16_t* ACT = (bf16_t*)(ws + WS_ACT);
    const float *cw = p.conv_w, *cb = p.conv_b;
    const int gt = blockIdx.x * 512 + threadIdx.x, NT = gridDim.x * 512;
    constexpr int NCH = FF / 4;
    constexpr int N_SLAB = 256 * 2 * NCH, N_SAMP = 128 * NCH;
    for (int it = gt; it < N_SLAB + N_SAMP; it += NT) {
        const float *u0, *u1, *u2; int row, j;
        if (it < N_SLAB) {
            const int ch = it % NCH, sr = it / NCH, rr = sr & 1, s = sr >> 1; j = ch * 4;
            row = s * 128 + rr;
            const float* l1 = (s & 31) ? HALO + (size_t)((s - 1) * 4 + 3) * FF2 : UPT + (size_t)15 * FF2;
            const float* l0 = (s & 31) ? HALO + (size_t)((s - 1) * 4 + 2) * FF2 : UPT + (size_t)14 * FF2;
            u0 = HALO + (size_t)(s * 4 + rr) * FF2;
            if (rr == 0) { u1 = l1; u2 = l0; } else { u1 = HALO + (size_t)(s * 4) * FF2; u2 = l1; }
        } else {
            const int t = it - N_SLAB, ch = t % NCH, q = t / NCH, b = q >> 4, i = q & 15; j = ch * 4;
            row = ROW_SAMP + q;
            u0 = UPT + (size_t)(16 + q) * FF2;
            u1 = (i >= 1) ? UPT + (size_t)(16 + q - 1) * FF2 : p.state_conv + ((size_t)b * 2 + 1) * FF2;
            u2 = (i >= 2) ? UPT + (size_t)(16 + q - 2) * FF2 : p.state_conv + ((size_t)b * 2 + i) * FF2;
        }
        const f32x4 g0 = *(const f32x4*)(u0 + j), g1 = *(const f32x4*)(u1 + j), g2 = *(const f32x4*)(u2 + j);
        const f32x4 v0 = *(const f32x4*)(u0 + FF + j), v1 = *(const f32x4*)(u1 + FF + j), v2 = *(const f32x4*)(u2 + FF + j);
        const f32x4 cg = *(const f32x4*)(cb + j) + *(const f32x4*)(cw + j) * g2 + *(const f32x4*)(cw + FF2 + j) * g1 + *(const f32x4*)(cw + 2 * FF2 + j) * g0;
        const f32x4 cv = *(const f32x4*)(cb + FF + j) + *(const f32x4*)(cw + FF + j) * v2 + *(const f32x4*)(cw + FF2 + FF + j) * v1 + *(const f32x4*)(cw + 2 * FF2 + FF + j) * v0;
        float a[4];
#pragma unroll
        for (int i = 0; i < 4; ++i) a[i] = cg[i] * sigmoidf_(cg[i]) * cv[i];
        u32x2 w; w.x = pk2(a[0], a[1]); w.y = pk2(a[2], a[3]);
        *(u32x2*)(ACT + (size_t)row * FF + j) = w;
    }
    { f32x4* q4 = (f32x4*)(ws + WS_SSQ2); for (int i = gt; i < MREAL * 4; i += NT) q4[i] = (f32x4){-1.f, -1.f, -1.f, -1.f};
      f32x4* t4 = (f32x4*)(ws + WS_SSQT2); for (int i = gt; i < 144 * 16; i += NT) t4[i] = (f32x4){-1.f, -1.f, -1.f, -1.f};
      unsigned* pc = (unsigned*)(ws + WS_PCNT); for (int i = gt; i < 128; i += NT) pc[64 * i] = 0u; }
    for (int i = gt; i < 8 * 2 * FF2; i += NT) {
        const int c = i % FF2, k = (i / FF2) & 1, b = i / (2 * FF2);
        p.out[O_PCONV + i] = HALO[(size_t)((b * 32 + 31) * 4 + 2 + k) * FF2 + c];
        p.out[O_SCONV + i] = UPT[(size_t)(16 + b * 16 + 14 + k) * FF2 + c];
    }
}
__device__ __forceinline__ void final_norm(const Params& p, int wave, int lane) {
    const float* ssq = (const float*)(p.ws + WS_SSQ2);
    const int gw = blockIdx.x * 8 + wave, NGW = gridDim.x * 8;
    f32x4 gv[4];
#pragma unroll
    for (int j = 0; j < 4; ++j) gv[j] = ((const f32x4*)p.g_norm_final)[lane + 64 * j];
    for (int m0 = gw * 4; m0 < MREAL + 128; m0 += NGW * 4) {
        float sv[4]; f32x4 x[4][4]; float* orow[4];
#pragma unroll
        for (int q = 0; q < 4; ++q) {
            const int m = m0 + q;
            orow[q] = m < MREAL ? p.out + O_YP + (size_t)m * D : p.out + O_YS + (size_t)(m - MREAL) * D;
            if (m < MREAL) sv[q] = ssq[(size_t)m * 16 + (lane & 15)];
            else { const float* st = (const float*)(p.ws + WS_SSQT2) + (16 + m - MREAL) * 64; sv[q] = (st[lane & 15] + st[16 + (lane & 15)]) + (st[32 + (lane & 15)] + st[48 + (lane & 15)]); }
#pragma unroll
            for (int j = 0; j < 4; ++j) x[q][j] = ((const f32x4*)orow[q])[lane + 64 * j];
        }
#pragma unroll
        for (int q = 0; q < 4; ++q) {
            float s = sv[q];
            s += __shfl_xor(s, 1); s += __shfl_xor(s, 2); s += __shfl_xor(s, 4); s += __shfl_xor(s, 8);
            const float r = rsqrtf(s * (1.0f / D) + RMS_EPS);
#pragma unroll
            for (int j = 0; j < 4; ++j) ((f32x4*)orow[q])[lane + 64 * j] = x[q][j] * r * gv[j];
        }
    }
}


struct EpiNull {
    static constexpr bool PERM = true, AFTER_DRAIN = false, APERM = false;
    float* sink;
    __device__ __forceinline__ void operator()(const f32x4 (&acc)[2][2][4][2], const Unit& u, int wr, int wc, int fr, int fq) const {
        f32x4 t = {0.f, 0.f, 0.f, 0.f};
#pragma unroll
        for (int a = 0; a < 2; ++a)
#pragma unroll
            for (int b = 0; b < 2; ++b)
#pragma unroll
                for (int m = 0; m < 4; ++m)
#pragma unroll
                    for (int n = 0; n < 2; ++n) t += acc[a][b][m][n];
        if (t[0] + t[1] + t[2] + t[3] == 123456.789f) sink[threadIdx.x] = t[0];
    }
};
struct SamePanelOrder {
    int G, c, nr;
    __device__ bool next(int i, Unit& u) const { if (i >= nr) return false; u.pm = 0; u.pn = (c >> 6) & 3; return true; }
    __device__ __forceinline__ void a_ready(const Unit&) const {}
    __device__ __forceinline__ void done(const Unit&) const {}
};

typedef unsigned v4u_unused_t;
#define XB_TMO      128
#define XB_XCNT(j)  (256  + 64 * (j))
#define XB_XSUB(j)  (1280 + 64 * (j))
#define XB_XGEN(j)  (2304 + 64 * (j))
#define XB_TOP      3328
#define XB_TOPGEN   3392
#define XCD_BAR_WORDS 3456
#define XB_SPIN_CAP (1u << 18)

__device__ __forceinline__ unsigned xb_ld(unsigned* p)              { return __hip_atomic_load(p, __ATOMIC_RELAXED, __HIP_MEMORY_SCOPE_AGENT); }
__device__ __forceinline__ unsigned xb_add(unsigned* p, unsigned v) { return __hip_atomic_fetch_add(p, v, __ATOMIC_RELAXED, __HIP_MEMORY_SCOPE_AGENT); }
__device__ __forceinline__ unsigned xb_xcc_id() { return (unsigned)__builtin_amdgcn_s_getreg((3 << 11) | 20) & 0xFu; }
#define XB_SPIN(cond, bar) do { unsigned _sp = 0; while (cond) { __builtin_amdgcn_s_sleep(1); \
    if ((++_sp & 255u) == 0u) { if (xb_ld(&(bar)[XB_TMO])) break; if (_sp > XB_SPIN_CAP) { atomicAdd(&(bar)[XB_TMO], 1u); break; } } } } while (0)

struct XcdBarrier {
    unsigned* bar; unsigned x;
    volatile LAS unsigned* st;
};

__device__ __forceinline__ XcdBarrier xcd_barrier_post(unsigned* bar, volatile LAS unsigned* st) {
    XcdBarrier b; b.bar = bar; b.x = xb_xcc_id(); b.st = st;
    if (threadIdx.x == 0) (void)xb_add(&bar[XB_XCNT(b.x)], 1u);
    return b;
}
__device__ __forceinline__ void xcd_barrier_complete(unsigned* bar, unsigned x, unsigned& nloc, unsigned& nx) {
    const unsigned G = gridDim.x * gridDim.y * gridDim.z;
    unsigned sum, cnt, mine, sp = 0u;
    for (;;) {
        sum = 0u; cnt = 0u; mine = 0u;
#pragma unroll
        for (unsigned j = 0; j < 16; ++j) { const unsigned c = xb_ld(&bar[XB_XCNT(j)]); sum += c; cnt += (c > 0u) ? 1u : 0u; mine = (j == x) ? c : mine; }
        if (sum == G) break;
        __builtin_amdgcn_s_sleep(1);
        if ((++sp & 255u) == 0u) { if (xb_ld(&bar[XB_TMO])) break; if (sp > XB_SPIN_CAP) { atomicAdd(&bar[XB_TMO], 1u); break; } }
    }
    nloc = mine > 0u ? mine : 1u; nx = cnt > 0u ? cnt : 1u;
}

__device__ __forceinline__ void xcd_barrier(const XcdBarrier& b) {
    asm volatile("s_waitcnt vmcnt(0)" ::: "memory");
    __syncthreads();
    if (threadIdx.x == 0) {
        unsigned* bar = b.bar;
        __builtin_amdgcn_s_waitcnt(0);
        unsigned nloc = b.st[0], nx = b.st[1];
        if (nloc == 0u) { xcd_barrier_complete(bar, b.x, nloc, nx); b.st[0] = nloc; b.st[1] = nx; }
        const unsigned old = xb_add(&bar[XB_XSUB(b.x)], 1u);
        const unsigned gen = old / nloc;
        if (old + 1u == (gen + 1u) * nloc) {
            __builtin_amdgcn_fence(__ATOMIC_RELEASE, "agent");
            asm volatile("s_waitcnt vmcnt(0)" ::: "memory");
            const unsigned og = xb_add(&bar[XB_TOP], 1u);
            const unsigned tg = og / nx;
            if (og + 1u == (tg + 1u) * nx) xb_add(&bar[XB_TOPGEN], 1u);
            else XB_SPIN(xb_ld(&bar[XB_TOPGEN]) == tg, bar);
            __builtin_amdgcn_fence(__ATOMIC_ACQUIRE, "agent");
            xb_add(&bar[XB_XGEN(b.x)], 1u);
            asm volatile("s_waitcnt vmcnt(0)" ::: "memory");
        } else {
            XB_SPIN(xb_ld(&bar[XB_XGEN(b.x)]) == gen, bar);
            __builtin_amdgcn_fence(__ATOMIC_ACQUIRE, "agent");
            asm volatile("s_waitcnt vmcnt(0)" ::: "memory");
        }
    }
    __syncthreads();
}

__device__ __forceinline__ void grid_bar(unsigned* ctr, unsigned target) {
    asm volatile("s_waitcnt vmcnt(0) lgkmcnt(0)" ::: "memory");
    __syncthreads();
    if (threadIdx.x == 0) {
        __hip_atomic_fetch_add(ctr, 1u, __ATOMIC_RELEASE, __HIP_MEMORY_SCOPE_AGENT);
        unsigned spins = 0;
        while (__hip_atomic_load(ctr, __ATOMIC_RELAXED, __HIP_MEMORY_SCOPE_AGENT) < target) { __builtin_amdgcn_s_sleep(2); if (++spins > (1u << 24)) break; }
        __builtin_amdgcn_fence(__ATOMIC_ACQUIRE, "agent");
        asm volatile("s_waitcnt vmcnt(0)" ::: "memory");
    }
    __syncthreads();
}
__global__ void __launch_bounds__(512, 2) fwd_megakernel(Params p) {
    extern __shared__ __attribute__((aligned(16))) unsigned char lds_raw[];
    LAS unsigned char* lds = (LAS unsigned char*)lds_raw;
    cg::grid_group grid = cg::this_grid();
    const int wave = __builtin_amdgcn_readfirstlane(threadIdx.x >> 6);
#define TIDLANE() int tid = threadIdx.x; asm volatile("" : "+v"(tid)); const int lane = tid & 63
    unsigned char* ws = p.ws;
    const int lo = p.ph_lo, hi = p.ph_hi, G = gridDim.x;
#define IN(k) (lo <= (k) && (k) < hi)
#define SEAM(k) do { if (IN(k) && IN((k) + 1)) xcd_barrier(xbar); } while (0)
    if (lo < 0) grid.sync();
    volatile LAS unsigned* xst = (volatile LAS unsigned*)(lds + LDS_BYTES - 32);
    if (threadIdx.x < 2) xst[threadIdx.x] = 0u;
    __syncthreads();
    XcdBarrier xbar = xcd_barrier_post((unsigned*)(ws + 4096), xst);
    if (IN(0)) { TIDLANE(); (void)tid; p0_prologue(p, lds, wave, lane); __syncthreads(); }
    SEAM(0);
    if (IN(1)) {
        pg8::Gemm g{(const bf16_t*)(ws + WS_XN), (const bf16_t*)(ws + WS_WIN), M, INW, D}; pg8::StaticOrder S; S.init(M, INW, G, (int)blockIdx.x);
        EpiZ E{(bf16_t*)(ws + WS_Q), (bf16_t*)(ws + WS_K), (bf16_t*)(ws + WS_V), (bf16_t*)(ws + WS_P), (bf16_t*)(ws + WS_GA), (bf16_t*)(ws + WS_GP), p.b_gate, (const float*)(ws + WS_ROPE)};
        pg8::gemm_phase<EpiZ, pg8::StaticOrder, true, true>(lds, g, S, E);
    }
    SEAM(1);
    if (IN(2)) {
        TIDLANE();
        for (int unit = blockIdx.x; unit < 1024; unit += G) attn_chunk_unit(p, lds, unit, tid, wave, lane);
        constexpr int N_EXTRA = 27;
        if (G > 2 * N_EXTRA) {
            if ((int)blockIdx.x < N_EXTRA) { const int e = blockIdx.x; if (e < 18) attn_small_unit(p, lds, e, tid, wave, lane); else pool_unit(p, lds, 512 + e - 18, tid, wave, lane); }
            else for (int unit = blockIdx.x - N_EXTRA; unit < 512; unit += G - N_EXTRA) pool_unit(p, lds, unit, tid, wave, lane);
        } else {
            for (int unit = blockIdx.x; unit < 18 + 521; unit += G) { if (unit < 18) attn_small_unit(p, lds, unit, tid, wave, lane); else pool_unit(p, lds, unit - 18, tid, wave, lane); }
        }
        small_outputs(p);
    }
    SEAM(2);
    if (IN(3)) {
        { TIDLANE(); (void)tid; for (int unit = blockIdx.x; unit < 192; unit += G) tail_mix_unit3(p, lds, unit, wave, lane); }
        { pg8::Gemm g{(const bf16_t*)(ws + WS_ATT), (const bf16_t*)(ws + WS_WAO), MREAL, D, D}; pg8::StaticOrder S; S.init(MREAL, D, G, (int)blockIdx.x);
          EpiT1 E{(const bf16_t*)(ws + WS_GA), (bf16_t*)(ws + WS_MIX)};
          pg8::gemm_phase<EpiT1, pg8::StaticOrder, true, true>(lds, g, S, E); }
        __syncthreads();
        { pg8::Gemm g{(const bf16_t*)(ws + WS_POOL), (const bf16_t*)(ws + WS_WPO), MREAL, D, PW}; pg8::StaticOrder S; S.init(MREAL, D, G, (int)blockIdx.x);
          EpiMix E{(const bf16_t*)(ws + WS_GP), (bf16_t*)(ws + WS_MIX)};
          pg8::gemm_phase<EpiMix, pg8::StaticOrder, true, true>(lds, g, S, E); }
    }
    SEAM(3);
    if (IN(4)) {
        { TIDLANE(); (void)tid; for (int unit = blockIdx.x; unit < 192; unit += G) tail_x1_unit3(p, lds, unit, wave, lane); }
        pg8::Gemm g{(const bf16_t*)(ws + WS_MIX), (const bf16_t*)(ws + WS_WOUT), MREAL, D, D}; pg8::StaticOrder S; S.init(MREAL, D, G, (int)blockIdx.x);
        EpiX1 E{(const bf16_t*)(ws + WS_XN), (const float*)(ws + WS_R0I), p.g_norm_mix, p.g_norm_ffn, (bf16_t*)(ws + WS_XG), (float*)(ws + WS_SSQ1)};
        pg8::gemm_phase<EpiX1, pg8::StaticOrder, true, true>(lds, g, S, E);
    }
    SEAM(4);
    if (IN(5)) {
        { TIDLANE(); (void)tid; for (int unit = blockIdx.x; unit < FF2 / 16; unit += G) tail_up_unit(p, lds, unit, wave, lane); }
        pg8::Gemm g{(const bf16_t*)(ws + WS_XG), (const bf16_t*)(ws + WS_WUP), MREAL, FF2, D}; pg8::StaticOrder S; S.init(MREAL, FF2, G, (int)blockIdx.x);
        EpiUp E{(const float*)(ws + WS_SSQ1), p.conv_w, p.conv_b, (bf16_t*)(ws + WS_ACT), (float*)(ws + WS_HALO), (float*)(ws + WS_UPT)};
        pg8::gemm_phase<EpiUp, pg8::StaticOrder, true, true>(lds, g, S, E);
    }
    SEAM(5);
    if (IN(6)) conv_fix(p);
    SEAM(6);
    if (IN(7)) {
        { TIDLANE(); (void)tid; for (int unit = blockIdx.x; unit < 192; unit += G) tail_down_unit3(p, lds, unit, wave, lane); }
        pg8::Gemm g{(const bf16_t*)(ws + WS_ACT), (const bf16_t*)(ws + WS_WDOWN), MREAL, D, FF}; pg8::StaticOrder S; S.init(MREAL, D, G, (int)blockIdx.x, 1);
        EpiDown E{(const bf16_t*)(ws + WS_XG), p.g_norm_ffn, p.g_norm_final, p.out, (float*)(ws + WS_SSQ2)};
        pg8::gemm_phase<EpiDown, pg8::StaticOrder, true, true>(lds, g, S, E);
    }
    if (IN(8)) { TIDLANE(); for (int unit = blockIdx.x; unit < 1024; unit += G) attn_chunk_unit(p, lds, unit, tid, wave, lane); }
    if (IN(9)) { TIDLANE(); for (int unit = blockIdx.x; unit < 512; unit += G) pool_unit(p, lds, unit, tid, wave, lane); }
    if (IN(12)) { TIDLANE(); for (int unit = 512 + blockIdx.x; unit < 521; unit += G) pool_unit(p, lds, unit, tid, wave, lane); }
    if (IN(10)) { TIDLANE(); for (int unit = blockIdx.x; unit < 18; unit += G) attn_small_unit(p, lds, unit, tid, wave, lane); }
    if (IN(11)) { small_outputs(p); }
    if (IN(17)) { pg8::Gemm g{(const bf16_t*)(ws + WS_ACT), (const bf16_t*)(ws + WS_WDOWN), MREAL, D, FF}; pg8::StaticOrder S; S.init(MREAL, D, G, (int)blockIdx.x, 1);
        EpiDown E{(const bf16_t*)(ws + WS_XG), p.g_norm_ffn, p.g_norm_final, p.out, (float*)(ws + WS_SSQ2)};
        pg8::gemm_phase<EpiDown, pg8::StaticOrder, true, true>(lds, g, S, E); }
    if (IN(18)) { TIDLANE(); (void)tid; for (int unit = blockIdx.x; unit < 192; unit += G) tail_down_unit3(p, lds, unit, wave, lane); }
    if (IN(14)) { pg8::Gemm g{(const bf16_t*)(ws + WS_ACT), (const bf16_t*)(ws + WS_WDOWN), MREAL, D, FF}; pg8::StaticOrder S; S.init(MREAL, D, G, (int)blockIdx.x, 1); EpiNull E{(float*)(ws + WS_SSQ1)};
        pg8::gemm_phase<EpiNull, pg8::StaticOrder, true, true>(lds, g, S, E); }
    if (IN(15)) { pg8::Gemm g{(const bf16_t*)(ws + WS_ACT), (const bf16_t*)(ws + WS_WDOWN), MREAL, D, FF}; SamePanelOrder S{G, (int)blockIdx.x, 2}; EpiNull E{(float*)(ws + WS_SSQ1)};
        pg8::gemm_phase<EpiNull, SamePanelOrder, true, true>(lds, g, S, E); }
    if (IN(16)) { pg8::Gemm g{(const bf16_t*)(ws + WS_MIX), (const bf16_t*)(ws + WS_WOUT), MREAL, D, D}; pg8::StaticOrder S; S.init(MREAL, D, G, (int)blockIdx.x); EpiNull E{(float*)(ws + WS_SSQ1)};
        pg8::gemm_phase<EpiNull, pg8::StaticOrder, true, true>(lds, g, S, E); }
#undef IN
#undef SEAM
}

#ifndef MK_N_LAUNCHES
#define MK_N_LAUNCHES 1
#endif
#ifndef PROBE_PHASE
#define PROBE_PHASE -1
#endif
extern "C" void kernel_launch(void* const* d_in, const int* in_sizes, int n_in, void* d_out, int out_size, void* d_ws, size_t ws_size, hipStream_t stream) {
    static int grid = 0;
    if (grid == 0) {
        if (n_in != 24 || (size_t)out_size != O_END || ws_size < WS_END) { fprintf(stderr, "kernel_launch: unexpected shapes: n_in %d out %d ws %zu (need %zu)\n", n_in, out_size, ws_size, (size_t)WS_END); grid = -1; return; }
        int dev = 0, cus = 0, per_cu = 0;
        hipGetDevice(&dev); hipDeviceGetAttribute(&cus, hipDeviceAttributeMultiprocessorCount, dev);
        if (hipFuncSetAttribute((const void*)fwd_megakernel, hipFuncAttributeMaxDynamicSharedMemorySize, LDS_BYTES) != hipSuccess) { fprintf(stderr, "kernel_launch: hipFuncSetAttribute failed\n"); grid = -1; return; }
        if (hipOccupancyMaxActiveBlocksPerMultiprocessor(&per_cu, (const void*)fwd_megakernel, 512, LDS_BYTES) != hipSuccess || per_cu < 1) { fprintf(stderr, "kernel_launch: occupancy query gave %d\n", per_cu); per_cu = 1; }
        (void)hipGetLastError();
        grid = cus;
        fprintf(stderr, "kernel_launch: grid %d (per_cu %d)\n", grid, per_cu);
    }
    if (grid < 0) return;
    Params p{};
    const float** pp = (const float**)&p;
    for (int i = 0; i < 24; ++i) pp[i] = (const float*)d_in[i];
    p.out = (float*)d_out; p.ws = (unsigned char*)d_ws;
    for (int i = 0; i < 32; ++i) p.inv_freq[i] = powf(10000.0f, -(float)i / 32.0f);
    const int NPH = 8;
    int seq[8][2]; int nseq = 0;
    if (PROBE_PHASE >= NPH) { seq[0][0] = 0; seq[0][1] = NPH; seq[1][0] = PROBE_PHASE; seq[1][1] = PROBE_PHASE + 1; nseq = 2; }
    else if (PROBE_PHASE >= 0) { seq[0][0] = 0; seq[0][1] = PROBE_PHASE + 1; seq[1][0] = PROBE_PHASE; seq[1][1] = PROBE_PHASE + 1; nseq = 2; if (PROBE_PHASE + 1 < NPH) { seq[2][0] = PROBE_PHASE + 1; seq[2][1] = NPH; nseq = 3; } }
    else { seq[0][0] = 0; seq[0][1] = NPH; nseq = 1; }
    for (int k = 0; k < nseq; ++k) {
        if (hipMemsetAsync(d_ws, 0, 32768, stream) != hipSuccess) fprintf(stderr, "kernel_launch: memset failed\n");
        p.ph_lo = seq[k][0]; p.ph_hi = seq[k][1];
        void* args[] = {&p}; hipError_t e = hipLaunchCooperativeKernel((const void*)fwd_megakernel, dim3(grid), dim3(512), args, LDS_BYTES, stream);
        if (e != hipSuccess) fprintf(stderr, "kernel_launch: cooperative launch %d failed: %s\n", k, hipGetErrorString(e));
    }
}
```

```cpp
#include <hip/hip_runtime.h>
#include <hip/hip_cooperative_groups.h>
#include <cstdio>
#include <cstdint>
#include <cmath>
namespace cg = cooperative_groups;
namespace pg8 {
#define PG8_LAS __attribute__((address_space(3)))
typedef unsigned short bf16_t;
typedef short bf16x8 __attribute__((ext_vector_type(8)));
typedef float f32x4 __attribute__((ext_vector_type(4)));
typedef unsigned u32x4 __attribute__((ext_vector_type(4)));
constexpr int BM = 256, BK = 64, HALF = 128, HTB = HALF * BK * 2  , STAGE_BYTES = 8 * HTB, NXCD = 8, WGM = 8;

__host__ __device__ __forceinline__ int lds_byte(int r, int c) { const int st = (r >> 4) * 2 + (c >> 5), rr = r & 15, cc = c & 31, ob = rr * 64 + cc * 2; return st * 1024 + (ob ^ (((ob >> 9) & 1) << 5)); }
__host__ __device__ __forceinline__ void stage_rc(int b, int& R, int& C) { const int st = b / 1024, sb = b % 1024, swz = sb ^ (((sb >> 9) & 1) << 5); R = (st >> 1) * 16 + swz / 64; C = (st & 1) * 32 + (swz % 64) / 2; }
__host__ __device__ __forceinline__ int perm32(int rho) { const int n = rho >> 4, i = rho & 15; return 8 * (i >> 2) + 4 * n + (i & 3); }

struct Unit { int pm, pn; };
struct Gemm { const bf16_t* A; const bf16_t* Bt; int M, N, K; };

struct StaticOrder {
    int nM, nN, nwg, G, c, rev;
    __host__ __device__ void init(int M, int N, int G_, int c_, int rev_ = 0) { nM = M / BM; nN = N / BM; nwg = nM * nN; G = G_; c = c_; rev = rev_; }
    __host__ __device__ bool next(int i, Unit& u) const {
        const int nr = (nwg + G - 1) / G;
        if (i >= nr) return false;
        const long L = (long)((rev && nwg % G == 0) ? nr - 1 - i : i) * G + c; if (L >= nwg) return false;
        int wgid = (int)L; { const int q = nwg / NXCD, r = nwg % NXCD, xcd = wgid % NXCD, off = wgid / NXCD; wgid = (xcd < r ? xcd * (q + 1) : r * (q + 1) + (xcd - r) * q) + off; }
        const int nig = WGM * nN, gid = wgid / nig, fm = gid * WGM, gsz = (nM - fm) < WGM ? (nM - fm) : WGM;
        u.pm = fm + ((wgid % nig) % gsz); u.pn = (wgid % nig) / gsz; return true;
    }
    __device__ __forceinline__ void a_ready(const Unit&) const {}
    __device__ __forceinline__ void done(const Unit&) const {}
};

__device__ __forceinline__ unsigned cvt_pk_bf16(float lo, float hi) { unsigned r; asm volatile("v_cvt_pk_bf16_f32 %0, %1, %2" : "=v"(r) : "v"(lo), "v"(hi)); return r; }
template <class Epi, class Sched, bool ALIGN_EPI = false, bool SP2 = false>
__device__ __forceinline__ void gemm_phase(PG8_LAS unsigned char* lds, const Gemm g, const Sched& S, const Epi& E) {
    const int tid = threadIdx.x, wid = __builtin_amdgcn_readfirstlane(tid >> 6), lane = tid & 63, wr = wid >> 2, wc = wid & 3, fr = lane & 15, fq = lane >> 4;
    const int K = g.K, nt = K / BK;
    unsigned voffA[2], voffB[2];
#pragma unroll
    for (int i = 0; i < 2; ++i) { int R, C; stage_rc(tid * 16 + i * 8192, R, C); const int Rb = Epi::PERM ? ((R & ~31) + perm32(R & 31)) : R;
        const int Ra = Epi::APERM ? ((R >> 6) * 128 + (R & 63)) : R;
        voffA[i] = (unsigned)(Ra * K + C) * 2u; voffB[i] = (unsigned)(Rb * K + C) * 2u; }
    const size_t kstep = (size_t)(BK * 2);
    const size_t hstep = (size_t)HALF * K * 2;
    const size_t tstep = 2 * hstep;
    const size_t hstepA = Epi::APERM ? (size_t)64 * K * 2 : hstep;
    const unsigned ldsw = (unsigned)wid * 1024u;
    const int aoff = lds_byte(wr * 64 + fr, fq * 8), boff = lds_byte(wc * 32 + fr, fq * 8);
#define PG8_SA(b, h) (((b) * 2 + (h)) * HTB)
#define PG8_SB(b, h) ((4 + (b) * 2 + (h)) * HTB)
#define PG8_STAGE(bufoff, gbase, voff) do { _Pragma("unroll") for (int _i = 0; _i < 2; ++_i) \
        __builtin_amdgcn_global_load_lds((const unsigned*)((const char*)(gbase) + (voff)[_i]), (PG8_LAS unsigned*)(lds + (bufoff) + ldsw + _i * 8192), 16, 0, 0); } while (0)
#define PG8_LDA(dst, b, h) do { _Pragma("unroll") for (int m = 0; m < 4; ++m) _Pragma("unroll") for (int k = 0; k < 2; ++k) dst[m][k] = *(const PG8_LAS bf16x8*)(lds + PG8_SA(b, h) + aoff + m * 2048 + k * 1024); } while (0)
#define PG8_LDB(dst, b, h) do { _Pragma("unroll") for (int n = 0; n < 2; ++n) _Pragma("unroll") for (int k = 0; k < 2; ++k) dst[n][k] = *(const PG8_LAS bf16x8*)(lds + PG8_SB(b, h) + boff + n * 2048 + k * 1024); } while (0)
#define PG8_MMA(ai, bj, At, Bt) do { __builtin_amdgcn_s_setprio(1); _Pragma("unroll") for (int m = 0; m < 4; ++m) _Pragma("unroll") for (int n = 0; n < 2; ++n) _Pragma("unroll") for (int k = 0; k < 2; ++k) \
        acc[ai][bj][m][n] = __builtin_amdgcn_mfma_f32_16x16x32_bf16(Bt[n][k], At[m][k], acc[ai][bj][m][n], 0, 0, 0); __builtin_amdgcn_s_setprio(0); } while (0)
#define PG8_WAIT_V(n) asm volatile("s_waitcnt vmcnt(" #n ")" ::: "memory")
#define PG8_WAIT_L(n) asm volatile("s_waitcnt lgkmcnt(" #n ")" ::: "memory")
#define PG8_BAR __builtin_amdgcn_s_barrier()
#define PG8_SCHED __builtin_amdgcn_sched_barrier(0)
    Unit cur, nxt; int ui = 0;
    if (!S.next(0, cur)) return;
    f32x4 acc[2][2][4][2];
#pragma unroll
    for (int a = 0; a < 2; ++a)
#pragma unroll
        for (int b = 0; b < 2; ++b)
#pragma unroll
            for (int m = 0; m < 4; ++m)
#pragma unroll
                for (int n = 0; n < 2; ++n) acc[a][b][m][n] = (f32x4){0.f, 0.f, 0.f, 0.f};
    bf16x8 At[4][2], B0[2][2], B1[2][2];
    const char* cA = (const char*)g.A + (size_t)cur.pm * tstep; const char* cB = (const char*)g.Bt + (size_t)cur.pn * tstep;
    S.a_ready(cur);
    if constexpr (SP2) {
        PG8_STAGE(PG8_SB(0, 0), cB, voffB); PG8_STAGE(PG8_SB(0, 1), cB + hstep, voffB); PG8_STAGE(PG8_SA(0, 0), cA, voffA); PG8_STAGE(PG8_SA(0, 1), cA + hstepA, voffA);
        if (wr == 1) PG8_BAR;
        PG8_WAIT_V(2); PG8_BAR;
        PG8_STAGE(PG8_SB(1, 0), cB + kstep, voffB); PG8_STAGE(PG8_SA(1, 0), cA + kstep, voffA); PG8_STAGE(PG8_SB(1, 1), cB + hstep + kstep, voffB);
        PG8_WAIT_V(6); PG8_BAR;
    } else {
        PG8_STAGE(PG8_SB(0, 0), cB, voffB); PG8_STAGE(PG8_SA(0, 0), cA, voffA); PG8_STAGE(PG8_SB(0, 1), cB + hstep, voffB); PG8_STAGE(PG8_SA(0, 1), cA + hstepA, voffA);
        if (wr == 1) PG8_BAR;
        PG8_WAIT_V(4); PG8_BAR;
        PG8_STAGE(PG8_SB(1, 0), cB + kstep, voffB); PG8_STAGE(PG8_SA(1, 0), cA + kstep, voffA); PG8_STAGE(PG8_SB(1, 1), cB + hstep + kstep, voffB);
        PG8_WAIT_V(6); PG8_BAR;
    }
    for (;;) {
        const bool has_next = S.next(ui + 1, nxt);
        const char* nA = has_next ? (const char*)g.A + (size_t)nxt.pm * tstep : cA; const char* nB = has_next ? (const char*)g.Bt + (size_t)nxt.pn * tstep : cB;
        for (int t = 0; t < nt; t += 2) {
            const bool last = (t == nt - 2);
            const char* a1 = cA + (size_t)(t + 1) * kstep;
            const char* a2 = last ? nA : cA + (size_t)(t + 2) * kstep; const char* b2 = last ? nB : cB + (size_t)(t + 2) * kstep;
            const char* a3 = a2 + kstep; const char* b3 = b2 + kstep;
            if (last && has_next) S.a_ready(nxt);
            if constexpr (SP2) {
            PG8_LDB(B0, 0, 0); PG8_LDB(B1, 0, 1); PG8_SCHED; PG8_LDA(At, 0, 0); PG8_STAGE(PG8_SA(1, 1), a1 + hstepA, voffA);
            PG8_WAIT_V(8); PG8_WAIT_L(0); PG8_BAR; PG8_MMA(0, 0, At, B0); PG8_MMA(0, 1, At, B1); PG8_BAR; PG8_SCHED;
            PG8_LDA(At, 0, 1); PG8_STAGE(PG8_SB(0, 0), b2, voffB); PG8_STAGE(PG8_SB(0, 1), b2 + hstep, voffB); PG8_STAGE(PG8_SA(0, 0), a2, voffA);
            PG8_WAIT_V(8); PG8_WAIT_L(0); PG8_BAR; PG8_MMA(1, 0, At, B0); PG8_MMA(1, 1, At, B1); PG8_BAR; PG8_SCHED;
            PG8_LDB(B0, 1, 0); PG8_LDB(B1, 1, 1); PG8_SCHED; PG8_LDA(At, 1, 0); PG8_STAGE(PG8_SA(0, 1), a2 + hstepA, voffA);
            PG8_WAIT_V(8); PG8_WAIT_L(0); PG8_BAR; PG8_MMA(0, 0, At, B0); PG8_MMA(0, 1, At, B1); PG8_BAR; PG8_SCHED;
            PG8_LDA(At, 1, 1); PG8_STAGE(PG8_SB(1, 0), b3, voffB); PG8_STAGE(PG8_SB(1, 1), b3 + hstep, voffB); PG8_STAGE(PG8_SA(1, 0), a3, voffA);
            PG8_WAIT_V(8); PG8_WAIT_L(0); PG8_BAR; PG8_MMA(1, 0, At, B0); PG8_MMA(1, 1, At, B1); PG8_BAR; PG8_SCHED;
            } else {
            PG8_LDB(B0, 0, 0); PG8_SCHED; PG8_LDA(At, 0, 0); PG8_STAGE(PG8_SA(1, 1), a1 + hstepA, voffA);
            PG8_WAIT_L(8); PG8_BAR; PG8_WAIT_L(0); PG8_MMA(0, 0, At, B0); PG8_BAR; PG8_SCHED;
            PG8_LDB(B1, 0, 1); PG8_STAGE(PG8_SB(0, 0), b2, voffB);
            PG8_BAR; PG8_WAIT_L(0); PG8_MMA(0, 1, At, B1); PG8_BAR;
            PG8_LDA(At, 0, 1); PG8_STAGE(PG8_SA(0, 0), a2, voffA);
            PG8_BAR; PG8_WAIT_L(0); PG8_MMA(1, 0, At, B0); PG8_BAR; PG8_SCHED;
            PG8_STAGE(PG8_SB(0, 1), b2 + hstep, voffB);
            PG8_WAIT_V(6); PG8_BAR; PG8_MMA(1, 1, At, B1); PG8_BAR;
            PG8_LDB(B0, 1, 0); PG8_SCHED; PG8_LDA(At, 1, 0); PG8_STAGE(PG8_SA(0, 1), a2 + hstepA, voffA);
            PG8_WAIT_L(8); PG8_BAR; PG8_WAIT_L(0); PG8_MMA(0, 0, At, B0); PG8_BAR; PG8_SCHED;
            PG8_LDB(B1, 1, 1); PG8_STAGE(PG8_SB(1, 0), b3, voffB);
            PG8_BAR; PG8_WAIT_L(0); PG8_MMA(0, 1, At, B1); PG8_BAR;
            PG8_LDA(At, 1, 1); PG8_STAGE(PG8_SA(1, 0), a3, voffA);
            PG8_BAR; PG8_WAIT_L(0); PG8_MMA(1, 0, At, B0); PG8_BAR; PG8_SCHED;
            PG8_STAGE(PG8_SB(1, 1), b3 + hstep, voffB);
            PG8_WAIT_V(6); PG8_BAR; PG8_MMA(1, 1, At, B1); PG8_BAR;
            }
        }
        if constexpr (ALIGN_EPI) { if (wr == 0) PG8_BAR; }
        if constexpr (!Epi::AFTER_DRAIN) { E(acc, cur, wr, wc, fr, fq); S.done(cur); }
        if (!has_next) break;
#pragma unroll
        for (int a = 0; a < 2; ++a)
#pragma unroll
            for (int b = 0; b < 2; ++b)
#pragma unroll
                for (int m = 0; m < 4; ++m)
#pragma unroll
                    for (int n = 0; n < 2; ++n) acc[a][b][m][n] = (f32x4){0.f, 0.f, 0.f, 0.f};
        cur = nxt; cA = nA; cB = nB; ++ui;
        if constexpr (ALIGN_EPI) { if (wr == 1) PG8_BAR; }
    }
    PG8_WAIT_V(0);
    if constexpr (!ALIGN_EPI) { if (wr == 0) PG8_BAR; }
    PG8_BAR;
    if constexpr (Epi::AFTER_DRAIN) { E.fused(acc, cur, wr, wc, fr, fq, lds, wid, lane); S.done(cur); }
#undef PG8_SA
#undef PG8_SB
#undef PG8_STAGE
#undef PG8_LDA
#undef PG8_LDB
#undef PG8_MMA
#undef PG8_WAIT_V
#undef PG8_WAIT_L
#undef PG8_BAR
#undef PG8_SCHED
}
}

using pg8::bf16_t; using pg8::bf16x8; using pg8::f32x4; using pg8::u32x4; using pg8::Unit;
#define LAS __attribute__((address_space(3)))
typedef float f32x2v __attribute__((ext_vector_type(2)));
typedef __bf16 bf16x2v __attribute__((ext_vector_type(2)));
typedef unsigned u32x2 __attribute__((ext_vector_type(2)));

constexpr int D = 1024, NBATCH = 8, SEQ = 4096;
constexpr int MREAL = NBATCH * SEQ;
constexpr int ROW_META = MREAL;
constexpr int ROW_SAMP = MREAL + 16;
constexpr int ROW_PAD = ROW_SAMP + 128;
constexpr int M = MREAL + 256;
constexpr int INW = 3840, FF = 2816, FF2 = 5632, PW = 512;
constexpr float RMS_EPS = 1e-6f;
constexpr int NPOS = 4112;

constexpr size_t MiB = 1u << 20;
constexpr size_t WS_ROPE = 1 * MiB, WS_SSQ1 = 3 * MiB, WS_SSQ2 = 6 * MiB;
constexpr size_t WS_WIN = 9 * MiB, WS_WAO = 17 * MiB, WS_WPO = 19 * MiB, WS_WOUT = 20 * MiB, WS_WUP = 22 * MiB, WS_WDOWN = 33 * MiB, WS_WGRP = 39 * MiB;
constexpr size_t WS_XN = 40 * MiB, WS_MIX = 105 * MiB  , WS_HALO = 40 * MiB, WS_UPT = 84 * MiB;
constexpr size_t WS_R0I = 64 * 1024;
constexpr size_t WS_Q = 105 * MiB, WS_K = 170 * MiB, WS_V = 179 * MiB, WS_P = 188 * MiB, WS_GA = 221 * MiB, WS_GP = 286 * MiB, WS_ATT = 351 * MiB, WS_POOL = 416 * MiB;
constexpr size_t WS_X1 = 105 * MiB, WS_XG = 234 * MiB, WS_ACT = 299 * MiB, WS_END = 477 * MiB;

constexpr int LDS_BYTES = 147456;

struct Params {
    const float *x_prompt, *x_sample, *cache_swa_k, *cache_swa_v, *cache_meta_k, *cache_meta_v, *state_pool, *state_conv, *meta_tokens, *g_norm_mix, *w_in, *b_gate, *sinks,
        *w_attn_o, *w_pool_grp, *pool_scale, *w_pool_o, *w_out, *g_norm_ffn, *w_up, *conv_w, *conv_b, *w_down, *g_norm_final;
    float* out; unsigned char* ws;
    float inv_freq[32];
    int ph_lo, ph_hi;
};
constexpr size_t O_YP = 0, O_YS = O_YP + (size_t)MREAL * D, O_PSK = O_YS + 128 * D, O_PSV = O_PSK + 131072, O_KM = O_PSV + 131072, O_VM = O_KM + 16384,
    O_PPOOL = O_VM + 16384, O_PCONV = O_PPOOL + 61440, O_SSK = O_PCONV + 90112, O_SSV = O_SSK + 16384, O_SPOOL = O_SSV + 16384, O_SCONV = O_SPOOL + 61440, O_END = O_SCONV + 90112;

__device__ __forceinline__ unsigned pk2(float lo, float hi) { f32x2v v = {lo, hi}; bf16x2v b = __builtin_convertvector(v, bf16x2v); return __builtin_bit_cast(unsigned, b); }
__device__ __forceinline__ float bf_lo(unsigned u) { return __uint_as_float(u << 16); }
__device__ __forceinline__ float bf_hi(unsigned u) { return __uint_as_float(u & 0xffff0000u); }
__device__ __forceinline__ float bf1(bf16_t h) { return __uint_as_float((unsigned)h << 16); }
__device__ __forceinline__ int row_pos(int r) {
    if (r < MREAL) return 16 + (r & 4095);
    if (r < ROW_SAMP) return r - ROW_META;
    if (r < ROW_PAD) return 16 + 1024 + ((r - ROW_SAMP) & 15);
    return 0;
}
__device__ __forceinline__ const float* row_x(const float* xp, const float* mt, const float* xs, int r) {
    if (r < MREAL) return xp + (size_t)r * D;
    if (r < ROW_SAMP) return mt + (size_t)(r - ROW_META) * D;
    if (r < ROW_PAD) return xs + (size_t)(r - ROW_SAMP) * D;
    return nullptr;
}
__device__ __forceinline__ float wave_sum(float v) {
#pragma unroll
    for (int o = 1; o < 64; o <<= 1) v += __shfl_xor(v, o);
    return v;
}
__device__ __forceinline__ float sigmoidf_(float x) { return __builtin_amdgcn_rcpf(1.0f + __builtin_amdgcn_exp2f(x * -1.4426950408889634f)); }

struct EpiZ {
    static constexpr bool PERM = true, AFTER_DRAIN = false, APERM = false;
    bf16_t *Q, *Kb, *Vb, *Pb, *GA, *GP; const float* b_gate; const float* rope;
    __device__ __forceinline__ void operator()(const f32x4 (&acc)[2][2][4][2], const Unit& u, int wr, int wc, int fr_in, int fq_in) const {
        int fr = fr_in, fq = fq_in; asm volatile("" : "+v"(fr), "+v"(fq));
        const int pn = u.pn, cw = wc * 32 + 8 * fq;
        if (pn < 4) {
#pragma unroll
            for (int ai = 0; ai < 2; ++ai) {
                f32x4 t[4][2][2];
#pragma unroll
                for (int m = 0; m < 4; ++m) {
                    const int row = u.pm * 256 + ai * 128 + wr * 64 + m * 16 + fr; const int pos = row_pos(row);
#pragma unroll
                    for (int bj = 0; bj < 2; ++bj) { const f32x4* tp = (const f32x4*)(rope + ((size_t)pos * 32 + (((bj * 128 + cw) & 63) >> 1)) * 2); t[m][bj][0] = tp[0]; t[m][bj][1] = tp[1]; }
                }
#pragma unroll
                for (int m = 0; m < 4; ++m) {
                    const int row = u.pm * 256 + ai * 128 + wr * 64 + m * 16 + fr;
#pragma unroll
                    for (int bj = 0; bj < 2; ++bj) {
                        const f32x4 v0 = acc[ai][bj][m][0], v1 = acc[ai][bj][m][1], t0 = t[m][bj][0], t1 = t[m][bj][1];
                        u32x4 w;
                        w.x = pk2(v0[0] * t0[0] - v0[1] * t0[1], v0[1] * t0[0] + v0[0] * t0[1]); w.y = pk2(v0[2] * t0[2] - v0[3] * t0[3], v0[3] * t0[2] + v0[2] * t0[3]);
                        w.z = pk2(v1[0] * t1[0] - v1[1] * t1[1], v1[1] * t1[0] + v1[0] * t1[1]); w.w = pk2(v1[2] * t1[2] - v1[3] * t1[3], v1[3] * t1[2] + v1[2] * t1[3]);
                        *(u32x4*)(Q + (size_t)row * 1024 + pn * 256 + bj * 128 + cw) = w;
                    }
                }
            }
        } else if (pn == 4) {
            f32x4 t[2][4][2];
#pragma unroll
            for (int ai = 0; ai < 2; ++ai)
#pragma unroll
                for (int m = 0; m < 4; ++m) {
                    const int row = u.pm * 256 + ai * 128 + wr * 64 + m * 16 + fr; const int pos = row_pos(row);
                    const f32x4* tp = (const f32x4*)(rope + ((size_t)pos * 32 + ((cw & 63) >> 1)) * 2); t[ai][m][0] = tp[0]; t[ai][m][1] = tp[1];
                }
#pragma unroll
            for (int ai = 0; ai < 2; ++ai)
#pragma unroll
                for (int m = 0; m < 4; ++m) {
                    const int row = u.pm * 256 + ai * 128 + wr * 64 + m * 16 + fr;
                    { const f32x4 v0 = acc[ai][0][m][0], v1 = acc[ai][0][m][1], t0 = t[ai][m][0], t1 = t[ai][m][1];
                      u32x4 w;
                      w.x = pk2(v0[0] * t0[0] - v0[1] * t0[1], v0[1] * t0[0] + v0[0] * t0[1]); w.y = pk2(v0[2] * t0[2] - v0[3] * t0[3], v0[3] * t0[2] + v0[2] * t0[3]);
                      w.z = pk2(v1[0] * t1[0] - v1[1] * t1[1], v1[1] * t1[0] + v1[0] * t1[1]); w.w = pk2(v1[2] * t1[2] - v1[3] * t1[3], v1[3] * t1[2] + v1[2] * t1[3]);
                      *(u32x4*)(Kb + (size_t)row * 128 + cw) = w; }
                    { const f32x4 v0 = acc[ai][1][m][0], v1 = acc[ai][1][m][1];
                      u32x4 w; w.x = pk2(v0[0], v0[1]); w.y = pk2(v0[2], v0[3]); w.z = pk2(v1[0], v1[1]); w.w = pk2(v1[2], v1[3]);
                      *(u32x4*)(Vb + (size_t)row * 128 + cw) = w; }
                }
        } else if (pn < 7) {
#pragma unroll
            for (int ai = 0; ai < 2; ++ai)
#pragma unroll
                for (int m = 0; m < 4; ++m) {
                    const int row = u.pm * 256 + ai * 128 + wr * 64 + m * 16 + fr;
#pragma unroll
                    for (int bj = 0; bj < 2; ++bj) {
                        const f32x4 v0 = acc[ai][bj][m][0], v1 = acc[ai][bj][m][1];
                        u32x4 w; w.x = pk2(v0[0], v0[1]); w.y = pk2(v0[2], v0[3]); w.z = pk2(v1[0], v1[1]); w.w = pk2(v1[2], v1[3]);
                        *(u32x4*)(Pb + (size_t)row * 512 + (pn - 5) * 256 + bj * 128 + cw) = w;
                    }
                }
        } else {
            const int gc = pn * 256 - 1792 + cw;
            f32x4 b[2][2];
#pragma unroll
            for (int bj = 0; bj < 2; ++bj) { b[bj][0] = *(const f32x4*)(b_gate + gc + bj * 128); b[bj][1] = *(const f32x4*)(b_gate + gc + bj * 128 + 4); }
            bf16_t* dstb = (pn < 11) ? GA + gc : GP + (gc - 1024);
#pragma unroll
            for (int ai = 0; ai < 2; ++ai)
#pragma unroll
                for (int m = 0; m < 4; ++m) {
                    const int row = u.pm * 256 + ai * 128 + wr * 64 + m * 16 + fr;
#pragma unroll
                    for (int bj = 0; bj < 2; ++bj) {
                        f32x4 v0 = acc[ai][bj][m][0] + b[bj][0], v1 = acc[ai][bj][m][1] + b[bj][1];
#pragma unroll
                        for (int i = 0; i < 4; ++i) { v0[i] = sigmoidf_(v0[i]); v1[i] = sigmoidf_(v1[i]); }
                        u32x4 w; w.x = pk2(v0[0], v0[1]); w.y = pk2(v0[2], v0[3]); w.z = pk2(v1[0], v1[1]); w.w = pk2(v1[2], v1[3]);
                        __builtin_nontemporal_store(w, (u32x4*)(dstb + (size_t)row * 1024 + bj * 128));
                    }
                }
        }
    }
};
struct EpiT1 {
    static constexpr bool PERM = true, AFTER_DRAIN = false, APERM = false;
    const bf16_t* G; bf16_t* O;
    __device__ __forceinline__ void operator()(const f32x4 (&acc)[2][2][4][2], const Unit& u, int wr, int wc, int fr_in, int fq_in) const {
        int fr = fr_in, fq = fq_in; asm volatile("" : "+v"(fr), "+v"(fq));
        const size_t base = (size_t)(u.pm * 256 + wr * 64 + fr) * 1024 + u.pn * 256 + wc * 32 + 8 * fq;
        u32x4 g[2][4][2];
#pragma unroll
        for (int ai = 0; ai < 2; ++ai)
#pragma unroll
            for (int m = 0; m < 4; ++m)
#pragma unroll
                for (int bj = 0; bj < 2; ++bj) g[ai][m][bj] = __builtin_nontemporal_load((const u32x4*)(G + base + (size_t)(ai * 128 + m * 16) * 1024 + bj * 128));
#pragma unroll
        for (int ai = 0; ai < 2; ++ai)
#pragma unroll
            for (int m = 0; m < 4; ++m)
#pragma unroll
                for (int bj = 0; bj < 2; ++bj) {
                    const u32x4 gg = g[ai][m][bj]; const f32x4 v0 = acc[ai][bj][m][0], v1 = acc[ai][bj][m][1];
                    u32x4 w; w.x = pk2(v0[0] * bf_lo(gg.x), v0[1] * bf_hi(gg.x)); w.y = pk2(v0[2] * bf_lo(gg.y), v0[3] * bf_hi(gg.y));
                    w.z = pk2(v1[0] * bf_lo(gg.z), v1[1] * bf_hi(gg.z)); w.w = pk2(v1[2] * bf_lo(gg.w), v1[3] * bf_hi(gg.w));
                    *(u32x4*)(O + base + (size_t)(ai * 128 + m * 16) * 1024 + bj * 128) = w;
                }
    }
};
struct EpiMix {
    static constexpr bool PERM = true, AFTER_DRAIN = false, APERM = false;
    const bf16_t* G; bf16_t* O;
    __device__ __forceinline__ void operator()(const f32x4 (&acc)[2][2][4][2], const Unit& u, int wr, int wc, int fr_in, int fq_in) const {
        int fr = fr_in, fq = fq_in; asm volatile("" : "+v"(fr), "+v"(fq));
        const size_t base = (size_t)(u.pm * 256 + wr * 64 + fr) * 1024 + u.pn * 256 + wc * 32 + 8 * fq;
#pragma unroll
        for (int ai = 0; ai < 2; ++ai) {
            u32x4 g[4][2], t[4][2];
#pragma unroll
            for (int m = 0; m < 4; ++m)
#pragma unroll
                for (int bj = 0; bj < 2; ++bj) { g[m][bj] = __builtin_nontemporal_load((const u32x4*)(G + base + (size_t)(ai * 128 + m * 16) * 1024 + bj * 128)); t[m][bj] = *(const u32x4*)(O + base + (size_t)(ai * 128 + m * 16) * 1024 + bj * 128); }
#pragma unroll
            for (int m = 0; m < 4; ++m)
#pragma unroll
                for (int bj = 0; bj < 2; ++bj) {
                    const u32x4 gg = g[m][bj], tt = t[m][bj]; const f32x4 v0 = acc[ai][bj][m][0], v1 = acc[ai][bj][m][1];
                    u32x4 w; w.x = pk2(bf_lo(tt.x) + v0[0] * bf_lo(gg.x), bf_hi(tt.x) + v0[1] * bf_hi(gg.x)); w.y = pk2(bf_lo(tt.y) + v0[2] * bf_lo(gg.y), bf_hi(tt.y) + v0[3] * bf_hi(gg.y));
                    w.z = pk2(bf_lo(tt.z) + v1[0] * bf_lo(gg.z), bf_hi(tt.z) + v1[1] * bf_hi(gg.z)); w.w = pk2(bf_lo(tt.w) + v1[2] * bf_lo(gg.w), bf_hi(tt.w) + v1[3] * bf_hi(gg.w));
                    *(u32x4*)(O + base + (size_t)(ai * 128 + m * 16) * 1024 + bj * 128) = w;
                }
        }
    }
};
struct EpiX1 {
    static constexpr bool PERM = true, AFTER_DRAIN = false, APERM = false;
    const bf16_t* XN; const float *r0i, *gmix, *gffn; bf16_t* XG; float* ssq;
    __device__ __forceinline__ void operator()(const f32x4 (&acc)[2][2][4][2], const Unit& u, int wr, int wc, int fr_in, int fq_in) const {
        int fr = fr_in, fq = fq_in; asm volatile("" : "+v"(fr), "+v"(fq));
        const int col0 = u.pn * 256 + wc * 32 + 8 * fq;
        f32x4 g[2][2], ig[2][2];
#pragma unroll
        for (int bj = 0; bj < 2; ++bj)
#pragma unroll
            for (int hh = 0; hh < 2; ++hh) { g[bj][hh] = *(const f32x4*)(gffn + col0 + bj * 128 + 4 * hh); const f32x4 gm = *(const f32x4*)(gmix + col0 + bj * 128 + 4 * hh);
#pragma unroll
                for (int i = 0; i < 4; ++i) ig[bj][hh][i] = __builtin_amdgcn_rcpf(gm[i]); }
#pragma unroll
        for (int ai = 0; ai < 2; ++ai) {
            u32x4 xn[4][2]; float ri[4];
#pragma unroll
            for (int m = 0; m < 4; ++m) {
                const int row = u.pm * 256 + ai * 128 + wr * 64 + m * 16 + fr;
                ri[m] = r0i[row];
#pragma unroll
                for (int bj = 0; bj < 2; ++bj) xn[m][bj] = *(const u32x4*)(XN + (size_t)row * 1024 + col0 + bj * 128);
            }
#pragma unroll
            for (int m = 0; m < 4; ++m) {
                const int row = u.pm * 256 + ai * 128 + wr * 64 + m * 16 + fr;
                const float rr = ri[m];
                float ss = 0.f;
#pragma unroll
                for (int bj = 0; bj < 2; ++bj) {
                    const u32x4 q = xn[m][bj];
                    f32x4 x0, x1;
                    x0[0] = bf_lo(q.x) * rr * ig[bj][0][0]; x0[1] = bf_hi(q.x) * rr * ig[bj][0][1]; x0[2] = bf_lo(q.y) * rr * ig[bj][0][2]; x0[3] = bf_hi(q.y) * rr * ig[bj][0][3];
                    x1[0] = bf_lo(q.z) * rr * ig[bj][1][0]; x1[1] = bf_hi(q.z) * rr * ig[bj][1][1]; x1[2] = bf_lo(q.w) * rr * ig[bj][1][2]; x1[3] = bf_hi(q.w) * rr * ig[bj][1][3];
                    const f32x4 v0 = acc[ai][bj][m][0] + x0, v1 = acc[ai][bj][m][1] + x1, g0 = g[bj][0], g1 = g[bj][1];
                    u32x4 w; w.x = pk2(v0[0] * g0[0], v0[1] * g0[1]); w.y = pk2(v0[2] * g0[2], v0[3] * g0[3]); w.z = pk2(v1[0] * g1[0], v1[1] * g1[1]); w.w = pk2(v1[2] * g1[2], v1[3] * g1[3]);
                    *(u32x4*)(XG + (size_t)row * 1024 + col0 + bj * 128) = w;
                    ss += (v0[0] * v0[0] + v0[1] * v0[1]) + (v0[2] * v0[2] + v0[3] * v0[3]) + (v1[0] * v1[0] + v1[1] * v1[1]) + (v1[2] * v1[2] + v1[3] * v1[3]);
                }
                ss += __shfl_xor(ss, 16); ss += __shfl_xor(ss, 32);
                if (fq == 0) ssq[(size_t)row * 16 + u.pn * 4 + wc] = ss;
            }
        }
    }
};
__device__ __forceinline__ float ror1(float x) { return __builtin_bit_cast(float, __builtin_amdgcn_mov_dpp(__builtin_bit_cast(int, x), 0x121, 0xf, 0xf, false)); }
__device__ __forceinline__ float ror2(float x) { return __builtin_bit_cast(float, __builtin_amdgcn_mov_dpp(__builtin_bit_cast(int, x), 0x122, 0xf, 0xf, false)); }
__device__ __forceinline__ float shr1(float old, float x) { return __builtin_bit_cast(float, __builtin_amdgcn_update_dpp(__builtin_bit_cast(int, old), __builtin_bit_cast(int, x), 0x111, 0xf, 0xf, false)); }
__device__ __forceinline__ float shr2(float old, float x) { return __builtin_bit_cast(float, __builtin_amdgcn_update_dpp(__builtin_bit_cast(int, old), __builtin_bit_cast(int, x), 0x112, 0xf, 0xf, false)); }
struct EpiUp {
    static constexpr bool PERM = true, AFTER_DRAIN = false, APERM = true;
    const float *ssq, *cw, *cb; bf16_t* ACT; float* HALO; float* UPT;
    __device__ __forceinline__ void operator()(const f32x4 (&acc)[2][2][4][2], const Unit& u, int wr, int wc, int fr_in, int fq_in) const {
        int fr = fr_in, fq = fq_in; asm volatile("" : "+v"(fr), "+v"(fq));
        const int jb = u.pn * 128 + wc * 32 + 8 * fq;
        const int row0 = u.pm * 256 + wr * 128 + fr;
        float r1[2][4];
#pragma unroll
        for (int ai = 0; ai < 2; ++ai)
#pragma unroll
            for (int m = 0; m < 4; ++m) {
                const f32x4* sp = (const f32x4*)(ssq + (size_t)(row0 + ai * 64 + m * 16) * 16);
                const f32x4 a = sp[0], b = sp[1], c = sp[2], d = sp[3];
                const float s = ((a[0] + a[1]) + (a[2] + a[3])) + ((b[0] + b[1]) + (b[2] + b[3])) + ((c[0] + c[1]) + (c[2] + c[3])) + ((d[0] + d[1]) + (d[2] + d[3]));
                r1[ai][m] = rsqrtf(s * (1.0f / 1024.0f) + RMS_EPS);
            }
#pragma unroll
        for (int ai = 0; ai < 2; ++ai)
#pragma unroll
            for (int m = 0; m < 4; ++m) asm volatile("" : "+v"(r1[ai][m]));
        __builtin_amdgcn_sched_barrier(0);
        const int slab = u.pm * 2 + wr;
#pragma unroll
        for (int n = 0; n < 2; ++n) {
            int jg = jb + 4 * n; asm volatile("" : "+v"(jg) :: "memory");
            const f32x4 w0g = *(const f32x4*)(cw + jg), w1g = *(const f32x4*)(cw + FF2 + jg), w2g = *(const f32x4*)(cw + 2 * FF2 + jg), bg = *(const f32x4*)(cb + jg);
            const f32x4 w0v = *(const f32x4*)(cw + FF + jg), w1v = *(const f32x4*)(cw + FF2 + FF + jg), w2v = *(const f32x4*)(cw + 2 * FF2 + FF + jg), bv = *(const f32x4*)(cb + FF + jg);
            f32x4 pg = {0.f, 0.f, 0.f, 0.f}, pv = {0.f, 0.f, 0.f, 0.f};
#pragma unroll
            for (int ai = 0; ai < 2; ++ai) {
#pragma unroll
                for (int m = 0; m < 4; ++m) {
                    const int row = row0 + ai * 64 + m * 16;
                    const f32x4 ug = acc[ai][0][m][n] * r1[ai][m], uv = acc[ai][1][m][n] * r1[ai][m];
                    const bool first = (ai == 0 && m == 0), last = (ai == 1 && m == 3);
                    if (first && fr < 2) { *(f32x4*)(HALO + (size_t)(slab * 4 + fr) * FF2 + jg) = ug; *(f32x4*)(HALO + (size_t)(slab * 4 + fr) * FF2 + FF + jg) = uv; }
                    if (last && fr >= 14) { *(f32x4*)(HALO + (size_t)(slab * 4 + fr - 12) * FF2 + jg) = ug; *(f32x4*)(HALO + (size_t)(slab * 4 + fr - 12) * FF2 + FF + jg) = uv; }
                    f32x4 g1, g2, v1, v2;
#pragma unroll
                    for (int i = 0; i < 4; ++i) {
                        g1[i] = shr1(ror1(pg[i]), ug[i]); g2[i] = shr2(ror2(pg[i]), ug[i]);
                        v1[i] = shr1(ror1(pv[i]), uv[i]); v2[i] = shr2(ror2(pv[i]), uv[i]);
                    }
                    const f32x4 cg = bg + w0g * g2 + w1g * g1 + w2g * ug;
                    const f32x4 cv = bv + w0v * v2 + w1v * v1 + w2v * uv;
                    float a[4];
#pragma unroll
                    for (int i = 0; i < 4; ++i) a[i] = cg[i] * sigmoidf_(cg[i]) * cv[i];
                    if (!(first && fr < 2)) { u32x2 w; w.x = pk2(a[0], a[1]); w.y = pk2(a[2], a[3]); *(u32x2*)(ACT + (size_t)row * FF + jg) = w; }
                    pg = ug; pv = uv;
                }
            }
        }
    }
};
constexpr size_t WS_PCNT = 8 * MiB + 768 * 1024;
#define AG_LD(p) __hip_atomic_load((p), __ATOMIC_RELAXED, __HIP_MEMORY_SCOPE_AGENT)
#define AG_ST(p, v) __hip_atomic_store((p), (v), __ATOMIC_RELAXED, __HIP_MEMORY_SCOPE_AGENT)
struct EpiDown {
    static constexpr bool PERM = true, AFTER_DRAIN = false, APERM = false;
    const bf16_t* XG; const float* gffn; const float* gfin; float* out; float* ssq;
    __device__ __forceinline__ void operator()(const f32x4 (&acc_c)[2][2][4][2], const Unit& u, int wr, int wc, int fr_in, int fq_in) const {
        int fr = fr_in, fq = fq_in; asm volatile("" : "+v"(fr), "+v"(fq));
        f32x4 (&acc)[2][2][4][2] = const_cast<f32x4 (&)[2][2][4][2]>(acc_c);
        const int col0 = u.pn * 256 + wc * 32 + 8 * fq;
        f32x4 ig[2][2];
#pragma unroll
        for (int bj = 0; bj < 2; ++bj)
#pragma unroll
            for (int hh = 0; hh < 2; ++hh) { const f32x4 gg = *(const f32x4*)(gffn + col0 + bj * 128 + 4 * hh);
#pragma unroll
                for (int i = 0; i < 4; ++i) ig[bj][hh][i] = __builtin_amdgcn_rcpf(gg[i]); }
#pragma unroll
        for (int ai = 0; ai < 2; ++ai) {
            u32x4 xgv[4][2];
#pragma unroll
            for (int m = 0; m < 4; ++m)
#pragma unroll
                for (int bj = 0; bj < 2; ++bj) xgv[m][bj] = __builtin_nontemporal_load((const u32x4*)(XG + (size_t)(u.pm * 256 + ai * 128 + wr * 64 + m * 16 + fr) * 1024 + col0 + bj * 128));
#pragma unroll
            for (int m = 0; m < 4; ++m) {
                const int row = u.pm * 256 + ai * 128 + wr * 64 + m * 16 + fr;
                float ss = 0.f;
#pragma unroll
                for (int bj = 0; bj < 2; ++bj) {
                    const u32x4 xg = xgv[m][bj];
                    f32x4 x0, x1;
                    x0[0] = bf_lo(xg.x) * ig[bj][0][0]; x0[1] = bf_hi(xg.x) * ig[bj][0][1]; x0[2] = bf_lo(xg.y) * ig[bj][0][2]; x0[3] = bf_hi(xg.y) * ig[bj][0][3];
                    x1[0] = bf_lo(xg.z) * ig[bj][1][0]; x1[1] = bf_hi(xg.z) * ig[bj][1][1]; x1[2] = bf_lo(xg.w) * ig[bj][1][2]; x1[3] = bf_hi(xg.w) * ig[bj][1][3];
                    const f32x4 v0 = acc[ai][bj][m][0] + x0, v1 = acc[ai][bj][m][1] + x1;
                    acc[ai][bj][m][0] = v0; acc[ai][bj][m][1] = v1;
                    ss += (v0[0] * v0[0] + v0[1] * v0[1]) + (v0[2] * v0[2] + v0[3] * v0[3]) + (v1[0] * v1[0] + v1[1] * v1[1]) + (v1[2] * v1[2] + v1[3] * v1[3]);
                }
                ss += __shfl_xor(ss, 16); ss += __shfl_xor(ss, 32);
                if (fq == 0) AG_ST(ssq + (size_t)row * 16 + u.pn * 4 + wc, ss);
            }
        }
        asm volatile("s_waitcnt vmcnt(0)" ::: "memory");
        unsigned* pc = (unsigned*)((char*)ssq + (WS_PCNT - WS_SSQ2)) + 64 * u.pm;
        if (fr == 0 && fq == 0) __hip_atomic_fetch_add(pc, 1u, __ATOMIC_RELAXED, __HIP_MEMORY_SCOPE_AGENT);
        for (int tries = 0; tries < (1 << 18); ++tries) {
            const unsigned c = (unsigned)__builtin_amdgcn_readfirstlane((int)AG_LD(pc));
            if (c >= 32u) break;
            __builtin_amdgcn_s_sleep(2);
        }
        float rs[2][4];
        {
            float* spb = ssq + (size_t)(u.pm * 256 + wr * 64 + fr) * 16 + 4 * fq;
#pragma unroll
            for (int ai = 0; ai < 2; ++ai)
#pragma unroll
                for (int m = 0; m < 4; ++m) {
                    float* sp = spb + (ai * 128 + m * 16) * 16;
                    const float a = AG_LD(sp), b = AG_LD(sp + 1), c = AG_LD(sp + 2), d = AG_LD(sp + 3);
                    rs[ai][m] = (a + b) + (c + d);
                }
        }
#pragma unroll
        for (int ai = 0; ai < 2; ++ai)
#pragma unroll
            for (int m = 0; m < 4; ++m) {
                const int row = u.pm * 256 + ai * 128 + wr * 64 + m * 16 + fr;
                float s = rs[ai][m]; s += __shfl_xor(s, 16); s += __shfl_xor(s, 32);
                const float r = rsqrtf(s * (1.0f / 1024.0f) + RMS_EPS);
                float* orow = out + O_YP + (size_t)row * D;
#pragma unroll
                for (int bj = 0; bj < 2; ++bj) {
                    const int col = u.pn * 256 + bj * 128 + wc * 32 + 8 * fq;
                    const f32x4 g0 = *(const f32x4*)(gfin + col), g1 = *(const f32x4*)(gfin + col + 4);
                    *(f32x4*)(orow + col) = acc[ai][bj][m][0] * r * g0; *(f32x4*)(orow + col + 4) = acc[ai][bj][m][1] * r * g1;
                }
            }
    }
};

struct MapId { __device__ __forceinline__ int operator()(int n) const { return n; } };
struct MapIn { __device__ __forceinline__ int operator()(int n) const { return n < 1152 ? ((n & ~63) + 2 * (n & 31) + ((n >> 5) & 1)) : n; } };
struct MapUp { __device__ __forceinline__ int operator()(int n) const { if (n < FF) return 256 * (n >> 7) + (n & 127); const int m = n - FF; return 256 * (m >> 7) + 128 + (m & 127); } };
template <class Map>
__device__ __forceinline__ void p0_transpose_item(const float* W, int K, int N, bf16_t* WT, LAS float* scr, int item, int lane, Map map) {
    const int nblk = N / 32, kb = item / nblk, nb = item % nblk, k0 = 64 * kb, n0 = 32 * nb;
#pragma unroll
    for (int i = 0; i < 32; ++i) { const int kk = 2 * i + (lane >> 5); scr[kk * 33 + (lane & 31)] = __builtin_nontemporal_load(W + (size_t)(k0 + kk) * N + n0 + (lane & 31)); }
    asm volatile("s_waitcnt lgkmcnt(0)" ::: "memory");
    const int c = lane & 7;
#pragma unroll
    for (int j = 0; j < 4; ++j) { const int n = (lane >> 3) + 8 * j; const LAS float* s = scr + (8 * c) * 33 + n;
        u32x4 o; o.x = pk2(s[0 * 33], s[1 * 33]); o.y = pk2(s[2 * 33], s[3 * 33]); o.z = pk2(s[4 * 33], s[5 * 33]); o.w = pk2(s[6 * 33], s[7 * 33]);
        *(u32x4*)(WT + (size_t)map(n0 + n) * K + k0 + 8 * c) = o; }
    asm volatile("s_waitcnt lgkmcnt(0)" ::: "memory");
}
__device__ __forceinline__ void p0_prologue(const Params& p, LAS unsigned char* lds, int wave, int lane) {
    unsigned char* ws = p.ws;
    if (wave < 3) {
        bf16_t* XN = (bf16_t*)(ws + WS_XN);
        const int gw = blockIdx.x * 3 + wave, NGW = gridDim.x * 3;
        f32x4 gv[4];
#pragma unroll
        for (int j = 0; j < 4; ++j) gv[j] = ((const f32x4*)p.g_norm_mix)[lane + 64 * j];
        for (int m0 = gw * 4; m0 < M; m0 += NGW * 4) {
            f32x4 v[4][4]; const float* xr[4];
#pragma unroll
            for (int q = 0; q < 4; ++q) {
                xr[q] = row_x(p.x_prompt, p.meta_tokens, p.x_sample, m0 + q);
#pragma unroll
                for (int j = 0; j < 4; ++j) v[q][j] = xr[q] ? __builtin_nontemporal_load((const f32x4*)xr[q] + lane + 64 * j) : (f32x4){0.f, 0.f, 0.f, 0.f};
            }
#pragma unroll
            for (int q = 0; q < 4; ++q) {
                float s = 0.f;
#pragma unroll
                for (int j = 0; j < 4; ++j) s += (v[q][j][0] * v[q][j][0] + v[q][j][1] * v[q][j][1]) + (v[q][j][2] * v[q][j][2] + v[q][j][3] * v[q][j][3]);
                const float ms = wave_sum(s) * (1.0f / D) + RMS_EPS;
                const float r = rsqrtf(ms);
                if (lane == 0) ((float*)(ws + WS_R0I))[m0 + q] = sqrtf(ms);
                unsigned long long* o8 = (unsigned long long*)(XN + (size_t)(m0 + q) * D) + lane;
#pragma unroll
                for (int j = 0; j < 4; ++j) { const f32x4 w = v[q][j] * r * gv[j]; o8[64 * j] = (unsigned long long)pk2(w[0], w[1]) | ((unsigned long long)pk2(w[2], w[3]) << 32); }
            }
        }
        return;
    }
    LAS float* scr = (LAS float*)(lds + wave * 16384);
    const int gw = blockIdx.x * 5 + (wave - 3), NGW = gridDim.x * 5;
    const int gt = blockIdx.x * 320 + (int)threadIdx.x - 192, NT = gridDim.x * 320;
    constexpr int I_IN = 16 * (INW / 32), I_AO = 16 * 32, I_OUT = 16 * 32, I_UP = 16 * (FF2 / 32), I_DN = (FF / 64) * 32;
    constexpr int NITEMS = I_IN + I_AO + I_OUT + I_UP + I_DN;
    for (int it = gw; it < NITEMS; it += NGW) {
        int r = it;
        if (r < I_IN) { p0_transpose_item(p.w_in, D, INW, (bf16_t*)(ws + WS_WIN), scr, r, lane, MapIn()); continue; } r -= I_IN;
        if (r < I_AO) { p0_transpose_item(p.w_attn_o, D, D, (bf16_t*)(ws + WS_WAO), scr, r, lane, MapId()); continue; } r -= I_AO;
        if (r < I_OUT) { p0_transpose_item(p.w_out, D, D, (bf16_t*)(ws + WS_WOUT), scr, r, lane, MapId()); continue; } r -= I_OUT;
        if (r < I_UP) { p0_transpose_item(p.w_up, D, FF2, (bf16_t*)(ws + WS_WUP), scr, r, lane, MapUp()); continue; } r -= I_UP;
        p0_transpose_item(p.w_down, FF, D, (bf16_t*)(ws + WS_WDOWN), scr, r, lane, MapId());
    }
    {
        bf16_t* WP = (bf16_t*)(ws + WS_WPO);
        for (int idx = gt; idx < 1024 * 128; idx += NT) {
            const int n = idx & 1023, k0 = (idx >> 10) * 4, g = k0 >> 7;
            const float* wg = p.w_pool_grp + (size_t)k0 * 128;
            const float* sc = p.pool_scale + g * 128;
            const float* wo = p.w_pool_o + (size_t)(g * 128) * 1024 + n;
            float a[4] = {0.f, 0.f, 0.f, 0.f};
#pragma unroll 2
            for (int d = 0; d < 128; d += 4) {
                const f32x4 s4 = *(const f32x4*)(sc + d);
                float wv[4];
#pragma unroll
                for (int e = 0; e < 4; ++e) wv[e] = wo[(size_t)(d + e) * 1024] * s4[e];
#pragma unroll
                for (int j = 0; j < 4; ++j) { const f32x4 w4 = *(const f32x4*)(wg + j * 128 + d); a[j] += (w4[0] * wv[0] + w4[1] * wv[1]) + (w4[2] * wv[2] + w4[3] * wv[3]); }
            }
            u32x2 o; o.x = pk2(a[0], a[1]); o.y = pk2(a[2], a[3]);
            *(u32x2*)(WP + (size_t)n * 512 + k0) = o;
        }
    }
    float* rope = (float*)(ws + WS_ROPE);
    for (int i = gt; i < NPOS * 32; i += NT) {
        const int pos = i >> 5, d = i & 31;
        const float ang = (float)pos * p.inv_freq[d];
        const double rev = (double)ang * 0.15915494309189535;
        const float fr = (float)(rev - floor(rev));
        rope[2 * i] = __builtin_amdgcn_cosf(fr); rope[2 * i + 1] = __builtin_amdgcn_sinf(fr);
    }
}

constexpr int KS_PITCH = 144, VT_PITCH = 464, ATT_VT_OFF = 208 * KS_PITCH;
constexpr float LOG2E = 1.4426950408889634f, C2 = 0.125f * 1.4426950408889634f;

template <int NQ>
__device__ __forceinline__ void attn_load_q(bf16x8 (&qf)[NQ][2], const bf16_t* Qb, int qrow0, int h, int lane) {
    const int fr = lane & 15, fq = lane >> 4;
#pragma unroll
    for (int qb = 0; qb < NQ; ++qb)
#pragma unroll
        for (int ks = 0; ks < 2; ++ks) qf[qb][ks] = __builtin_nontemporal_load((const bf16x8*)(Qb + (size_t)(qrow0 + 16 * qb + fr) * 1024 + h * 64 + 32 * ks + 8 * fq));
}
template <int NQ>
__device__ __forceinline__ void attn_compute(LAS unsigned char* lds, const bf16x8 (&qf)[NQ][2], bf16_t* ATT, int qrow0, int h, unsigned vmask, float sink2, int lane) {
    const int fr = lane & 15, fq = lane >> 4;
    f32x4 s[NQ][13];
    const LAS unsigned char* kp = lds + fr * KS_PITCH + fq * 16;
    bf16x8 kc0 = *(const LAS bf16x8*)kp, kc1 = *(const LAS bf16x8*)(kp + 64);
#pragma unroll
    for (int kb = 0; kb < 13; ++kb) {
        bf16x8 kn0 = kc0, kn1 = kc1;
        if (kb < 12) { kn0 = *(const LAS bf16x8*)(kp + (kb + 1) * 16 * KS_PITCH); kn1 = *(const LAS bf16x8*)(kp + (kb + 1) * 16 * KS_PITCH + 64); }
#pragma unroll
        for (int qb = 0; qb < NQ; ++qb) {
            f32x4 a = {0.f, 0.f, 0.f, 0.f};
            a = __builtin_amdgcn_mfma_f32_16x16x32_bf16(kc0, qf[qb][0], a, 0, 0, 0);
            a = __builtin_amdgcn_mfma_f32_16x16x32_bf16(kc1, qf[qb][1], a, 0, 0, 0);
            s[qb][kb] = a;
        }
        kc0 = kn0; kc1 = kn1;
        __builtin_amdgcn_sched_barrier(0);
    }
    float rl[NQ];
#pragma unroll
    for (int qb = 0; qb < NQ; ++qb) {
        float mr = -1e30f;
#pragma unroll
        for (int kb = 0; kb < 13; ++kb) {
            if (vmask != 0x1fffu) {
                const bool valid = (vmask >> kb) & 1u;
#pragma unroll
                for (int i = 0; i < 4; ++i) s[qb][kb][i] = valid ? s[qb][kb][i] : -1e30f;
            }
            mr = fmaxf(mr, fmaxf(fmaxf(s[qb][kb][0], s[qb][kb][1]), fmaxf(s[qb][kb][2], s[qb][kb][3])));
        }
        mr = fmaxf(mr, __shfl_xor(mr, 16)); mr = fmaxf(mr, __shfl_xor(mr, 32));
        const float mx = fmaxf(mr * C2, sink2), nmx = -mx;
        float l = 0.f;
#pragma unroll
        for (int kb = 0; kb < 13; ++kb)
#pragma unroll
            for (int i = 0; i < 4; ++i) { const float pv = __builtin_amdgcn_exp2f(fmaf(s[qb][kb][i], C2, nmx)); s[qb][kb][i] = pv; l += pv; }
        l += __shfl_xor(l, 16); l += __shfl_xor(l, 32);
        l += __builtin_amdgcn_exp2f(sink2 - mx);
        rl[qb] = __builtin_amdgcn_rcpf(l);
    }
    f32x4 o[NQ][4];
#pragma unroll
    for (int qb = 0; qb < NQ; ++qb)
#pragma unroll
        for (int db = 0; db < 4; ++db) o[qb][db] = (f32x4){0.f, 0.f, 0.f, 0.f};
    const LAS unsigned char* vp = lds + ATT_VT_OFF + fr * VT_PITCH + fq * 8;
    u32x2 vlo[4], vhi[4];
#pragma unroll
    for (int db = 0; db < 4; ++db) { vlo[db] = *(const LAS u32x2*)(vp + db * 16 * VT_PITCH); vhi[db] = *(const LAS u32x2*)(vp + db * 16 * VT_PITCH + 32); }
#pragma unroll
    for (int kk = 0; kk < 7; ++kk) {
        u32x2 nlo[4], nhi[4];
#pragma unroll
        for (int db = 0; db < 4; ++db) { nlo[db] = vlo[db]; nhi[db] = vhi[db]; }
        if (kk < 6) {
#pragma unroll
            for (int db = 0; db < 4; ++db) { nlo[db] = *(const LAS u32x2*)(vp + db * 16 * VT_PITCH + (kk + 1) * 64); nhi[db] = *(const LAS u32x2*)(vp + db * 16 * VT_PITCH + (kk + 1) * 64 + 32); }
        }
        bf16x8 pf[NQ];
#pragma unroll
        for (int qb = 0; qb < NQ; ++qb) {
            u32x4 w;
            w.x = pk2(s[qb][2 * kk][0], s[qb][2 * kk][1]); w.y = pk2(s[qb][2 * kk][2], s[qb][2 * kk][3]);
            if (2 * kk + 1 < 13) { w.z = pk2(s[qb][(2 * kk + 1) % 13][0], s[qb][(2 * kk + 1) % 13][1]); w.w = pk2(s[qb][(2 * kk + 1) % 13][2], s[qb][(2 * kk + 1) % 13][3]); }
            else { w.z = 0u; w.w = 0u; }
            pf[qb] = __builtin_bit_cast(bf16x8, w);
        }
#pragma unroll
        for (int db = 0; db < 4; ++db) {
            u32x4 vv; vv.x = vlo[db].x; vv.y = vlo[db].y; vv.z = vhi[db].x; vv.w = vhi[db].y;
            const bf16x8 vf = __builtin_bit_cast(bf16x8, vv);
#pragma unroll
            for (int qb = 0; qb < NQ; ++qb) o[qb][db] = __builtin_amdgcn_mfma_f32_16x16x32_bf16(vf, pf[qb], o[qb][db], 0, 0, 0);
        }
#pragma unroll
        for (int db = 0; db < 4; ++db) { vlo[db] = nlo[db]; vhi[db] = nhi[db]; }
        __builtin_amdgcn_sched_barrier(0);
    }
#pragma unroll
    for (int qb = 0; qb < NQ; ++qb)
#pragma unroll
        for (int db = 0; db < 4; ++db) {
            const f32x4 v = o[qb][db] * rl[qb];
            u32x2 w; w.x = pk2(v[0], v[1]); w.y = pk2(v[2], v[3]);
            *(u32x2*)(ATT + (size_t)(qrow0 + 16 * qb + fr) * 1024 + h * 64 + 16 * db + 4 * fq) = w;
        }
}
__device__ __forceinline__ void attn_zero_pad(LAS unsigned char* lds, int tid) {
    if (tid < 128) { const int row = tid >> 1, half = tid & 1; *(LAS u32x4*)(lds + ATT_VT_OFF + row * VT_PITCH + 416 + half * 16) = (u32x4){0u, 0u, 0u, 0u}; }
}
__device__ __forceinline__ void attn_fill_bf16(LAS unsigned char* lds, const bf16_t* Kb, const bf16_t* Vb, int srow, int n, int kk, int ch) {
    u32x4 kv = {0u, 0u, 0u, 0u}, vv = {0u, 0u, 0u, 0u};
    if (srow >= 0) { kv = *(const u32x4*)(Kb + (size_t)srow * 128 + n * 64 + ch * 8); vv = *(const u32x4*)(Vb + (size_t)srow * 128 + n * 64 + ch * 8); }
    *(LAS u32x4*)(lds + kk * KS_PITCH + ch * 16) = kv;
    LAS unsigned short* vt = (LAS unsigned short*)(lds + ATT_VT_OFF + (ch * 8) * VT_PITCH + kk * 2);
    vt[0 * (VT_PITCH / 2)] = (unsigned short)(vv.x & 0xffffu); vt[1 * (VT_PITCH / 2)] = (unsigned short)(vv.x >> 16);
    vt[2 * (VT_PITCH / 2)] = (unsigned short)(vv.y & 0xffffu); vt[3 * (VT_PITCH / 2)] = (unsigned short)(vv.y >> 16);
    vt[4 * (VT_PITCH / 2)] = (unsigned short)(vv.z & 0xffffu); vt[5 * (VT_PITCH / 2)] = (unsigned short)(vv.z >> 16);
    vt[6 * (VT_PITCH / 2)] = (unsigned short)(vv.w & 0xffffu); vt[7 * (VT_PITCH / 2)] = (unsigned short)(vv.w >> 16);
}
__device__ __forceinline__ void attn_fill_f32(LAS unsigned char* lds, const float* ksrc, const float* vsrc, int kk, int ch) {
    const f32x4 k0 = *(const f32x4*)(ksrc + ch * 8), k1 = *(const f32x4*)(ksrc + ch * 8 + 4);
    const f32x4 v0 = *(const f32x4*)(vsrc + ch * 8), v1 = *(const f32x4*)(vsrc + ch * 8 + 4);
    LAS unsigned short* kr = (LAS unsigned short*)(lds + kk * KS_PITCH);
    LAS unsigned short* vt = (LAS unsigned short*)(lds + ATT_VT_OFF + (ch * 8) * VT_PITCH + kk * 2);
#pragma unroll
    for (int e = 0; e < 8; ++e) {
        const int d = ch * 8 + e;
        const float kvv = e < 4 ? k0[e & 3] : k1[e & 3], vvv = e < 4 ? v0[e & 3] : v1[e & 3];
        kr[2 * (d & 31) + (d >> 5)] = (unsigned short)(pk2(kvv, 0.f) & 0xffffu);
        vt[e * (VT_PITCH / 2)] = (unsigned short)(pk2(vvv, 0.f) & 0xffffu);
    }
}
__device__ __forceinline__ void attn_chunk_unit(const Params& p, LAS unsigned char* lds, int unit, int tid, int wave, int lane) {
    unsigned char* ws = p.ws;
    const bf16_t *Qb = (const bf16_t*)(ws + WS_Q), *Kb = (const bf16_t*)(ws + WS_K), *Vb = (const bf16_t*)(ws + WS_V); bf16_t* ATT = (bf16_t*)(ws + WS_ATT);
    const int n = unit & 1, c = (unit >> 1) & 63, b = unit >> 7;
    asm volatile("" : "+v"(tid), "+v"(lane));
    const int h = n * 8 + wave, r0 = b * SEQ + c * 64;
    bf16x8 qa[2][2], qb2[2][2];
    attn_load_q<2>(qa, Qb, r0, h, lane);
#pragma unroll
    for (int jb = 0; jb < 2; ++jb) {
        u32x4 kv[2], vv[2];
#pragma unroll
        for (int j = 0; j < 2; ++j) {
            const int i = tid + 512 * (2 * jb + j), kk = i >> 3, ch = i & 7;
            int srow;
            if (kk < 16) srow = ROW_META + kk;
            else { const int t = (c - 2) * 64 + kk - 16; srow = t < 0 ? -1 : b * SEQ + t; }
            kv[j] = (u32x4){0u, 0u, 0u, 0u}; vv[j] = (u32x4){0u, 0u, 0u, 0u};
            if (i < 208 * 8 && srow >= 0) { kv[j] = *(const u32x4*)(Kb + (size_t)srow * 128 + n * 64 + ch * 8); vv[j] = *(const u32x4*)(Vb + (size_t)srow * 128 + n * 64 + ch * 8); }
        }
#pragma unroll
        for (int j = 0; j < 2; ++j) {
            const int i = tid + 512 * (2 * jb + j), kk = i >> 3, ch = i & 7;
            if (i < 208 * 8) {
                *(LAS u32x4*)(lds + kk * KS_PITCH + ch * 16) = kv[j];
                LAS unsigned short* vt = (LAS unsigned short*)(lds + ATT_VT_OFF + (ch * 8) * VT_PITCH + kk * 2);
                vt[0 * (VT_PITCH / 2)] = (unsigned short)(vv[j].x & 0xffffu); vt[1 * (VT_PITCH / 2)] = (unsigned short)(vv[j].x >> 16);
                vt[2 * (VT_PITCH / 2)] = (unsigned short)(vv[j].y & 0xffffu); vt[3 * (VT_PITCH / 2)] = (unsigned short)(vv[j].y >> 16);
                vt[4 * (VT_PITCH / 2)] = (unsigned short)(vv[j].z & 0xffffu); vt[5 * (VT_PITCH / 2)] = (unsigned short)(vv[j].z >> 16);
                vt[6 * (VT_PITCH / 2)] = (unsigned short)(vv[j].w & 0xffffu); vt[7 * (VT_PITCH / 2)] = (unsigned short)(vv[j].w >> 16);
            }
        }
    }
    attn_zero_pad(lds, tid);
    __syncthreads();
    unsigned vmask = 0x1fffu;
    if (c == 0) vmask = 0x1e01u; else if (c == 1) vmask = 0x1fe1u;
    const float sink2 = p.sinks[h] * LOG2E;
    attn_compute<2>(lds, qa, ATT, r0, h, vmask, sink2, lane);
    attn_load_q<2>(qb2, Qb, r0 + 32, h, lane);
    attn_compute<2>(lds, qb2, ATT, r0 + 32, h, vmask, sink2, lane);
    __syncthreads();
}
__device__ __forceinline__ void attn_small_unit(const Params& p, LAS unsigned char* lds, int unit, int tid, int wave, int lane) {
    unsigned char* ws = p.ws;
    const bf16_t *Qb = (const bf16_t*)(ws + WS_Q), *Kb = (const bf16_t*)(ws + WS_K), *Vb = (const bf16_t*)(ws + WS_V); bf16_t* ATT = (bf16_t*)(ws + WS_ATT);
    int n, qrow0; unsigned vmask;
    if (unit < 2) {
        n = unit; qrow0 = ROW_META; vmask = 1u;
        for (int i = tid; i < 208 * 8; i += 512) { const int kk = i >> 3, ch = i & 7; attn_fill_bf16(lds, Kb, Vb, kk < 16 ? ROW_META + kk : -1, n, kk, ch); }
    } else {
        const int b = (unit - 2) >> 1; n = (unit - 2) & 1; qrow0 = ROW_SAMP + b * 16; vmask = 0x3ffu;
        for (int i = tid; i < 208 * 8; i += 512) {
            const int kk = i >> 3, ch = i & 7;
            if (kk < 16) attn_fill_f32(lds, p.cache_meta_k + ((size_t)(b * 16 + kk) * 2 + n) * 64, p.cache_meta_v + ((size_t)(b * 16 + kk) * 2 + n) * 64, kk, ch);
            else if (kk < 144) attn_fill_f32(lds, p.cache_swa_k + ((size_t)(b * 128 + kk - 16) * 2 + n) * 64, p.cache_swa_v + ((size_t)(b * 128 + kk - 16) * 2 + n) * 64, kk, ch);
            else attn_fill_bf16(lds, Kb, Vb, kk < 160 ? ROW_SAMP + b * 16 + kk - 144 : -1, n, kk, ch);
        }
    }
    attn_zero_pad(lds, tid);
    __syncthreads();
    const int h = n * 8 + wave;
    bf16x8 q1[1][2]; attn_load_q<1>(q1, Qb, qrow0, h, lane);
    attn_compute<1>(lds, q1, ATT, qrow0, h, vmask, p.sinks[h] * LOG2E, lane);
    __syncthreads();
}
constexpr int PM_PITCH = 1040;
__device__ __forceinline__ void add8(float (&s)[8], const u32x4 v) {
    s[0] += bf_lo(v.x); s[1] += bf_hi(v.x); s[2] += bf_lo(v.y); s[3] += bf_hi(v.y); s[4] += bf_lo(v.z); s[5] += bf_hi(v.z); s[6] += bf_lo(v.w); s[7] += bf_hi(v.w);
}
__device__ __forceinline__ void unpack8(float (&s)[8], const u32x4 v) {
    s[0] = bf_lo(v.x); s[1] = bf_hi(v.x); s[2] = bf_lo(v.y); s[3] = bf_hi(v.y); s[4] = bf_lo(v.z); s[5] = bf_hi(v.z); s[6] = bf_lo(v.w); s[7] = bf_hi(v.w);
}
template <int W>
__device__ __forceinline__ void pool_pm_main(const bf16_t* Pb, bf16_t* POOL, int R0, int wave, int lane) {
    const int g = wave >> 1, col = (g * 16 + (lane & 15)) * 8, seg = (wave & 1) * 4 + (lane >> 4);
    const int sb = R0 & 4095, s0 = sb + seg * 8, base = R0 - sb;
    constexpr int NL = 8 + W - 1;
    u32x4 v[NL];
#pragma unroll
    for (int t = 0; t < NL; ++t) {
        const int sk = s0 + t - (W - 1);
        const int row = sk >= 0 ? base + sk : ROW_META + 16 + sk;
        v[t] = *(const u32x4*)(Pb + (size_t)row * PW + col);
    }
    float s[8] = {0.f, 0.f, 0.f, 0.f, 0.f, 0.f, 0.f, 0.f};
#pragma unroll
    for (int t = 0; t < W - 1; ++t) add8(s, v[t]);
#pragma unroll
    for (int j = 0; j < 8; ++j) {
        float cur[8], old[8];
        unpack8(cur, v[j + W - 1]); unpack8(old, v[j]);
#pragma unroll
        for (int e = 0; e < 8; ++e) s[e] += cur[e];
        constexpr float inv = 1.0f / (float)W;
        u32x4 o; o.x = pk2(s[0] * inv - cur[0], s[1] * inv - cur[1]); o.y = pk2(s[2] * inv - cur[2], s[3] * inv - cur[3]);
        o.z = pk2(s[4] * inv - cur[4], s[5] * inv - cur[5]); o.w = pk2(s[6] * inv - cur[6], s[7] * inv - cur[7]);
        *(u32x4*)(POOL + (size_t)(R0 + seg * 8 + j) * PW + col) = o;
#pragma unroll
        for (int e = 0; e < 8; ++e) s[e] -= old[e];
    }
}
__device__ __forceinline__ void pool_unit(const Params& p, LAS unsigned char* lds, int pt, int tid, int wave, int lane) {
    unsigned char* ws = p.ws;
    const bf16_t* Pb = (const bf16_t*)(ws + WS_P); bf16_t* POOL = (bf16_t*)(ws + WS_POOL);
    const bool tail = pt >= 512;
    const int R0 = tail ? MREAL + 16 * (pt - 512) : pt * 64;
    if (!tail) {
        switch (wave >> 1) {
            case 0: pool_pm_main<2>(Pb, POOL, R0, wave, lane); break;
            case 1: pool_pm_main<4>(Pb, POOL, R0, wave, lane); break;
            case 2: pool_pm_main<8>(Pb, POOL, R0, wave, lane); break;
            default: pool_pm_main<16>(Pb, POOL, R0, wave, lane); break;
        }
    } else
    for (int i = tid; i < 1024; i += 512) {
        const int rr = i >> 6, ch = i & 63, R = R0 + rr, g = ch >> 4, w = 2 << g, col = ch * 8;
        float s[8] = {0.f, 0.f, 0.f, 0.f, 0.f, 0.f, 0.f, 0.f}, cur[8] = {0.f, 0.f, 0.f, 0.f, 0.f, 0.f, 0.f, 0.f};
        float inv = 1.0f / (float)w;
        if (R < ROW_SAMP) {
            const int pos = R - ROW_META; const int cnt = w < pos + 1 ? w : pos + 1; inv = 1.0f / (float)cnt;
#pragma unroll
            for (int k = 0; k < 16; ++k) {
                const bool on = k < cnt;
                float t[8]; unpack8(t, *(const u32x4*)(Pb + (size_t)(on ? R - k : R) * PW + col));
#pragma unroll
                for (int e = 0; e < 8; ++e) { s[e] += on ? t[e] : 0.f; if (k == 0) cur[e] = t[e]; }
            }
        } else if (R < ROW_PAD) {
            const int q = R - ROW_SAMP, b = q >> 4, ii = q & 15;
#pragma unroll
            for (int k = 0; k < 16; ++k) {
                const bool on = k < w, frombuf = ii - k >= 0;
                float t[8]; unpack8(t, *(const u32x4*)(Pb + (size_t)(frombuf ? R - k : R) * PW + col));
                const float* sp = p.state_pool + ((size_t)b * 15 + (frombuf ? 0 : 15 + ii - k)) * PW + col; const f32x4 a = *(const f32x4*)sp, c2 = *(const f32x4*)(sp + 4);
                const float u[8] = {a[0], a[1], a[2], a[3], c2[0], c2[1], c2[2], c2[3]};
#pragma unroll
                for (int e = 0; e < 8; ++e) { const float x = frombuf ? t[e] : u[e]; s[e] += on ? x : 0.f; if (k == 0) cur[e] = t[e]; }
            }
        }
        u32x4 o; o.x = pk2(s[0] * inv - cur[0], s[1] * inv - cur[1]); o.y = pk2(s[2] * inv - cur[2], s[3] * inv - cur[3]);
        o.z = pk2(s[4] * inv - cur[4], s[5] * inv - cur[5]); o.w = pk2(s[6] * inv - cur[6], s[7] * inv - cur[7]);
        *(u32x4*)(POOL + (size_t)R * PW + col) = o;
    }
}
__device__ __forceinline__ int deinter(int d) { return 2 * (d & 31) + (d >> 5); }
__device__ __forceinline__ void small_outputs(const Params& p) {
    unsigned char* ws = p.ws;
    const bf16_t *Kb = (const bf16_t*)(ws + WS_K), *Vb = (const bf16_t*)(ws + WS_V), *Pb = (const bf16_t*)(ws + WS_P);
    float* out = p.out;
    const int gt = blockIdx.x * 512 + threadIdx.x, NT = gridDim.x * 512;
    for (int i = gt; i < 131072; i += NT) {
        const int d = i & 63, n = (i >> 6) & 1, w = (i >> 7) & 127, b = i >> 14; const size_t row = (size_t)b * SEQ + 3968 + w;
        out[O_PSK + i] = bf1(Kb[row * 128 + n * 64 + deinter(d)]); out[O_PSV + i] = bf1(Vb[row * 128 + n * 64 + d]);
    }
    for (int i = gt; i < 16384; i += NT) {
        const int d = i & 63, n = (i >> 6) & 1, t = (i >> 7) & 15, b = i >> 11;
        const size_t rm = (size_t)ROW_META + t, rs = (size_t)ROW_SAMP + b * 16 + t;
        out[O_KM + i] = bf1(Kb[rm * 128 + n * 64 + deinter(d)]); out[O_VM + i] = bf1(Vb[rm * 128 + n * 64 + d]);
        out[O_SSK + i] = bf1(Kb[rs * 128 + n * 64 + deinter(d)]); out[O_SSV + i] = bf1(Vb[rs * 128 + n * 64 + d]);
    }
    for (int i = gt; i < 61440; i += NT) {
        const int c = i & 511, r = (i >> 9) % 15, b = (i >> 9) / 15;
        out[O_PPOOL + i] = bf1(Pb[((size_t)b * SEQ + 4081 + r) * PW + c]);
        out[O_SPOOL + i] = bf1(Pb[((size_t)ROW_SAMP + b * 16 + 1 + r) * PW + c]);
    }
}


constexpr size_t WS_SSQT1 = 5 * MiB + 512 * 1024, WS_SSQT2 = 8 * MiB + 512 * 1024;
struct SkinnyOp { const bf16_t* A; const bf16_t* Bt; int K; };
__device__ __forceinline__ void skinny_accum(const SkinnyOp op, int n0, int wave, int lane, f32x4 (&acc)[9]) {
    const int fr = lane & 15, fq = lane >> 4;
    const bf16_t* bp = op.Bt + (size_t)(n0 + fr) * op.K + 8 * fq;
    const bf16_t* ap = op.A + (size_t)(ROW_META + fr) * op.K + 8 * fq;
    const int nks = op.K >> 5;
    for (int ks = wave; ks < nks; ks += 16) {
        const bool two = ks + 8 < nks;
        const int k0 = ks * 32, k1 = two ? (ks + 8) * 32 : k0;
        const bf16x8 b0 = *(const bf16x8*)(bp + k0), b1 = *(const bf16x8*)(bp + k1);
        bf16x8 a0[9], a1[9];
#pragma unroll
        for (int rb = 0; rb < 9; ++rb) { a0[rb] = *(const bf16x8*)(ap + (size_t)rb * 16 * op.K + k0); a1[rb] = *(const bf16x8*)(ap + (size_t)rb * 16 * op.K + k1); }
#pragma unroll
        for (int rb = 0; rb < 9; ++rb) acc[rb] = __builtin_amdgcn_mfma_f32_16x16x32_bf16(b0, a0[rb], acc[rb], 0, 0, 0);
        if (two) {
#pragma unroll
            for (int rb = 0; rb < 9; ++rb) acc[rb] = __builtin_amdgcn_mfma_f32_16x16x32_bf16(b1, a1[rb], acc[rb], 0, 0, 0);
        }
    }
}
__device__ __forceinline__ void skinny_reduce(LAS unsigned char* lds, const f32x4 (&acc)[9], int wave, int lane, f32x4& r0, f32x4& r8) {
    LAS f32x4* part = (LAS f32x4*)lds;
#pragma unroll
    for (int rb = 0; rb < 9; ++rb) part[(wave * 9 + rb) * 64 + lane] = acc[rb];
    __syncthreads();
    r0 = (f32x4){0.f, 0.f, 0.f, 0.f}; r8 = (f32x4){0.f, 0.f, 0.f, 0.f};
#pragma unroll
    for (int w = 0; w < 8; ++w) r0 += part[(w * 9 + wave) * 64 + lane];
    if (wave == 0) {
#pragma unroll
        for (int w = 0; w < 8; ++w) r8 += part[(w * 9 + 8) * 64 + lane];
    }
    __syncthreads();
}
#define ZERO9(a) _Pragma("unroll") for (int z_ = 0; z_ < 9; ++z_) a[z_] = (f32x4){0.f, 0.f, 0.f, 0.f}
__device__ __forceinline__ void tail_mix_unit(const Params& p, LAS unsigned char* lds, int unit, int wave, int lane) {
    unsigned char* ws = p.ws; const int n0 = unit * 16, fr = lane & 15, fq = lane >> 4;
    f32x4 acc[9], a0, a8, b0, b8;
    ZERO9(acc); skinny_accum(SkinnyOp{(const bf16_t*)(ws + WS_ATT), (const bf16_t*)(ws + WS_WAO), 1024}, n0, wave, lane, acc); skinny_reduce(lds, acc, wave, lane, a0, a8);
    ZERO9(acc); skinny_accum(SkinnyOp{(const bf16_t*)(ws + WS_POOL), (const bf16_t*)(ws + WS_WPO), 512}, n0, wave, lane, acc); skinny_reduce(lds, acc, wave, lane, b0, b8);
    const bf16_t *GA = (const bf16_t*)(ws + WS_GA), *GP = (const bf16_t*)(ws + WS_GP); bf16_t* MIX = (bf16_t*)(ws + WS_MIX);
#pragma unroll
    for (int t = 0; t < 2; ++t) {
        if (t == 1 && wave != 0) break;
        const int rb = t ? 8 : wave; const f32x4 va = t ? a8 : a0, vb = t ? b8 : b0;
        const size_t off = (size_t)(ROW_META + 16 * rb + fr) * 1024 + n0 + 4 * fq;
        const u32x2 ga = *(const u32x2*)(GA + off), gp = *(const u32x2*)(GP + off);
        u32x2 w; w.x = pk2(bf_lo(ga.x) * va[0] + bf_lo(gp.x) * vb[0], bf_hi(ga.x) * va[1] + bf_hi(gp.x) * vb[1]);
        w.y = pk2(bf_lo(ga.y) * va[2] + bf_lo(gp.y) * vb[2], bf_hi(ga.y) * va[3] + bf_hi(gp.y) * vb[3]);
        *(u32x2*)(MIX + off) = w;
    }
}
__device__ __forceinline__ void tail_x1_unit(const Params& p, LAS unsigned char* lds, int unit, int wave, int lane) {
    unsigned char* ws = p.ws; const int n0 = unit * 16, fr = lane & 15, fq = lane >> 4;
    f32x4 acc[9], a0, a8;
    ZERO9(acc); skinny_accum(SkinnyOp{(const bf16_t*)(ws + WS_MIX), (const bf16_t*)(ws + WS_WOUT), 1024}, n0, wave, lane, acc); skinny_reduce(lds, acc, wave, lane, a0, a8);
    bf16_t* XG = (bf16_t*)(ws + WS_XG); float* ssqt = (float*)(ws + WS_SSQT1);
#pragma unroll
    for (int t = 0; t < 2; ++t) {
        if (t == 1 && wave != 0) break;
        const int rb = t ? 8 : wave; const f32x4 va = t ? a8 : a0;
        const int lr = 16 * rb + fr, row = ROW_META + lr, col = n0 + 4 * fq;
        const f32x4 x = *(const f32x4*)(row_x(p.x_prompt, p.meta_tokens, p.x_sample, row) + col);
        const f32x4 v = va + x, g = *(const f32x4*)(p.g_norm_ffn + col);
        u32x2 w; w.x = pk2(v[0] * g[0], v[1] * g[1]); w.y = pk2(v[2] * g[2], v[3] * g[3]);
        *(u32x2*)(XG + (size_t)row * 1024 + col) = w;
        float ss = (v[0] * v[0] + v[1] * v[1]) + (v[2] * v[2] + v[3] * v[3]);
        ss += __shfl_xor(ss, 16); ss += __shfl_xor(ss, 32);
        if (fq == 0) ssqt[lr * 64 + unit] = ss;
    }
}
__device__ __forceinline__ float tail_row_sum64(const float* ssqt, int lr) {
    const f32x4* sp = (const f32x4*)(ssqt + lr * 64); float s = 0.f;
#pragma unroll
    for (int j = 0; j < 16; ++j) { const f32x4 a = sp[j]; s += (a[0] + a[1]) + (a[2] + a[3]); }
    return s;
}
__device__ __forceinline__ void tail_up_unit(const Params& p, LAS unsigned char* lds, int unit, int wave, int lane) {
    unsigned char* ws = p.ws; const int n0 = unit * 16, fr = lane & 15, fq = lane >> 4;
    f32x4 acc[9], a0, a8;
    ZERO9(acc); skinny_accum(SkinnyOp{(const bf16_t*)(ws + WS_XG), (const bf16_t*)(ws + WS_WUP), 1024}, n0, wave, lane, acc); skinny_reduce(lds, acc, wave, lane, a0, a8);
    float* UPT = (float*)(ws + WS_UPT); const float* ssqt = (const float*)(ws + WS_SSQT1);
    const int oc = ((n0 >> 7) & 1) * FF + 128 * (n0 >> 8) + (n0 & 127) + 4 * fq;
#pragma unroll
    for (int t = 0; t < 2; ++t) {
        if (t == 1 && wave != 0) break;
        const int rb = t ? 8 : wave; const f32x4 va = t ? a8 : a0;
        const int lr = 16 * rb + fr;
        const float r1 = rsqrtf(tail_row_sum64(ssqt, lr) * (1.0f / 1024.0f) + RMS_EPS);
        *(f32x4*)(UPT + (size_t)lr * FF2 + oc) = va * r1;
    }
}
__device__ __forceinline__ void tail_down_unit(const Params& p, LAS unsigned char* lds, int unit, int wave, int lane) {
    unsigned char* ws = p.ws; const int n0 = unit * 16, fr = lane & 15, fq = lane >> 4;
    f32x4 acc[9], a0, a8;
    ZERO9(acc); skinny_accum(SkinnyOp{(const bf16_t*)(ws + WS_ACT), (const bf16_t*)(ws + WS_WDOWN), FF}, n0, wave, lane, acc); skinny_reduce(lds, acc, wave, lane, a0, a8);
    const bf16_t* XG = (const bf16_t*)(ws + WS_XG); float* ssqt = (float*)(ws + WS_SSQT2);
    f32x4 vv[2];
#pragma unroll
    for (int t = 0; t < 2; ++t) {
        if (t == 1 && wave != 0) break;
        const int rb = t ? 8 : wave; const f32x4 va = t ? a8 : a0;
        const int lr = 16 * rb + fr, row = ROW_META + lr, col = n0 + 4 * fq;
        const u32x2 xg = *(const u32x2*)(XG + (size_t)row * 1024 + col); const f32x4 g = *(const f32x4*)(p.g_norm_ffn + col);
        f32x4 v;
        v[0] = va[0] + bf_lo(xg.x) * __builtin_amdgcn_rcpf(g[0]); v[1] = va[1] + bf_hi(xg.x) * __builtin_amdgcn_rcpf(g[1]);
        v[2] = va[2] + bf_lo(xg.y) * __builtin_amdgcn_rcpf(g[2]); v[3] = va[3] + bf_hi(xg.y) * __builtin_amdgcn_rcpf(g[3]);
        vv[t] = v;
        float ss = (v[0] * v[0] + v[1] * v[1]) + (v[2] * v[2] + v[3] * v[3]);
        ss += __shfl_xor(ss, 16); ss += __shfl_xor(ss, 32);
        if (fq == 0) AG_ST(ssqt + lr * 64 + unit, ss);
    }
#pragma unroll
    for (int t = 0; t < 2; ++t) {
        if (t == 1 && wave != 0) break;
        const int rb = t ? 8 : wave;
        const int lr = 16 * rb + fr, col = n0 + 4 * fq;
        float s = 0.f;
        for (int tries = 0; tries < (1 << 16); ++tries) {
            bool ready = true; s = 0.f;
#pragma unroll
            for (int j = 0; j < 16; ++j) { const float a = AG_LD(ssqt + lr * 64 + 16 * fq + j); ready = ready && (a >= 0.f); s += a; }
            if (__all(ready)) break;
            __builtin_amdgcn_s_sleep(8);
        }
        s += __shfl_xor(s, 16); s += __shfl_xor(s, 32);
        const float r = rsqrtf(s * (1.0f / 1024.0f) + RMS_EPS);
        if (lr >= 16) *(f32x4*)(p.out + O_YS + (size_t)(lr - 16) * D + col) = vv[t] * r * *(const f32x4*)(p.g_norm_final + col);
    }
}

__device__ __forceinline__ void skinny_accum3(const SkinnyOp op, int n0, int rb0, int wave, int lane, f32x4 (&acc)[3]) {
    const int fr = lane & 15, fq = lane >> 4;
    const bf16_t* bp = op.Bt + (size_t)(n0 + fr) * op.K + 8 * fq;
    const bf16_t* ap = op.A + (size_t)(ROW_META + 16 * rb0 + fr) * op.K + 8 * fq;
    const int nks = op.K >> 5;
    for (int ks0 = wave; ks0 < nks; ks0 += 32) {
        bf16x8 b[4], a[4][3];
#pragma unroll
        for (int j = 0; j < 4; ++j) {
            const int ks = ks0 + 8 * j; const int k = (ks < nks ? ks : ks0) * 32;
            b[j] = *(const bf16x8*)(bp + k);
#pragma unroll
            for (int rb = 0; rb < 3; ++rb) a[j][rb] = *(const bf16x8*)(ap + (size_t)rb * 16 * op.K + k);
        }
#pragma unroll
        for (int j = 0; j < 4; ++j) {
            if (ks0 + 8 * j < nks) {
#pragma unroll
                for (int rb = 0; rb < 3; ++rb) acc[rb] = __builtin_amdgcn_mfma_f32_16x16x32_bf16(b[j], a[j][rb], acc[rb], 0, 0, 0);
            }
        }
    }
}
__device__ __forceinline__ f32x4 skinny_reduce3(LAS unsigned char* lds, const f32x4 (&acc)[3], int wave, int lane) {
    LAS f32x4* part = (LAS f32x4*)lds;
#pragma unroll
    for (int rb = 0; rb < 3; ++rb) part[(wave * 3 + rb) * 64 + lane] = acc[rb];
    __syncthreads();
    f32x4 r = {0.f, 0.f, 0.f, 0.f};
    if (wave < 3) {
#pragma unroll
        for (int w = 0; w < 8; ++w) r += part[(w * 3 + wave) * 64 + lane];
    }
    __syncthreads();
    return r;
}
#define ZERO3(a) _Pragma("unroll") for (int z_ = 0; z_ < 3; ++z_) a[z_] = (f32x4){0.f, 0.f, 0.f, 0.f}
__device__ __forceinline__ void tail_mix_unit3(const Params& p, LAS unsigned char* lds, int unit, int wave, int lane) {
    unsigned char* ws = p.ws; const int n0 = (unit & 63) * 16, rb0 = 3 * (unit >> 6), fr = lane & 15, fq = lane >> 4;
    f32x4 acc[3];
    ZERO3(acc); skinny_accum3(SkinnyOp{(const bf16_t*)(ws + WS_ATT), (const bf16_t*)(ws + WS_WAO), 1024}, n0, rb0, wave, lane, acc); const f32x4 va = skinny_reduce3(lds, acc, wave, lane);
    ZERO3(acc); skinny_accum3(SkinnyOp{(const bf16_t*)(ws + WS_POOL), (const bf16_t*)(ws + WS_WPO), 512}, n0, rb0, wave, lane, acc); const f32x4 vb = skinny_reduce3(lds, acc, wave, lane);
    if (wave < 3) {
        const bf16_t *GA = (const bf16_t*)(ws + WS_GA), *GP = (const bf16_t*)(ws + WS_GP); bf16_t* MIX = (bf16_t*)(ws + WS_MIX);
        const size_t off = (size_t)(ROW_META + 16 * (rb0 + wave) + fr) * 1024 + n0 + 4 * fq;
        const u32x2 ga = *(const u32x2*)(GA + off), gp = *(const u32x2*)(GP + off);
        u32x2 w; w.x = pk2(bf_lo(ga.x) * va[0] + bf_lo(gp.x) * vb[0], bf_hi(ga.x) * va[1] + bf_hi(gp.x) * vb[1]);
        w.y = pk2(bf_lo(ga.y) * va[2] + bf_lo(gp.y) * vb[2], bf_hi(ga.y) * va[3] + bf_hi(gp.y) * vb[3]);
        *(u32x2*)(MIX + off) = w;
    }
}
__device__ __forceinline__ void tail_x1_unit3(const Params& p, LAS unsigned char* lds, int unit, int wave, int lane) {
    unsigned char* ws = p.ws; const int cu = unit & 63, n0 = cu * 16, rb0 = 3 * (unit >> 6), fr = lane & 15, fq = lane >> 4;
    f32x4 acc[3];
    ZERO3(acc); skinny_accum3(SkinnyOp{(const bf16_t*)(ws + WS_MIX), (const bf16_t*)(ws + WS_WOUT), 1024}, n0, rb0, wave, lane, acc); const f32x4 va = skinny_reduce3(lds, acc, wave, lane);
    if (wave < 3) {
        bf16_t* XG = (bf16_t*)(ws + WS_XG); float* ssqt = (float*)(ws + WS_SSQT1);
        const int lr = 16 * (rb0 + wave) + fr, row = ROW_META + lr, col = n0 + 4 * fq;
        const f32x4 x = *(const f32x4*)(row_x(p.x_prompt, p.meta_tokens, p.x_sample, row) + col);
        const f32x4 v = va + x, g = *(const f32x4*)(p.g_norm_ffn + col);
        u32x2 w; w.x = pk2(v[0] * g[0], v[1] * g[1]); w.y = pk2(v[2] * g[2], v[3] * g[3]);
        *(u32x2*)(XG + (size_t)row * 1024 + col) = w;
        float ss = (v[0] * v[0] + v[1] * v[1]) + (v[2] * v[2] + v[3] * v[3]);
        ss += __shfl_xor(ss, 16); ss += __shfl_xor(ss, 32);
        if (fq == 0) ssqt[lr * 64 + cu] = ss;
    }
}
__device__ __forceinline__ void tail_down_unit3(const Params& p, LAS unsigned char* lds, int unit, int wave, int lane) {
    unsigned char* ws = p.ws; const int cu = unit & 63, n0 = cu * 16, rb0 = 3 * (unit >> 6), fr = lane & 15, fq = lane >> 4;
    f32x4 acc[3];
    ZERO3(acc); skinny_accum3(SkinnyOp{(const bf16_t*)(ws + WS_ACT), (const bf16_t*)(ws + WS_WDOWN), FF}, n0, rb0, wave, lane, acc); const f32x4 va = skinny_reduce3(lds, acc, wave, lane);
    if (wave < 3) {
        const bf16_t* XG = (const bf16_t*)(ws + WS_XG); float* ssqt = (float*)(ws + WS_SSQT2);
        const int lr = 16 * (rb0 + wave) + fr, row = ROW_META + lr, col = n0 + 4 * fq;
        const u32x2 xg = *(const u32x2*)(XG + (size_t)row * 1024 + col); const f32x4 g = *(const f32x4*)(p.g_norm_ffn + col);
        f32x4 v;
        v[0] = va[0] + bf_lo(xg.x) * __builtin_amdgcn_rcpf(g[0]); v[1] = va[1] + bf_hi(xg.x) * __builtin_amdgcn_rcpf(g[1]);
        v[2] = va[2] + bf_lo(xg.y) * __builtin_amdgcn_rcpf(g[2]); v[3] = va[3] + bf_hi(xg.y) * __builtin_amdgcn_rcpf(g[3]);
        float ss = (v[0] * v[0] + v[1] * v[1]) + (v[2] * v[2] + v[3] * v[3]);
        ss += __shfl_xor(ss, 16); ss += __shfl_xor(ss, 32);
        if (fq == 0) AG_ST(ssqt + lr * 64 + cu, ss);
        float s = 0.f;
        for (int tries = 0; tries < (1 << 16); ++tries) {
            bool ready = true; s = 0.f;
#pragma unroll
            for (int j = 0; j < 16; ++j) { const float a = AG_LD(ssqt + lr * 64 + 16 * fq + j); ready = ready && (a >= 0.f); s += a; }
            if (__all(ready)) break;
            __builtin_amdgcn_s_sleep(2);
        }
        s += __shfl_xor(s, 16); s += __shfl_xor(s, 32);
        const float r = rsqrtf(s * (1.0f / 1024.0f) + RMS_EPS);
        if (lr >= 16) *(f32x4*)(p.out + O_YS + (size_t)(lr - 16) * D + col) = v * r * *(const f32x4*)(p.g_norm_final + col);
    }
}

__device__ __forceinline__ void conv_fix(const Params& p) {
    unsigned char* ws = p.ws;
    const float* HALO = (const float*)(ws + WS_HALO); const float* UPT = (const float*)(ws + WS_UPT); bf16_t* ACT = (bf16_t*)(ws + WS_ACT);
    const float *cw = p.conv_w, *cb = p.conv_b;
    const int gt = blockIdx.x * 512 + threadIdx.x, NT = gridDim.x * 512;
    constexpr int NCH = FF / 4;
    constexpr int N_SLAB = 256 * 2 * NCH, N_SAMP = 128 * NCH;
    for (int it = gt; it < N_SLAB + N_SAMP; it += NT) {
        const float *u0, *u1, *u2; int row, j;
        if (it < N_SLAB) {
            const int ch = it % NCH, sr = it / NCH, rr = sr & 1, s = sr >> 1; j = ch * 4;
            row = s * 128 + rr;
            const float* l1 = (s & 31) ? HALO + (size_t)((s - 1) * 4 + 3) * FF2 : UPT + (size_t)15 * FF2;
            const float* l0 = (s & 31) ? HALO + (size_t)((s - 1) * 4 + 2) * FF2 : UPT + (size_t)14 * FF2;
            u0 = HALO + (size_t)(s * 4 + rr) * FF2;
            if (rr == 0) { u1 = l1; u2 = l0; } else { u1 = HALO + (size_t)(s * 4) * FF2; u2 = l1; }
        } else {
            const int t = it - N_SLAB, ch = t % NCH, q = t / NCH, b = q >> 4, i = q & 15; j = ch * 4;
            row = ROW_SAMP + q;
            u0 = UPT + (size_t)(16 + q) * FF2;
            u1 = (i >= 1) ? UPT + (size_t)(16 + q - 1) * FF2 : p.state_conv + ((size_t)b * 2 + 1) * FF2;
            u2 = (i >= 2) ? UPT + (size_t)(16 + q - 2) * FF2 : p.state_conv + ((size_t)b * 2 + i) * FF2;
        }
        const f32x4 g0 = *(const f32x4*)(u0 + j), g1 = *(const f32x4*)(u1 + j), g2 = *(const f32x4*)(u2 + j);
        const f32x4 v0 = *(const f32x4*)(u0 + FF + j), v1 = *(const f32x4*)(u1 + FF + j), v2 = *(const f32x4*)(u2 + FF + j);
        const f32x4 cg = *(const f32x4*)(cb + j) + *(const f32x4*)(cw + j) * g2 + *(const f32x4*)(cw + FF2 + j) * g1 + *(const f32x4*)(cw + 2 * FF2 + j) * g0;
        const f32x4 cv = *(const f32x4*)(cb + FF + j) + *(const f32x4*)(cw + FF + j) * v2 + *(const f32x4*)(cw + FF2 + FF + j) * v1 + *(const f32x4*)(cw + 2 * FF2 + FF + j) * v0;
        float a[4];
#pragma unroll
        for (int i = 0; i < 4; ++i) a[i] = cg[i] * sigmoidf_(cg[i]) * cv[i];
        u32x2 w; w.x = pk2(a[0], a[1]); w.y = pk2(a[2], a[3]);
        *(u32x2*)(ACT + (size_t)row * FF + j) = w;
    }
    { f32x4* q4 = (f32x4*)(ws + WS_SSQ2); for (int i = gt; i < MREAL * 4; i += NT) q4[i] = (f32x4){-1.f, -1.f, -1.f, -1.f};
      f32x4* t4 = (f32x4*)(ws + WS_SSQT2); for (int i = gt; i < 144 * 16; i += NT) t4[i] = (f32x4){-1.f, -1.f, -1.f, -1.f};
      unsigned* pc = (unsigned*)(ws + WS_PCNT); for (int i = gt; i < 128; i += NT) pc[64 * i] = 0u; }
    for (int i = gt; i < 8 * 2 * FF2; i += NT) {
        const int c = i % FF2, k = (i / FF2) & 1, b = i / (2 * FF2);
        p.out[O_PCONV + i] = HALO[(size_t)((b * 32 + 31) * 4 + 2 + k) * FF2 + c];
        p.out[O_SCONV + i] = UPT[(size_t)(16 + b * 16 + 14 + k) * FF2 + c];
    }
}
__device__ __forceinline__ void final_norm(const Params& p, int wave, int lane) {
    const float* ssq = (const float*)(p.ws + WS_SSQ2);
    const int gw = blockIdx.x * 8 + wave, NGW = gridDim.x * 8;
    f32x4 gv[4];
#pragma unroll
    for (int j = 0; j < 4; ++j) gv[j] = ((const f32x4*)p.g_norm_final)[lane + 64 * j];
    for (int m0 = gw * 4; m0 < MREAL + 128; m0 += NGW * 4) {
        float sv[4]; f32x4 x[4][4]; float* orow[4];
#pragma unroll
        for (int q = 0; q < 4; ++q) {
            const int m = m0 + q;
            orow[q] = m < MREAL ? p.out + O_YP + (size_t)m * D : p.out + O_YS + (size_t)(m - MREAL) * D;
            if (m < MREAL) sv[q] = ssq[(size_t)m * 16 + (lane & 15)];
            else { const float* st = (const float*)(p.ws + WS_SSQT2) + (16 + m - MREAL) * 64; sv[q] = (st[lane & 15] + st[16 + (lane & 15)]) + (st[32 + (lane & 15)] + st[48 + (lane & 15)]); }
#pragma unroll
            for (int j = 0; j < 4; ++j) x[q][j] = ((const f32x4*)orow[q])[lane + 64 * j];
        }
#pragma unroll
        for (int q = 0; q < 4; ++q) {
            float s = sv[q];
            s += __shfl_xor(s, 1); s += __shfl_xor(s, 2); s += __shfl_xor(s, 4); s += __shfl_xor(s, 8);
            const float r = rsqrtf(s * (1.0f / D) + RMS_EPS);
#pragma unroll
            for (int j = 0; j < 4; ++j) ((f32x4*)orow[q])[lane + 64 * j] = x[q][j] * r * gv[j];
        }
    }
}


struct EpiNull {
    static constexpr bool PERM = true, AFTER_DRAIN = false, APERM = false;
    float* sink;
    __device__ __forceinline__ void operator()(const f32x4 (&acc)[2][2][4][2], const Unit& u, int wr, int wc, int fr, int fq) const {
        f32x4 t = {0.f, 0.f, 0.f, 0.f};
#pragma unroll
        for (int a = 0; a < 2; ++a)
#pragma unroll
            for (int b = 0; b < 2; ++b)
#pragma unroll
                for (int m = 0; m < 4; ++m)
#pragma unroll
                    for (int n = 0; n < 2; ++n) t += acc[a][b][m][n];
        if (t[0] + t[1] + t[2] + t[3] == 123456.789f) sink[threadIdx.x] = t[0];
    }
};
struct SamePanelOrder {
    int G, c, nr;
    __device__ bool next(int i, Unit& u) const { if (i >= nr) return false; u.pm = 0; u.pn = (c >> 6) & 3; return true; }
    __device__ __forceinline__ void a_ready(const Unit&) const {}
    __device__ __forceinline__ void done(const Unit&) const {}
};

typedef unsigned v4u_unused_t;
#define XB_TMO      128
#define XB_XCNT(j)  (256  + 64 * (j))
#define XB_XSUB(j)  (1280 + 64 * (j))
#define XB_XGEN(j)  (2304 + 64 * (j))
#define XB_TOP      3328
#define XB_TOPGEN   3392
#define XCD_BAR_WORDS 3456
#define XB_SPIN_CAP (1u << 18)

__device__ __forceinline__ unsigned xb_ld(unsigned* p)              { return __hip_atomic_load(p, __ATOMIC_RELAXED, __HIP_MEMORY_SCOPE_AGENT); }
__device__ __forceinline__ unsigned xb_add(unsigned* p, unsigned v) { return __hip_atomic_fetch_add(p, v, __ATOMIC_RELAXED, __HIP_MEMORY_SCOPE_AGENT); }
__device__ __forceinline__ unsigned xb_xcc_id() { return (unsigned)__builtin_amdgcn_s_getreg((3 << 11) | 20) & 0xFu; }
#define XB_SPIN(cond, bar) do { unsigned _sp = 0; while (cond) { __builtin_amdgcn_s_sleep(1); \
    if ((++_sp & 255u) == 0u) { if (xb_ld(&(bar)[XB_TMO])) break; if (_sp > XB_SPIN_CAP) { atomicAdd(&(bar)[XB_TMO], 1u); break; } } } } while (0)

struct XcdBarrier {
    unsigned* bar; unsigned x;
    volatile LAS unsigned* st;
};

__device__ __forceinline__ XcdBarrier xcd_barrier_post(unsigned* bar, volatile LAS unsigned* st) {
    XcdBarrier b; b.bar = bar; b.x = xb_xcc_id(); b.st = st;
    if (threadIdx.x == 0) (void)xb_add(&bar[XB_XCNT(b.x)], 1u);
    return b;
}
__device__ __forceinline__ void xcd_barrier_complete(unsigned* bar, unsigned x, unsigned& nloc, unsigned& nx) {
    const unsigned G = gridDim.x * gridDim.y * gridDim.z;
    unsigned sum, cnt, mine, sp = 0u;
    for (;;) {
        sum = 0u; cnt = 0u; mine = 0u;
#pragma unroll
        for (unsigned j = 0; j < 16; ++j) { const unsigned c = xb_ld(&bar[XB_XCNT(j)]); sum += c; cnt += (c > 0u) ? 1u : 0u; mine = (j == x) ? c : mine; }
        if (sum == G) break;
        __builtin_amdgcn_s_sleep(1);
        if ((++sp & 255u) == 0u) { if (xb_ld(&bar[XB_TMO])) break; if (sp > XB_SPIN_CAP) { atomicAdd(&bar[XB_TMO], 1u); break; } }
    }
    nloc = mine > 0u ? mine : 1u; nx = cnt > 0u ? cnt : 1u;
}

__device__ __forceinline__ void xcd_barrier(const XcdBarrier& b) {
    asm volatile("s_waitcnt vmcnt(0)" ::: "memory");
    __syncthreads();
    if (threadIdx.x == 0) {
        unsigned* bar = b.bar;
        __builtin_amdgcn_s_waitcnt(0);
        unsigned nloc = b.st[0], nx = b.st[1];
        if (nloc == 0u) { xcd_barrier_complete(bar, b.x, nloc, nx); b.st[0] = nloc; b.st[1] = nx; }
        const unsigned old = xb_add(&bar[XB_XSUB(b.x)], 1u);
        const unsigned gen = old / nloc;
        if (old + 1u == (gen + 1u) * nloc) {
            __builtin_amdgcn_fence(__ATOMIC_RELEASE, "agent");
            asm volatile("s_waitcnt vmcnt(0)" ::: "memory");
            const unsigned og = xb_add(&bar[XB_TOP], 1u);
            const unsigned tg = og / nx;
            if (og + 1u == (tg + 1u) * nx) xb_add(&bar[XB_TOPGEN], 1u);
            else XB_SPIN(xb_ld(&bar[XB_TOPGEN]) == tg, bar);
            __builtin_amdgcn_fence(__ATOMIC_ACQUIRE, "agent");
            xb_add(&bar[XB_XGEN(b.x)], 1u);
            asm volatile("s_waitcnt vmcnt(0)" ::: "memory");
        } else {
            XB_SPIN(xb_ld(&bar[XB_XGEN(b.x)]) == gen, bar);
            __builtin_amdgcn_fence(__ATOMIC_ACQUIRE, "agent");
            asm volatile("s_waitcnt vmcnt(0)" ::: "memory");
        }
    }
    __syncthreads();
}

__device__ __forceinline__ void grid_bar(unsigned* ctr, unsigned target) {
    asm volatile("s_waitcnt vmcnt(0) lgkmcnt(0)" ::: "memory");
    __syncthreads();
    if (threadIdx.x == 0) {
        __hip_atomic_fetch_add(ctr, 1u, __ATOMIC_RELEASE, __HIP_MEMORY_SCOPE_AGENT);
        unsigned spins = 0;
        while (__hip_atomic_load(ctr, __ATOMIC_RELAXED, __HIP_MEMORY_SCOPE_AGENT) < target) { __builtin_amdgcn_s_sleep(2); if (++spins > (1u << 24)) break; }
        __builtin_amdgcn_fence(__ATOMIC_ACQUIRE, "agent");
        asm volatile("s_waitcnt vmcnt(0)" ::: "memory");
    }
    __syncthreads();
}
__global__ void __launch_bounds__(512, 2) fwd_megakernel(Params p) {
    extern __shared__ __attribute__((aligned(16))) unsigned char lds_raw[];
    LAS unsigned char* lds = (LAS unsigned char*)lds_raw;
    cg::grid_group grid = cg::this_grid();
    const int wave = __builtin_amdgcn_readfirstlane(threadIdx.x >> 6);
#define TIDLANE() int tid = threadIdx.x; asm volatile("" : "+v"(tid)); const int lane = tid & 63
    unsigned char* ws = p.ws;
    const int lo = p.ph_lo, hi = p.ph_hi, G = gridDim.x;
#define IN(k) (lo <= (k) && (k) < hi)
#define SEAM(k) do { if (IN(k) && IN((k) + 1)) xcd_barrier(xbar); } while (0)
    if (lo < 0) grid.sync();
    volatile LAS unsigned* xst = (volatile LAS unsigned*)(lds + LDS_BYTES - 32);
    if (threadIdx.x < 2) xst[threadIdx.x] = 0u;
    __syncthreads();
    XcdBarrier xbar = xcd_barrier_post((unsigned*)(ws + 4096), xst);
    if (IN(0)) { TIDLANE(); (void)tid; p0_prologue(p, lds, wave, lane); __syncthreads(); }
    SEAM(0);
    if (IN(1)) {
        pg8::Gemm g{(const bf16_t*)(ws + WS_XN), (const bf16_t*)(ws + WS_WIN), M, INW, D}; pg8::StaticOrder S; S.init(M, INW, G, (int)blockIdx.x);
        EpiZ E{(bf16_t*)(ws + WS_Q), (bf16_t*)(ws + WS_K), (bf16_t*)(ws + WS_V), (bf16_t*)(ws + WS_P), (bf16_t*)(ws + WS_GA), (bf16_t*)(ws + WS_GP), p.b_gate, (const float*)(ws + WS_ROPE)};
        pg8::gemm_phase<EpiZ, pg8::StaticOrder, true, true>(lds, g, S, E);
    }
    SEAM(1);
    if (IN(2)) {
        TIDLANE();
        for (int unit = blockIdx.x; unit < 1024; unit += G) attn_chunk_unit(p, lds, unit, tid, wave, lane);
        constexpr int N_EXTRA = 27;
        if (G > 2 * N_EXTRA) {
            if ((int)blockIdx.x < N_EXTRA) { const int e = blockIdx.x; if (e < 18) attn_small_unit(p, lds, e, tid, wave, lane); else pool_unit(p, lds, 512 + e - 18, tid, wave, lane); }
            else for (int unit = blockIdx.x - N_EXTRA; unit < 512; unit += G - N_EXTRA) pool_unit(p, lds, unit, tid, wave, lane);
        } else {
            for (int unit = blockIdx.x; unit < 18 + 521; unit += G) { if (unit < 18) attn_small_unit(p, lds, unit, tid, wave, lane); else pool_unit(p, lds, unit - 18, tid, wave, lane); }
        }
        small_outputs(p);
    }
    SEAM(2);
    if (IN(3)) {
        { TIDLANE(); (void)tid; for (int unit = blockIdx.x; unit < 192; unit += G) tail_mix_unit3(p, lds, unit, wave, lane); }
        { pg8::Gemm g{(const bf16_t*)(ws + WS_ATT), (const bf16_t*)(ws + WS_WAO), MREAL, D, D}; pg8::StaticOrder S; S.init(MREAL, D, G, (int)blockIdx.x);
          EpiT1 E{(const bf16_t*)(ws + WS_GA), (bf16_t*)(ws + WS_MIX)};
          pg8::gemm_phase<EpiT1, pg8::StaticOrder, true, true>(lds, g, S, E); }
        __syncthreads();
        { pg8::Gemm g{(const bf16_t*)(ws + WS_POOL), (const bf16_t*)(ws + WS_WPO), MREAL, D, PW}; pg8::StaticOrder S; S.init(MREAL, D, G, (int)blockIdx.x);
          EpiMix E{(const bf16_t*)(ws + WS_GP), (bf16_t*)(ws + WS_MIX)};
          pg8::gemm_phase<EpiMix, pg8::StaticOrder, true, true>(lds, g, S, E); }
    }
    SEAM(3);
    if (IN(4)) {
        { TIDLANE(); (void)tid; for (int unit = blockIdx.x; unit < 192; unit += G) tail_x1_unit3(p, lds, unit, wave, lane); }
        pg8::Gemm g{(const bf16_t*)(ws + WS_MIX), (const bf16_t*)(ws + WS_WOUT), MREAL, D, D}; pg8::StaticOrder S; S.init(MREAL, D, G, (int)blockIdx.x);
        EpiX1 E{(const bf16_t*)(ws + WS_XN), (const float*)(ws + WS_R0I), p.g_norm_mix, p.g_norm_ffn, (bf16_t*)(ws + WS_XG), (float*)(ws + WS_SSQ1)};
        pg8::gemm_phase<EpiX1, pg8::StaticOrder, true, true>(lds, g, S, E);
    }
    SEAM(4);
    if (IN(5)) {
        { TIDLANE(); (void)tid; for (int unit = blockIdx.x; unit < FF2 / 16; unit += G) tail_up_unit(p, lds, unit, wave, lane); }
        pg8::Gemm g{(const bf16_t*)(ws + WS_XG), (const bf16_t*)(ws + WS_WUP), MREAL, FF2, D}; pg8::StaticOrder S; S.init(MREAL, FF2, G, (int)blockIdx.x);
        EpiUp E{(const float*)(ws + WS_SSQ1), p.conv_w, p.conv_b, (bf16_t*)(ws + WS_ACT), (float*)(ws + WS_HALO), (float*)(ws + WS_UPT)};
        pg8::gemm_phase<EpiUp, pg8::StaticOrder, true, true>(lds, g, S, E);
    }
    SEAM(5);
    if (IN(6)) conv_fix(p);
    SEAM(6);
    if (IN(7)) {
        { TIDLANE(); (void)tid; for (int unit = blockIdx.x; unit < 192; unit += G) tail_down_unit3(p, lds, unit, wave, lane); }
        pg8::Gemm g{(const bf16_t*)(ws + WS_ACT), (const bf16_t*)(ws + WS_WDOWN), MREAL, D, FF}; pg8::StaticOrder S; S.init(MREAL, D, G, (int)blockIdx.x, 1);
        EpiDown E{(const bf16_t*)(ws + WS_XG), p.g_norm_ffn, p.g_norm_final, p.out, (float*)(ws + WS_SSQ2)};
        pg8::gemm_phase<EpiDown, pg8::StaticOrder, true, true>(lds, g, S, E);
    }
    if (IN(8)) { TIDLANE(); for (int unit = blockIdx.x; unit < 1024; unit += G) attn_chunk_unit(p, lds, unit, tid, wave, lane); }
    if (IN(9)) { TIDLANE(); for (int unit = blockIdx.x; unit < 512; unit += G) pool_unit(p, lds, unit, tid, wave, lane); }
    if (IN(12)) { TIDLANE(); for (int unit = 512 + blockIdx.x; unit < 521; unit += G) pool_unit(p, lds, unit, tid, wave, lane); }
    if (IN(10)) { TIDLANE(); for (int unit = blockIdx.x; unit < 18; unit += G) attn_small_unit(p, lds, unit, tid, wave, lane); }
    if (IN(11)) { small_outputs(p); }
    if (IN(17)) { pg8::Gemm g{(const bf16_t*)(ws + WS_ACT), (const bf16_t*)(ws + WS_WDOWN), MREAL, D, FF}; pg8::StaticOrder S; S.init(MREAL, D, G, (int)blockIdx.x, 1);
        EpiDown E{(const bf16_t*)(ws + WS_XG), p.g_norm_ffn, p.g_norm_final, p.out, (float*)(ws + WS_SSQ2)};
        pg8::gemm_phase<EpiDown, pg8::StaticOrder, true, true>(lds, g, S, E); }
    if (IN(18)) { TIDLANE(); (void)tid; for (int unit = blockIdx.x; unit < 192; unit += G) tail_down_unit3(p, lds, unit, wave, lane); }
    if (IN(14)) { pg8::Gemm g{(const bf16_t*)(ws + WS_ACT), (const bf16_t*)(ws + WS_WDOWN), MREAL, D, FF}; pg8::StaticOrder S; S.init(MREAL, D, G, (int)blockIdx.x, 1); EpiNull E{(float*)(ws + WS_SSQ1)};
        pg8::gemm_phase<EpiNull, pg8::StaticOrder, true, true>(lds, g, S, E); }
    if (IN(15)) { pg8::Gemm g{(const bf16_t*)(ws + WS_ACT), (const bf16_t*)(ws + WS_WDOWN), MREAL, D, FF}; SamePanelOrder S{G, (int)blockIdx.x, 2}; EpiNull E{(float*)(ws + WS_SSQ1)};
        pg8::gemm_phase<EpiNull, SamePanelOrder, true, true>(lds, g, S, E); }
    if (IN(16)) { pg8::Gemm g{(const bf16_t*)(ws + WS_MIX), (const bf16_t*)(ws + WS_WOUT), MREAL, D, D}; pg8::StaticOrder S; S.init(MREAL, D, G, (int)blockIdx.x); EpiNull E{(float*)(ws + WS_SSQ1)};
        pg8::gemm_phase<EpiNull, pg8::StaticOrder, true, true>(lds, g, S, E); }
#undef IN
#undef SEAM
}

#ifndef MK_N_LAUNCHES
#define MK_N_LAUNCHES 1
#endif
#ifndef PROBE_PHASE
#define PROBE_PHASE -1
#endif
extern "C" void kernel_launch(void* const* d_in, const int* in_sizes, int n_in, void* d_out, int out_size, void* d_ws, size_t ws_size, hipStream_t stream) {
    static int grid = 0;
    if (grid == 0) {
        if (n_in != 24 || (size_t)out_size != O_END || ws_size < WS_END) { fprintf(stderr, "kernel_launch: unexpected shapes: n_in %d out %d ws %zu (need %zu)\n", n_in, out_size, ws_size, (size_t)WS_END); grid = -1; return; }
        int dev = 0, cus = 0, per_cu = 0;
        hipGetDevice(&dev); hipDeviceGetAttribute(&cus, hipDeviceAttributeMultiprocessorCount, dev);
        if (hipFuncSetAttribute((const void*)fwd_megakernel, hipFuncAttributeMaxDynamicSharedMemorySize, LDS_BYTES) != hipSuccess) { fprintf(stderr, "kernel_launch: hipFuncSetAttribute failed\n"); grid = -1; return; }
        if (hipOccupancyMaxActiveBlocksPerMultiprocessor(&per_cu, (const void*)fwd_megakernel, 512, LDS_BYTES) != hipSuccess || per_cu < 1) { fprintf(stderr, "kernel_launch: occupancy query gave %d\n", per_cu); per_cu = 1; }
        (void)hipGetLastError();
        grid = cus;
        fprintf(stderr, "kernel_launch: grid %d (per_cu %d)\n", grid, per_cu);
    }
    if (grid < 0) return;
    Params p{};
    const float** pp = (const float**)&p;
    for (int i = 0; i < 24; ++i) pp[i] = (const float*)d_in[i];
    p.out = (float*)d_out; p.ws = (unsigned char*)d_ws;
    for (int i = 0; i < 32; ++i) p.inv_freq[i] = powf(10000.0f, -(float)i / 32.0f);
    const int NPH = 8;
    int seq[8][2]; int nseq = 0;
    if (PROBE_PHASE >= NPH) { seq[0][0] = 0; seq[0][1] = NPH; seq[1][0] = PROBE_PHASE; seq[1][1] = PROBE_PHASE + 1; nseq = 2; }
    else if (PROBE_PHASE >= 0) { seq[0][0] = 0; seq[0][1] = PROBE_PHASE + 1; seq[1][0] = PROBE_PHASE; seq[1][1] = PROBE_PHASE + 1; nseq = 2; if (PROBE_PHASE + 1 < NPH) { seq[2][0] = PROBE_PHASE + 1; seq[2][1] = NPH; nseq = 3; } }
    else { seq[0][0] = 0; seq[0][1] = NPH; nseq = 1; }
    for (int k = 0; k < nseq; ++k) {
        if (hipMemsetAsync(d_ws, 0, 32768, stream) != hipSuccess) fprintf(stderr, "kernel_launch: memset failed\n");
        p.ph_lo = seq[k][0]; p.ph_hi = seq[k][1];
        void* args[] = {&p}; hipError_t e = hipLaunchCooperativeKernel((const void*)fwd_megakernel, dim3(grid), dim3(512), args, LDS_BYTES, stream);
        if (e != hipSuccess) fprintf(stderr, "kernel_launch: cooperative launch %d failed: %s\n", k, hipGetErrorString(e));
    }
}
```
